# Optimizing an MI355X kernel written in HIP

```python
import jax, jax.numpy as jnp
from jax import lax
import numpy as np

D_MODEL = 1024
BATCH = 8
SEQ = 8192
DEPTH = 1

CHUNK = 64
PLE_DIM = 256
MIX_WIDTH = D_MODEL
LRU_WIDTH = MIX_WIDTH // 2
LRU_BLOCKS = 8
LRU_BLOCK_W = LRU_WIDTH // LRU_BLOCKS
LRU_C = 8.0
CONV_W = 4
ATTN_WIDTH = MIX_WIDTH - LRU_WIDTH
HEAD_DIM = 64
N_HEADS = ATTN_WIDTH // HEAD_DIM
LEFT_CHUNKS = 8
BAND = (LEFT_CHUNKS + 1) * CHUNK
MAX_REL = 256
D_FF = 4 * D_MODEL
EPS = 1e-6
NEG_INF = -1e30
IN_WIDTH = 2 * LRU_WIDTH + 3 * ATTN_WIDTH

kernel_name = "hymba_rglru_chunk_attn_block"


def rms_norm(x, g):
    xf = x.astype(jnp.float32)
    y = xf * lax.rsqrt(jnp.mean(xf * xf, axis=-1, keepdims=True) + EPS)
    return (y * g.astype(jnp.float32)).astype(x.dtype)


def causal_depthwise_conv(x, w, b):
    s_len = x.shape[1]
    xp = jnp.pad(x, ((0, 0), (CONV_W - 1, 0), (0, 0)))
    y = xp[:, 0:s_len] * w[0]
    for tap in range(1, CONV_W):
        y = y + xp[:, tap:tap + s_len] * w[tap]
    return y + b


def block_diag_linear(x, w, b):
    bsz, s_len, _ = x.shape
    xb = x.reshape(bsz, s_len, LRU_BLOCKS, LRU_BLOCK_W)
    y = jnp.einsum("bsnc,ncd->bsnd", xb, w)
    return y.reshape(bsz, s_len, LRU_WIDTH) + b


def rg_lru(x, w_r, b_r, w_i, b_i, lam):
    xf = x.astype(jnp.float32)
    r = jax.nn.sigmoid(block_diag_linear(xf, w_r.astype(jnp.float32), b_r.astype(jnp.float32)))
    i = jax.nn.sigmoid(block_diag_linear(xf, w_i.astype(jnp.float32), b_i.astype(jnp.float32)))
    log_a = -LRU_C * r * jax.nn.softplus(-lam.astype(jnp.float32))
    a = jnp.exp(log_a)
    mult = jnp.sqrt(jnp.maximum(-jnp.expm1(2.0 * log_a), 0.0))
    u = mult * (i * xf)

    def combine(left, right):
        a1, b1 = left
        a2, b2 = right
        return a1 * a2, a2 * b1 + b2

    _, h = lax.associative_scan(combine, (a, u), axis=1)
    return h.astype(x.dtype)


def chunk_band_attention(q, k, v, bias, key_valid):
    s_len = q.shape[0]
    n_chunks = s_len // CHUNK
    qc = q.reshape(n_chunks, CHUNK, N_HEADS, HEAD_DIM)
    pad = ((LEFT_CHUNKS, 0), (0, 0), (0, 0), (0, 0))
    kp = jnp.pad(k.reshape(n_chunks, CHUNK, N_HEADS, HEAD_DIM), pad)
    vp = jnp.pad(v.reshape(n_chunks, CHUNK, N_HEADS, HEAD_DIM), pad)
    band_idx = jnp.arange(n_chunks)[:, None] + jnp.arange(LEFT_CHUNKS + 1)[None, :]
    kb = kp[band_idx].reshape(n_chunks, BAND, N_HEADS, HEAD_DIM)
    vb = vp[band_idx].reshape(n_chunks, BAND, N_HEADS, HEAD_DIM)
    scores = jnp.einsum("nqhd,nkhd->nhqk", qc, kb).astype(jnp.float32) * (HEAD_DIM ** -0.5)
    scores = scores + bias[None]
    scores = jnp.where(key_valid[:, None, None, :], scores, NEG_INF)
    probs = jax.nn.softmax(scores, axis=-1).astype(v.dtype)
    out = jnp.einsum("nhqk,nkhd->nqhd", probs, vb)
    return out.reshape(s_len, N_HEADS, HEAD_DIM)


def setup_inputs(seed: int = 0) -> dict:
    key = jax.random.key(seed)
    ks = jax.random.split(key, 24)
    f32 = jnp.float32

    def nrm(k, shape, scale):
        return jax.random.normal(k, shape, f32) * scale

    def gain(k, shape):
        return 1.0 + 0.02 * jax.random.normal(k, shape, f32)

    a0 = jax.random.uniform(ks[9], (DEPTH, LRU_WIDTH), f32, minval=0.9, maxval=0.999)
    s0 = a0 ** (1.0 / LRU_C)
    lru_lambda = jnp.log(s0) - jnp.log1p(-s0)
    return {
        "x": jax.random.normal(ks[0], (BATCH, SEQ, D_MODEL), f32),
        "p": jax.random.normal(ks[1], (DEPTH, BATCH, SEQ, PLE_DIM), f32),
        "norm_mix_g": gain(ks[2], (DEPTH, D_MODEL)),
        "w_in": nrm(ks[3], (DEPTH, D_MODEL, IN_WIDTH), D_MODEL ** -0.5),
        "conv_w": nrm(ks[4], (DEPTH, CONV_W, LRU_WIDTH), CONV_W ** -0.5),
        "conv_b": nrm(ks[5], (DEPTH, LRU_WIDTH), 0.02),
        "w_rg": nrm(ks[6], (DEPTH, LRU_BLOCKS, LRU_BLOCK_W, LRU_BLOCK_W), LRU_BLOCK_W ** -0.5),
        "b_rg": nrm(ks[7], (DEPTH, LRU_WIDTH), 0.02),
        "w_ig": nrm(ks[8], (DEPTH, LRU_BLOCKS, LRU_BLOCK_W, LRU_BLOCK_W), LRU_BLOCK_W ** -0.5),
        "b_ig": nrm(ks[10], (DEPTH, LRU_WIDTH), 0.02),
        "lru_lambda": lru_lambda,
        "q_norm_g": gain(ks[11], (DEPTH, HEAD_DIM)),
        "k_norm_g": gain(ks[12], (DEPTH, HEAD_DIM)),
        "rel_bias": nrm(ks[13], (DEPTH, N_HEADS, 2 * MAX_REL + 1), 0.1),
        "out_norm_lru_g": gain(ks[14], (DEPTH, LRU_WIDTH)),
        "out_norm_attn_g": gain(ks[15], (DEPTH, ATTN_WIDTH)),
        "w_out": nrm(ks[16], (DEPTH, MIX_WIDTH, D_MODEL), MIX_WIDTH ** -0.5),
        "norm_mlp_g": gain(ks[17], (DEPTH, D_MODEL)),
        "w_up": nrm(ks[18], (DEPTH, D_MODEL, D_FF), D_MODEL ** -0.5),
        "w_down": nrm(ks[19], (DEPTH, D_FF, D_MODEL), D_FF ** -0.5),
        "norm_ple_g": gain(ks[20], (DEPTH, D_MODEL)),
        "w_ple_gate": nrm(ks[21], (DEPTH, D_MODEL, D_MODEL), D_MODEL ** -0.5),
        "w_ple_proj": nrm(ks[22], (DEPTH, PLE_DIM, D_MODEL), PLE_DIM ** -0.5),
    }


def reference(x, p, norm_mix_g, w_in, conv_w, conv_b, w_rg, b_rg, w_ig, b_ig,
              lru_lambda, q_norm_g, k_norm_g, rel_bias, out_norm_lru_g,
              out_norm_attn_g, w_out, norm_mlp_g, w_up, w_down, norm_ple_g,
              w_ple_gate, w_ple_proj):
    bsz, s_len, _ = x.shape
    n_chunks = s_len // CHUNK

    q_in_chunk = jnp.arange(CHUNK)[:, None]
    k_in_band = jnp.arange(BAND)[None, :]
    rel = q_in_chunk + LEFT_CHUNKS * CHUNK - k_in_band
    rel_idx = jnp.clip(rel, -MAX_REL, MAX_REL) + MAX_REL
    key_chunk = jnp.arange(n_chunks)[:, None] - LEFT_CHUNKS + (jnp.arange(BAND) // CHUNK)[None, :]
    key_valid = key_chunk >= 0

    splits = [LRU_WIDTH, 2 * LRU_WIDTH, 2 * LRU_WIDTH + ATTN_WIDTH,
              2 * LRU_WIDTH + 2 * ATTN_WIDTH]

    h = x
    for i in range(DEPTH):
        u = rms_norm(h, norm_mix_g[i])
        proj = u @ w_in[i]
        x_lru, g_lru, q, k, v = jnp.split(proj, splits, axis=-1)

        x_lru = causal_depthwise_conv(x_lru, conv_w[i], conv_b[i])
        y_lru = rg_lru(x_lru, w_rg[i], b_rg[i], w_ig[i], b_ig[i], lru_lambda[i])
        y_lru = y_lru * jax.nn.gelu(g_lru)

        q = rms_norm(q.reshape(bsz, s_len, N_HEADS, HEAD_DIM), q_norm_g[i])
        k = rms_norm(k.reshape(bsz, s_len, N_HEADS, HEAD_DIM), k_norm_g[i])
        v = v.reshape(bsz, s_len, N_HEADS, HEAD_DIM)
        bias = rel_bias[i][:, rel_idx].astype(jnp.float32)
        y_attn = lax.map(lambda qkv: chunk_band_attention(qkv[0], qkv[1], qkv[2], bias, key_valid),
                         (q, k, v))
        y_attn = y_attn.reshape(bsz, s_len, ATTN_WIDTH)

        merged = jnp.concatenate([rms_norm(y_lru, out_norm_lru_g[i]),
                                  rms_norm(y_attn, out_norm_attn_g[i])], axis=-1)
        h = h + merged @ w_out[i]

        u = rms_norm(h, norm_mlp_g[i])
        h = h + jnp.square(jax.nn.relu(u @ w_up[i])) @ w_down[i]

        gate = jax.nn.sigmoid(rms_norm(h, norm_ple_g[i]) @ w_ple_gate[i])
        h = h + gate * (p[i] @ w_ple_proj[i])
    return h
```

```cpp
#include <hip/hip_runtime.h>
#include <hip/hip_cooperative_groups.h>
#include <cstdio>
#include <cstdint>
namespace cg = cooperative_groups;
__device__ __forceinline__ int lane_id_v() { int l; asm volatile("v_mbcnt_lo_u32_b32 %0, -1, 0\n\tv_mbcnt_hi_u32_b32 %0, -1, %0" : "=v"(l)); return l; }
namespace pg8 {
#define PG8_LAS __attribute__((address_space(3)))
typedef unsigned short bf16_t;
typedef short bf16x8 __attribute__((ext_vector_type(8)));
typedef float f32x4 __attribute__((ext_vector_type(4)));
typedef unsigned u32x4 __attribute__((ext_vector_type(4)));
constexpr int BM = 256, BK = 64, HALF = 128, HTB = HALF * BK * 2  , STAGE_BYTES = 8 * HTB, NXCD = 8, WGM = 8;

__host__ __device__ __forceinline__ int lds_byte(int r, int c) { const int st = (r >> 4) * 2 + (c >> 5), rr = r & 15, cc = c & 31, ob = rr * 64 + cc * 2; return st * 1024 + (ob ^ (((ob >> 9) & 1) << 5)); }
__host__ __device__ __forceinline__ void stage_rc(int b, int& R, int& C) { const int st = b / 1024, sb = b % 1024, swz = sb ^ (((sb >> 9) & 1) << 5); R = (st >> 1) * 16 + swz / 64; C = (st & 1) * 32 + (swz % 64) / 2; }
__host__ __device__ __forceinline__ int perm32(int rho) { const int n = rho >> 4, i = rho & 15; return 8 * (i >> 2) + 4 * n + (i & 3); }

struct Unit { int pm, pn; };
struct Gemm { const bf16_t* A; const bf16_t* Bt; int M, N, K; };

struct StaticOrder {
    int nM, nN, nwg, G, c, rev;
    __host__ __device__ void init(int M, int N, int G_, int c_, int rev_ = 0) { nM = M / BM; nN = N / BM; nwg = nM * nN; G = G_; c = c_; rev = rev_; }
    __host__ __device__ bool next(int i, Unit& u) const {
        const int cnt = (nwg - c + G - 1) / G; if (i < 0 || i >= cnt) return false;
        const long L = (long)(rev ? cnt - 1 - i : i) * G + c;
        int wgid = (int)L; { const int q = nwg / NXCD, r = nwg % NXCD, xcd = wgid % NXCD, off = wgid / NXCD; wgid = (xcd < r ? xcd * (q + 1) : r * (q + 1) + (xcd - r) * q) + off; }
        const int nig = WGM * nN, gid = wgid / nig, fm = gid * WGM, gsz = (nM - fm) < WGM ? (nM - fm) : WGM;
        u.pm = fm + ((wgid % nig) % gsz); u.pn = (wgid % nig) / gsz; return true;
    }
    __device__ __forceinline__ void a_ready(const Unit&) const {}
    __device__ __forceinline__ void done(const Unit&) const {}
};

__device__ __forceinline__ unsigned cvt_pk_bf16(float lo, float hi) { unsigned r; asm volatile("v_cvt_pk_bf16_f32 %0, %1, %2" : "=v"(r) : "v"(lo), "v"(hi)); return r; }
typedef float f32x2 __attribute__((ext_vector_type(2)));
template <class Epi, class Sched, bool ALIGN_EPI = false, bool SP2 = false, bool EPI2 = false>
__device__ __forceinline__ void gemm_phase(PG8_LAS unsigned char* lds, const Gemm g, const Sched& S, const Epi& E, const int wave_u) {
    int tid_ = wave_u * 64 + lane_id_v(); asm volatile("" : "+v"(tid_));
    const int tid = tid_, wid = __builtin_amdgcn_readfirstlane(tid >> 6), lane = tid & 63, wr = wid >> 2, wc = wid & 3, fr = lane & 15, fq = lane >> 4;
    const int K = g.K, nt = K / BK;
    unsigned voffA[2], voffB[2];
#pragma unroll
    for (int i = 0; i < 2; ++i) { int R, C; stage_rc(tid * 16 + i * 8192, R, C); const int Rp = Epi::PERM ? perm32(R & 31) : (R & 31); const int Rb = Epi::HEADMAP ? (64 * (R >> 5) + Rp) : ((R & ~31) + Rp);
        voffA[i] = (unsigned)(R * K + C) * 2u; voffB[i] = (unsigned)(Rb * K + C) * 2u; }
    const size_t kstep = (size_t)(BK * 2);
    const size_t hstep = (size_t)HALF * K * 2;
    const size_t hstepB = Epi::HEADMAP ? (size_t)32 * K * 2 : hstep;
    const size_t tstep = 2 * hstep;
    const unsigned ldsw = (unsigned)wid * 1024u;
    const int aoff = lds_byte(wr * 64 + fr, fq * 8), boff = lds_byte(wc * 32 + fr, fq * 8);
#define PG8_SA(b, h) (((b) * 2 + (h)) * HTB)
#define PG8_SB(b, h) ((4 + (b) * 2 + (h)) * HTB)
#define PG8_STAGE(bufoff, gbase, voff) do { _Pragma("unroll") for (int _i = 0; _i < 2; ++_i) \
        __builtin_amdgcn_global_load_lds((const unsigned*)((const char*)(gbase) + (voff)[_i]), (PG8_LAS unsigned*)(lds + (bufoff) + ldsw + _i * 8192), 16, 0, 0); } while (0)
#define PG8_LDA(dst, b, h) do { _Pragma("unroll") for (int m = 0; m < 4; ++m) _Pragma("unroll") for (int k = 0; k < 2; ++k) dst[m][k] = *(const PG8_LAS bf16x8*)(lds + PG8_SA(b, h) + aoff + m * 2048 + k * 1024); } while (0)
#define PG8_LDB(dst, b, h) do { _Pragma("unroll") for (int n = 0; n < 2; ++n) _Pragma("unroll") for (int k = 0; k < 2; ++k) dst[n][k] = *(const PG8_LAS bf16x8*)(lds + PG8_SB(b, h) + boff + n * 2048 + k * 1024); } while (0)
#define PG8_MMA(ai, bj, At, Bt) do { __builtin_amdgcn_s_setprio(1); _Pragma("unroll") for (int m = 0; m < 4; ++m) _Pragma("unroll") for (int n = 0; n < 2; ++n) _Pragma("unroll") for (int k = 0; k < 2; ++k) \
        acc[ai][bj][m][n] = __builtin_amdgcn_mfma_f32_16x16x32_bf16(Bt[n][k], At[m][k], acc[ai][bj][m][n], 0, 0, 0); __builtin_amdgcn_s_setprio(0); } while (0)
#define PG8_WAIT_V(n) asm volatile("s_waitcnt vmcnt(" #n ")" ::: "memory")
#define PG8_WAIT_L(n) asm volatile("s_waitcnt lgkmcnt(" #n ")" ::: "memory")
#define PG8_BAR __builtin_amdgcn_s_barrier()
#define PG8_SCHED __builtin_amdgcn_sched_barrier(0)
    Unit cur, nxt; int ui = 0;
    if (!S.next(0, cur)) return;
    f32x4 acc[2][2][4][2];
#pragma unroll
    for (int a = 0; a < 2; ++a)
#pragma unroll
        for (int b = 0; b < 2; ++b)
#pragma unroll
            for (int m = 0; m < 4; ++m)
#pragma unroll
                for (int n = 0; n < 2; ++n) acc[a][b][m][n] = (f32x4){0.f, 0.f, 0.f, 0.f};
    bf16x8 At[4][2], B0[2][2], B1[2][2];
    const char* cA = (const char*)g.A + (size_t)cur.pm * tstep; const char* cB = (const char*)g.Bt + (size_t)cur.pn * tstep;
    S.a_ready(cur);
    if constexpr (SP2) {
        PG8_STAGE(PG8_SB(0, 0), cB, voffB); PG8_STAGE(PG8_SB(0, 1), cB + hstepB, voffB); PG8_STAGE(PG8_SA(0, 0), cA, voffA); PG8_STAGE(PG8_SA(0, 1), cA + hstep, voffA);
        if (wr == 1) PG8_BAR;
        PG8_WAIT_V(2); PG8_BAR;
        PG8_STAGE(PG8_SB(1, 0), cB + kstep, voffB); PG8_STAGE(PG8_SA(1, 0), cA + kstep, voffA); PG8_STAGE(PG8_SB(1, 1), cB + hstepB + kstep, voffB);
        PG8_WAIT_V(6); PG8_BAR;
    } else {
        PG8_STAGE(PG8_SB(0, 0), cB, voffB); PG8_STAGE(PG8_SA(0, 0), cA, voffA); PG8_STAGE(PG8_SB(0, 1), cB + hstepB, voffB); PG8_STAGE(PG8_SA(0, 1), cA + hstep, voffA);
        if (wr == 1) PG8_BAR;
        PG8_WAIT_V(4); PG8_BAR;
        PG8_STAGE(PG8_SB(1, 0), cB + kstep, voffB); PG8_STAGE(PG8_SA(1, 0), cA + kstep, voffA); PG8_STAGE(PG8_SB(1, 1), cB + hstepB + kstep, voffB);
        PG8_WAIT_V(6); PG8_BAR;
    }
    for (;;) {
        const bool has_next = S.next(ui + 1, nxt);
        const char* nA = has_next ? (const char*)g.A + (size_t)nxt.pm * tstep : cA; const char* nB = has_next ? (const char*)g.Bt + (size_t)nxt.pn * tstep : cB;
#pragma nounroll
        for (int t = 0; t < nt; t += 2) {
            const bool last = (t == nt - 2);
            const char* a1 = cA + (size_t)(t + 1) * kstep;
            const char* a2 = last ? nA : cA + (size_t)(t + 2) * kstep; const char* b2 = last ? nB : cB + (size_t)(t + 2) * kstep;
            const char* a3 = a2 + kstep; const char* b3 = b2 + kstep;
            if (last && has_next) S.a_ready(nxt);
            if constexpr (SP2) {
            PG8_LDB(B0, 0, 0); PG8_LDB(B1, 0, 1); PG8_SCHED; PG8_LDA(At, 0, 0); PG8_STAGE(PG8_SA(1, 1), a1 + hstep, voffA);
            PG8_WAIT_V(8); PG8_WAIT_L(0); PG8_BAR; PG8_MMA(0, 0, At, B0); PG8_MMA(0, 1, At, B1); PG8_BAR; PG8_SCHED;
            PG8_LDA(At, 0, 1); PG8_STAGE(PG8_SB(0, 0), b2, voffB); PG8_STAGE(PG8_SB(0, 1), b2 + hstepB, voffB); PG8_STAGE(PG8_SA(0, 0), a2, voffA);
            PG8_WAIT_V(8); PG8_WAIT_L(0); PG8_BAR; PG8_MMA(1, 0, At, B0); PG8_MMA(1, 1, At, B1); PG8_BAR; PG8_SCHED;
            PG8_LDB(B0, 1, 0); PG8_LDB(B1, 1, 1); PG8_SCHED; PG8_LDA(At, 1, 0); PG8_STAGE(PG8_SA(0, 1), a2 + hstep, voffA);
            PG8_WAIT_V(8); PG8_WAIT_L(0); PG8_BAR; PG8_MMA(0, 0, At, B0); PG8_MMA(0, 1, At, B1); PG8_BAR; PG8_SCHED;
            PG8_LDA(At, 1, 1); PG8_STAGE(PG8_SB(1, 0), b3, voffB); PG8_STAGE(PG8_SB(1, 1), b3 + hstepB, voffB); PG8_STAGE(PG8_SA(1, 0), a3, voffA);
            PG8_WAIT_V(8); PG8_WAIT_L(0); PG8_BAR; PG8_MMA(1, 0, At, B0); PG8_MMA(1, 1, At, B1); PG8_BAR; PG8_SCHED;
            } else {
            PG8_LDB(B0, 0, 0); PG8_SCHED; PG8_LDA(At, 0, 0); PG8_STAGE(PG8_SA(1, 1), a1 + hstep, voffA);
            PG8_WAIT_L(8); PG8_BAR; PG8_WAIT_L(0); PG8_MMA(0, 0, At, B0); PG8_BAR; PG8_SCHED;
            PG8_LDB(B1, 0, 1); PG8_STAGE(PG8_SB(0, 0), b2, voffB);
            PG8_BAR; PG8_WAIT_L(0); PG8_MMA(0, 1, At, B1); PG8_BAR;
            PG8_LDA(At, 0, 1); PG8_STAGE(PG8_SA(0, 0), a2, voffA);
            PG8_BAR; PG8_WAIT_L(0); PG8_MMA(1, 0, At, B0); PG8_BAR; PG8_SCHED;
            PG8_STAGE(PG8_SB(0, 1), b2 + hstepB, voffB);
            PG8_WAIT_V(6); PG8_BAR; PG8_MMA(1, 1, At, B1); PG8_BAR;
            PG8_LDB(B0, 1, 0); PG8_SCHED; PG8_LDA(At, 1, 0); PG8_STAGE(PG8_SA(0, 1), a2 + hstep, voffA);
            PG8_WAIT_L(8); PG8_BAR; PG8_WAIT_L(0); PG8_MMA(0, 0, At, B0); PG8_BAR; PG8_SCHED;
            PG8_LDB(B1, 1, 1); PG8_STAGE(PG8_SB(1, 0), b3, voffB);
            PG8_BAR; PG8_WAIT_L(0); PG8_MMA(0, 1, At, B1); PG8_BAR;
            PG8_LDA(At, 1, 1); PG8_STAGE(PG8_SA(1, 0), a3, voffA);
            PG8_BAR; PG8_WAIT_L(0); PG8_MMA(1, 0, At, B0); PG8_BAR; PG8_SCHED;
            PG8_STAGE(PG8_SB(1, 1), b3 + hstepB, voffB);
            PG8_WAIT_V(6); PG8_BAR; PG8_MMA(1, 1, At, B1); PG8_BAR;
            }
        }
        if constexpr (ALIGN_EPI) { if (wr == 0) PG8_BAR; }
        if constexpr (!Epi::AFTER_DRAIN) { E(acc, cur, wr, wc, fr, fq); if constexpr (EPI2) { asm volatile("" ::: "memory"); E(acc, cur, wr, wc, fr, fq); } S.done(cur); }
        if (!has_next) break;
#pragma unroll
        for (int a = 0; a < 2; ++a)
#pragma unroll
            for (int b = 0; b < 2; ++b)
#pragma unroll
                for (int m = 0; m < 4; ++m)
#pragma unroll
                    for (int n = 0; n < 2; ++n) acc[a][b][m][n] = (f32x4){0.f, 0.f, 0.f, 0.f};
        cur = nxt; cA = nA; cB = nB; ++ui;
        if constexpr (ALIGN_EPI) { if (wr == 1) PG8_BAR; }
    }
    PG8_WAIT_V(0);
    if constexpr (!ALIGN_EPI) { if (wr == 0) PG8_BAR; }
    PG8_BAR;
    if constexpr (Epi::AFTER_DRAIN) { E.fused(acc, cur, wr, wc, fr, fq, lds, wid, lane); S.done(cur); }
#undef PG8_SA
#undef PG8_SB
#undef PG8_STAGE
#undef PG8_LDA
#undef PG8_LDB
#undef PG8_MMA
#undef PG8_WAIT_V
#undef PG8_WAIT_L
#undef PG8_BAR
#undef PG8_SCHED
}

template <class EpiMid, class EpiFin, class Sched>
__device__ __forceinline__ void gemm_phase_ple(PG8_LAS unsigned char* lds, const bf16_t* AP, const bf16_t* BP, const bf16_t* AZ, const bf16_t* BZ, const Sched& S, const EpiMid& EM, const EpiFin& E, const int wave_u) {
    constexpr bool ALIGN_EPI = true;
    int tid_ = wave_u * 64 + lane_id_v(); asm volatile("" : "+v"(tid_));
    const int tid = tid_, wid = __builtin_amdgcn_readfirstlane(tid >> 6), lane = tid & 63, wr = wid >> 2, wc = wid & 3, fr = lane & 15, fq = lane >> 4;
    constexpr int KP = 256, KZ = 1024, NT = 20;
    unsigned vAP[2], vBP[2], vAZ[2], vBZ[2];
#pragma unroll
    for (int i = 0; i < 2; ++i) { int R, C; stage_rc(tid * 16 + i * 8192, R, C); const int Rb = (R & ~31) + perm32(R & 31);
        vAP[i] = (unsigned)(R * KP + C) * 2u; vBP[i] = (unsigned)(Rb * KP + C) * 2u; vAZ[i] = (unsigned)(R * KZ + C) * 2u; vBZ[i] = (unsigned)(Rb * KZ + C) * 2u; }
    const size_t kstep = (size_t)(BK * 2);
    const size_t hsP = (size_t)HALF * KP * 2, hsZ = (size_t)HALF * KZ * 2, tsP = 2 * hsP, tsZ = 2 * hsZ;
    const unsigned ldsw = (unsigned)wid * 1024u;
    const int aoff = lds_byte(wr * 64 + fr, fq * 8), boff = lds_byte(wc * 32 + fr, fq * 8);
#define PG8_SA(b, h) (((b) * 2 + (h)) * HTB)
#define PG8_SB(b, h) ((4 + (b) * 2 + (h)) * HTB)
#define PG8_STAGE(bufoff, gbase, voff) do { _Pragma("unroll") for (int _i = 0; _i < 2; ++_i) \
        __builtin_amdgcn_global_load_lds((const unsigned*)((const char*)(gbase) + (voff)[_i]), (PG8_LAS unsigned*)(lds + (bufoff) + ldsw + _i * 8192), 16, 0, 0); } while (0)
#define PG8_LDA(dst, b, h) do { _Pragma("unroll") for (int m = 0; m < 4; ++m) _Pragma("unroll") for (int k = 0; k < 2; ++k) dst[m][k] = *(const PG8_LAS bf16x8*)(lds + PG8_SA(b, h) + aoff + m * 2048 + k * 1024); } while (0)
#define PG8_LDB(dst, b, h) do { _Pragma("unroll") for (int n = 0; n < 2; ++n) _Pragma("unroll") for (int k = 0; k < 2; ++k) dst[n][k] = *(const PG8_LAS bf16x8*)(lds + PG8_SB(b, h) + boff + n * 2048 + k * 1024); } while (0)
#define PG8_MMA(ai, bj, At, Bt) do { __builtin_amdgcn_s_setprio(1); _Pragma("unroll") for (int m = 0; m < 4; ++m) _Pragma("unroll") for (int n = 0; n < 2; ++n) _Pragma("unroll") for (int k = 0; k < 2; ++k) \
        acc[ai][bj][m][n] = __builtin_amdgcn_mfma_f32_16x16x32_bf16(Bt[n][k], At[m][k], acc[ai][bj][m][n], 0, 0, 0); __builtin_amdgcn_s_setprio(0); } while (0)
#define PG8_WAIT_V(n) asm volatile("s_waitcnt vmcnt(" #n ")" ::: "memory")
#define PG8_WAIT_L(n) asm volatile("s_waitcnt lgkmcnt(" #n ")" ::: "memory")
#define PG8_BAR __builtin_amdgcn_s_barrier()
#define PG8_SCHED __builtin_amdgcn_sched_barrier(0)
    Unit cur, nxt; int ui = 0;
    if (!S.next(0, cur)) return;
    f32x4 acc[2][2][4][2];
#pragma unroll
    for (int a = 0; a < 2; ++a)
#pragma unroll
        for (int b = 0; b < 2; ++b)
#pragma unroll
            for (int m = 0; m < 4; ++m)
#pragma unroll
                for (int n = 0; n < 2; ++n) acc[a][b][m][n] = (f32x4){0.f, 0.f, 0.f, 0.f};
    bf16x8 At[4][2], B0[2][2], B1[2][2];
    const char* cAP = (const char*)AP + (size_t)cur.pm * tsP; const char* cBP = (const char*)BP + (size_t)cur.pn * tsP;
    const char* cAZ = (const char*)AZ + (size_t)cur.pm * tsZ; const char* cBZ = (const char*)BZ + (size_t)cur.pn * tsZ;
    S.a_ready(cur);
    PG8_STAGE(PG8_SB(0, 0), cBP, vBP); PG8_STAGE(PG8_SB(0, 1), cBP + hsP, vBP); PG8_STAGE(PG8_SA(0, 0), cAP, vAP); PG8_STAGE(PG8_SA(0, 1), cAP + hsP, vAP);
    if (wr == 1) PG8_BAR;
    PG8_WAIT_V(2); PG8_BAR;
    PG8_STAGE(PG8_SB(1, 0), cBP + kstep, vBP); PG8_STAGE(PG8_SA(1, 0), cAP + kstep, vAP); PG8_STAGE(PG8_SB(1, 1), cBP + hsP + kstep, vBP);
    PG8_WAIT_V(6); PG8_BAR;
    for (;;) {
        const bool has_next = S.next(ui + 1, nxt);
        const char* nAP = has_next ? (const char*)AP + (size_t)nxt.pm * tsP : cAP; const char* nBP = has_next ? (const char*)BP + (size_t)nxt.pn * tsP : cBP;
#pragma nounroll
        for (int t = 0; t < NT; t += 2) {
            if (t == 4) {
                EM(acc, cur, wr, wc, fr, fq);
#pragma unroll
                for (int a = 0; a < 2; ++a)
#pragma unroll
                    for (int b = 0; b < 2; ++b)
#pragma unroll
                        for (int m = 0; m < 4; ++m)
#pragma unroll
                            for (int n = 0; n < 2; ++n) acc[a][b][m][n] = (f32x4){0.f, 0.f, 0.f, 0.f};
            }
            const bool p1 = (t < 4), p23 = (t == 0) || (t == NT - 2);
            const char* a1 = p1 ? cAP + (size_t)(t + 1) * kstep : cAZ + (size_t)(t - 3) * kstep;
            const char* a2 = (t == 0) ? cAP + 2 * kstep : (t == NT - 2) ? nAP : cAZ + (size_t)(t - 2) * kstep;
            const char* b2 = (t == 0) ? cBP + 2 * kstep : (t == NT - 2) ? nBP : cBZ + (size_t)(t - 2) * kstep;
            const char* a3 = a2 + kstep; const char* b3 = b2 + kstep;
            const size_t hstep1 = p1 ? hsP : hsZ, hstep = p23 ? hsP : hsZ, hstepB = hstep;
            unsigned voffA1[2], voffA[2], voffB[2];
#pragma unroll
            for (int i = 0; i < 2; ++i) { voffA1[i] = p1 ? vAP[i] : vAZ[i]; voffA[i] = p23 ? vAP[i] : vAZ[i]; voffB[i] = p23 ? vBP[i] : vBZ[i]; }
            if (t == NT - 2 && has_next) S.a_ready(nxt);
            PG8_LDB(B0, 0, 0); PG8_LDB(B1, 0, 1); PG8_SCHED; PG8_LDA(At, 0, 0); PG8_STAGE(PG8_SA(1, 1), a1 + hstep1, voffA1);
            PG8_WAIT_V(8); PG8_WAIT_L(0); PG8_BAR; PG8_MMA(0, 0, At, B0); PG8_MMA(0, 1, At, B1); PG8_BAR; PG8_SCHED;
            PG8_LDA(At, 0, 1); PG8_STAGE(PG8_SB(0, 0), b2, voffB); PG8_STAGE(PG8_SB(0, 1), b2 + hstepB, voffB); PG8_STAGE(PG8_SA(0, 0), a2, voffA);
            PG8_WAIT_V(8); PG8_WAIT_L(0); PG8_BAR; PG8_MMA(1, 0, At, B0); PG8_MMA(1, 1, At, B1); PG8_BAR; PG8_SCHED;
            PG8_LDB(B0, 1, 0); PG8_LDB(B1, 1, 1); PG8_SCHED; PG8_LDA(At, 1, 0); PG8_STAGE(PG8_SA(0, 1), a2 + hstep, voffA);
            PG8_WAIT_V(8); PG8_WAIT_L(0); PG8_BAR; PG8_MMA(0, 0, At, B0); PG8_MMA(0, 1, At, B1); PG8_BAR; PG8_SCHED;
            PG8_LDA(At, 1, 1); PG8_STAGE(PG8_SB(1, 0), b3, voffB); PG8_STAGE(PG8_SB(1, 1), b3 + hstepB, voffB); PG8_STAGE(PG8_SA(1, 0), a3, voffA);
            PG8_WAIT_V(8); PG8_WAIT_L(0); PG8_BAR; PG8_MMA(1, 0, At, B0); PG8_MMA(1, 1, At, B1); PG8_BAR; PG8_SCHED;
        }
        if constexpr (ALIGN_EPI) { if (wr == 0) PG8_BAR; }
        E(acc, cur, wr, wc, fr, fq); S.done(cur);
        if (!has_next) break;
#pragma unroll
        for (int a = 0; a < 2; ++a)
#pragma unroll
            for (int b = 0; b < 2; ++b)
#pragma unroll
                for (int m = 0; m < 4; ++m)
#pragma unroll
                    for (int n = 0; n < 2; ++n) acc[a][b][m][n] = (f32x4){0.f, 0.f, 0.f, 0.f};
        cur = nxt; cAP = nAP; cBP = nBP; cAZ = (const char*)AZ + (size_t)cur.pm * tsZ; cBZ = (const char*)BZ + (size_t)cur.pn * tsZ; ++ui;
        if constexpr (ALIGN_EPI) { if (wr == 1) PG8_BAR; }
    }
    PG8_WAIT_V(0);
    if constexpr (!ALIGN_EPI) { if (wr == 0) PG8_BAR; }
    PG8_BAR;
#undef PG8_SA
#undef PG8_SB
#undef PG8_STAGE
#undef PG8_LDA
#undef PG8_LDB
#undef PG8_MMA
#undef PG8_WAIT_V
#undef PG8_WAIT_L
#undef PG8_BAR
#undef PG8_SCHED
}
}
#ifndef PG8_SP2
#define PG8_SP2 true
#endif
#ifndef PG8_ALIGN
#define PG8_ALIGN true
#endif
using pg8::bf16_t; using pg8::bf16x8; using pg8::f32x4; using pg8::u32x4;
#define LAS __attribute__((address_space(3)))
typedef float f32x2 __attribute__((ext_vector_type(2)));
typedef float f32x16 __attribute__((ext_vector_type(16)));
typedef unsigned u32x2 __attribute__((ext_vector_type(2)));
typedef __bf16 bf16x2_t __attribute__((ext_vector_type(2)));

constexpr int T_ = 65536, DM_ = 1024, SEQ_ = 8192, PJW = 2048, FF_ = 4096, PLE_ = 256, NUNIT_ATT = 1024, NUNIT_LRU = 256;
constexpr float EPS_ = 1e-6f, LOG2E = 1.4426950408889634f, QSCALE = 0.125f * 1.4426950408889634f;
constexpr int NWAVES = 8, NTHR = 512;
constexpr int RING_BYTES = 131072, SSL_OFF = RING_BYTES, MISC_OFF = 147456 - 64, LDS_BYTES = 147456;
constexpr size_t MiB = 1u << 20;
constexpr size_t WS_WIN = 0, WS_WOUT = 5 * MiB, WS_WUP = 7 * MiB, WS_WDN = 15 * MiB, WS_WPG = 23 * MiB, WS_WPP = 25 * MiB, WS_WG = 25 * MiB + 512 * 1024;
constexpr size_t WS_RSTD1 = 27 * MiB, WS_RSTD2 = 27 * MiB + 256 * 1024, WS_DUMMY = 27 * MiB + 512 * 1024, WS_SUMM = 28 * MiB;
constexpr size_t WS_CTL = 31 * MiB, CTL_BYTES = 16384;
constexpr size_t WS_XN = 32 * MiB;
constexpr size_t WS_PP = 160 * MiB;
constexpr size_t WS_PB = 288 * MiB;
constexpr size_t WS_PROJ = 320 * MiB;
constexpr size_t WS_VT = 576 * MiB;
constexpr size_t WS_MERGED = 640 * MiB;
constexpr size_t WS_ACT = 320 * MiB;
constexpr size_t WS_END = 832 * MiB;

__device__ __forceinline__ unsigned cvtpk(float lo, float hi) { f32x2 v = {lo, hi}; bf16x2_t b = __builtin_convertvector(v, bf16x2_t); return __builtin_bit_cast(unsigned, b); }
__device__ __forceinline__ float bf2f(unsigned short u) { return __uint_as_float((unsigned)u << 16); }
__device__ __forceinline__ float bflo(unsigned w) { return __uint_as_float(w << 16); }
__device__ __forceinline__ float bfhi(unsigned w) { return __uint_as_float(w & 0xffff0000u); }
__device__ __forceinline__ float ex2(float x) { return __builtin_amdgcn_exp2f(x); }
__device__ __forceinline__ float rcpf_(float x) { return __builtin_amdgcn_rcpf(x); }
__device__ __forceinline__ float rsqf_(float x) { return __builtin_amdgcn_rsqf(x); }
__device__ __forceinline__ float sigm(float z) { return rcpf_(1.f + ex2(-LOG2E * z)); }
__device__ __forceinline__ float gelu_tanh(float g) { const float z = 0.7978845608028654f * (g + 0.044715f * g * g * g); return g * sigm(2.f * z); }
__device__ __forceinline__ float wave_sum(float v) {
#pragma unroll
    for (int o = 1; o < 64; o <<= 1) v += __shfl_xor(v, o);
    return v;
}
__device__ __forceinline__ float wave_max(float v) {
#pragma unroll
    for (int o = 1; o < 64; o <<= 1) v = fmaxf(v, __shfl_xor(v, o));
    return v;
}
__device__ __forceinline__ int crow(int r, int hi) { return (r & 3) + 8 * (r >> 2) + 4 * hi; }
#define MFMA32(a, b, c) __builtin_amdgcn_mfma_f32_32x32x16_bf16((a), (b), (c), 0, 0, 0)

#define RLX_AGENT __ATOMIC_RELAXED, __HIP_MEMORY_SCOPE_AGENT
#define XB_TMO      128
#define XB_XCNT(j)  (256  + 64 * (j))
#define XB_XSUB(j)  (1280 + 64 * (j))
#define XB_XGEN(j)  (2304 + 64 * (j))
#define XB_TOP      3328
#define XB_TOPGEN   3392
#define XCD_BAR_WORDS 3456
#define XB_SPIN_CAP (1u << 18)

__device__ __forceinline__ unsigned xb_ld(unsigned* p)              { return __hip_atomic_load(p, __ATOMIC_RELAXED, __HIP_MEMORY_SCOPE_AGENT); }
__device__ __forceinline__ unsigned xb_add(unsigned* p, unsigned v) { return __hip_atomic_fetch_add(p, v, __ATOMIC_RELAXED, __HIP_MEMORY_SCOPE_AGENT); }
__device__ __forceinline__ unsigned xb_xcc_id() { return (unsigned)__builtin_amdgcn_s_getreg((3 << 11) | 20) & 0xFu; }
#define XB_SPIN(cond, bar) do { unsigned _sp = 0; while (cond) { __builtin_amdgcn_s_sleep(1); \
    if ((++_sp & 255u) == 0u) { if (xb_ld(&(bar)[XB_TMO])) break; if (_sp > XB_SPIN_CAP) { atomicAdd(&(bar)[XB_TMO], 1u); break; } } } } while (0)

struct XcdBarrier {
    unsigned* bar; unsigned x;
    volatile LAS unsigned* st;
};

__device__ __forceinline__ XcdBarrier xcd_barrier_post(unsigned* bar, volatile LAS unsigned* st) {
    XcdBarrier b; b.bar = bar; b.x = xb_xcc_id(); b.st = st;
    if (threadIdx.x == 0) (void)xb_add(&bar[XB_XCNT(b.x)], 1u);
    return b;
}
__device__ __forceinline__ void xcd_barrier_complete(unsigned* bar, unsigned x, unsigned& nloc, unsigned& nx) {
    const unsigned G = gridDim.x * gridDim.y * gridDim.z;
    unsigned sum, cnt, mine, sp = 0u;
    for (;;) {
        sum = 0u; cnt = 0u; mine = 0u;
#pragma unroll
        for (unsigned j = 0; j < 16; ++j) { const unsigned c = xb_ld(&bar[XB_XCNT(j)]); sum += c; cnt += (c > 0u) ? 1u : 0u; mine = (j == x) ? c : mine; }
        if (sum == G) break;
        __builtin_amdgcn_s_sleep(1);
        if ((++sp & 255u) == 0u) { if (xb_ld(&bar[XB_TMO])) break; if (sp > XB_SPIN_CAP) { atomicAdd(&bar[XB_TMO], 1u); break; } }
    }
    nloc = mine > 0u ? mine : 1u; nx = cnt > 0u ? cnt : 1u;
}

__device__ __forceinline__ void xcd_barrier(const XcdBarrier& b) {
    asm volatile("s_waitcnt vmcnt(0)" ::: "memory");
    __syncthreads();
    if (threadIdx.x == 0) {
        unsigned* bar = b.bar;
        __builtin_amdgcn_s_waitcnt(0);
        unsigned nloc = b.st[0], nx = b.st[1];
        if (nloc == 0u) { xcd_barrier_complete(bar, b.x, nloc, nx); b.st[0] = nloc; b.st[1] = nx; }
        const unsigned old = xb_add(&bar[XB_XSUB(b.x)], 1u);
        const unsigned gen = old / nloc;
        if (old + 1u == (gen + 1u) * nloc) {
            __builtin_amdgcn_fence(__ATOMIC_RELEASE, "agent");
            asm volatile("s_waitcnt vmcnt(0)" ::: "memory");
            const unsigned og = xb_add(&bar[XB_TOP], 1u);
            const unsigned tg = og / nx;
            if (og + 1u == (tg + 1u) * nx) xb_add(&bar[XB_TOPGEN], 1u);
            else XB_SPIN(xb_ld(&bar[XB_TOPGEN]) == tg, bar);
            __builtin_amdgcn_fence(__ATOMIC_ACQUIRE, "agent");
            xb_add(&bar[XB_XGEN(b.x)], 1u);
            asm volatile("s_waitcnt vmcnt(0)" ::: "memory");
        } else {
            XB_SPIN(xb_ld(&bar[XB_XGEN(b.x)]) == gen, bar);
            __builtin_amdgcn_fence(__ATOMIC_ACQUIRE, "agent");
            asm volatile("s_waitcnt vmcnt(0)" ::: "memory");
        }
    }
    __syncthreads();
}

struct PanelOrder {
    int pm;
    __device__ bool next(int i, pg8::Unit& u) const { if (i >= 4) return false; u.pm = pm; u.pn = i; return true; }
    __device__ __forceinline__ void a_ready(const pg8::Unit&) const {}
    __device__ __forceinline__ void done(const pg8::Unit&) const {}
};

struct EpiPlain {
    static constexpr bool PERM = true, AFTER_DRAIN = false, HEADMAP = false;
    bf16_t* O; int ldc;
    __device__ __forceinline__ void operator()(const f32x4 (&acc)[2][2][4][2], const pg8::Unit& u, int wr, int wc, int fr, int fq) const {
        const int row0 = u.pm * 256 + wr * 64 + fr, col0 = u.pn * 256 + wc * 32 + 8 * fq;
#pragma unroll
        for (int ai = 0; ai < 2; ++ai)
#pragma unroll
            for (int m = 0; m < 4; ++m) { bf16_t* rowp = O + (size_t)(row0 + ai * 128 + m * 16) * ldc + col0;
#pragma unroll
                for (int bj = 0; bj < 2; ++bj) { const f32x4 v0 = acc[ai][bj][m][0], v1 = acc[ai][bj][m][1];
                    u32x4 w; w.x = cvtpk(v0[0], v0[1]); w.y = cvtpk(v0[2], v0[3]); w.z = cvtpk(v1[0], v1[1]); w.w = cvtpk(v1[2], v1[3]);
                    *(u32x4*)(rowp + bj * 128) = w; } }
    }
};
struct EpiVT {
    static constexpr bool PERM = true, AFTER_DRAIN = false, HEADMAP = false;
    bf16_t* O;
    __device__ __forceinline__ void operator()(const f32x4 (&acc)[2][2][4][2], const pg8::Unit& u, int wr, int wc, int fr, int fq) const {
        const int row0 = u.pm * 256 + wr * 64 + fr, col0 = u.pn * 256 + wc * 32 + 16 * (fq >> 1) + 4 * (fq & 1);
#pragma unroll
        for (int ai = 0; ai < 2; ++ai)
#pragma unroll
            for (int m = 0; m < 4; ++m) { bf16_t* rowp = O + (size_t)(row0 + ai * 128 + m * 16) * T_ + col0;
#pragma unroll
                for (int bj = 0; bj < 2; ++bj)
#pragma unroll
                    for (int n = 0; n < 2; ++n) { const f32x4 v = acc[ai][bj][m][n]; u32x2 w; w.x = cvtpk(v[0], v[1]); w.y = cvtpk(v[2], v[3]);
                        *(u32x2*)(rowp + bj * 128 + 8 * n) = w; } }
    }
};
struct EpiProj {
    static constexpr bool PERM = true, AFTER_DRAIN = false, HEADMAP = true;
    bf16_t* O; const float* gq; const float* gk;
    __device__ __forceinline__ void operator()(const f32x4 (&acc)[2][2][4][2], const pg8::Unit& u, int wr, int wc, int fr, int fq) const {
        const int row0 = u.pm * 256 + wr * 64 + fr, col0 = u.pn * 256 + wc * 64 + 8 * fq, kind = u.pn >> 1;
        f32x4 gv[2][2];
        if (kind >= 2) { const float* g = (kind == 2) ? gq : gk; const float sc = (kind == 2) ? QSCALE : 1.f;
#pragma unroll
            for (int bj = 0; bj < 2; ++bj)
#pragma unroll
                for (int n = 0; n < 2; ++n) gv[bj][n] = *(const f32x4*)(g + 32 * bj + 8 * fq + 4 * n) * sc; }
#pragma unroll
        for (int ai = 0; ai < 2; ++ai)
#pragma unroll
            for (int m = 0; m < 4; ++m) { bf16_t* rowp = O + (size_t)(row0 + ai * 128 + m * 16) * PJW + col0;
                f32x4 v[2][2];
#pragma unroll
                for (int bj = 0; bj < 2; ++bj)
#pragma unroll
                    for (int n = 0; n < 2; ++n) v[bj][n] = acc[ai][bj][m][n];
                if (kind == 1) {
#pragma unroll
                    for (int bj = 0; bj < 2; ++bj)
#pragma unroll
                        for (int n = 0; n < 2; ++n)
#pragma unroll
                            for (int e = 0; e < 4; ++e) v[bj][n][e] = gelu_tanh(v[bj][n][e]);
                } else if (kind >= 2) {
                    float ss = 0.f;
#pragma unroll
                    for (int bj = 0; bj < 2; ++bj)
#pragma unroll
                        for (int n = 0; n < 2; ++n) { const f32x4 x = v[bj][n]; ss += (x[0] * x[0] + x[1] * x[1]) + (x[2] * x[2] + x[3] * x[3]); }
                    ss += __shfl_xor(ss, 16); ss += __shfl_xor(ss, 32);
                    const float rstd = rsqf_(ss * (1.f / 64.f) + EPS_);
#pragma unroll
                    for (int bj = 0; bj < 2; ++bj)
#pragma unroll
                        for (int n = 0; n < 2; ++n) v[bj][n] = v[bj][n] * gv[bj][n] * rstd;
                }
#pragma unroll
                for (int bj = 0; bj < 2; ++bj) { const f32x4 v0 = v[bj][0], v1 = v[bj][1];
                    u32x4 w; w.x = cvtpk(v0[0], v0[1]); w.y = cvtpk(v0[2], v0[3]); w.z = cvtpk(v1[0], v1[1]); w.w = cvtpk(v1[2], v1[3]);
                    *(u32x4*)(rowp + bj * 32) = w; } }
    }
};
struct EpiRes {
    static constexpr bool PERM = true, AFTER_DRAIN = false, HEADMAP = false;
    const float* base; float* out; bf16_t* hb; float* ssq; int rowmask;
    __device__ __forceinline__ void operator()(const f32x4 (&acc)[2][2][4][2], const pg8::Unit& u, int wr, int wc, int fr, int fq) const {
        const int row0 = u.pm * 256 + wr * 64 + fr, col0 = u.pn * 256 + wc * 32 + 8 * fq;
#pragma unroll
        for (int ai = 0; ai < 2; ++ai)
#pragma unroll
            for (int m = 0; m < 4; ++m) { const size_t off = (size_t)(row0 + ai * 128 + m * 16) * DM_ + col0; const size_t ooff = (size_t)((row0 + ai * 128 + m * 16) & rowmask) * DM_ + col0; float ss = 0.f;
#pragma unroll
                for (int bj = 0; bj < 2; ++bj) {
                    const f32x4 b0 = *(const f32x4*)(base + off + bj * 128), b1 = *(const f32x4*)(base + off + bj * 128 + 4);
                    const f32x4 v0 = b0 + acc[ai][bj][m][0], v1 = b1 + acc[ai][bj][m][1];
                    ss += (v0[0] * v0[0] + v0[1] * v0[1]) + (v0[2] * v0[2] + v0[3] * v0[3]) + (v1[0] * v1[0] + v1[1] * v1[1]) + (v1[2] * v1[2] + v1[3] * v1[3]);
                    *(f32x4*)(out + ooff + bj * 128) = v0; *(f32x4*)(out + ooff + bj * 128 + 4) = v1;
                    u32x4 w; w.x = cvtpk(v0[0], v0[1]); w.y = cvtpk(v0[2], v0[3]); w.z = cvtpk(v1[0], v1[1]); w.w = cvtpk(v1[2], v1[3]);
                    *(u32x4*)(hb + off + bj * 128) = w; }
                ss += __shfl_xor(ss, 16); ss += __shfl_xor(ss, 32);
                if (fq == 0) __hip_atomic_fetch_add(ssq + row0 + ai * 128 + m * 16, ss, __ATOMIC_RELAXED, __HIP_MEMORY_SCOPE_AGENT);
                asm volatile("" ::: "memory"); }
    }
};
struct EpiUp {
    static constexpr bool PERM = true, AFTER_DRAIN = false, HEADMAP = false;
    bf16_t* O; const float* rstd;
    __device__ __forceinline__ void operator()(const f32x4 (&acc)[2][2][4][2], const pg8::Unit& u, int wr, int wc, int fr, int fq) const {
        const int row0 = u.pm * 256 + wr * 64 + fr, col0 = u.pn * 256 + wc * 32 + 8 * fq;
#pragma unroll
        for (int ai = 0; ai < 2; ++ai)
#pragma unroll
            for (int m = 0; m < 4; ++m) { const int row = row0 + ai * 128 + m * 16; const float rs = rsqf_(rstd[row] * (1.f / DM_) + EPS_); bf16_t* rowp = O + (size_t)row * FF_ + col0;
#pragma unroll
                for (int bj = 0; bj < 2; ++bj) { f32x4 v0 = acc[ai][bj][m][0] * rs, v1 = acc[ai][bj][m][1] * rs;
#pragma unroll
                    for (int e = 0; e < 4; ++e) { const float a = fmaxf(v0[e], 0.f), b = fmaxf(v1[e], 0.f); v0[e] = a * a; v1[e] = b * b; }
                    u32x4 w; w.x = cvtpk(v0[0], v0[1]); w.y = cvtpk(v0[2], v0[3]); w.z = cvtpk(v1[0], v1[1]); w.w = cvtpk(v1[2], v1[3]);
                    *(u32x4*)(rowp + bj * 128) = w; } }
    }
};
struct EpiFinal {
    static constexpr bool PERM = true, AFTER_DRAIN = false, HEADMAP = false;
    const float* hin; float* out; const bf16_t* pp; const float* rstd;
    __device__ __forceinline__ void operator()(const f32x4 (&acc)[2][2][4][2], const pg8::Unit& u, int wr, int wc, int fr, int fq) const {
        const int row0 = u.pm * 256 + wr * 64 + fr, col0 = u.pn * 256 + wc * 32 + 8 * fq;
#pragma unroll
        for (int ai = 0; ai < 2; ++ai)
#pragma unroll
            for (int m = 0; m < 4; ++m) { const int row = row0 + ai * 128 + m * 16; const float rs = rsqf_(rstd[row] * (1.f / DM_) + EPS_); const size_t off = (size_t)row * DM_ + col0;
#pragma unroll
                for (int bj = 0; bj < 2; ++bj) {
                    const f32x4 h0 = *(const f32x4*)(hin + off + bj * 128), h1 = *(const f32x4*)(hin + off + bj * 128 + 4);
                    const u32x4 pw = *(const u32x4*)(pp + off + bj * 128);
                    const f32x4 a0 = acc[ai][bj][m][0] * rs, a1 = acc[ai][bj][m][1] * rs;
                    f32x4 o0, o1;
                    o0[0] = h0[0] + sigm(a0[0]) * bflo(pw.x); o0[1] = h0[1] + sigm(a0[1]) * bfhi(pw.x); o0[2] = h0[2] + sigm(a0[2]) * bflo(pw.y); o0[3] = h0[3] + sigm(a0[3]) * bfhi(pw.y);
                    o1[0] = h1[0] + sigm(a1[0]) * bflo(pw.z); o1[1] = h1[1] + sigm(a1[1]) * bfhi(pw.z); o1[2] = h1[2] + sigm(a1[2]) * bflo(pw.w); o1[3] = h1[3] + sigm(a1[3]) * bfhi(pw.w);
                    *(f32x4*)(out + off + bj * 128) = o0; *(f32x4*)(out + off + bj * 128 + 4) = o1; }
                asm volatile("" ::: "memory"); }
    }
};


struct EpiRes4 {
    static constexpr bool PERM = true, AFTER_DRAIN = false, HEADMAP = false;
    const float* base; bf16_t* hb; float* ssq;
    __device__ __forceinline__ void operator()(const f32x4 (&acc)[2][2][4][2], const pg8::Unit& u, int wr, int wc, int fr, int fq) const {
        const int row0 = u.pm * 256 + wr * 64 + fr, col0 = u.pn * 256 + wc * 32 + 8 * fq;
        f32x4 X[8][2][2];
#define E4_LD(g) do { const size_t off_ = (size_t)(row0 + ((g) >> 2) * 128 + ((g) & 3) * 16) * DM_ + col0; \
        _Pragma("unroll") for (int bj = 0; bj < 2; ++bj) { X[g][bj][0] = *(const f32x4*)(base + off_ + bj * 128); X[g][bj][1] = *(const f32x4*)(base + off_ + bj * 128 + 4); } } while (0)
        E4_LD(0); E4_LD(1); E4_LD(2); E4_LD(3);
        asm volatile("" ::: "memory");
#pragma unroll
        for (int g = 0; g < 8; ++g) { const int ai = g >> 2, m = g & 3; const size_t off = (size_t)(row0 + ai * 128 + m * 16) * DM_ + col0; float ss = 0.f;
#pragma unroll
            for (int bj = 0; bj < 2; ++bj) {
                const f32x4 v0 = X[g][bj][0] + acc[ai][bj][m][0], v1 = X[g][bj][1] + acc[ai][bj][m][1];
                ss += (v0[0] * v0[0] + v0[1] * v0[1]) + (v0[2] * v0[2] + v0[3] * v0[3]) + (v1[0] * v1[0] + v1[1] * v1[1]) + (v1[2] * v1[2] + v1[3] * v1[3]);
                u32x4 w; w.x = cvtpk(v0[0], v0[1]); w.y = cvtpk(v0[2], v0[3]); w.z = cvtpk(v1[0], v1[1]); w.w = cvtpk(v1[2], v1[3]);
                *(u32x4*)(hb + off + bj * 128) = w; }
            ss += __shfl_xor(ss, 16); ss += __shfl_xor(ss, 32);
            if (fq == 0) __hip_atomic_fetch_add(ssq + row0 + ai * 128 + m * 16, ss, __ATOMIC_RELAXED, __HIP_MEMORY_SCOPE_AGENT);
            if (g + 4 < 8) { E4_LD(g + 4); }
            asm volatile("" ::: "memory"); }
#undef E4_LD
    }
};
struct EpiRes6 {
    static constexpr bool PERM = true, AFTER_DRAIN = false, HEADMAP = false;
    bf16_t* hb; float* ssq;
    __device__ __forceinline__ void operator()(const f32x4 (&acc)[2][2][4][2], const pg8::Unit& u, int wr, int wc, int fr, int fq) const {
        const int row0 = u.pm * 256 + wr * 64 + fr, col0 = u.pn * 256 + wc * 32 + 8 * fq;
        u32x4 H[8][2];
#define E6_LD(g) do { const size_t off_ = (size_t)(row0 + ((g) >> 2) * 128 + ((g) & 3) * 16) * DM_ + col0; \
        _Pragma("unroll") for (int bj = 0; bj < 2; ++bj) H[g][bj] = *(const u32x4*)(hb + off_ + bj * 128); } while (0)
        E6_LD(0); E6_LD(1); E6_LD(2); E6_LD(3);
        asm volatile("" ::: "memory");
#pragma unroll
        for (int g = 0; g < 8; ++g) { const int ai = g >> 2, m = g & 3; const size_t off = (size_t)(row0 + ai * 128 + m * 16) * DM_ + col0; float ss = 0.f;
#pragma unroll
            for (int bj = 0; bj < 2; ++bj) { const u32x4 hw = H[g][bj];
                const f32x4 b0 = {bflo(hw.x), bfhi(hw.x), bflo(hw.y), bfhi(hw.y)}, b1 = {bflo(hw.z), bfhi(hw.z), bflo(hw.w), bfhi(hw.w)};
                const f32x4 v0 = b0 + acc[ai][bj][m][0], v1 = b1 + acc[ai][bj][m][1];
                ss += (v0[0] * v0[0] + v0[1] * v0[1]) + (v0[2] * v0[2] + v0[3] * v0[3]) + (v1[0] * v1[0] + v1[1] * v1[1]) + (v1[2] * v1[2] + v1[3] * v1[3]);
                u32x4 w; w.x = cvtpk(v0[0], v0[1]); w.y = cvtpk(v0[2], v0[3]); w.z = cvtpk(v1[0], v1[1]); w.w = cvtpk(v1[2], v1[3]);
                *(u32x4*)(hb + off + bj * 128) = w; }
            ss += __shfl_xor(ss, 16); ss += __shfl_xor(ss, 32);
            if (fq == 0) __hip_atomic_fetch_add(ssq + row0 + ai * 128 + m * 16, ss, __ATOMIC_RELAXED, __HIP_MEMORY_SCOPE_AGENT);
            if (g + 4 < 8) { E6_LD(g + 4); }
            asm volatile("" ::: "memory"); }
#undef E6_LD
    }
};
struct EpiFinalB {
    static constexpr bool PERM = true, AFTER_DRAIN = false, HEADMAP = false;
    const bf16_t* hb; float* out; const bf16_t* pp; const float* rstd;
    __device__ __forceinline__ void operator()(const f32x4 (&acc)[2][2][4][2], const pg8::Unit& u, int wr, int wc, int fr, int fq) const {
        const int row0 = u.pm * 256 + wr * 64 + fr, col0 = u.pn * 256 + wc * 32 + 8 * fq;
        u32x4 H[8][2], P[8][2]; float RS[8];
#define EF_LD(g) do { const int row_ = row0 + ((g) >> 2) * 128 + ((g) & 3) * 16; const size_t off_ = (size_t)row_ * DM_ + col0; RS[g] = rstd[row_]; \
        _Pragma("unroll") for (int bj = 0; bj < 2; ++bj) { H[g][bj] = *(const u32x4*)(hb + off_ + bj * 128); P[g][bj] = *(const u32x4*)(pp + off_ + bj * 128); } } while (0)
        EF_LD(0); EF_LD(1); EF_LD(2); EF_LD(3);
        asm volatile("" ::: "memory");
#pragma unroll
        for (int g = 0; g < 8; ++g) { const int ai = g >> 2, m = g & 3; const size_t off = (size_t)(row0 + ai * 128 + m * 16) * DM_ + col0; const float rs = rsqf_(RS[g] * (1.f / DM_) + EPS_);
#pragma unroll
            for (int bj = 0; bj < 2; ++bj) { const u32x4 hw = H[g][bj], pw = P[g][bj];
                const f32x4 a0 = acc[ai][bj][m][0] * rs, a1 = acc[ai][bj][m][1] * rs;
                f32x4 o0, o1;
                o0[0] = bflo(hw.x) + sigm(a0[0]) * bflo(pw.x); o0[1] = bfhi(hw.x) + sigm(a0[1]) * bfhi(pw.x); o0[2] = bflo(hw.y) + sigm(a0[2]) * bflo(pw.y); o0[3] = bfhi(hw.y) + sigm(a0[3]) * bfhi(pw.y);
                o1[0] = bflo(hw.z) + sigm(a1[0]) * bflo(pw.z); o1[1] = bfhi(hw.z) + sigm(a1[1]) * bfhi(pw.z); o1[2] = bflo(hw.w) + sigm(a1[2]) * bflo(pw.w); o1[3] = bfhi(hw.w) + sigm(a1[3]) * bfhi(pw.w);
                *(f32x4*)(out + off + bj * 128) = o0; *(f32x4*)(out + off + bj * 128 + 4) = o1; }
            if (g + 4 < 8) { EF_LD(g + 4); }
            asm volatile("" ::: "memory"); }
#undef EF_LD
    }
};

struct EpiMidPP {
    u32x4* park;
    __device__ __forceinline__ void operator()(const f32x4 (&acc)[2][2][4][2], const pg8::Unit& u, int wr, int wc, int fr, int fq) const {
        asm volatile("" : "+v"(fr), "+v"(fq));
        const unsigned pko_ = (unsigned)((wr * 4 + wc) * 64 + fq * 16 + fr);
#pragma unroll
        for (int ai = 0; ai < 2; ++ai)
#pragma unroll
            for (int m = 0; m < 4; ++m)
#pragma unroll
                for (int bj = 0; bj < 2; ++bj) { const f32x4 v0 = acc[ai][bj][m][0], v1 = acc[ai][bj][m][1];
                    u32x4 w; w.x = cvtpk(v0[0], v0[1]); w.y = cvtpk(v0[2], v0[3]); w.z = cvtpk(v1[0], v1[1]); w.w = cvtpk(v1[2], v1[3]);
                    park[pko_ + (unsigned)((((ai * 4 + m) * 2 + bj) * 8) * 64)] = w; }
    }
};
struct EpiFinalC {
    const bf16_t* hb; float* out; const float* rstd; const u32x4* park;
    __device__ __forceinline__ void operator()(const f32x4 (&acc)[2][2][4][2], const pg8::Unit& u, int wr, int wc, int fr, int fq) const {
        asm volatile("" : "+v"(fr), "+v"(fq));
        const int row0 = u.pm * 256 + wr * 64 + fr, col0 = u.pn * 256 + wc * 32 + 8 * fq;
        const unsigned pko_ = (unsigned)((wr * 4 + wc) * 64 + fq * 16 + fr);
        u32x4 H[8][2], P[8][2]; float RS[8];
#define EF_LD(g) do { const int row_ = row0 + ((g) >> 2) * 128 + ((g) & 3) * 16; const size_t off_ = (size_t)row_ * DM_ + col0; RS[g] = rstd[row_]; \
        _Pragma("unroll") for (int bj = 0; bj < 2; ++bj) { H[g][bj] = *(const u32x4*)(hb + off_ + bj * 128); P[g][bj] = park[pko_ + (unsigned)((((g) * 2 + bj) * 8) * 64)]; } } while (0)
        EF_LD(0); EF_LD(1); EF_LD(2); EF_LD(3);
        asm volatile("" ::: "memory");
#pragma unroll
        for (int g = 0; g < 8; ++g) { const int ai = g >> 2, m = g & 3; const size_t off = (size_t)(row0 + ai * 128 + m * 16) * DM_ + col0; const float rs = rsqf_(RS[g] * (1.f / DM_) + EPS_);
#pragma unroll
            for (int bj = 0; bj < 2; ++bj) { const u32x4 hw = H[g][bj], pw = P[g][bj];
                const f32x4 a0 = acc[ai][bj][m][0] * rs, a1 = acc[ai][bj][m][1] * rs;
                f32x4 o0, o1;
                o0[0] = bflo(hw.x) + sigm(a0[0]) * bflo(pw.x); o0[1] = bfhi(hw.x) + sigm(a0[1]) * bfhi(pw.x); o0[2] = bflo(hw.y) + sigm(a0[2]) * bflo(pw.y); o0[3] = bfhi(hw.y) + sigm(a0[3]) * bfhi(pw.y);
                o1[0] = bflo(hw.z) + sigm(a1[0]) * bflo(pw.z); o1[1] = bfhi(hw.z) + sigm(a1[1]) * bfhi(pw.z); o1[2] = bflo(hw.w) + sigm(a1[2]) * bflo(pw.w); o1[3] = bfhi(hw.w) + sigm(a1[3]) * bfhi(pw.w);
                *(f32x4*)(out + off + bj * 128) = o0; *(f32x4*)(out + off + bj * 128 + 4) = o1; }
            if (g + 4 < 8) { EF_LD(g + 4); }
            asm volatile("" ::: "memory"); }
#undef EF_LD
    }
};

__device__ __forceinline__ void p0_transpose_item(const float* W, int K, int N, bf16_t* WT, const float* ks0, const float* ks1, int ksplit, LAS float* scr, int item, int lane) {
    const int nblk = N / 32, kb = item / nblk, nb = item % nblk, k0 = 64 * kb, n0 = 32 * nb;
#pragma unroll 8
    for (int i = 0; i < 32; ++i) { const int kk = 2 * i + (lane >> 5), k = k0 + kk; float s = 1.f; if (ks0) s = (k < ksplit) ? ks0[k] : ks1[k - ksplit];
        scr[kk * 33 + (lane & 31)] = W[(size_t)k * N + n0 + (lane & 31)] * s; }
    asm volatile("s_waitcnt lgkmcnt(0)" ::: "memory");
    const int c = lane & 7;
#pragma unroll
    for (int j = 0; j < 4; ++j) { const int n = (lane >> 3) + 8 * j; const LAS float* s = scr + (8 * c) * 33 + n;
        u32x4 o; o.x = cvtpk(s[0 * 33], s[1 * 33]); o.y = cvtpk(s[2 * 33], s[3 * 33]); o.z = cvtpk(s[4 * 33], s[5 * 33]); o.w = cvtpk(s[6 * 33], s[7 * 33]);
        *(u32x4*)(WT + (size_t)(n0 + n) * K + k0 + 8 * c) = o; }
    asm volatile("s_waitcnt lgkmcnt(0)" ::: "memory");
}
__device__ __forceinline__ void attn_phase(LAS unsigned char* lds, const bf16_t* PROJ, const bf16_t* VT, const float* gq, const float* gk, const float* rb, bf16_t* MERGED, int vcu, int G, const int wave_u) {
    int tid_ = wave_u * 64 + lane_id_v(); asm volatile("" : "+v"(tid_));
    const int tid = tid_, lane = tid & 63, h = __builtin_amdgcn_readfirstlane(tid >> 6), ql = lane & 31, hi = lane >> 5;
    LAS float* SQ = (LAS float*)lds;
    LAS float* EXT = (LAS float*)(lds + 2048) + h * 640;
    float mq = wave_max(fabsf(gq[lane])), mk = wave_max(fabsf(gk[lane])); float mb = -1e30f;
    for (int i = lane; i < 513; i += 64) mb = fmaxf(mb, rb[h * 513 + i]);
    mb = wave_max(mb);
    const float mshift = (8.f * mq * mk + mb) * LOG2E;
    const float cconst = rb[h * 513 + 512] * LOG2E - mshift;
    for (int i = lane; i < 640; i += 64) { int rel = i - 64; rel = rel > 256 ? 256 : (rel < -256 ? -256 : rel); EXT[i] = rb[h * 513 + rel + 256] * LOG2E - mshift; }
    asm volatile("s_waitcnt lgkmcnt(0)" ::: "memory");
    __syncthreads();
    for (int unit = vcu; unit < NUNIT_ATT; unit += G) {
        const int b = unit >> 7, n = unit & 127; const long tok0 = (long)b * SEQ_ + n * 64;
        bf16x8 qf[2][4];
        { const bf16_t* qp = PROJ + (tok0 + ql) * PJW + 1024 + h * 64 + hi * 8;
#pragma unroll
          for (int qb = 0; qb < 2; ++qb)
#pragma unroll
              for (int d0 = 0; d0 < 4; ++d0) qf[qb][d0] = *(const bf16x8*)(qp + (long)qb * 32 * PJW + d0 * 16); }
        f32x16 o[2][2];
#pragma unroll
        for (int a = 0; a < 2; ++a)
#pragma unroll
            for (int c = 0; c < 2; ++c)
#pragma unroll
                for (int r = 0; r < 16; ++r) o[a][c][r] = 0.f;
        float lsum[2] = {0.f, 0.f};
        f32x16 CC;
#pragma unroll
        for (int r = 0; r < 16; ++r) CC[r] = cconst;
        asm volatile("" : "+v"(CC));
        const int it0 = (n < 8) ? 2 * (8 - n) : 0;
        const bf16_t* kbase = PROJ + (tok0 - 512 + ql) * PJW + 1536 + h * 64 + hi * 8;
        const bf16_t* vbase = VT + (long)(h * 64 + ql) * T_ + (tok0 - 512) + 8 * hi;
        bf16x8 kn[4], vn[2][2];
#define LOADKV(IT) do { const bf16_t* kp_ = kbase + (long)(IT) * 32 * PJW; const bf16_t* vp_ = vbase + (IT) * 32; \
        _Pragma("unroll") for (int d0 = 0; d0 < 4; ++d0) kn[d0] = *(const bf16x8*)(kp_ + d0 * 16); \
        _Pragma("unroll") for (int db = 0; db < 2; ++db) _Pragma("unroll") for (int ks = 0; ks < 2; ++ks) vn[db][ks] = *(const bf16x8*)(vp_ + (long)db * 32 * T_ + ks * 16); } while (0)
        LOADKV(it0);
        for (int it = it0; it < 18; ++it) {
            bf16x8 kf[4], vf[2][2];
#pragma unroll
            for (int d0 = 0; d0 < 4; ++d0) kf[d0] = kn[d0];
#pragma unroll
            for (int db = 0; db < 2; ++db)
#pragma unroll
                for (int ks = 0; ks < 2; ++ks) vf[db][ks] = vn[db][ks];
            { const int itn = (it + 1 < 18) ? it + 1 : it; LOADKV(itn); }
            const bool tab = (it >= 8);
#pragma unroll
            for (int qb = 0; qb < 2; ++qb) {
                f32x16 s;
                if (tab) { const LAS float* e = EXT + (576 + 32 * qb + ql - 32 * it - 4 * hi); f32x16 cin;
#pragma unroll
                    for (int r = 0; r < 16; ++r) cin[r] = e[-((r & 3) + 8 * (r >> 2))];
                    s = MFMA32(kf[0], qf[qb][0], cin); }
                else s = MFMA32(kf[0], qf[qb][0], CC);
#pragma unroll
                for (int d0 = 1; d0 < 4; ++d0) s = MFMA32(kf[d0], qf[qb][d0], s);
                float ps = 0.f;
#pragma unroll
                for (int r = 0; r < 16; ++r) { s[r] = ex2(s[r]); ps += s[r]; }
                lsum[qb] += ps;
                bf16x8 pk[2];
#pragma unroll
                for (int ks = 0; ks < 2; ++ks) { u32x4 w; w.x = cvtpk(s[8 * ks], s[8 * ks + 1]); w.y = cvtpk(s[8 * ks + 2], s[8 * ks + 3]); w.z = cvtpk(s[8 * ks + 4], s[8 * ks + 5]); w.w = cvtpk(s[8 * ks + 6], s[8 * ks + 7]);
                    pk[ks] = __builtin_bit_cast(bf16x8, w); }
#pragma unroll
                for (int db = 0; db < 2; ++db)
#pragma unroll
                    for (int ks = 0; ks < 2; ++ks) o[db][qb] = MFMA32(vf[db][ks], pk[ks], o[db][qb]);
            }
        }
#undef LOADKV
        float inv[2], sq[2];
#pragma unroll
        for (int qb = 0; qb < 2; ++qb) { float l = lsum[qb]; l += __shfl_xor(l, 32); inv[qb] = 1.f / l; float q2 = 0.f;
#pragma unroll
            for (int db = 0; db < 2; ++db)
#pragma unroll
                for (int r = 0; r < 16; ++r) { const float v = o[db][qb][r] * inv[qb]; o[db][qb][r] = v; q2 += v * v; }
            q2 += __shfl_xor(q2, 32); sq[qb] = q2;
            if (hi == 0) SQ[h * 64 + 32 * qb + ql] = q2; }
        asm volatile("s_waitcnt lgkmcnt(0)" ::: "memory");
        __syncthreads();
#pragma unroll
        for (int qb = 0; qb < 2; ++qb) { float tot = 0.f;
#pragma unroll
            for (int hh = 0; hh < 8; ++hh) tot += SQ[hh * 64 + 32 * qb + ql];
            const float rstd = rsqf_(tot * (1.f / 512.f) + EPS_);
            bf16_t* op = MERGED + (tok0 + 32 * qb + ql) * DM_ + 512 + h * 64 + 4 * hi;
#pragma unroll
            for (int db = 0; db < 2; ++db)
#pragma unroll
                for (int r4 = 0; r4 < 4; ++r4) { u32x2 w; w.x = cvtpk(o[db][qb][4 * r4] * rstd, o[db][qb][4 * r4 + 1] * rstd); w.y = cvtpk(o[db][qb][4 * r4 + 2] * rstd, o[db][qb][4 * r4 + 3] * rstd);
                    *(u32x2*)(op + 32 * db + 8 * r4) = w; } }
        __syncthreads();
    }
}

template <bool PASS2>
__device__ __forceinline__ void lru_unit(LAS unsigned char* lds, int unit, const bf16_t* PROJ, const bf16_t* WGT, const float* conv_w, const float* conv_b, const float* b_rg, const float* b_ig,
                                         const float* lam, f32x2* SUMM, bf16_t* MERGED, const int wave_u) {
    int tid_ = wave_u * 64 + lane_id_v(); asm volatile("" : "+v"(tid_));
    const int tid = tid_, lane = tid & 63, w = __builtin_amdgcn_readfirstlane(tid >> 6), ql = lane & 31, hi = lane >> 5;
    const int b = unit >> 5, seg = unit & 31; const long tok0 = (long)b * SEQ_ + seg * 256;
    LAS bf16_t* XC = (LAS bf16_t*)lds + w * (64 * 72);
    LAS bf16_t* YT = (LAS bf16_t*)(lds + 73728);
    const int chc = 64 * w + lane;
    const float cw0 = conv_w[chc], cw1 = conv_w[512 + chc], cw2 = conv_w[1024 + chc], cw3 = conv_w[1536 + chc], cbv = conv_b[chc];
    float brg[2], big[2], sp[2];
#pragma unroll
    for (int nb = 0; nb < 2; ++nb) { const int ch = 64 * w + 32 * nb + ql; brg[nb] = b_rg[ch]; big[nb] = b_ig[ch];
        sp[nb] = -8.f * LOG2E * log1pf(expf(-lam[ch])); }
    float carry[2] = {0.f, 0.f}, ptot[2] = {1.f, 1.f};
    if (PASS2) {
#pragma unroll
        for (int nb = 0; nb < 2; ++nb) { float c = 0.f; const f32x2* sp_ = SUMM + (size_t)(b * 32) * 512 + 64 * w + 32 * nb + ql;
            for (int s0 = 0; s0 < seg; s0 += 8) { f32x2 v[8];
#pragma unroll
                for (int j = 0; j < 8; ++j) v[j] = (s0 + j < seg) ? sp_[(size_t)(s0 + j) * 512] : (f32x2){1.f, 0.f};
#pragma unroll
                for (int j = 0; j < 8; ++j) c = v[j].x * c + v[j].y; }
            carry[nb] = c; }
    }
#pragma nounroll
    for (int st = 0; st < 4; ++st) {
        const long t0 = tok0 + 64 * st;
        {
            const bf16_t* xp = PROJ + t0 * PJW + chc;
            float x1 = 0.f, x2 = 0.f, x3 = 0.f;
            if (seg != 0 || st != 0) { x1 = bf2f(xp[-1 * PJW]); x2 = bf2f(xp[-2 * PJW]); x3 = bf2f(xp[-3 * PJW]); }
#pragma unroll 16
            for (int t = 0; t < 64; ++t) { const float xv = bf2f(xp[(long)t * PJW]); const float xc = cbv + cw0 * x3 + cw1 * x2 + cw2 * x1 + cw3 * xv;
                XC[t * 72 + lane] = (bf16_t)(cvtpk(xc, 0.f) & 0xffffu); x3 = x2; x2 = x1; x1 = xv; }
        }
        asm volatile("s_waitcnt lgkmcnt(0)" ::: "memory");
#pragma unroll
        for (int nb = 0; nb < 2; ++nb) {
            bf16x8 wrf[4], wif[4];
            { int woff = ((w * 64 + 32 * nb + ql) * 64 + 8 * hi); asm volatile("" : "+v"(woff));
#pragma unroll
              for (int ks = 0; ks < 4; ++ks) { wrf[ks] = *(const bf16x8*)(WGT + woff + 16 * ks); wif[ks] = *(const bf16x8*)(WGT + 8 * 4096 + woff + 16 * ks); } }
#pragma unroll
            for (int tb = 0; tb < 2; ++tb) {
                bf16x8 af[4];
#pragma unroll
                for (int ks = 0; ks < 4; ++ks) af[ks] = *(const LAS bf16x8*)(XC + (32 * tb + ql) * 72 + 16 * ks + 8 * hi);
                f32x16 dr, di;
#pragma unroll
                for (int r = 0; r < 16; ++r) { dr[r] = 0.f; di[r] = 0.f; }
#pragma unroll
                for (int ks = 0; ks < 4; ++ks) { dr = MFMA32(af[ks], wrf[ks], dr); di = MFMA32(af[ks], wif[ks], di); }
                float A[16], U[16];
#pragma unroll
                for (int r = 0; r < 16; ++r) { const int tok = 32 * tb + crow(r, hi); const float xcv = bf2f(XC[tok * 72 + 32 * nb + ql]);
                    const float rg = sigm(dr[r] + brg[nb]), ig = sigm(di[r] + big[nb]); const float a = ex2(rg * sp[nb]);
                    const float mult = __builtin_amdgcn_sqrtf(fmaxf(1.f - a * a, 0.f)); A[r] = a; U[r] = mult * ig * xcv; }
#pragma unroll
                for (int q4 = 0; q4 < 4; ++q4)
#pragma unroll
                    for (int e = 1; e < 4; ++e) { U[4 * q4 + e] = A[4 * q4 + e] * U[4 * q4 + e - 1] + U[4 * q4 + e]; A[4 * q4 + e] = A[4 * q4 + e - 1] * A[4 * q4 + e]; }
                float c = carry[nb], HIN[4];
#pragma unroll
                for (int q4 = 0; q4 < 4; ++q4) { const float e0 = A[4 * q4 + 3] * c + U[4 * q4 + 3]; const float p = __shfl_xor(e0, 32); const float hin = hi ? p : c; HIN[q4] = hin;
                    const float e1 = A[4 * q4 + 3] * hin + U[4 * q4 + 3]; const float q = __shfl_xor(e1, 32); c = hi ? e1 : q; }
                carry[nb] = c;
                if (!PASS2) { const float po = (A[3] * A[7]) * (A[11] * A[15]); ptot[nb] *= po * __shfl_xor(po, 32); }
                else {
                    const bf16_t* gb = PROJ + t0 * PJW + 512 + 64 * w + 32 * nb + (32 * tb) * PJW;
                    const unsigned goff = (unsigned)(4 * hi) * PJW + ql;
#pragma unroll
                    for (int r = 0; r < 16; ++r) { const int tok = 32 * tb + crow(r, hi); const float hval = U[r] + A[r] * HIN[r >> 2]; const float gl = bf2f(gb[goff + (unsigned)((r & 3) + 8 * (r >> 2)) * PJW]);
                        YT[tok * 520 + 64 * w + 32 * nb + ql] = (bf16_t)(cvtpk(hval * gl, 0.f) & 0xffffu); }
                }
            }
        }
        if (PASS2) {
            asm volatile("s_waitcnt lgkmcnt(0)" ::: "memory");
            __syncthreads();
#pragma unroll
            for (int i = 0; i < 8; ++i) { const int tok = 8 * w + i; const u32x4 v = *(const LAS u32x4*)(YT + tok * 520 + 8 * lane);
                const float f0 = bflo(v.x), f1 = bfhi(v.x), f2 = bflo(v.y), f3 = bfhi(v.y), f4 = bflo(v.z), f5 = bfhi(v.z), f6 = bflo(v.w), f7 = bfhi(v.w);
                float ss = (f0 * f0 + f1 * f1) + (f2 * f2 + f3 * f3) + (f4 * f4 + f5 * f5) + (f6 * f6 + f7 * f7); ss = wave_sum(ss);
                const float rs = rsqf_(ss * (1.f / 512.f) + EPS_);
                u32x4 o; o.x = cvtpk(f0 * rs, f1 * rs); o.y = cvtpk(f2 * rs, f3 * rs); o.z = cvtpk(f4 * rs, f5 * rs); o.w = cvtpk(f6 * rs, f7 * rs);
                *(u32x4*)(MERGED + (t0 + tok) * DM_ + 8 * lane) = o; }
            __syncthreads();
        }
        asm volatile("" ::: "memory");
    }
    if (!PASS2) { if (hi == 0) {
#pragma unroll
        for (int nb = 0; nb < 2; ++nb) SUMM[(size_t)unit * 512 + 64 * w + 32 * nb + ql] = (f32x2){ptot[nb], carry[nb]}; } }
}

#ifndef PROBE_MASK
#define PROBE_MASK 0
#endif
#ifndef RES_BF16
#define RES_BF16 1
#endif
struct Args { const float* in[23]; float* out; unsigned char* ws; };
__global__ void __launch_bounds__(NTHR, 2) fwd_megakernel(Args args) {
    extern __shared__ __attribute__((aligned(16))) unsigned char lds_raw[];
    cg::grid_group grid = cg::this_grid();
    LAS unsigned char* lds = (LAS unsigned char*)lds_raw;
    const int wave = __builtin_amdgcn_readfirstlane(threadIdx.x >> 6);
#define tid (wave * 64 + lane_id_v())
#define lane (lane_id_v())
    const int G = gridDim.x, bx = blockIdx.x, vcu = (G % 8 == 0) ? (bx % 8) * (G / 8) + bx / 8 : bx;
    unsigned char* ws = args.ws;
    volatile LAS unsigned* MISC = (volatile LAS unsigned*)(lds + MISC_OFF);
    if (threadIdx.x < 16) MISC[threadIdx.x] = 0u;
    __syncthreads();
    XcdBarrier bar; bar.bar = (unsigned*)(ws + WS_CTL); bar.x = xb_xcc_id(); bar.st = MISC;
    if (blockIdx.x == 0) for (int i = threadIdx.x; i < (int)(CTL_BYTES / 4); i += NTHR) bar.bar[i] = 0u;
    const float* x = args.in[0]; const float* p = args.in[1]; float* out = args.out;
    bf16_t* WT_IN = (bf16_t*)(ws + WS_WIN); bf16_t* WT_OUT = (bf16_t*)(ws + WS_WOUT); bf16_t* WT_UP = (bf16_t*)(ws + WS_WUP); bf16_t* WT_DN = (bf16_t*)(ws + WS_WDN);
    bf16_t* WT_PG = (bf16_t*)(ws + WS_WPG); bf16_t* WT_PP = (bf16_t*)(ws + WS_WPP); bf16_t* WGT = (bf16_t*)(ws + WS_WG);
    float* RSTD1 = (float*)(ws + WS_RSTD1); float* RSTD2 = (float*)(ws + WS_RSTD2); f32x2* SUMM = (f32x2*)(ws + WS_SUMM);
    bf16_t* XN = (bf16_t*)(ws + WS_XN); bf16_t* PP = (bf16_t*)(ws + WS_PP); bf16_t* PB = (bf16_t*)(ws + WS_PB);
    bf16_t* PROJ = (bf16_t*)(ws + WS_PROJ); bf16_t* VT = (bf16_t*)(ws + WS_VT); bf16_t* MERGED = (bf16_t*)(ws + WS_MERGED); bf16_t* ACT = (bf16_t*)(ws + WS_ACT);

    for (int rep_ = 0; rep_ < 1 + ((PROBE_MASK >> 0) & 1); ++rep_) {
        LAS float* scr = (LAS float*)(lds + wave * 16384);
        const int gw = vcu * NWAVES + wave, NGW = G * NWAVES;
        constexpr int I_IN = 16 * 80, I_OUT = 16 * 32, I_UP = 16 * 128, I_DN = 64 * 32, I_PG = 16 * 32, I_PP = 4 * 32;
        constexpr int NITEMS = I_IN + I_OUT + I_UP + I_DN + I_PG + I_PP;
        for (int it = gw; it < NITEMS; it += NGW) {
            int r = it;
            if (r < I_IN) { p0_transpose_item(args.in[3], 1024, 2560, WT_IN, nullptr, nullptr, 0, scr, r, lane); continue; } r -= I_IN;
            if (r < I_OUT) { p0_transpose_item(args.in[16], 1024, 1024, WT_OUT, args.in[14], args.in[15], 512, scr, r, lane); continue; } r -= I_OUT;
            if (r < I_UP) { p0_transpose_item(args.in[18], 1024, 4096, WT_UP, args.in[17], args.in[17], 1 << 30, scr, r, lane); continue; } r -= I_UP;
            if (r < I_DN) { p0_transpose_item(args.in[19], 4096, 1024, WT_DN, nullptr, nullptr, 0, scr, r, lane); continue; } r -= I_DN;
            if (r < I_PG) { p0_transpose_item(args.in[21], 1024, 1024, WT_PG, args.in[20], args.in[20], 1 << 30, scr, r, lane); continue; } r -= I_PG;
            p0_transpose_item(args.in[22], 256, 1024, WT_PP, nullptr, nullptr, 0, scr, r, lane);
        }
        for (int i = bx * NTHR + tid; i < T_; i += G * NTHR) { RSTD1[i] = 0.f; RSTD2[i] = 0.f; }
        for (int i = bx * NTHR + tid; i < 65536; i += G * NTHR) { const int k = i & 63, n = (i >> 6) & 63, blk = (i >> 12) & 7, gate = i >> 15;
            const float v = (gate ? args.in[8] : args.in[6])[blk * 4096 + k * 64 + n]; WGT[i] = (bf16_t)(cvtpk(v, 0.f) & 0xffffu); }
        const float* g1 = args.in[2];
        f32x4 gv[4];
#pragma unroll
        for (int j = 0; j < 4; ++j) gv[j] = *((const f32x4*)g1 + lane + 64 * j);
        for (int m = gw; m < T_; m += NGW) {
            const f32x4* xr = (const f32x4*)(x + (size_t)m * DM_) + lane; f32x4 v[4]; float s = 0.f;
#pragma unroll
            for (int j = 0; j < 4; ++j) { v[j] = __builtin_nontemporal_load(xr + 64 * j); s += (v[j].x * v[j].x + v[j].y * v[j].y) + (v[j].z * v[j].z + v[j].w * v[j].w); }
            const float rstd = rsqf_(wave_sum(s) * (1.f / DM_) + EPS_);
            u32x2* o8 = (u32x2*)(XN + (size_t)m * DM_) + lane;
#pragma unroll
            for (int j = 0; j < 4; ++j) { const f32x4 y = v[j] * gv[j] * rstd; u32x2 w; w.x = cvtpk(y.x, y.y); w.y = cvtpk(y.z, y.w); o8[64 * j] = w; }
            const f32x4 pv = __builtin_nontemporal_load((const f32x4*)(p + (size_t)m * PLE_) + lane); u32x2 pw; pw.x = cvtpk(pv.x, pv.y); pw.y = cvtpk(pv.z, pv.w);
            *((u32x2*)(PB + (size_t)m * PLE_) + lane) = pw;
        }
    }
    grid.sync();
    if (threadIdx.x == 0) MISC[2] = xb_add(&bar.bar[XB_XCNT(bar.x)], 1u);
    int cid = bx, vcu2 = vcu;
#define CENSUS_IDS() do { \
    if (threadIdx.x == 0) { unsigned okc = 1u; \
        for (unsigned j = 0; j < 16; ++j) { const unsigned c_ = xb_ld(&bar.bar[XB_XCNT(j)]); okc &= (j < 8 ? (c_ == (unsigned)G / 8u) : (c_ == 0u)) ? 1u : 0u; } \
        MISC[3] = (okc && (G % 8 == 0)) ? 1u : 0u; } \
    __syncthreads(); \
    { const bool okmap = MISC[3] != 0u; \
      cid = __builtin_amdgcn_readfirstlane(okmap ? (int)(MISC[2] * 8u + bar.x) : bx); \
      vcu2 = __builtin_amdgcn_readfirstlane(okmap ? (int)(bar.x * (unsigned)(G / 8) + MISC[2]) : vcu); } } while (0)
#if 0
    if (threadIdx.x == 0) { unsigned okc = 1u;
        for (unsigned j = 0; j < 16; ++j) { const unsigned c_ = xb_ld(&bar.bar[XB_XCNT(j)]); okc &= (j < 8 ? (c_ == (unsigned)G / 8u) : (c_ == 0u)) ? 1u : 0u; }
        MISC[3] = (okc && (G % 8 == 0)) ? 1u : 0u; }
    __syncthreads();
    const bool okmap = MISC[3] != 0u;
    const int cid = __builtin_amdgcn_readfirstlane(okmap ? (int)(MISC[2] * 8u + bar.x) : bx);
    const int vcu2 = __builtin_amdgcn_readfirstlane(okmap ? (int)(bar.x * (unsigned)(G / 8) + MISC[2]) : vcu);
#endif
    for (int rep_ = 0; rep_ < 1 + ((PROBE_MASK >> 1) & 1); ++rep_) {
        { pg8::Gemm g{XN, WT_IN, T_, 2048, 1024}; pg8::StaticOrder S; S.init(T_, 2048, G, cid); EpiProj E{PROJ, args.in[11], args.in[12]};
          pg8::gemm_phase<EpiProj, pg8::StaticOrder, PG8_ALIGN, PG8_SP2>(lds, g, S, E, wave); }
        { pg8::Gemm g{WT_IN + (size_t)2048 * 1024, XN, 512, T_, 1024}; pg8::StaticOrder S; S.init(512, T_, G, cid); EpiVT E{VT};
          pg8::gemm_phase<EpiVT, pg8::StaticOrder, PG8_ALIGN, PG8_SP2>(lds, g, S, E, wave); }
    }
    xcd_barrier(bar);
    CENSUS_IDS();
    for (int rep_ = 0; rep_ < 1 + ((PROBE_MASK >> 2) & 1); ++rep_)
    attn_phase(lds, PROJ, VT, args.in[11]  , args.in[12], args.in[13], MERGED, vcu2, G, wave);
    for (int rep_ = 0; rep_ < 1 + ((PROBE_MASK >> 3) & 1); ++rep_)
    for (int unit = vcu2; unit < NUNIT_LRU; unit += G)
        lru_unit<false>(lds, unit, PROJ, WGT, args.in[4], args.in[5], args.in[7], args.in[9], args.in[10], SUMM, MERGED, wave);
    xcd_barrier(bar);
    for (int rep_ = 0; rep_ < 1 + ((PROBE_MASK >> 4) & 1); ++rep_)
    for (int unit = vcu2; unit < NUNIT_LRU; unit += G)
        lru_unit<true>(lds, unit, PROJ, WGT, args.in[4], args.in[5], args.in[7], args.in[9], args.in[10], SUMM, MERGED, wave);
    xcd_barrier(bar);
#if RES_BF16
    { pg8::Gemm g{MERGED, WT_OUT, T_, 1024, 1024}; pg8::StaticOrder S; S.init(T_, 1024, G, cid); EpiRes4 E{x, XN, RSTD1};
      pg8::gemm_phase<EpiRes4, pg8::StaticOrder, PG8_ALIGN, PG8_SP2>(lds, g, S, E, wave); }
#else
    for (int rep_ = ((PROBE_MASK >> 5) & 1) ? 0 : 1; rep_ < 2; ++rep_)
    { pg8::Gemm g{MERGED, WT_OUT, T_, 1024, 1024}; pg8::StaticOrder S; S.init(T_, 1024, G, cid); EpiRes E{x, out, XN, rep_ ? RSTD1 : (float*)(ws + WS_DUMMY), 0xFFFF};
      pg8::gemm_phase<EpiRes, pg8::StaticOrder, PG8_ALIGN, PG8_SP2>(lds, g, S, E, wave); }
#endif
    xcd_barrier(bar);
    for (int rep_ = 0; rep_ < 1 + ((PROBE_MASK >> 6) & 1); ++rep_) { pg8::Gemm g{XN, WT_UP, T_, 4096, 1024}; pg8::StaticOrder S; S.init(T_, 4096, G, cid, 1); EpiUp E{ACT, RSTD1};
      pg8::gemm_phase<EpiUp, pg8::StaticOrder, PG8_ALIGN, PG8_SP2, (PROBE_MASK >> 9) & 1>(lds, g, S, E, wave); }
    xcd_barrier(bar);
#if RES_BF16
    { pg8::Gemm g{ACT, WT_DN, T_, 1024, 4096}; pg8::StaticOrder S; S.init(T_, 1024, G, cid); EpiRes6 E{XN, RSTD2};
      pg8::gemm_phase<EpiRes6, pg8::StaticOrder, PG8_ALIGN, PG8_SP2>(lds, g, S, E, wave); }
#else
    for (int rep_ = ((PROBE_MASK >> 7) & 1) ? 0 : 1; rep_ < 2; ++rep_)
    { pg8::Gemm g{ACT, WT_DN, T_, 1024, 4096}; pg8::StaticOrder S; S.init(T_, 1024, G, cid);
      EpiRes E{out, rep_ ? out : (float*)(ws + WS_END), XN, rep_ ? RSTD2 : (float*)(ws + WS_DUMMY), rep_ ? 0xFFFF : 0x7FFF};
      pg8::gemm_phase<EpiRes, pg8::StaticOrder, PG8_ALIGN, PG8_SP2>(lds, g, S, E, wave); }
#endif
    xcd_barrier(bar);
#if RES_BF16
    { pg8::StaticOrder S; S.init(T_, 1024, G, cid, 1); EpiMidPP EM{(u32x4*)(ws + WS_PP) + (size_t)bx * 8192}; EpiFinalC EF{XN, out, RSTD2, (const u32x4*)(ws + WS_PP) + (size_t)bx * 8192};
      pg8::gemm_phase_ple<EpiMidPP, EpiFinalC, pg8::StaticOrder>(lds, PB, WT_PP, XN, WT_PG, S, EM, EF, wave); }
#else
    for (int rep_ = ((PROBE_MASK >> 8) & 1) ? 0 : 1; rep_ < 2; ++rep_)
    { pg8::Gemm g{XN, WT_PG, T_, 1024, 1024}; pg8::StaticOrder S; S.init(T_, 1024, G, cid); EpiFinal E{out, rep_ ? out : (float*)ACT, PP, RSTD2};
      pg8::gemm_phase<EpiFinal, pg8::StaticOrder, PG8_ALIGN, PG8_SP2>(lds, g, S, E, wave); }
#endif
}

#undef tid
#undef lane
extern "C" void kernel_launch(void* const* d_in, const int* in_sizes, int n_in, void* d_out, int out_size, void* d_ws, size_t ws_size, hipStream_t stream) {
    static int grid = 0;
    if (grid == 0) {
        if (n_in != 23 || in_sizes[0] != T_ * DM_ || out_size != T_ * DM_ || ws_size < WS_END) { fprintf(stderr, "kernel_launch: unexpected shapes (n_in %d, in0 %d, out %d, ws %zu)\n", n_in, n_in > 0 ? in_sizes[0] : -1, out_size, ws_size); grid = -1; return; }
        int dev = 0, cus = 0, per_cu = 0;
        (void)hipGetDevice(&dev); (void)hipDeviceGetAttribute(&cus, hipDeviceAttributeMultiprocessorCount, dev);
        (void)hipFuncSetAttribute((const void*)fwd_megakernel, hipFuncAttributeMaxDynamicSharedMemorySize, LDS_BYTES);
        if (hipOccupancyMaxActiveBlocksPerMultiprocessor(&per_cu, (const void*)fwd_megakernel, NTHR, LDS_BYTES) != hipSuccess || per_cu < 1) per_cu = 1;
        (void)hipGetLastError();
        grid = cus * per_cu;
        if (grid > 256) grid = 256;
        fprintf(stderr, "kernel_launch: cus %d per_cu %d grid %d\n", cus, per_cu, grid);
    }
    if (grid < 0) return;
    Args a{};
    for (int i = 0; i < 23; ++i) a.in[i] = (const float*)d_in[i];
    a.out = (float*)d_out; a.ws = (unsigned char*)d_ws;
    void* kargs[] = {&a};
    hipError_t e = hipLaunchCooperativeKernel((const void*)fwd_megakernel, dim3(grid), dim3(NTHR), kargs, LDS_BYTES, stream);
    if (e != hipSuccess) fprintf(stderr, "kernel_launch: cooperative launch failed: %s (grid %d)\n", hipGetErrorString(e), grid);
}
```

```cpp
#include <hip/hip_runtime.h>
#include <hip/hip_cooperative_groups.h>
#include <cstdio>
#include <cstdint>
namespace cg = cooperative_groups;
__device__ __forceinline__ int lane_id_v() { int l; asm volatile("v_mbcnt_lo_u32_b32 %0, -1, 0\n\tv_mbcnt_hi_u32_b32 %0, -1, %0" : "=v"(l)); return l; }
namespace pg8 {
#define PG8_LAS __attribute__((address_space(3)))
typedef unsigned short bf16_t;
typedef short bf16x8 __attribute__((ext_vector_type(8)));
typedef float f32x4 __attribute__((ext_vector_type(4)));
typedef unsigned u32x4 __attribute__((ext_vector_type(4)));
constexpr int BM = 256, BK = 64, HALF = 128, HTB = HALF * BK * 2  , STAGE_BYTES = 8 * HTB, NXCD = 8, WGM = 8;

__host__ __device__ __forceinline__ int lds_byte(int r, int c) { const int st = (r >> 4) * 2 + (c >> 5), rr = r & 15, cc = c & 31, ob = rr * 64 + cc * 2; return st * 1024 + (ob ^ (((ob >> 9) & 1) << 5)); }
__host__ __device__ __forceinline__ void stage_rc(int b, int& R, int& C) { const int st = b / 1024, sb = b % 1024, swz = sb ^ (((sb >> 9) & 1) << 5); R = (st >> 1) * 16 + swz / 64; C = (st & 1) * 32 + (swz % 64) / 2; }
__host__ __device__ __forceinline__ int perm32(int rho) { const int n = rho >> 4, i = rho & 15; return 8 * (i >> 2) + 4 * n + (i & 3); }

struct Unit { int pm, pn; };
struct Gemm { const bf16_t* A; const bf16_t* Bt; int M, N, K; };

struct StaticOrder {
    int nM, nN, nwg, G, c;
    __host__ __device__ void init(int M, int N, int G_, int c_) { nM = M / BM; nN = N / BM; nwg = nM * nN; G = G_; c = c_; }
    __host__ __device__ bool next(int i, Unit& u) const {
        const long L = (long)i * G + c; if (L >= nwg) return false;
        int wgid = (int)L; { const int q = nwg / NXCD, r = nwg % NXCD, xcd = wgid % NXCD, off = wgid / NXCD; wgid = (xcd < r ? xcd * (q + 1) : r * (q + 1) + (xcd - r) * q) + off; }
        const int nig = WGM * nN, gid = wgid / nig, fm = gid * WGM, gsz = (nM - fm) < WGM ? (nM - fm) : WGM;
        u.pm = fm + ((wgid % nig) % gsz); u.pn = (wgid % nig) / gsz; return true;
    }
    __device__ __forceinline__ void a_ready(const Unit&) const {}
    __device__ __forceinline__ void done(const Unit&) const {}
};

__device__ __forceinline__ unsigned cvt_pk_bf16(float lo, float hi) { unsigned r; asm volatile("v_cvt_pk_bf16_f32 %0, %1, %2" : "=v"(r) : "v"(lo), "v"(hi)); return r; }
typedef float f32x2 __attribute__((ext_vector_type(2)));
template <class Epi, class Sched, bool ALIGN_EPI = false, bool SP2 = false, bool EPI2 = false>
__device__ __forceinline__ void gemm_phase(PG8_LAS unsigned char* lds, const Gemm g, const Sched& S, const Epi& E, const int wave_u) {
    int tid_ = wave_u * 64 + lane_id_v(); asm volatile("" : "+v"(tid_));
    const int tid = tid_, wid = __builtin_amdgcn_readfirstlane(tid >> 6), lane = tid & 63, wr = wid >> 2, wc = wid & 3, fr = lane & 15, fq = lane >> 4;
    const int K = g.K, nt = K / BK;
    unsigned voffA[2], voffB[2];
#pragma unroll
    for (int i = 0; i < 2; ++i) { int R, C; stage_rc(tid * 16 + i * 8192, R, C); const int Rp = Epi::PERM ? perm32(R & 31) : (R & 31); const int Rb = Epi::HEADMAP ? (64 * (R >> 5) + Rp) : ((R & ~31) + Rp);
        voffA[i] = (unsigned)(R * K + C) * 2u; voffB[i] = (unsigned)(Rb * K + C) * 2u; }
    const size_t kstep = (size_t)(BK * 2);
    const size_t hstep = (size_t)HALF * K * 2;
    const size_t hstepB = Epi::HEADMAP ? (size_t)32 * K * 2 : hstep;
    const size_t tstep = 2 * hstep;
    const unsigned ldsw = (unsigned)wid * 1024u;
    const int aoff = lds_byte(wr * 64 + fr, fq * 8), boff = lds_byte(wc * 32 + fr, fq * 8);
#define PG8_SA(b, h) (((b) * 2 + (h)) * HTB)
#define PG8_SB(b, h) ((4 + (b) * 2 + (h)) * HTB)
#define PG8_STAGE(bufoff, gbase, voff) do { _Pragma("unroll") for (int _i = 0; _i < 2; ++_i) \
        __builtin_amdgcn_global_load_lds((const unsigned*)((const char*)(gbase) + (voff)[_i]), (PG8_LAS unsigned*)(lds + (bufoff) + ldsw + _i * 8192), 16, 0, 0); } while (0)
#define PG8_LDA(dst, b, h) do { _Pragma("unroll") for (int m = 0; m < 4; ++m) _Pragma("unroll") for (int k = 0; k < 2; ++k) dst[m][k] = *(const PG8_LAS bf16x8*)(lds + PG8_SA(b, h) + aoff + m * 2048 + k * 1024); } while (0)
#define PG8_LDB(dst, b, h) do { _Pragma("unroll") for (int n = 0; n < 2; ++n) _Pragma("unroll") for (int k = 0; k < 2; ++k) dst[n][k] = *(const PG8_LAS bf16x8*)(lds + PG8_SB(b, h) + boff + n * 2048 + k * 1024); } while (0)
#define PG8_MMA(ai, bj, At, Bt) do { __builtin_amdgcn_s_setprio(1); _Pragma("unroll") for (int m = 0; m < 4; ++m) _Pragma("unroll") for (int n = 0; n < 2; ++n) _Pragma("unroll") for (int k = 0; k < 2; ++k) \
        acc[ai][bj][m][n] = __builtin_amdgcn_mfma_f32_16x16x32_bf16(Bt[n][k], At[m][k], acc[ai][bj][m][n], 0, 0, 0); __builtin_amdgcn_s_setprio(0); } while (0)
#define PG8_WAIT_V(n) asm volatile("s_waitcnt vmcnt(" #n ")" ::: "memory")
#define PG8_WAIT_L(n) asm volatile("s_waitcnt lgkmcnt(" #n ")" ::: "memory")
#define PG8_BAR __builtin_amdgcn_s_barrier()
#define PG8_SCHED __builtin_amdgcn_sched_barrier(0)
    Unit cur, nxt; int ui = 0;
    if (!S.next(0, cur)) return;
    f32x4 acc[2][2][4][2];
#pragma unroll
    for (int a = 0; a < 2; ++a)
#pragma unroll
        for (int b = 0; b < 2; ++b)
#pragma unroll
            for (int m = 0; m < 4; ++m)
#pragma unroll
                for (int n = 0; n < 2; ++n) acc[a][b][m][n] = (f32x4){0.f, 0.f, 0.f, 0.f};
    bf16x8 At[4][2], B0[2][2], B1[2][2];
    const char* cA = (const char*)g.A + (size_t)cur.pm * tstep; const char* cB = (const char*)g.Bt + (size_t)cur.pn * tstep;
    S.a_ready(cur);
    if constexpr (SP2) {
        PG8_STAGE(PG8_SB(0, 0), cB, voffB); PG8_STAGE(PG8_SB(0, 1), cB + hstepB, voffB); PG8_STAGE(PG8_SA(0, 0), cA, voffA); PG8_STAGE(PG8_SA(0, 1), cA + hstep, voffA);
        if (wr == 1) PG8_BAR;
        PG8_WAIT_V(2); PG8_BAR;
        PG8_STAGE(PG8_SB(1, 0), cB + kstep, voffB); PG8_STAGE(PG8_SA(1, 0), cA + kstep, voffA); PG8_STAGE(PG8_SB(1, 1), cB + hstepB + kstep, voffB);
        PG8_WAIT_V(6); PG8_BAR;
    } else {
        PG8_STAGE(PG8_SB(0, 0), cB, voffB); PG8_STAGE(PG8_SA(0, 0), cA, voffA); PG8_STAGE(PG8_SB(0, 1), cB + hstepB, voffB); PG8_STAGE(PG8_SA(0, 1), cA + hstep, voffA);
        if (wr == 1) PG8_BAR;
        PG8_WAIT_V(4); PG8_BAR;
        PG8_STAGE(PG8_SB(1, 0), cB + kstep, voffB); PG8_STAGE(PG8_SA(1, 0), cA + kstep, voffA); PG8_STAGE(PG8_SB(1, 1), cB + hstepB + kstep, voffB);
        PG8_WAIT_V(6); PG8_BAR;
    }
    for (;;) {
        const bool has_next = S.next(ui + 1, nxt);
        const char* nA = has_next ? (const char*)g.A + (size_t)nxt.pm * tstep : cA; const char* nB = has_next ? (const char*)g.Bt + (size_t)nxt.pn * tstep : cB;
#pragma nounroll
        for (int t = 0; t < nt; t += 2) {
            const bool last = (t == nt - 2);
            const char* a1 = cA + (size_t)(t + 1) * kstep;
            const char* a2 = last ? nA : cA + (size_t)(t + 2) * kstep; const char* b2 = last ? nB : cB + (size_t)(t + 2) * kstep;
            const char* a3 = a2 + kstep; const char* b3 = b2 + kstep;
            if (last && has_next) S.a_ready(nxt);
            if constexpr (SP2) {
            PG8_LDB(B0, 0, 0); PG8_LDB(B1, 0, 1); PG8_SCHED; PG8_LDA(At, 0, 0); PG8_STAGE(PG8_SA(1, 1), a1 + hstep, voffA);
            PG8_WAIT_V(8); PG8_WAIT_L(0); PG8_BAR; PG8_MMA(0, 0, At, B0); PG8_MMA(0, 1, At, B1); PG8_BAR; PG8_SCHED;
            PG8_LDA(At, 0, 1); PG8_STAGE(PG8_SB(0, 0), b2, voffB); PG8_STAGE(PG8_SB(0, 1), b2 + hstepB, voffB); PG8_STAGE(PG8_SA(0, 0), a2, voffA);
            PG8_WAIT_V(8); PG8_WAIT_L(0); PG8_BAR; PG8_MMA(1, 0, At, B0); PG8_MMA(1, 1, At, B1); PG8_BAR; PG8_SCHED;
            PG8_LDB(B0, 1, 0); PG8_LDB(B1, 1, 1); PG8_SCHED; PG8_LDA(At, 1, 0); PG8_STAGE(PG8_SA(0, 1), a2 + hstep, voffA);
            PG8_WAIT_V(8); PG8_WAIT_L(0); PG8_BAR; PG8_MMA(0, 0, At, B0); PG8_MMA(0, 1, At, B1); PG8_BAR; PG8_SCHED;
            PG8_LDA(At, 1, 1); PG8_STAGE(PG8_SB(1, 0), b3, voffB); PG8_STAGE(PG8_SB(1, 1), b3 + hstepB, voffB); PG8_STAGE(PG8_SA(1, 0), a3, voffA);
            PG8_WAIT_V(8); PG8_WAIT_L(0); PG8_BAR; PG8_MMA(1, 0, At, B0); PG8_MMA(1, 1, At, B1); PG8_BAR; PG8_SCHED;
            } else {
            PG8_LDB(B0, 0, 0); PG8_SCHED; PG8_LDA(At, 0, 0); PG8_STAGE(PG8_SA(1, 1), a1 + hstep, voffA);
            PG8_WAIT_L(8); PG8_BAR; PG8_WAIT_L(0); PG8_MMA(0, 0, At, B0); PG8_BAR; PG8_SCHED;
            PG8_LDB(B1, 0, 1); PG8_STAGE(PG8_SB(0, 0), b2, voffB);
            PG8_BAR; PG8_WAIT_L(0); PG8_MMA(0, 1, At, B1); PG8_BAR;
            PG8_LDA(At, 0, 1); PG8_STAGE(PG8_SA(0, 0), a2, voffA);
            PG8_BAR; PG8_WAIT_L(0); PG8_MMA(1, 0, At, B0); PG8_BAR; PG8_SCHED;
            PG8_STAGE(PG8_SB(0, 1), b2 + hstepB, voffB);
            PG8_WAIT_V(6); PG8_BAR; PG8_MMA(1, 1, At, B1); PG8_BAR;
            PG8_LDB(B0, 1, 0); PG8_SCHED; PG8_LDA(At, 1, 0); PG8_STAGE(PG8_SA(0, 1), a2 + hstep, voffA);
            PG8_WAIT_L(8); PG8_BAR; PG8_WAIT_L(0); PG8_MMA(0, 0, At, B0); PG8_BAR; PG8_SCHED;
            PG8_LDB(B1, 1, 1); PG8_STAGE(PG8_SB(1, 0), b3, voffB);
            PG8_BAR; PG8_WAIT_L(0); PG8_MMA(0, 1, At, B1); PG8_BAR;
            PG8_LDA(At, 1, 1); PG8_STAGE(PG8_SA(1, 0), a3, voffA);
            PG8_BAR; PG8_WAIT_L(0); PG8_MMA(1, 0, At, B0); PG8_BAR; PG8_SCHED;
            PG8_STAGE(PG8_SB(1, 1), b3 + hstepB, voffB);
            PG8_WAIT_V(6); PG8_BAR; PG8_MMA(1, 1, At, B1); PG8_BAR;
            }
        }
        if constexpr (ALIGN_EPI) { if (wr == 0) PG8_BAR; }
        if constexpr (!Epi::AFTER_DRAIN) { E(acc, cur, wr, wc, fr, fq); if constexpr (EPI2) { asm volatile("" ::: "memory"); E(acc, cur, wr, wc, fr, fq); } S.done(cur); }
        if (!has_next) break;
#pragma unroll
        for (int a = 0; a < 2; ++a)
#pragma unroll
            for (int b = 0; b < 2; ++b)
#pragma unroll
                for (int m = 0; m < 4; ++m)
#pragma unroll
                    for (int n = 0; n < 2; ++n) acc[a][b][m][n] = (f32x4){0.f, 0.f, 0.f, 0.f};
        cur = nxt; cA = nA; cB = nB; ++ui;
        if constexpr (ALIGN_EPI) { if (wr == 1) PG8_BAR; }
    }
    PG8_WAIT_V(0);
    if constexpr (!ALIGN_EPI) { if (wr == 0) PG8_BAR; }
    PG8_BAR;
    if constexpr (Epi::AFTER_DRAIN) { E.fused(acc, cur, wr, wc, fr, fq, lds, wid, lane); S.done(cur); }
#undef PG8_SA
#undef PG8_SB
#undef PG8_STAGE
#undef PG8_LDA
#undef PG8_LDB
#undef PG8_MMA
#undef PG8_WAIT_V
#undef PG8_WAIT_L
#undef PG8_BAR
#undef PG8_SCHED
}

template <class EpiMid, class EpiFin, class Sched>
__device__ __forceinline__ void gemm_phase_ple(PG8_LAS unsigned char* lds, const bf16_t* AP, const bf16_t* BP, const bf16_t* AZ, const bf16_t* BZ, const Sched& S, const EpiMid& EM, const EpiFin& E, const int wave_u) {
    constexpr bool ALIGN_EPI = true;
    int tid_ = wave_u * 64 + lane_id_v(); asm volatile("" : "+v"(tid_));
    const int tid = tid_, wid = __builtin_amdgcn_readfirstlane(tid >> 6), lane = tid & 63, wr = wid >> 2, wc = wid & 3, fr = lane & 15, fq = lane >> 4;
    constexpr int KP = 256, KZ = 1024, NT = 20;
    unsigned vAP[2], vBP[2], vAZ[2], vBZ[2];
#pragma unroll
    for (int i = 0; i < 2; ++i) { int R, C; stage_rc(tid * 16 + i * 8192, R, C); const int Rb = (R & ~31) + perm32(R & 31);
        vAP[i] = (unsigned)(R * KP + C) * 2u; vBP[i] = (unsigned)(Rb * KP + C) * 2u; vAZ[i] = (unsigned)(R * KZ + C) * 2u; vBZ[i] = (unsigned)(Rb * KZ + C) * 2u; }
    const size_t kstep = (size_t)(BK * 2);
    const size_t hsP = (size_t)HALF * KP * 2, hsZ = (size_t)HALF * KZ * 2, tsP = 2 * hsP, tsZ = 2 * hsZ;
    const unsigned ldsw = (unsigned)wid * 1024u;
    const int aoff = lds_byte(wr * 64 + fr, fq * 8), boff = lds_byte(wc * 32 + fr, fq * 8);
#define PG8_SA(b, h) (((b) * 2 + (h)) * HTB)
#define PG8_SB(b, h) ((4 + (b) * 2 + (h)) * HTB)
#define PG8_STAGE(bufoff, gbase, voff) do { _Pragma("unroll") for (int _i = 0; _i < 2; ++_i) \
        __builtin_amdgcn_global_load_lds((const unsigned*)((const char*)(gbase) + (voff)[_i]), (PG8_LAS unsigned*)(lds + (bufoff) + ldsw + _i * 8192), 16, 0, 0); } while (0)
#define PG8_LDA(dst, b, h) do { _Pragma("unroll") for (int m = 0; m < 4; ++m) _Pragma("unroll") for (int k = 0; k < 2; ++k) dst[m][k] = *(const PG8_LAS bf16x8*)(lds + PG8_SA(b, h) + aoff + m * 2048 + k * 1024); } while (0)
#define PG8_LDB(dst, b, h) do { _Pragma("unroll") for (int n = 0; n < 2; ++n) _Pragma("unroll") for (int k = 0; k < 2; ++k) dst[n][k] = *(const PG8_LAS bf16x8*)(lds + PG8_SB(b, h) + boff + n * 2048 + k * 1024); } while (0)
#define PG8_MMA(ai, bj, At, Bt) do { __builtin_amdgcn_s_setprio(1); _Pragma("unroll") for (int m = 0; m < 4; ++m) _Pragma("unroll") for (int n = 0; n < 2; ++n) _Pragma("unroll") for (int k = 0; k < 2; ++k) \
        acc[ai][bj][m][n] = __builtin_amdgcn_mfma_f32_16x16x32_bf16(Bt[n][k], At[m][k], acc[ai][bj][m][n], 0, 0, 0); __builtin_amdgcn_s_setprio(0); } while (0)
#define PG8_WAIT_V(n) asm volatile("s_waitcnt vmcnt(" #n ")" ::: "memory")
#define PG8_WAIT_L(n) asm volatile("s_waitcnt lgkmcnt(" #n ")" ::: "memory")
#define PG8_BAR __builtin_amdgcn_s_barrier()
#define PG8_SCHED __builtin_amdgcn_sched_barrier(0)
    Unit cur, nxt; int ui = 0;
    if (!S.next(0, cur)) return;
    f32x4 acc[2][2][4][2];
#pragma unroll
    for (int a = 0; a < 2; ++a)
#pragma unroll
        for (int b = 0; b < 2; ++b)
#pragma unroll
            for (int m = 0; m < 4; ++m)
#pragma unroll
                for (int n = 0; n < 2; ++n) acc[a][b][m][n] = (f32x4){0.f, 0.f, 0.f, 0.f};
    bf16x8 At[4][2], B0[2][2], B1[2][2];
    const char* cAP = (const char*)AP + (size_t)cur.pm * tsP; const char* cBP = (const char*)BP + (size_t)cur.pn * tsP;
    const char* cAZ = (const char*)AZ + (size_t)cur.pm * tsZ; const char* cBZ = (const char*)BZ + (size_t)cur.pn * tsZ;
    S.a_ready(cur);
    PG8_STAGE(PG8_SB(0, 0), cBP, vBP); PG8_STAGE(PG8_SB(0, 1), cBP + hsP, vBP); PG8_STAGE(PG8_SA(0, 0), cAP, vAP); PG8_STAGE(PG8_SA(0, 1), cAP + hsP, vAP);
    if (wr == 1) PG8_BAR;
    PG8_WAIT_V(2); PG8_BAR;
    PG8_STAGE(PG8_SB(1, 0), cBP + kstep, vBP); PG8_STAGE(PG8_SA(1, 0), cAP + kstep, vAP); PG8_STAGE(PG8_SB(1, 1), cBP + hsP + kstep, vBP);
    PG8_WAIT_V(6); PG8_BAR;
    for (;;) {
        const bool has_next = S.next(ui + 1, nxt);
        const char* nAP = has_next ? (const char*)AP + (size_t)nxt.pm * tsP : cAP; const char* nBP = has_next ? (const char*)BP + (size_t)nxt.pn * tsP : cBP;
#pragma nounroll
        for (int t = 0; t < NT; t += 2) {
            if (t == 4) {
                EM(acc, cur, wr, wc, fr, fq);
#pragma unroll
                for (int a = 0; a < 2; ++a)
#pragma unroll
                    for (int b = 0; b < 2; ++b)
#pragma unroll
                        for (int m = 0; m < 4; ++m)
#pragma unroll
                            for (int n = 0; n < 2; ++n) acc[a][b][m][n] = (f32x4){0.f, 0.f, 0.f, 0.f};
            }
            const bool p1 = (t < 4), p23 = (t == 0) || (t == NT - 2);
            const char* a1 = p1 ? cAP + (size_t)(t + 1) * kstep : cAZ + (size_t)(t - 3) * kstep;
            const char* a2 = (t == 0) ? cAP + 2 * kstep : (t == NT - 2) ? nAP : cAZ + (size_t)(t - 2) * kstep;
            const char* b2 = (t == 0) ? cBP + 2 * kstep : (t == NT - 2) ? nBP : cBZ + (size_t)(t - 2) * kstep;
            const char* a3 = a2 + kstep; const char* b3 = b2 + kstep;
            const size_t hstep1 = p1 ? hsP : hsZ, hstep = p23 ? hsP : hsZ, hstepB = hstep;
            unsigned voffA1[2], voffA[2], voffB[2];
#pragma unroll
            for (int i = 0; i < 2; ++i) { voffA1[i] = p1 ? vAP[i] : vAZ[i]; voffA[i] = p23 ? vAP[i] : vAZ[i]; voffB[i] = p23 ? vBP[i] : vBZ[i]; }
            if (t == NT - 2 && has_next) S.a_ready(nxt);
            PG8_LDB(B0, 0, 0); PG8_LDB(B1, 0, 1); PG8_SCHED; PG8_LDA(At, 0, 0); PG8_STAGE(PG8_SA(1, 1), a1 + hstep1, voffA1);
            PG8_WAIT_V(8); PG8_WAIT_L(0); PG8_BAR; PG8_MMA(0, 0, At, B0); PG8_MMA(0, 1, At, B1); PG8_BAR; PG8_SCHED;
            PG8_LDA(At, 0, 1); PG8_STAGE(PG8_SB(0, 0), b2, voffB); PG8_STAGE(PG8_SB(0, 1), b2 + hstepB, voffB); PG8_STAGE(PG8_SA(0, 0), a2, voffA);
            PG8_WAIT_V(8); PG8_WAIT_L(0); PG8_BAR; PG8_MMA(1, 0, At, B0); PG8_MMA(1, 1, At, B1); PG8_BAR; PG8_SCHED;
            PG8_LDB(B0, 1, 0); PG8_LDB(B1, 1, 1); PG8_SCHED; PG8_LDA(At, 1, 0); PG8_STAGE(PG8_SA(0, 1), a2 + hstep, voffA);
            PG8_WAIT_V(8); PG8_WAIT_L(0); PG8_BAR; PG8_MMA(0, 0, At, B0); PG8_MMA(0, 1, At, B1); PG8_BAR; PG8_SCHED;
            PG8_LDA(At, 1, 1); PG8_STAGE(PG8_SB(1, 0), b3, voffB); PG8_STAGE(PG8_SB(1, 1), b3 + hstepB, voffB); PG8_STAGE(PG8_SA(1, 0), a3, voffA);
            PG8_WAIT_V(8); PG8_WAIT_L(0); PG8_BAR; PG8_MMA(1, 0, At, B0); PG8_MMA(1, 1, At, B1); PG8_BAR; PG8_SCHED;
        }
        if constexpr (ALIGN_EPI) { if (wr == 0) PG8_BAR; }
        E(acc, cur, wr, wc, fr, fq); S.done(cur);
        if (!has_next) break;
#pragma unroll
        for (int a = 0; a < 2; ++a)
#pragma unroll
            for (int b = 0; b < 2; ++b)
#pragma unroll
                for (int m = 0; m < 4; ++m)
#pragma unroll
                    for (int n = 0; n < 2; ++n) acc[a][b][m][n] = (f32x4){0.f, 0.f, 0.f, 0.f};
        cur = nxt; cAP = nAP; cBP = nBP; cAZ = (const char*)AZ + (size_t)cur.pm * tsZ; cBZ = (const char*)BZ + (size_t)cur.pn * tsZ; ++ui;
        if constexpr (ALIGN_EPI) { if (wr == 1) PG8_BAR; }
    }
    PG8_WAIT_V(0);
    if constexpr (!ALIGN_EPI) { if (wr == 0) PG8_BAR; }
    PG8_BAR;
#undef PG8_SA
#undef PG8_SB
#undef PG8_STAGE
#undef PG8_LDA
#undef PG8_LDB
#undef PG8_MMA
#undef PG8_WAIT_V
#undef PG8_WAIT_L
#undef PG8_BAR
#undef PG8_SCHED
}
}
#ifndef PG8_SP2
#define PG8_SP2 true
#endif
#ifndef PG8_ALIGN
#define PG8_ALIGN true
#endif
using pg8::bf16_t; using pg8::bf16x8; using pg8::f32x4; using pg8::u32x4;
#define LAS __attribute__((address_space(3)))
typedef float f32x2 __attribute__((ext_vector_type(2)));
typedef float f32x16 __attribute__((ext_vector_type(16)));
typedef unsigned u32x2 __attribute__((ext_vector_type(2)));
typedef __bf16 bf16x2_t __attribute__((ext_vector_type(2)));

constexpr int T_ = 65536, DM_ = 1024, SEQ_ = 8192, PJW = 2048, FF_ = 4096, PLE_ = 256, NUNIT_ATT = 1024, NUNIT_LRU = 256;
constexpr float EPS_ = 1e-6f, LOG2E = 1.4426950408889634f, QSCALE = 0.125f * 1.4426950408889634f;
constexpr int NWAVES = 8, NTHR = 512;
constexpr int RING_BYTES = 131072, SSL_OFF = RING_BYTES, MISC_OFF = 147456 - 64, LDS_BYTES = 147456;
constexpr size_t MiB = 1u << 20;
constexpr size_t WS_WIN = 0, WS_WOUT = 5 * MiB, WS_WUP = 7 * MiB, WS_WDN = 15 * MiB, WS_WPG = 23 * MiB, WS_WPP = 25 * MiB, WS_WG = 25 * MiB + 512 * 1024;
constexpr size_t WS_RSTD1 = 27 * MiB, WS_RSTD2 = 27 * MiB + 256 * 1024, WS_DUMMY = 27 * MiB + 512 * 1024, WS_SUMM = 28 * MiB;
constexpr size_t WS_CTL = 31 * MiB, CTL_BYTES = 16384;
constexpr size_t WS_XN = 32 * MiB;
constexpr size_t WS_PP = 160 * MiB;
constexpr size_t WS_PB = 288 * MiB;
constexpr size_t WS_PROJ = 320 * MiB;
constexpr size_t WS_VT = 576 * MiB;
constexpr size_t WS_MERGED = 640 * MiB;
constexpr size_t WS_ACT = 320 * MiB;
constexpr size_t WS_END = 832 * MiB;

__device__ __forceinline__ unsigned cvtpk(float lo, float hi) { f32x2 v = {lo, hi}; bf16x2_t b = __builtin_convertvector(v, bf16x2_t); return __builtin_bit_cast(unsigned, b); }
__device__ __forceinline__ float bf2f(unsigned short u) { return __uint_as_float((unsigned)u << 16); }
__device__ __forceinline__ float bflo(unsigned w) { return __uint_as_float(w << 16); }
__device__ __forceinline__ float bfhi(unsigned w) { return __uint_as_float(w & 0xffff0000u); }
__device__ __forceinline__ float ex2(float x) { return __builtin_amdgcn_exp2f(x); }
__device__ __forceinline__ float rcpf_(float x) { return __builtin_amdgcn_rcpf(x); }
__device__ __forceinline__ float rsqf_(float x) { return __builtin_amdgcn_rsqf(x); }
__device__ __forceinline__ float sigm(float z) { return rcpf_(1.f + ex2(-LOG2E * z)); }
__device__ __forceinline__ float gelu_tanh(float g) { const float z = 0.7978845608028654f * (g + 0.044715f * g * g * g); return g * sigm(2.f * z); }
__device__ __forceinline__ float wave_sum(float v) {
#pragma unroll
    for (int o = 1; o < 64; o <<= 1) v += __shfl_xor(v, o);
    return v;
}
__device__ __forceinline__ float wave_max(float v) {
#pragma unroll
    for (int o = 1; o < 64; o <<= 1) v = fmaxf(v, __shfl_xor(v, o));
    return v;
}
__device__ __forceinline__ int crow(int r, int hi) { return (r & 3) + 8 * (r >> 2) + 4 * hi; }
#define MFMA32(a, b, c) __builtin_amdgcn_mfma_f32_32x32x16_bf16((a), (b), (c), 0, 0, 0)

#define RLX_AGENT __ATOMIC_RELAXED, __HIP_MEMORY_SCOPE_AGENT
#define XB_TMO      128
#define XB_XCNT(j)  (256  + 64 * (j))
#define XB_XSUB(j)  (1280 + 64 * (j))
#define XB_XGEN(j)  (2304 + 64 * (j))
#define XB_TOP      3328
#define XB_TOPGEN   3392
#define XCD_BAR_WORDS 3456
#define XB_SPIN_CAP (1u << 18)

__device__ __forceinline__ unsigned xb_ld(unsigned* p)              { return __hip_atomic_load(p, __ATOMIC_RELAXED, __HIP_MEMORY_SCOPE_AGENT); }
__device__ __forceinline__ unsigned xb_add(unsigned* p, unsigned v) { return __hip_atomic_fetch_add(p, v, __ATOMIC_RELAXED, __HIP_MEMORY_SCOPE_AGENT); }
__device__ __forceinline__ unsigned xb_xcc_id() { return (unsigned)__builtin_amdgcn_s_getreg((3 << 11) | 20) & 0xFu; }
#define XB_SPIN(cond, bar) do { unsigned _sp = 0; while (cond) { __builtin_amdgcn_s_sleep(1); \
    if ((++_sp & 255u) == 0u) { if (xb_ld(&(bar)[XB_TMO])) break; if (_sp > XB_SPIN_CAP) { atomicAdd(&(bar)[XB_TMO], 1u); break; } } } } while (0)

struct XcdBarrier {
    unsigned* bar; unsigned x;
    volatile LAS unsigned* st;
};

__device__ __forceinline__ XcdBarrier xcd_barrier_post(unsigned* bar, volatile LAS unsigned* st) {
    XcdBarrier b; b.bar = bar; b.x = xb_xcc_id(); b.st = st;
    if (threadIdx.x == 0) (void)xb_add(&bar[XB_XCNT(b.x)], 1u);
    return b;
}
__device__ __forceinline__ void xcd_barrier_complete(unsigned* bar, unsigned x, unsigned& nloc, unsigned& nx) {
    const unsigned G = gridDim.x * gridDim.y * gridDim.z;
    unsigned sum, cnt, mine, sp = 0u;
    for (;;) {
        sum = 0u; cnt = 0u; mine = 0u;
#pragma unroll
        for (unsigned j = 0; j < 16; ++j) { const unsigned c = xb_ld(&bar[XB_XCNT(j)]); sum += c; cnt += (c > 0u) ? 1u : 0u; mine = (j == x) ? c : mine; }
        if (sum == G) break;
        __builtin_amdgcn_s_sleep(1);
        if ((++sp & 255u) == 0u) { if (xb_ld(&bar[XB_TMO])) break; if (sp > XB_SPIN_CAP) { atomicAdd(&bar[XB_TMO], 1u); break; } }
    }
    nloc = mine > 0u ? mine : 1u; nx = cnt > 0u ? cnt : 1u;
}

__device__ __forceinline__ void xcd_barrier(const XcdBarrier& b) {
    asm volatile("s_waitcnt vmcnt(0)" ::: "memory");
    __syncthreads();
    if (threadIdx.x == 0) {
        unsigned* bar = b.bar;
        __builtin_amdgcn_s_waitcnt(0);
        unsigned nloc = b.st[0], nx = b.st[1];
        if (nloc == 0u) { xcd_barrier_complete(bar, b.x, nloc, nx); b.st[0] = nloc; b.st[1] = nx; }
        const unsigned old = xb_add(&bar[XB_XSUB(b.x)], 1u);
        const unsigned gen = old / nloc;
        if (old + 1u == (gen + 1u) * nloc) {
            __builtin_amdgcn_fence(__ATOMIC_RELEASE, "agent");
            asm volatile("s_waitcnt vmcnt(0)" ::: "memory");
            const unsigned og = xb_add(&bar[XB_TOP], 1u);
            const unsigned tg = og / nx;
            if (og + 1u == (tg + 1u) * nx) xb_add(&bar[XB_TOPGEN], 1u);
            else XB_SPIN(xb_ld(&bar[XB_TOPGEN]) == tg, bar);
            __builtin_amdgcn_fence(__ATOMIC_ACQUIRE, "agent");
            xb_add(&bar[XB_XGEN(b.x)], 1u);
            asm volatile("s_waitcnt vmcnt(0)" ::: "memory");
        } else {
            XB_SPIN(xb_ld(&bar[XB_XGEN(b.x)]) == gen, bar);
            __builtin_amdgcn_fence(__ATOMIC_ACQUIRE, "agent");
            asm volatile("s_waitcnt vmcnt(0)" ::: "memory");
        }
    }
    __syncthreads();
}

struct PanelOrder {
    int pm;
    __device__ bool next(int i, pg8::Unit& u) const { if (i >= 4) return false; u.pm = pm; u.pn = i; return true; }
    __device__ __forceinline__ void a_ready(const pg8::Unit&) const {}
    __device__ __forceinline__ void done(const pg8::Unit&) const {}
};

struct EpiPlain {
    static constexpr bool PERM = true, AFTER_DRAIN = false, HEADMAP = false;
    bf16_t* O; int ldc;
    __device__ __forceinline__ void operator()(const f32x4 (&acc)[2][2][4][2], const pg8::Unit& u, int wr, int wc, int fr, int fq) const {
        const int row0 = u.pm * 256 + wr * 64 + fr, col0 = u.pn * 256 + wc * 32 + 8 * fq;
#pragma unroll
        for (int ai = 0; ai < 2; ++ai)
#pragma unroll
            for (int m = 0; m < 4; ++m) { bf16_t* rowp = O + (size_t)(row0 + ai * 128 + m * 16) * ldc + col0;
#pragma unroll
                for (int bj = 0; bj < 2; ++bj) { const f32x4 v0 = acc[ai][bj][m][0], v1 = acc[ai][bj][m][1];
                    u32x4 w; w.x = cvtpk(v0[0], v0[1]); w.y = cvtpk(v0[2], v0[3]); w.z = cvtpk(v1[0], v1[1]); w.w = cvtpk(v1[2], v1[3]);
                    *(u32x4*)(rowp + bj * 128) = w; } }
    }
};
struct EpiVT {
    static constexpr bool PERM = true, AFTER_DRAIN = false, HEADMAP = false;
    bf16_t* O;
    __device__ __forceinline__ void operator()(const f32x4 (&acc)[2][2][4][2], const pg8::Unit& u, int wr, int wc, int fr, int fq) const {
        const int row0 = u.pm * 256 + wr * 64 + fr, col0 = u.pn * 256 + wc * 32 + 16 * (fq >> 1) + 4 * (fq & 1);
#pragma unroll
        for (int ai = 0; ai < 2; ++ai)
#pragma unroll
            for (int m = 0; m < 4; ++m) { bf16_t* rowp = O + (size_t)(row0 + ai * 128 + m * 16) * T_ + col0;
#pragma unroll
                for (int bj = 0; bj < 2; ++bj)
#pragma unroll
                    for (int n = 0; n < 2; ++n) { const f32x4 v = acc[ai][bj][m][n]; u32x2 w; w.x = cvtpk(v[0], v[1]); w.y = cvtpk(v[2], v[3]);
                        *(u32x2*)(rowp + bj * 128 + 8 * n) = w; } }
    }
};
struct EpiProj {
    static constexpr bool PERM = true, AFTER_DRAIN = false, HEADMAP = true;
    bf16_t* O; const float* gq; const float* gk;
    __device__ __forceinline__ void operator()(const f32x4 (&acc)[2][2][4][2], const pg8::Unit& u, int wr, int wc, int fr, int fq) const {
        const int row0 = u.pm * 256 + wr * 64 + fr, col0 = u.pn * 256 + wc * 64 + 8 * fq, kind = u.pn >> 1;
        f32x4 gv[2][2];
        if (kind >= 2) { const float* g = (kind == 2) ? gq : gk; const float sc = (kind == 2) ? QSCALE : 1.f;
#pragma unroll
            for (int bj = 0; bj < 2; ++bj)
#pragma unroll
                for (int n = 0; n < 2; ++n) gv[bj][n] = *(const f32x4*)(g + 32 * bj + 8 * fq + 4 * n) * sc; }
#pragma unroll
        for (int ai = 0; ai < 2; ++ai)
#pragma unroll
            for (int m = 0; m < 4; ++m) { bf16_t* rowp = O + (size_t)(row0 + ai * 128 + m * 16) * PJW + col0;
                f32x4 v[2][2];
#pragma unroll
                for (int bj = 0; bj < 2; ++bj)
#pragma unroll
                    for (int n = 0; n < 2; ++n) v[bj][n] = acc[ai][bj][m][n];
                if (kind == 1) {
#pragma unroll
                    for (int bj = 0; bj < 2; ++bj)
#pragma unroll
                        for (int n = 0; n < 2; ++n)
#pragma unroll
                            for (int e = 0; e < 4; ++e) v[bj][n][e] = gelu_tanh(v[bj][n][e]);
                } else if (kind >= 2) {
                    float ss = 0.f;
#pragma unroll
                    for (int bj = 0; bj < 2; ++bj)
#pragma unroll
                        for (int n = 0; n < 2; ++n) { const f32x4 x = v[bj][n]; ss += (x[0] * x[0] + x[1] * x[1]) + (x[2] * x[2] + x[3] * x[3]); }
                    ss += __shfl_xor(ss, 16); ss += __shfl_xor(ss, 32);
                    const float rstd = rsqf_(ss * (1.f / 64.f) + EPS_);
#pragma unroll
                    for (int bj = 0; bj < 2; ++bj)
#pragma unroll
                        for (int n = 0; n < 2; ++n) v[bj][n] = v[bj][n] * gv[bj][n] * rstd;
                }
#pragma unroll
                for (int bj = 0; bj < 2; ++bj) { const f32x4 v0 = v[bj][0], v1 = v[bj][1];
                    u32x4 w; w.x = cvtpk(v0[0], v0[1]); w.y = cvtpk(v0[2], v0[3]); w.z = cvtpk(v1[0], v1[1]); w.w = cvtpk(v1[2], v1[3]);
                    *(u32x4*)(rowp + bj * 32) = w; } }
    }
};
struct EpiRes {
    static constexpr bool PERM = true, AFTER_DRAIN = false, HEADMAP = false;
    const float* base; float* out; bf16_t* hb; float* ssq; int rowmask;
    __device__ __forceinline__ void operator()(const f32x4 (&acc)[2][2][4][2], const pg8::Unit& u, int wr, int wc, int fr, int fq) const {
        const int row0 = u.pm * 256 + wr * 64 + fr, col0 = u.pn * 256 + wc * 32 + 8 * fq;
#pragma unroll
        for (int ai = 0; ai < 2; ++ai)
#pragma unroll
            for (int m = 0; m < 4; ++m) { const size_t off = (size_t)(row0 + ai * 128 + m * 16) * DM_ + col0; const size_t ooff = (size_t)((row0 + ai * 128 + m * 16) & rowmask) * DM_ + col0; float ss = 0.f;
#pragma unroll
                for (int bj = 0; bj < 2; ++bj) {
                    const f32x4 b0 = *(const f32x4*)(base + off + bj * 128), b1 = *(const f32x4*)(base + off + bj * 128 + 4);
                    const f32x4 v0 = b0 + acc[ai][bj][m][0], v1 = b1 + acc[ai][bj][m][1];
                    ss += (v0[0] * v0[0] + v0[1] * v0[1]) + (v0[2] * v0[2] + v0[3] * v0[3]) + (v1[0] * v1[0] + v1[1] * v1[1]) + (v1[2] * v1[2] + v1[3] * v1[3]);
                    *(f32x4*)(out + ooff + bj * 128) = v0; *(f32x4*)(out + ooff + bj * 128 + 4) = v1;
                    u32x4 w; w.x = cvtpk(v0[0], v0[1]); w.y = cvtpk(v0[2], v0[3]); w.z = cvtpk(v1[0], v1[1]); w.w = cvtpk(v1[2], v1[3]);
                    *(u32x4*)(hb + off + bj * 128) = w; }
                ss += __shfl_xor(ss, 16); ss += __shfl_xor(ss, 32);
                if (fq == 0) __hip_atomic_fetch_add(ssq + row0 + ai * 128 + m * 16, ss, __ATOMIC_RELAXED, __HIP_MEMORY_SCOPE_AGENT);
                asm volatile("" ::: "memory"); }
    }
};
struct EpiUp {
    static constexpr bool PERM = true, AFTER_DRAIN = false, HEADMAP = false;
    bf16_t* O; const float* rstd;
    __device__ __forceinline__ void operator()(const f32x4 (&acc)[2][2][4][2], const pg8::Unit& u, int wr, int wc, int fr, int fq) const {
        const int row0 = u.pm * 256 + wr * 64 + fr, col0 = u.pn * 256 + wc * 32 + 8 * fq;
#pragma unroll
        for (int ai = 0; ai < 2; ++ai)
#pragma unroll
            for (int m = 0; m < 4; ++m) { const int row = row0 + ai * 128 + m * 16; const float rs = rsqf_(rstd[row] * (1.f / DM_) + EPS_); bf16_t* rowp = O + (size_t)row * FF_ + col0;
#pragma unroll
                for (int bj = 0; bj < 2; ++bj) { f32x4 v0 = acc[ai][bj][m][0] * rs, v1 = acc[ai][bj][m][1] * rs;
#pragma unroll
                    for (int e = 0; e < 4; ++e) { const float a = fmaxf(v0[e], 0.f), b = fmaxf(v1[e], 0.f); v0[e] = a * a; v1[e] = b * b; }
                    u32x4 w; w.x = cvtpk(v0[0], v0[1]); w.y = cvtpk(v0[2], v0[3]); w.z = cvtpk(v1[0], v1[1]); w.w = cvtpk(v1[2], v1[3]);
                    *(u32x4*)(rowp + bj * 128) = w; } }
    }
};
struct EpiFinal {
    static constexpr bool PERM = true, AFTER_DRAIN = false, HEADMAP = false;
    const float* hin; float* out; const bf16_t* pp; const float* rstd;
    __device__ __forceinline__ void operator()(const f32x4 (&acc)[2][2][4][2], const pg8::Unit& u, int wr, int wc, int fr, int fq) const {
        const int row0 = u.pm * 256 + wr * 64 + fr, col0 = u.pn * 256 + wc * 32 + 8 * fq;
#pragma unroll
        for (int ai = 0; ai < 2; ++ai)
#pragma unroll
            for (int m = 0; m < 4; ++m) { const int row = row0 + ai * 128 + m * 16; const float rs = rsqf_(rstd[row] * (1.f / DM_) + EPS_); const size_t off = (size_t)row * DM_ + col0;
#pragma unroll
                for (int bj = 0; bj < 2; ++bj) {
                    const f32x4 h0 = *(const f32x4*)(hin + off + bj * 128), h1 = *(const f32x4*)(hin + off + bj * 128 + 4);
                    const u32x4 pw = *(const u32x4*)(pp + off + bj * 128);
                    const f32x4 a0 = acc[ai][bj][m][0] * rs, a1 = acc[ai][bj][m][1] * rs;
                    f32x4 o0, o1;
                    o0[0] = h0[0] + sigm(a0[0]) * bflo(pw.x); o0[1] = h0[1] + sigm(a0[1]) * bfhi(pw.x); o0[2] = h0[2] + sigm(a0[2]) * bflo(pw.y); o0[3] = h0[3] + sigm(a0[3]) * bfhi(pw.y);
                    o1[0] = h1[0] + sigm(a1[0]) * bflo(pw.z); o1[1] = h1[1] + sigm(a1[1]) * bfhi(pw.z); o1[2] = h1[2] + sigm(a1[2]) * bflo(pw.w); o1[3] = h1[3] + sigm(a1[3]) * bfhi(pw.w);
                    *(f32x4*)(out + off + bj * 128) = o0; *(f32x4*)(out + off + bj * 128 + 4) = o1; }
                asm volatile("" ::: "memory"); }
    }
};


struct EpiRes4 {
    static constexpr bool PERM = true, AFTER_DRAIN = false, HEADMAP = false;
    const float* base; bf16_t* hb; float* ssq;
    __device__ __forceinline__ void operator()(const f32x4 (&acc)[2][2][4][2], const pg8::Unit& u, int wr, int wc, int fr, int fq) const {
        const int row0 = u.pm * 256 + wr * 64 + fr, col0 = u.pn * 256 + wc * 32 + 8 * fq;
        f32x4 X[8][2][2];
#define E4_LD(g) do { const size_t off_ = (size_t)(row0 + ((g) >> 2) * 128 + ((g) & 3) * 16) * DM_ + col0; \
        _Pragma("unroll") for (int bj = 0; bj < 2; ++bj) { X[g][bj][0] = *(const f32x4*)(base + off_ + bj * 128); X[g][bj][1] = *(const f32x4*)(base + off_ + bj * 128 + 4); } } while (0)
        E4_LD(0); E4_LD(1); E4_LD(2); E4_LD(3);
        asm volatile("" ::: "memory");
#pragma unroll
        for (int g = 0; g < 8; ++g) { const int ai = g >> 2, m = g & 3; const size_t off = (size_t)(row0 + ai * 128 + m * 16) * DM_ + col0; float ss = 0.f;
#pragma unroll
            for (int bj = 0; bj < 2; ++bj) {
                const f32x4 v0 = X[g][bj][0] + acc[ai][bj][m][0], v1 = X[g][bj][1] + acc[ai][bj][m][1];
                ss += (v0[0] * v0[0] + v0[1] * v0[1]) + (v0[2] * v0[2] + v0[3] * v0[3]) + (v1[0] * v1[0] + v1[1] * v1[1]) + (v1[2] * v1[2] + v1[3] * v1[3]);
                u32x4 w; w.x = cvtpk(v0[0], v0[1]); w.y = cvtpk(v0[2], v0[3]); w.z = cvtpk(v1[0], v1[1]); w.w = cvtpk(v1[2], v1[3]);
                *(u32x4*)(hb + off + bj * 128) = w; }
            ss += __shfl_xor(ss, 16); ss += __shfl_xor(ss, 32);
            if (fq == 0) __hip_atomic_fetch_add(ssq + row0 + ai * 128 + m * 16, ss, __ATOMIC_RELAXED, __HIP_MEMORY_SCOPE_AGENT);
            if (g + 4 < 8) { E4_LD(g + 4); }
            asm volatile("" ::: "memory"); }
#undef E4_LD
    }
};
struct EpiRes6 {
    static constexpr bool PERM = true, AFTER_DRAIN = false, HEADMAP = false;
    bf16_t* hb; float* ssq;
    __device__ __forceinline__ void operator()(const f32x4 (&acc)[2][2][4][2], const pg8::Unit& u, int wr, int wc, int fr, int fq) const {
        const int row0 = u.pm * 256 + wr * 64 + fr, col0 = u.pn * 256 + wc * 32 + 8 * fq;
        u32x4 H[8][2];
#define E6_LD(g) do { const size_t off_ = (size_t)(row0 + ((g) >> 2) * 128 + ((g) & 3) * 16) * DM_ + col0; \
        _Pragma("unroll") for (int bj = 0; bj < 2; ++bj) H[g][bj] = *(const u32x4*)(hb + off_ + bj * 128); } while (0)
        E6_LD(0); E6_LD(1); E6_LD(2); E6_LD(3);
        asm volatile("" ::: "memory");
#pragma unroll
        for (int g = 0; g < 8; ++g) { const int ai = g >> 2, m = g & 3; const size_t off = (size_t)(row0 + ai * 128 + m * 16) * DM_ + col0; float ss = 0.f;
#pragma unroll
            for (int bj = 0; bj < 2; ++bj) { const u32x4 hw = H[g][bj];
                const f32x4 b0 = {bflo(hw.x), bfhi(hw.x), bflo(hw.y), bfhi(hw.y)}, b1 = {bflo(hw.z), bfhi(hw.z), bflo(hw.w), bfhi(hw.w)};
                const f32x4 v0 = b0 + acc[ai][bj][m][0], v1 = b1 + acc[ai][bj][m][1];
                ss += (v0[0] * v0[0] + v0[1] * v0[1]) + (v0[2] * v0[2] + v0[3] * v0[3]) + (v1[0] * v1[0] + v1[1] * v1[1]) + (v1[2] * v1[2] + v1[3] * v1[3]);
                u32x4 w; w.x = cvtpk(v0[0], v0[1]); w.y = cvtpk(v0[2], v0[3]); w.z = cvtpk(v1[0], v1[1]); w.w = cvtpk(v1[2], v1[3]);
                *(u32x4*)(hb + off + bj * 128) = w; }
            ss += __shfl_xor(ss, 16); ss += __shfl_xor(ss, 32);
            if (fq == 0) __hip_atomic_fetch_add(ssq + row0 + ai * 128 + m * 16, ss, __ATOMIC_RELAXED, __HIP_MEMORY_SCOPE_AGENT);
            if (g + 4 < 8) { E6_LD(g + 4); }
            asm volatile("" ::: "memory"); }
#undef E6_LD
    }
};
struct EpiFinalB {
    static constexpr bool PERM = true, AFTER_DRAIN = false, HEADMAP = false;
    const bf16_t* hb; float* out; const bf16_t* pp; const float* rstd;
    __device__ __forceinline__ void operator()(const f32x4 (&acc)[2][2][4][2], const pg8::Unit& u, int wr, int wc, int fr, int fq) const {
        const int row0 = u.pm * 256 + wr * 64 + fr, col0 = u.pn * 256 + wc * 32 + 8 * fq;
        u32x4 H[8][2], P[8][2]; float RS[8];
#define EF_LD(g) do { const int row_ = row0 + ((g) >> 2) * 128 + ((g) & 3) * 16; const size_t off_ = (size_t)row_ * DM_ + col0; RS[g] = rstd[row_]; \
        _Pragma("unroll") for (int bj = 0; bj < 2; ++bj) { H[g][bj] = *(const u32x4*)(hb + off_ + bj * 128); P[g][bj] = *(const u32x4*)(pp + off_ + bj * 128); } } while (0)
        EF_LD(0); EF_LD(1); EF_LD(2); EF_LD(3);
        asm volatile("" ::: "memory");
#pragma unroll
        for (int g = 0; g < 8; ++g) { const int ai = g >> 2, m = g & 3; const size_t off = (size_t)(row0 + ai * 128 + m * 16) * DM_ + col0; const float rs = rsqf_(RS[g] * (1.f / DM_) + EPS_);
#pragma unroll
            for (int bj = 0; bj < 2; ++bj) { const u32x4 hw = H[g][bj], pw = P[g][bj];
                const f32x4 a0 = acc[ai][bj][m][0] * rs, a1 = acc[ai][bj][m][1] * rs;
                f32x4 o0, o1;
                o0[0] = bflo(hw.x) + sigm(a0[0]) * bflo(pw.x); o0[1] = bfhi(hw.x) + sigm(a0[1]) * bfhi(pw.x); o0[2] = bflo(hw.y) + sigm(a0[2]) * bflo(pw.y); o0[3] = bfhi(hw.y) + sigm(a0[3]) * bfhi(pw.y);
                o1[0] = bflo(hw.z) + sigm(a1[0]) * bflo(pw.z); o1[1] = bfhi(hw.z) + sigm(a1[1]) * bfhi(pw.z); o1[2] = bflo(hw.w) + sigm(a1[2]) * bflo(pw.w); o1[3] = bfhi(hw.w) + sigm(a1[3]) * bfhi(pw.w);
                *(f32x4*)(out + off + bj * 128) = o0; *(f32x4*)(out + off + bj * 128 + 4) = o1; }
            if (g + 4 < 8) { EF_LD(g + 4); }
            asm volatile("" ::: "memory"); }
#undef EF_LD
    }
};

struct EpiMidPP {
    u32x4* park;
    __device__ __forceinline__ void operator()(const f32x4 (&acc)[2][2][4][2], const pg8::Unit& u, int wr, int wc, int fr, int fq) const {
        asm volatile("" : "+v"(fr), "+v"(fq));
        const unsigned pko_ = (unsigned)((wr * 4 + wc) * 64 + fq * 16 + fr);
#pragma unroll
        for (int ai = 0; ai < 2; ++ai)
#pragma unroll
            for (int m = 0; m < 4; ++m)
#pragma unroll
                for (int bj = 0; bj < 2; ++bj) { const f32x4 v0 = acc[ai][bj][m][0], v1 = acc[ai][bj][m][1];
                    u32x4 w; w.x = cvtpk(v0[0], v0[1]); w.y = cvtpk(v0[2], v0[3]); w.z = cvtpk(v1[0], v1[1]); w.w = cvtpk(v1[2], v1[3]);
                    park[pko_ + (unsigned)((((ai * 4 + m) * 2 + bj) * 8) * 64)] = w; }
    }
};
struct EpiFinalC {
    const bf16_t* hb; float* out; const float* rstd; const u32x4* park;
    __device__ __forceinline__ void operator()(const f32x4 (&acc)[2][2][4][2], const pg8::Unit& u, int wr, int wc, int fr, int fq) const {
        asm volatile("" : "+v"(fr), "+v"(fq));
        const int row0 = u.pm * 256 + wr * 64 + fr, col0 = u.pn * 256 + wc * 32 + 8 * fq;
        const unsigned pko_ = (unsigned)((wr * 4 + wc) * 64 + fq * 16 + fr);
        u32x4 H[8][2], P[8][2]; float RS[8];
#define EF_LD(g) do { const int row_ = row0 + ((g) >> 2) * 128 + ((g) & 3) * 16; const size_t off_ = (size_t)row_ * DM_ + col0; RS[g] = rstd[row_]; \
        _Pragma("unroll") for (int bj = 0; bj < 2; ++bj) { H[g][bj] = *(const u32x4*)(hb + off_ + bj * 128); P[g][bj] = park[pko_ + (unsigned)((((g) * 2 + bj) * 8) * 64)]; } } while (0)
        EF_LD(0); EF_LD(1); EF_LD(2); EF_LD(3);
        asm volatile("" ::: "memory");
#pragma unroll
        for (int g = 0; g < 8; ++g) { const int ai = g >> 2, m = g & 3; const size_t off = (size_t)(row0 + ai * 128 + m * 16) * DM_ + col0; const float rs = rsqf_(RS[g] * (1.f / DM_) + EPS_);
#pragma unroll
            for (int bj = 0; bj < 2; ++bj) { const u32x4 hw = H[g][bj], pw = P[g][bj];
                const f32x4 a0 = acc[ai][bj][m][0] * rs, a1 = acc[ai][bj][m][1] * rs;
                f32x4 o0, o1;
                o0[0] = bflo(hw.x) + sigm(a0[0]) * bflo(pw.x); o0[1] = bfhi(hw.x) + sigm(a0[1]) * bfhi(pw.x); o0[2] = bflo(hw.y) + sigm(a0[2]) * bflo(pw.y); o0[3] = bfhi(hw.y) + sigm(a0[3]) * bfhi(pw.y);
                o1[0] = bflo(hw.z) + sigm(a1[0]) * bflo(pw.z); o1[1] = bfhi(hw.z) + sigm(a1[1]) * bfhi(pw.z); o1[2] = bflo(hw.w) + sigm(a1[2]) * bflo(pw.w); o1[3] = bfhi(hw.w) + sigm(a1[3]) * bfhi(pw.w);
                *(f32x4*)(out + off + bj * 128) = o0; *(f32x4*)(out + off + bj * 128 + 4) = o1; }
            if (g + 4 < 8) { EF_LD(g + 4); }
            asm volatile("" ::: "memory"); }
#undef EF_LD
    }
};

__device__ __forceinline__ void p0_transpose_item(const float* W, int K, int N, bf16_t* WT, const float* ks0, const float* ks1, int ksplit, LAS float* scr, int item, int lane) {
    const int nblk = N / 32, kb = item / nblk, nb = item % nblk, k0 = 64 * kb, n0 = 32 * nb;
#pragma unroll 8
    for (int i = 0; i < 32; ++i) { const int kk = 2 * i + (lane >> 5), k = k0 + kk; float s = 1.f; if (ks0) s = (k < ksplit) ? ks0[k] : ks1[k - ksplit];
        scr[kk * 33 + (lane & 31)] = W[(size_t)k * N + n0 + (lane & 31)] * s; }
    asm volatile("s_waitcnt lgkmcnt(0)" ::: "memory");
    const int c = lane & 7;
#pragma unroll
    for (int j = 0; j < 4; ++j) { const int n = (lane >> 3) + 8 * j; const LAS float* s = scr + (8 * c) * 33 + n;
        u32x4 o; o.x = cvtpk(s[0 * 33], s[1 * 33]); o.y = cvtpk(s[2 * 33], s[3 * 33]); o.z = cvtpk(s[4 * 33], s[5 * 33]); o.w = cvtpk(s[6 * 33], s[7 * 33]);
        *(u32x4*)(WT + (size_t)(n0 + n) * K + k0 + 8 * c) = o; }
    asm volatile("s_waitcnt lgkmcnt(0)" ::: "memory");
}
__device__ __forceinline__ void attn_phase(LAS unsigned char* lds, const bf16_t* PROJ, const bf16_t* VT, const float* gq, const float* gk, const float* rb, bf16_t* MERGED, int vcu, int G, const int wave_u) {
    int tid_ = wave_u * 64 + lane_id_v(); asm volatile("" : "+v"(tid_));
    const int tid = tid_, lane = tid & 63, h = __builtin_amdgcn_readfirstlane(tid >> 6), ql = lane & 31, hi = lane >> 5;
    LAS float* SQ = (LAS float*)lds;
    LAS float* EXT = (LAS float*)(lds + 2048) + h * 640;
    float mq = wave_max(fabsf(gq[lane])), mk = wave_max(fabsf(gk[lane])); float mb = -1e30f;
    for (int i = lane; i < 513; i += 64) mb = fmaxf(mb, rb[h * 513 + i]);
    mb = wave_max(mb);
    const float c512 = rb[h * 513 + 512]; (void)mq; (void)mk; (void)mb;
    for (int i = lane; i < 640; i += 64) { int rel = i - 64; rel = rel > 256 ? 256 : (rel < -256 ? -256 : rel); EXT[639 - i] = (rb[h * 513 + rel + 256] - c512) * LOG2E; }
    asm volatile("s_waitcnt lgkmcnt(0)" ::: "memory");
    __syncthreads();
    for (int unit = vcu; unit < NUNIT_ATT; unit += G) {
        const int b = unit >> 7, n = unit & 127; const long tok0 = (long)b * SEQ_ + n * 64;
        bf16x8 qf[2][4];
        { const bf16_t* qp = PROJ + (tok0 + ql) * PJW + 1024 + h * 64 + hi * 8;
#pragma unroll
          for (int qb = 0; qb < 2; ++qb)
#pragma unroll
              for (int d0 = 0; d0 < 4; ++d0) qf[qb][d0] = *(const bf16x8*)(qp + (long)qb * 32 * PJW + d0 * 16); }
        f32x16 o[2][2];
#pragma unroll
        for (int a = 0; a < 2; ++a)
#pragma unroll
            for (int c = 0; c < 2; ++c)
#pragma unroll
                for (int r = 0; r < 16; ++r) o[a][c][r] = 0.f;
        float lsum[2] = {0.f, 0.f};
        const int it0 = (n < 8) ? 2 * (8 - n) : 0;
        const bf16_t* kbase = PROJ + (tok0 - 512) * PJW + 1536 + h * 64;
        const bf16_t* vbase = VT + (long)(h * 64) * T_ + (tok0 - 512);
        const unsigned kgo = (unsigned)((lane >> 3) * PJW + (lane & 7) * 8), vgo = (unsigned)((lane >> 2) * T_ + (lane & 3) * 8);
        LAS unsigned char* kv = lds + 24576 + h * 8192;
        const unsigned wk = (unsigned)((lane >> 3) * 128 + (((lane & 7) ^ (lane >> 3)) * 16));
        const unsigned wv = (unsigned)(4096 + (lane >> 2) * 64 + (((lane & 3) ^ ((lane >> 3) & 3)) * 16));
        const unsigned rkb = (unsigned)(ql * 128), rks = (unsigned)(ql & 7), rvb = (unsigned)(4096 + ql * 64), rvs = (unsigned)((ql >> 1) & 3);
        bf16x8 kn[4], vn[4];
#define LOADKV(IT) do { const bf16_t* kp_ = kbase + (long)(IT) * 32 * PJW; const bf16_t* vp_ = vbase + (IT) * 32; \
        _Pragma("unroll") for (int i = 0; i < 4; ++i) { kn[i] = *(const bf16x8*)(kp_ + (kgo + (unsigned)(i * 8 * PJW))); vn[i] = *(const bf16x8*)(vp_ + (vgo + (unsigned)(i * 16 * T_))); } } while (0)
        LOADKV(it0);
        for (int it = it0; it < 18; ++it) {
#pragma unroll
            for (int i = 0; i < 4; ++i) { *(LAS bf16x8*)(kv + wk + i * 1024) = kn[i]; *(LAS bf16x8*)(kv + wv + i * 1024) = vn[i]; }
            { const int itn = (it + 1 < 18) ? it + 1 : it; LOADKV(itn); }
            bf16x8 kf[4], vf[2][2];
#pragma unroll
            for (int d0 = 0; d0 < 4; ++d0) kf[d0] = *(const LAS bf16x8*)(kv + rkb + (((unsigned)(2 * d0 + hi) ^ rks) * 16));
#pragma unroll
            for (int db = 0; db < 2; ++db)
#pragma unroll
                for (int ks = 0; ks < 2; ++ks) vf[db][ks] = *(const LAS bf16x8*)(kv + rvb + db * 2048 + (((unsigned)(2 * ks + hi) ^ rvs) * 16));
            const bool tab = (it >= 8);
#pragma unroll
            for (int qb = 0; qb < 2; ++qb) {
                f32x16 s;
                if (tab) { const LAS float* e = EXT + (63 - 32 * qb - ql + 32 * it + 4 * hi); f32x16 cin;
#pragma unroll
                    for (int r = 0; r < 16; ++r) cin[r] = e[(r & 3) + 8 * (r >> 2)];
                    s = MFMA32(kf[0], qf[qb][0], cin); }
                else { f32x16 z_;
#pragma unroll
                    for (int r = 0; r < 16; ++r) z_[r] = 0.f;
                    s = MFMA32(kf[0], qf[qb][0], z_); }
#pragma unroll
                for (int d0 = 1; d0 < 4; ++d0) s = MFMA32(kf[d0], qf[qb][d0], s);
                float ps = 0.f;
#pragma unroll
                for (int r = 0; r < 16; ++r) { s[r] = ex2(s[r]); ps += s[r]; }
                lsum[qb] += ps;
                bf16x8 pk[2];
#pragma unroll
                for (int ks = 0; ks < 2; ++ks) { u32x4 w; w.x = cvtpk(s[8 * ks], s[8 * ks + 1]); w.y = cvtpk(s[8 * ks + 2], s[8 * ks + 3]); w.z = cvtpk(s[8 * ks + 4], s[8 * ks + 5]); w.w = cvtpk(s[8 * ks + 6], s[8 * ks + 7]);
                    pk[ks] = __builtin_bit_cast(bf16x8, w); }
#pragma unroll
                for (int db = 0; db < 2; ++db)
#pragma unroll
                    for (int ks = 0; ks < 2; ++ks) o[db][qb] = MFMA32(vf[db][ks], pk[ks], o[db][qb]);
            }
        }
#undef LOADKV
        float inv[2], sq[2];
#pragma unroll
        for (int qb = 0; qb < 2; ++qb) { float l = lsum[qb]; l += __shfl_xor(l, 32); inv[qb] = 1.f / l; float q2 = 0.f;
#pragma unroll
            for (int db = 0; db < 2; ++db)
#pragma unroll
                for (int r = 0; r < 16; ++r) { const float v = o[db][qb][r] * inv[qb]; o[db][qb][r] = v; q2 += v * v; }
            q2 += __shfl_xor(q2, 32); sq[qb] = q2;
            if (hi == 0) SQ[h * 64 + 32 * qb + ql] = q2; }
        asm volatile("s_waitcnt lgkmcnt(0)" ::: "memory");
        __syncthreads();
#pragma unroll
        for (int qb = 0; qb < 2; ++qb) { float tot = 0.f;
#pragma unroll
            for (int hh = 0; hh < 8; ++hh) tot += SQ[hh * 64 + 32 * qb + ql];
            const float rstd = rsqf_(tot * (1.f / 512.f) + EPS_);
            bf16_t* op = MERGED + (tok0 + 32 * qb + ql) * DM_ + 512 + h * 64 + 4 * hi;
#pragma unroll
            for (int db = 0; db < 2; ++db)
#pragma unroll
                for (int r4 = 0; r4 < 4; ++r4) { u32x2 w; w.x = cvtpk(o[db][qb][4 * r4] * rstd, o[db][qb][4 * r4 + 1] * rstd); w.y = cvtpk(o[db][qb][4 * r4 + 2] * rstd, o[db][qb][4 * r4 + 3] * rstd);
                    *(u32x2*)(op + 32 * db + 8 * r4) = w; } }
        __syncthreads();
    }
}

template <bool PASS2>
__device__ __forceinline__ void lru_unit(LAS unsigned char* lds, int unit, const bf16_t* PROJ, const bf16_t* WGT, const float* conv_w, const float* conv_b, const float* b_rg, const float* b_ig,
                                         const float* lam, f32x2* SUMM, bf16_t* MERGED, const int wave_u) {
    int tid_ = wave_u * 64 + lane_id_v(); asm volatile("" : "+v"(tid_));
    const int tid = tid_, lane = tid & 63, w = __builtin_amdgcn_readfirstlane(tid >> 6), ql = lane & 31, hi = lane >> 5;
    const int b = unit >> 5, seg = unit & 31; const long tok0 = (long)b * SEQ_ + seg * 256;
    LAS bf16_t* XC = (LAS bf16_t*)lds + w * (64 * 72);
    LAS bf16_t* YT = (LAS bf16_t*)(lds + 73728);
    const int chc = 64 * w + lane;
    const float cw0 = conv_w[chc], cw1 = conv_w[512 + chc], cw2 = conv_w[1024 + chc], cw3 = conv_w[1536 + chc], cbv = conv_b[chc];
    float brg[2], big[2], sp[2];
#pragma unroll
    for (int nb = 0; nb < 2; ++nb) { const int ch = 64 * w + 32 * nb + ql; brg[nb] = b_rg[ch]; big[nb] = b_ig[ch];
        sp[nb] = -8.f * LOG2E * log1pf(expf(-lam[ch])); }
    float carry[2] = {0.f, 0.f}, ptot[2] = {1.f, 1.f};
    if (PASS2) {
#pragma unroll
        for (int nb = 0; nb < 2; ++nb) { float c = 0.f; const f32x2* sp_ = SUMM + (size_t)(b * 32) * 512 + 64 * w + 32 * nb + ql;
            for (int s0 = 0; s0 < seg; s0 += 8) { f32x2 v[8];
#pragma unroll
                for (int j = 0; j < 8; ++j) v[j] = (s0 + j < seg) ? sp_[(size_t)(s0 + j) * 512] : (f32x2){1.f, 0.f};
#pragma unroll
                for (int j = 0; j < 8; ++j) c = v[j].x * c + v[j].y; }
            carry[nb] = c; }
    }
#pragma nounroll
    for (int st = 0; st < 4; ++st) {
        const long t0 = tok0 + 64 * st;
        {
            const bf16_t* xp = PROJ + t0 * PJW + chc;
            float x1 = 0.f, x2 = 0.f, x3 = 0.f;
            if (seg != 0 || st != 0) { x1 = bf2f(xp[-1 * PJW]); x2 = bf2f(xp[-2 * PJW]); x3 = bf2f(xp[-3 * PJW]); }
#pragma unroll 16
            for (int t = 0; t < 64; ++t) { const float xv = bf2f(xp[(long)t * PJW]); const float xc = cbv + cw0 * x3 + cw1 * x2 + cw2 * x1 + cw3 * xv;
                XC[t * 72 + lane] = (bf16_t)(cvtpk(xc, 0.f) & 0xffffu); x3 = x2; x2 = x1; x1 = xv; }
        }
        asm volatile("s_waitcnt lgkmcnt(0)" ::: "memory");
#pragma unroll
        for (int nb = 0; nb < 2; ++nb) {
            bf16x8 wrf[4], wif[4];
            { int woff = ((w * 64 + 32 * nb + ql) * 64 + 8 * hi); asm volatile("" : "+v"(woff));
#pragma unroll
              for (int ks = 0; ks < 4; ++ks) { wrf[ks] = *(const bf16x8*)(WGT + woff + 16 * ks); wif[ks] = *(const bf16x8*)(WGT + 8 * 4096 + woff + 16 * ks); } }
#pragma unroll
            for (int tb = 0; tb < 2; ++tb) {
                bf16x8 af[4];
#pragma unroll
                for (int ks = 0; ks < 4; ++ks) af[ks] = *(const LAS bf16x8*)(XC + (32 * tb + ql) * 72 + 16 * ks + 8 * hi);
                f32x16 dr, di;
#pragma unroll
                for (int r = 0; r < 16; ++r) { dr[r] = 0.f; di[r] = 0.f; }
#pragma unroll
                for (int ks = 0; ks < 4; ++ks) { dr = MFMA32(af[ks], wrf[ks], dr); di = MFMA32(af[ks], wif[ks], di); }
                float A[16], U[16];
#pragma unroll
                for (int r = 0; r < 16; ++r) { const int tok = 32 * tb + crow(r, hi); const float xcv = bf2f(XC[tok * 72 + 32 * nb + ql]);
                    const float rg = sigm(dr[r] + brg[nb]), ig = sigm(di[r] + big[nb]); const float a = ex2(rg * sp[nb]);
                    const float mult = __builtin_amdgcn_sqrtf(fmaxf(1.f - a * a, 0.f)); A[r] = a; U[r] = mult * ig * xcv; }
#pragma unroll
                for (int q4 = 0; q4 < 4; ++q4)
#pragma unroll
                    for (int e = 1; e < 4; ++e) { U[4 * q4 + e] = A[4 * q4 + e] * U[4 * q4 + e - 1] + U[4 * q4 + e]; A[4 * q4 + e] = A[4 * q4 + e - 1] * A[4 * q4 + e]; }
                float c = carry[nb], HIN[4];
#pragma unroll
                for (int q4 = 0; q4 < 4; ++q4) { const float e0 = A[4 * q4 + 3] * c + U[4 * q4 + 3]; const float p = __shfl_xor(e0, 32); const float hin = hi ? p : c; HIN[q4] = hin;
                    const float e1 = A[4 * q4 + 3] * hin + U[4 * q4 + 3]; const float q = __shfl_xor(e1, 32); c = hi ? e1 : q; }
                carry[nb] = c;
                if (!PASS2) { const float po = (A[3] * A[7]) * (A[11] * A[15]); ptot[nb] *= po * __shfl_xor(po, 32); }
                else {
                    const bf16_t* gb = PROJ + t0 * PJW + 512 + 64 * w + 32 * nb + (32 * tb) * PJW;
                    const unsigned goff = (unsigned)(4 * hi) * PJW + ql;
#pragma unroll
                    for (int r = 0; r < 16; ++r) { const int tok = 32 * tb + crow(r, hi); const float hval = U[r] + A[r] * HIN[r >> 2]; const float gl = bf2f(gb[goff + (unsigned)((r & 3) + 8 * (r >> 2)) * PJW]);
                        YT[tok * 520 + 64 * w + 32 * nb + ql] = (bf16_t)(cvtpk(hval * gl, 0.f) & 0xffffu); }
                }
            }
        }
        if (PASS2) {
            asm volatile("s_waitcnt lgkmcnt(0)" ::: "memory");
            __syncthreads();
#pragma unroll
            for (int i = 0; i < 8; ++i) { const int tok = 8 * w + i; const u32x4 v = *(const LAS u32x4*)(YT + tok * 520 + 8 * lane);
                const float f0 = bflo(v.x), f1 = bfhi(v.x), f2 = bflo(v.y), f3 = bfhi(v.y), f4 = bflo(v.z), f5 = bfhi(v.z), f6 = bflo(v.w), f7 = bfhi(v.w);
                float ss = (f0 * f0 + f1 * f1) + (f2 * f2 + f3 * f3) + (f4 * f4 + f5 * f5) + (f6 * f6 + f7 * f7); ss = wave_sum(ss);
                const float rs = rsqf_(ss * (1.f / 512.f) + EPS_);
                u32x4 o; o.x = cvtpk(f0 * rs, f1 * rs); o.y = cvtpk(f2 * rs, f3 * rs); o.z = cvtpk(f4 * rs, f5 * rs); o.w = cvtpk(f6 * rs, f7 * rs);
                *(u32x4*)(MERGED + (t0 + tok) * DM_ + 8 * lane) = o; }
            __syncthreads();
        }
        asm volatile("" ::: "memory");
    }
    if (!PASS2) { if (hi == 0) {
#pragma unroll
        for (int nb = 0; nb < 2; ++nb) SUMM[(size_t)unit * 512 + 64 * w + 32 * nb + ql] = (f32x2){ptot[nb], carry[nb]}; } }
}

#ifndef PROBE_MASK
#define PROBE_MASK 0
#endif
#ifndef RES_BF16
#define RES_BF16 1
#endif
struct Args { const float* in[23]; float* out; unsigned char* ws; };
__global__ void __launch_bounds__(NTHR, 2) fwd_megakernel(Args args) {
    extern __shared__ __attribute__((aligned(16))) unsigned char lds_raw[];
    cg::grid_group grid = cg::this_grid();
    LAS unsigned char* lds = (LAS unsigned char*)lds_raw;
    const int wave = __builtin_amdgcn_readfirstlane(threadIdx.x >> 6);
#define tid (wave * 64 + lane_id_v())
#define lane (lane_id_v())
    const int G = gridDim.x, bx = blockIdx.x, vcu = (G % 8 == 0) ? (bx % 8) * (G / 8) + bx / 8 : bx;
    unsigned char* ws = args.ws;
    volatile LAS unsigned* MISC = (volatile LAS unsigned*)(lds + MISC_OFF);
    if (threadIdx.x < 16) MISC[threadIdx.x] = 0u;
    __syncthreads();
    XcdBarrier bar; bar.bar = (unsigned*)(ws + WS_CTL); bar.x = xb_xcc_id(); bar.st = MISC;
    if (blockIdx.x == 0) for (int i = threadIdx.x; i < (int)(CTL_BYTES / 4); i += NTHR) bar.bar[i] = 0u;
    const float* x = args.in[0]; const float* p = args.in[1]; float* out = args.out;
    bf16_t* WT_IN = (bf16_t*)(ws + WS_WIN); bf16_t* WT_OUT = (bf16_t*)(ws + WS_WOUT); bf16_t* WT_UP = (bf16_t*)(ws + WS_WUP); bf16_t* WT_DN = (bf16_t*)(ws + WS_WDN);
    bf16_t* WT_PG = (bf16_t*)(ws + WS_WPG); bf16_t* WT_PP = (bf16_t*)(ws + WS_WPP); bf16_t* WGT = (bf16_t*)(ws + WS_WG);
    float* RSTD1 = (float*)(ws + WS_RSTD1); float* RSTD2 = (float*)(ws + WS_RSTD2); f32x2* SUMM = (f32x2*)(ws + WS_SUMM);
    bf16_t* XN = (bf16_t*)(ws + WS_XN); bf16_t* PP = (bf16_t*)(ws + WS_PP); bf16_t* PB = (bf16_t*)(ws + WS_PB);
    bf16_t* PROJ = (bf16_t*)(ws + WS_PROJ); bf16_t* VT = (bf16_t*)(ws + WS_VT); bf16_t* MERGED = (bf16_t*)(ws + WS_MERGED); bf16_t* ACT = (bf16_t*)(ws + WS_ACT);

    for (int rep_ = 0; rep_ < 1 + ((PROBE_MASK >> 0) & 1); ++rep_) {
        LAS float* scr = (LAS float*)(lds + wave * 16384);
        const int gw = vcu * NWAVES + wave, NGW = G * NWAVES;
        constexpr int I_IN = 16 * 80, I_OUT = 16 * 32, I_UP = 16 * 128, I_DN = 64 * 32, I_PG = 16 * 32, I_PP = 4 * 32;
        constexpr int NITEMS = I_IN + I_OUT + I_UP + I_DN + I_PG + I_PP;
        for (int it = gw; it < NITEMS; it += NGW) {
            int r = it;
            if (r < I_IN) { p0_transpose_item(args.in[3], 1024, 2560, WT_IN, nullptr, nullptr, 0, scr, r, lane); continue; } r -= I_IN;
            if (r < I_OUT) { p0_transpose_item(args.in[16], 1024, 1024, WT_OUT, args.in[14], args.in[15], 512, scr, r, lane); continue; } r -= I_OUT;
            if (r < I_UP) { p0_transpose_item(args.in[18], 1024, 4096, WT_UP, args.in[17], args.in[17], 1 << 30, scr, r, lane); continue; } r -= I_UP;
            if (r < I_DN) { p0_transpose_item(args.in[19], 4096, 1024, WT_DN, nullptr, nullptr, 0, scr, r, lane); continue; } r -= I_DN;
            if (r < I_PG) { p0_transpose_item(args.in[21], 1024, 1024, WT_PG, args.in[20], args.in[20], 1 << 30, scr, r, lane); continue; } r -= I_PG;
            p0_transpose_item(args.in[22], 256, 1024, WT_PP, nullptr, nullptr, 0, scr, r, lane);
        }
        for (int i = bx * NTHR + tid; i < T_; i += G * NTHR) { RSTD1[i] = 0.f; RSTD2[i] = 0.f; }
        for (int i = bx * NTHR + tid; i < 65536; i += G * NTHR) { const int k = i & 63, n = (i >> 6) & 63, blk = (i >> 12) & 7, gate = i >> 15;
            const float v = (gate ? args.in[8] : args.in[6])[blk * 4096 + k * 64 + n]; WGT[i] = (bf16_t)(cvtpk(v, 0.f) & 0xffffu); }
        const float* g1 = args.in[2];
        f32x4 gv[4];
#pragma unroll
        for (int j = 0; j < 4; ++j) gv[j] = *((const f32x4*)g1 + lane + 64 * j);
        for (int m = gw; m < T_; m += NGW) {
            const f32x4* xr = (const f32x4*)(x + (size_t)m * DM_) + lane; f32x4 v[4]; float s = 0.f;
#pragma unroll
            for (int j = 0; j < 4; ++j) { v[j] = __builtin_nontemporal_load(xr + 64 * j); s += (v[j].x * v[j].x + v[j].y * v[j].y) + (v[j].z * v[j].z + v[j].w * v[j].w); }
            const float rstd = rsqf_(wave_sum(s) * (1.f / DM_) + EPS_);
            u32x2* o8 = (u32x2*)(XN + (size_t)m * DM_) + lane;
#pragma unroll
            for (int j = 0; j < 4; ++j) { const f32x4 y = v[j] * gv[j] * rstd; u32x2 w; w.x = cvtpk(y.x, y.y); w.y = cvtpk(y.z, y.w); o8[64 * j] = w; }
            const f32x4 pv = __builtin_nontemporal_load((const f32x4*)(p + (size_t)m * PLE_) + lane); u32x2 pw; pw.x = cvtpk(pv.x, pv.y); pw.y = cvtpk(pv.z, pv.w);
            *((u32x2*)(PB + (size_t)m * PLE_) + lane) = pw;
        }
    }
    grid.sync();
    if (threadIdx.x == 0) MISC[2] = xb_add(&bar.bar[XB_XCNT(bar.x)], 1u);
    int cid = bx, vcu2 = vcu;
#define CENSUS_IDS() do { \
    if (threadIdx.x == 0) { unsigned okc = 1u; \
        for (unsigned j = 0; j < 16; ++j) { const unsigned c_ = xb_ld(&bar.bar[XB_XCNT(j)]); okc &= (j < 8 ? (c_ == (unsigned)G / 8u) : (c_ == 0u)) ? 1u : 0u; } \
        MISC[3] = (okc && (G % 8 == 0)) ? 1u : 0u; } \
    __syncthreads(); \
    { const bool okmap = MISC[3] != 0u; \
      cid = __builtin_amdgcn_readfirstlane(okmap ? (int)(MISC[2] * 8u + bar.x) : bx); \
      vcu2 = __builtin_amdgcn_readfirstlane(okmap ? (int)(bar.x * (unsigned)(G / 8) + MISC[2]) : vcu); } } while (0)
#if 0
    if (threadIdx.x == 0) { unsigned okc = 1u;
        for (unsigned j = 0; j < 16; ++j) { const unsigned c_ = xb_ld(&bar.bar[XB_XCNT(j)]); okc &= (j < 8 ? (c_ == (unsigned)G / 8u) : (c_ == 0u)) ? 1u : 0u; }
        MISC[3] = (okc && (G % 8 == 0)) ? 1u : 0u; }
    __syncthreads();
    const bool okmap = MISC[3] != 0u;
    const int cid = __builtin_amdgcn_readfirstlane(okmap ? (int)(MISC[2] * 8u + bar.x) : bx);
    const int vcu2 = __builtin_amdgcn_readfirstlane(okmap ? (int)(bar.x * (unsigned)(G / 8) + MISC[2]) : vcu);
#endif
    for (int rep_ = 0; rep_ < 1 + ((PROBE_MASK >> 1) & 1); ++rep_) {
        { pg8::Gemm g{XN, WT_IN, T_, 2048, 1024}; pg8::StaticOrder S; S.init(T_, 2048, G, cid); EpiProj E{PROJ, args.in[11], args.in[12]};
          pg8::gemm_phase<EpiProj, pg8::StaticOrder, PG8_ALIGN, PG8_SP2>(lds, g, S, E, wave); }
        { pg8::Gemm g{WT_IN + (size_t)2048 * 1024, XN, 512, T_, 1024}; pg8::StaticOrder S; S.init(512, T_, G, cid); EpiVT E{VT};
          pg8::gemm_phase<EpiVT, pg8::StaticOrder, PG8_ALIGN, PG8_SP2>(lds, g, S, E, wave); }
    }
    xcd_barrier(bar);
    CENSUS_IDS();
    for (int rep_ = 0; rep_ < 1 + ((PROBE_MASK >> 2) & 1); ++rep_)
    attn_phase(lds, PROJ, VT, args.in[11]  , args.in[12], args.in[13], MERGED, vcu2, G, wave);
    for (int rep_ = 0; rep_ < 1 + ((PROBE_MASK >> 3) & 1); ++rep_)
    for (int unit = vcu2; unit < NUNIT_LRU; unit += G)
        lru_unit<false>(lds, unit, PROJ, WGT, args.in[4], args.in[5], args.in[7], args.in[9], args.in[10], SUMM, MERGED, wave);
    xcd_barrier(bar);
    for (int rep_ = 0; rep_ < 1 + ((PROBE_MASK >> 4) & 1); ++rep_)
    for (int unit = vcu2; unit < NUNIT_LRU; unit += G)
        lru_unit<true>(lds, unit, PROJ, WGT, args.in[4], args.in[5], args.in[7], args.in[9], args.in[10], SUMM, MERGED, wave);
    xcd_barrier(bar);
#if RES_BF16
    { pg8::Gemm g{MERGED, WT_OUT, T_, 1024, 1024}; pg8::StaticOrder S; S.init(T_, 1024, G, cid); EpiRes4 E{x, XN, RSTD1};
      pg8::gemm_phase<EpiRes4, pg8::StaticOrder, PG8_ALIGN, PG8_SP2>(lds, g, S, E, wave); }
#else
    for (int rep_ = ((PROBE_MASK >> 5) & 1) ? 0 : 1; rep_ < 2; ++rep_)
    { pg8::Gemm g{MERGED, WT_OUT, T_, 1024, 1024}; pg8::StaticOrder S; S.init(T_, 1024, G, cid); EpiRes E{x, out, XN, rep_ ? RSTD1 : (float*)(ws + WS_DUMMY), 0xFFFF};
      pg8::gemm_phase<EpiRes, pg8::StaticOrder, PG8_ALIGN, PG8_SP2>(lds, g, S, E, wave); }
#endif
    xcd_barrier(bar);
    for (int rep_ = 0; rep_ < 1 + ((PROBE_MASK >> 6) & 1); ++rep_) { pg8::Gemm g{XN, WT_UP, T_, 4096, 1024}; pg8::StaticOrder S; S.init(T_, 4096, G, cid); EpiUp E{ACT, RSTD1};
      pg8::gemm_phase<EpiUp, pg8::StaticOrder, PG8_ALIGN, PG8_SP2, (PROBE_MASK >> 9) & 1>(lds, g, S, E, wave); }
    xcd_barrier(bar);
#if RES_BF16
    { pg8::Gemm g{ACT, WT_DN, T_, 1024, 4096}; pg8::StaticOrder S; S.init(T_, 1024, G, cid); EpiRes6 E{XN, RSTD2};
      pg8::gemm_phase<EpiRes6, pg8::StaticOrder, PG8_ALIGN, PG8_SP2>(lds, g, S, E, wave); }
#else
    for (int rep_ = ((PROBE_MASK >> 7) & 1) ? 0 : 1; rep_ < 2; ++rep_)
    { pg8::Gemm g{ACT, WT_DN, T_, 1024, 4096}; pg8::StaticOrder S; S.init(T_, 1024, G, cid);
      EpiRes E{out, rep_ ? out : (float*)(ws + WS_END), XN, rep_ ? RSTD2 : (float*)(ws + WS_DUMMY), rep_ ? 0xFFFF : 0x7FFF};
      pg8::gemm_phase<EpiRes, pg8::StaticOrder, PG8_ALIGN, PG8_SP2>(lds, g, S, E, wave); }
#endif
    xcd_barrier(bar);
#if RES_BF16
    { pg8::StaticOrder S; S.init(T_, 1024, G, cid); EpiMidPP EM{(u32x4*)(ws + WS_PP) + (size_t)bx * 8192}; EpiFinalC EF{XN, out, RSTD2, (const u32x4*)(ws + WS_PP) + (size_t)bx * 8192};
      pg8::gemm_phase_ple<EpiMidPP, EpiFinalC, pg8::StaticOrder>(lds, PB, WT_PP, XN, WT_PG, S, EM, EF, wave); }
#else
    for (int rep_ = ((PROBE_MASK >> 8) & 1) ? 0 : 1; rep_ < 2; ++rep_)
    { pg8::Gemm g{XN, WT_PG, T_, 1024, 1024}; pg8::StaticOrder S; S.init(T_, 1024, G, cid); EpiFinal E{out, rep_ ? out : (float*)ACT, PP, RSTD2};
      pg8::gemm_phase<EpiFinal, pg8::StaticOrder, PG8_ALIGN, PG8_SP2>(lds, g, S, E, wave); }
#endif
}

#undef tid
#undef lane
extern "C" void kernel_launch(void* const* d_in, const int* in_sizes, int n_in, void* d_out, int out_size, void* d_ws, size_t ws_size, hipStream_t stream) {
    static int grid = 0;
    if (grid == 0) {
        if (n_in != 23 || in_sizes[0] != T_ * DM_ || out_size != T_ * DM_ || ws_size < WS_END) { fprintf(stderr, "kernel_launch: unexpected shapes (n_in %d, in0 %d, out %d, ws %zu)\n", n_in, n_in > 0 ? in_sizes[0] : -1, out_size, ws_size); grid = -1; return; }
        int dev = 0, cus = 0, per_cu = 0;
        (void)hipGetDevice(&dev); (void)hipDeviceGetAttribute(&cus, hipDeviceAttributeMultiprocessorCount, dev);
        (void)hipFuncSetAttribute((const void*)fwd_megakernel, hipFuncAttributeMaxDynamicSharedMemorySize, LDS_BYTES);
        if (hipOccupancyMaxActiveBlocksPerMultiprocessor(&per_cu, (const void*)fwd_megakernel, NTHR, LDS_BYTES) != hipSuccess || per_cu < 1) per_cu = 1;
        (void)hipGetLastError();
        grid = cus * per_cu;
        if (grid > 256) grid = 256;
        fprintf(stderr, "kernel_launch: cus %d per_cu %d grid %d\n", cus, per_cu, grid);
    }
    if (grid < 0) return;
    Args a{};
    for (int i = 0; i < 23; ++i) a.in[i] = (const float*)d_in[i];
    a.out = (float*)d_out; a.ws = (unsigned char*)d_ws;
    void* kargs[] = {&a};
    hipError_t e = hipLaunchCooperativeKernel((const void*)fwd_megakernel, dim3(grid), dim3(NTHR), kargs, LDS_BYTES, stream);
    if (e != hipSuccess) fprintf(stderr, "kernel_launch: cooperative launch failed: %s (grid %d)\n", hipGetErrorString(e), grid);
}
```

```cpp
#include <hip/hip_runtime.h>
#include <hip/hip_cooperative_groups.h>
#include <cstdio>
#include <cstdint>
namespace cg = cooperative_groups;
__device__ __forceinline__ int lane_id_v() { int l; asm volatile("v_mbcnt_lo_u32_b32 %0, -1, 0\n\tv_mbcnt_hi_u32_b32 %0, -1, %0" : "=v"(l)); return l; }
namespace pg8 {
#define PG8_LAS __attribute__((address_space(3)))
typedef unsigned short bf16_t;
typedef short bf16x8 __attribute__((ext_vector_type(8)));
typedef float f32x4 __attribute__((ext_vector_type(4)));
typedef unsigned u32x4 __attribute__((ext_vector_type(4)));
constexpr int BM = 256, BK = 64, HALF = 128, HTB = HALF * BK * 2  , STAGE_BYTES = 8 * HTB, NXCD = 8, WGM = 8;

__host__ __device__ __forceinline__ int lds_byte(int r, int c) { const int st = (r >> 4) * 2 + (c >> 5), rr = r & 15, cc = c & 31, ob = rr * 64 + cc * 2; return st * 1024 + (ob ^ (((ob >> 9) & 1) << 5)); }
__host__ __device__ __forceinline__ void stage_rc(int b, int& R, int& C) { const int st = b / 1024, sb = b % 1024, swz = sb ^ (((sb >> 9) & 1) << 5); R = (st >> 1) * 16 + swz / 64; C = (st & 1) * 32 + (swz % 64) / 2; }
__host__ __device__ __forceinline__ int perm32(int rho) { const int n = rho >> 4, i = rho & 15; return 8 * (i >> 2) + 4 * n + (i & 3); }

struct Unit { int pm, pn; };
struct Gemm { const bf16_t* A; const bf16_t* Bt; int M, N, K; };

struct StaticOrder {
    int nM, nN, nwg, G, c;
    __host__ __device__ void init(int M, int N, int G_, int c_) { nM = M / BM; nN = N / BM; nwg = nM * nN; G = G_; c = c_; }
    __host__ __device__ bool next(int i, Unit& u) const {
        const long L = (long)i * G + c; if (L >= nwg) return false;
        int wgid = (int)L; { const int q = nwg / NXCD, r = nwg % NXCD, xcd = wgid % NXCD, off = wgid / NXCD; wgid = (xcd < r ? xcd * (q + 1) : r * (q + 1) + (xcd - r) * q) + off; }
        const int nig = WGM * nN, gid = wgid / nig, fm = gid * WGM, gsz = (nM - fm) < WGM ? (nM - fm) : WGM;
        u.pm = fm + ((wgid % nig) % gsz); u.pn = (wgid % nig) / gsz; return true;
    }
    __device__ __forceinline__ void a_ready(const Unit&) const {}
    __device__ __forceinline__ void done(const Unit&) const {}
};

__device__ __forceinline__ unsigned cvt_pk_bf16(float lo, float hi) { unsigned r; asm volatile("v_cvt_pk_bf16_f32 %0, %1, %2" : "=v"(r) : "v"(lo), "v"(hi)); return r; }
typedef float f32x2 __attribute__((ext_vector_type(2)));
template <class Epi, class Sched, bool ALIGN_EPI = false, bool SP2 = false, bool EPI2 = false>
__device__ __forceinline__ void gemm_phase(PG8_LAS unsigned char* lds, const Gemm g, const Sched& S, const Epi& E, const int wave_u) {
    int tid_ = wave_u * 64 + lane_id_v(); asm volatile("" : "+v"(tid_));
    const int tid = tid_, wid = __builtin_amdgcn_readfirstlane(tid >> 6), lane = tid & 63, wr = wid >> 2, wc = wid & 3, fr = lane & 15, fq = lane >> 4;
    const int K = g.K, nt = K / BK;
    unsigned voffA[2], voffB[2];
#pragma unroll
    for (int i = 0; i < 2; ++i) { int R, C; stage_rc(tid * 16 + i * 8192, R, C); const int Rp = Epi::PERM ? perm32(R & 31) : (R & 31); const int Rb = Epi::HEADMAP ? (64 * (R >> 5) + Rp) : ((R & ~31) + Rp);
        voffA[i] = (unsigned)(R * K + C) * 2u; voffB[i] = (unsigned)(Rb * K + C) * 2u; }
    const size_t kstep = (size_t)(BK * 2);
    const size_t hstep = (size_t)HALF * K * 2;
    const size_t hstepB = Epi::HEADMAP ? (size_t)32 * K * 2 : hstep;
    const size_t tstep = 2 * hstep;
    const unsigned ldsw = (unsigned)wid * 1024u;
    const int aoff = lds_byte(wr * 64 + fr, fq * 8), boff = lds_byte(wc * 32 + fr, fq * 8);
#define PG8_SA(b, h) (((b) * 2 + (h)) * HTB)
#define PG8_SB(b, h) ((4 + (b) * 2 + (h)) * HTB)
#define PG8_STAGE(bufoff, gbase, voff) do { _Pragma("unroll") for (int _i = 0; _i < 2; ++_i) \
        __builtin_amdgcn_global_load_lds((const unsigned*)((const char*)(gbase) + (voff)[_i]), (PG8_LAS unsigned*)(lds + (bufoff) + ldsw + _i * 8192), 16, 0, 0); } while (0)
#define PG8_LDA(dst, b, h) do { _Pragma("unroll") for (int m = 0; m < 4; ++m) _Pragma("unroll") for (int k = 0; k < 2; ++k) dst[m][k] = *(const PG8_LAS bf16x8*)(lds + PG8_SA(b, h) + aoff + m * 2048 + k * 1024); } while (0)
#define PG8_LDB(dst, b, h) do { _Pragma("unroll") for (int n = 0; n < 2; ++n) _Pragma("unroll") for (int k = 0; k < 2; ++k) dst[n][k] = *(const PG8_LAS bf16x8*)(lds + PG8_SB(b, h) + boff + n * 2048 + k * 1024); } while (0)
#define PG8_MMA(ai, bj, At, Bt) do { __builtin_amdgcn_s_setprio(1); _Pragma("unroll") for (int m = 0; m < 4; ++m) _Pragma("unroll") for (int n = 0; n < 2; ++n) _Pragma("unroll") for (int k = 0; k < 2; ++k) \
        acc[ai][bj][m][n] = __builtin_amdgcn_mfma_f32_16x16x32_bf16(Bt[n][k], At[m][k], acc[ai][bj][m][n], 0, 0, 0); __builtin_amdgcn_s_setprio(0); } while (0)
#define PG8_WAIT_V(n) asm volatile("s_waitcnt vmcnt(" #n ")" ::: "memory")
#define PG8_WAIT_L(n) asm volatile("s_waitcnt lgkmcnt(" #n ")" ::: "memory")
#define PG8_BAR __builtin_amdgcn_s_barrier()
#define PG8_SCHED __builtin_amdgcn_sched_barrier(0)
    Unit cur, nxt; int ui = 0;
    if (!S.next(0, cur)) return;
    f32x4 acc[2][2][4][2];
#pragma unroll
    for (int a = 0; a < 2; ++a)
#pragma unroll
        for (int b = 0; b < 2; ++b)
#pragma unroll
            for (int m = 0; m < 4; ++m)
#pragma unroll
                for (int n = 0; n < 2; ++n) acc[a][b][m][n] = (f32x4){0.f, 0.f, 0.f, 0.f};
    bf16x8 At[4][2], B0[2][2], B1[2][2];
    const char* cA = (const char*)g.A + (size_t)cur.pm * tstep; const char* cB = (const char*)g.Bt + (size_t)cur.pn * tstep;
    S.a_ready(cur);
    if constexpr (SP2) {
        PG8_STAGE(PG8_SB(0, 0), cB, voffB); PG8_STAGE(PG8_SB(0, 1), cB + hstepB, voffB); PG8_STAGE(PG8_SA(0, 0), cA, voffA); PG8_STAGE(PG8_SA(0, 1), cA + hstep, voffA);
        if (wr == 1) PG8_BAR;
        PG8_WAIT_V(2); PG8_BAR;
        PG8_STAGE(PG8_SB(1, 0), cB + kstep, voffB); PG8_STAGE(PG8_SA(1, 0), cA + kstep, voffA); PG8_STAGE(PG8_SB(1, 1), cB + hstepB + kstep, voffB);
        PG8_WAIT_V(6); PG8_BAR;
    } else {
        PG8_STAGE(PG8_SB(0, 0), cB, voffB); PG8_STAGE(PG8_SA(0, 0), cA, voffA); PG8_STAGE(PG8_SB(0, 1), cB + hstepB, voffB); PG8_STAGE(PG8_SA(0, 1), cA + hstep, voffA);
        if (wr == 1) PG8_BAR;
        PG8_WAIT_V(4); PG8_BAR;
        PG8_STAGE(PG8_SB(1, 0), cB + kstep, voffB); PG8_STAGE(PG8_SA(1, 0), cA + kstep, voffA); PG8_STAGE(PG8_SB(1, 1), cB + hstepB + kstep, voffB);
        PG8_WAIT_V(6); PG8_BAR;
    }
    for (;;) {
        const bool has_next = S.next(ui + 1, nxt);
        const char* nA = has_next ? (const char*)g.A + (size_t)nxt.pm * tstep : cA; const char* nB = has_next ? (const char*)g.Bt + (size_t)nxt.pn * tstep : cB;
#pragma nounroll
        for (int t = 0; t < nt; t += 2) {
            const bool last = (t == nt - 2);
            const char* a1 = cA + (size_t)(t + 1) * kstep;
            const char* a2 = last ? nA : cA + (size_t)(t + 2) * kstep; const char* b2 = last ? nB : cB + (size_t)(t + 2) * kstep;
            const char* a3 = a2 + kstep; const char* b3 = b2 + kstep;
            if (last && has_next) S.a_ready(nxt);
            if constexpr (SP2) {
            PG8_LDB(B0, 0, 0); PG8_LDB(B1, 0, 1); PG8_SCHED; PG8_LDA(At, 0, 0); PG8_STAGE(PG8_SA(1, 1), a1 + hstep, voffA);
            PG8_WAIT_V(8); PG8_WAIT_L(0); PG8_BAR; PG8_MMA(0, 0, At, B0); PG8_MMA(0, 1, At, B1); PG8_BAR; PG8_SCHED;
            PG8_LDA(At, 0, 1); PG8_STAGE(PG8_SB(0, 0), b2, voffB); PG8_STAGE(PG8_SB(0, 1), b2 + hstepB, voffB); PG8_STAGE(PG8_SA(0, 0), a2, voffA);
            PG8_WAIT_V(8); PG8_WAIT_L(0); PG8_BAR; PG8_MMA(1, 0, At, B0); PG8_MMA(1, 1, At, B1); PG8_BAR; PG8_SCHED;
            PG8_LDB(B0, 1, 0); PG8_LDB(B1, 1, 1); PG8_SCHED; PG8_LDA(At, 1, 0); PG8_STAGE(PG8_SA(0, 1), a2 + hstep, voffA);
            PG8_WAIT_V(8); PG8_WAIT_L(0); PG8_BAR; PG8_MMA(0, 0, At, B0); PG8_MMA(0, 1, At, B1); PG8_BAR; PG8_SCHED;
            PG8_LDA(At, 1, 1); PG8_STAGE(PG8_SB(1, 0), b3, voffB); PG8_STAGE(PG8_SB(1, 1), b3 + hstepB, voffB); PG8_STAGE(PG8_SA(1, 0), a3, voffA);
            PG8_WAIT_V(8); PG8_WAIT_L(0); PG8_BAR; PG8_MMA(1, 0, At, B0); PG8_MMA(1, 1, At, B1); PG8_BAR; PG8_SCHED;
            } else {
            PG8_LDB(B0, 0, 0); PG8_SCHED; PG8_LDA(At, 0, 0); PG8_STAGE(PG8_SA(1, 1), a1 + hstep, voffA);
            PG8_WAIT_L(8); PG8_BAR; PG8_WAIT_L(0); PG8_MMA(0, 0, At, B0); PG8_BAR; PG8_SCHED;
            PG8_LDB(B1, 0, 1); PG8_STAGE(PG8_SB(0, 0), b2, voffB);
            PG8_BAR; PG8_WAIT_L(0); PG8_MMA(0, 1, At, B1); PG8_BAR;
            PG8_LDA(At, 0, 1); PG8_STAGE(PG8_SA(0, 0), a2, voffA);
            PG8_BAR; PG8_WAIT_L(0); PG8_MMA(1, 0, At, B0); PG8_BAR; PG8_SCHED;
            PG8_STAGE(PG8_SB(0, 1), b2 + hstepB, voffB);
            PG8_WAIT_V(6); PG8_BAR; PG8_MMA(1, 1, At, B1); PG8_BAR;
            PG8_LDB(B0, 1, 0); PG8_SCHED; PG8_LDA(At, 1, 0); PG8_STAGE(PG8_SA(0, 1), a2 + hstep, voffA);
            PG8_WAIT_L(8); PG8_BAR; PG8_WAIT_L(0); PG8_MMA(0, 0, At, B0); PG8_BAR; PG8_SCHED;
            PG8_LDB(B1, 1, 1); PG8_STAGE(PG8_SB(1, 0), b3, voffB);
            PG8_BAR; PG8_WAIT_L(0); PG8_MMA(0, 1, At, B1); PG8_BAR;
            PG8_LDA(At, 1, 1); PG8_STAGE(PG8_SA(1, 0), a3, voffA);
            PG8_BAR; PG8_WAIT_L(0); PG8_MMA(1, 0, At, B0); PG8_BAR; PG8_SCHED;
            PG8_STAGE(PG8_SB(1, 1), b3 + hstepB, voffB);
            PG8_WAIT_V(6); PG8_BAR; PG8_MMA(1, 1, At, B1); PG8_BAR;
            }
        }
        if constexpr (ALIGN_EPI) { if (wr == 0) PG8_BAR; }
        if constexpr (!Epi::AFTER_DRAIN) { E(acc, cur, wr, wc, fr, fq); if constexpr (EPI2) { asm volatile("" ::: "memory"); E(acc, cur, wr, wc, fr, fq); } S.done(cur); }
        if (!has_next) break;
#pragma unroll
        for (int a = 0; a < 2; ++a)
#pragma unroll
            for (int b = 0; b < 2; ++b)
#pragma unroll
                for (int m = 0; m < 4; ++m)
#pragma unroll
                    for (int n = 0; n < 2; ++n) acc[a][b][m][n] = (f32x4){0.f, 0.f, 0.f, 0.f};
        cur = nxt; cA = nA; cB = nB; ++ui;
        if constexpr (ALIGN_EPI) { if (wr == 1) PG8_BAR; }
    }
    PG8_WAIT_V(0);
    if constexpr (!ALIGN_EPI) { if (wr == 0) PG8_BAR; }
    PG8_BAR;
    if constexpr (Epi::AFTER_DRAIN) { E.fused(acc, cur, wr, wc, fr, fq, lds, wid, lane); S.done(cur); }
#undef PG8_SA
#undef PG8_SB
#undef PG8_STAGE
#undef PG8_LDA
#undef PG8_LDB
#undef PG8_MMA
#undef PG8_WAIT_V
#undef PG8_WAIT_L
#undef PG8_BAR
#undef PG8_SCHED
}

template <class EpiMid, class EpiFin, class Sched>
__device__ __forceinline__ void gemm_phase_ple(PG8_LAS unsigned char* lds, const bf16_t* AP, const bf16_t* BP, const bf16_t* AZ, const bf16_t* BZ, const Sched& S, const EpiMid& EM, const EpiFin& E, const int wave_u) {
    constexpr bool ALIGN_EPI = true;
    int tid_ = wave_u * 64 + lane_id_v(); asm volatile("" : "+v"(tid_));
    const int tid = tid_, wid = __builtin_amdgcn_readfirstlane(tid >> 6), lane = tid & 63, wr = wid >> 2, wc = wid & 3, fr = lane & 15, fq = lane >> 4;
    constexpr int KP = 256, KZ = 1024, NT = 20;
    unsigned vAP[2], vBP[2], vAZ[2], vBZ[2];
#pragma unroll
    for (int i = 0; i < 2; ++i) { int R, C; stage_rc(tid * 16 + i * 8192, R, C); const int Rb = (R & ~31) + perm32(R & 31);
        vAP[i] = (unsigned)(R * KP + C) * 2u; vBP[i] = (unsigned)(Rb * KP + C) * 2u; vAZ[i] = (unsigned)(R * KZ + C) * 2u; vBZ[i] = (unsigned)(Rb * KZ + C) * 2u; }
    const size_t kstep = (size_t)(BK * 2);
    const size_t hsP = (size_t)HALF * KP * 2, hsZ = (size_t)HALF * KZ * 2, tsP = 2 * hsP, tsZ = 2 * hsZ;
    const unsigned ldsw = (unsigned)wid * 1024u;
    const int aoff = lds_byte(wr * 64 + fr, fq * 8), boff = lds_byte(wc * 32 + fr, fq * 8);
#define PG8_SA(b, h) (((b) * 2 + (h)) * HTB)
#define PG8_SB(b, h) ((4 + (b) * 2 + (h)) * HTB)
#define PG8_STAGE(bufoff, gbase, voff) do { _Pragma("unroll") for (int _i = 0; _i < 2; ++_i) \
        __builtin_amdgcn_global_load_lds((const unsigned*)((const char*)(gbase) + (voff)[_i]), (PG8_LAS unsigned*)(lds + (bufoff) + ldsw + _i * 8192), 16, 0, 0); } while (0)
#define PG8_LDA(dst, b, h) do { _Pragma("unroll") for (int m = 0; m < 4; ++m) _Pragma("unroll") for (int k = 0; k < 2; ++k) dst[m][k] = *(const PG8_LAS bf16x8*)(lds + PG8_SA(b, h) + aoff + m * 2048 + k * 1024); } while (0)
#define PG8_LDB(dst, b, h) do { _Pragma("unroll") for (int n = 0; n < 2; ++n) _Pragma("unroll") for (int k = 0; k < 2; ++k) dst[n][k] = *(const PG8_LAS bf16x8*)(lds + PG8_SB(b, h) + boff + n * 2048 + k * 1024); } while (0)
#define PG8_MMA(ai, bj, At, Bt) do { __builtin_amdgcn_s_setprio(1); _Pragma("unroll") for (int m = 0; m < 4; ++m) _Pragma("unroll") for (int n = 0; n < 2; ++n) _Pragma("unroll") for (int k = 0; k < 2; ++k) \
        acc[ai][bj][m][n] = __builtin_amdgcn_mfma_f32_16x16x32_bf16(Bt[n][k], At[m][k], acc[ai][bj][m][n], 0, 0, 0); __builtin_amdgcn_s_setprio(0); } while (0)
#define PG8_WAIT_V(n) asm volatile("s_waitcnt vmcnt(" #n ")" ::: "memory")
#define PG8_WAIT_L(n) asm volatile("s_waitcnt lgkmcnt(" #n ")" ::: "memory")
#define PG8_BAR __builtin_amdgcn_s_barrier()
#define PG8_SCHED __builtin_amdgcn_sched_barrier(0)
    Unit cur, nxt; int ui = 0;
    if (!S.next(0, cur)) return;
    f32x4 acc[2][2][4][2];
#pragma unroll
    for (int a = 0; a < 2; ++a)
#pragma unroll
        for (int b = 0; b < 2; ++b)
#pragma unroll
            for (int m = 0; m < 4; ++m)
#pragma unroll
                for (int n = 0; n < 2; ++n) acc[a][b][m][n] = (f32x4){0.f, 0.f, 0.f, 0.f};
    bf16x8 At[4][2], B0[2][2], B1[2][2];
    const char* cAP = (const char*)AP + (size_t)cur.pm * tsP; const char* cBP = (const char*)BP + (size_t)cur.pn * tsP;
    const char* cAZ = (const char*)AZ + (size_t)cur.pm * tsZ; const char* cBZ = (const char*)BZ + (size_t)cur.pn * tsZ;
    S.a_ready(cur);
    PG8_STAGE(PG8_SB(0, 0), cBP, vBP); PG8_STAGE(PG8_SB(0, 1), cBP + hsP, vBP); PG8_STAGE(PG8_SA(0, 0), cAP, vAP); PG8_STAGE(PG8_SA(0, 1), cAP + hsP, vAP);
    if (wr == 1) PG8_BAR;
    PG8_WAIT_V(2); PG8_BAR;
    PG8_STAGE(PG8_SB(1, 0), cBP + kstep, vBP); PG8_STAGE(PG8_SA(1, 0), cAP + kstep, vAP); PG8_STAGE(PG8_SB(1, 1), cBP + hsP + kstep, vBP);
    PG8_WAIT_V(6); PG8_BAR;
    for (;;) {
        const bool has_next = S.next(ui + 1, nxt);
        const char* nAP = has_next ? (const char*)AP + (size_t)nxt.pm * tsP : cAP; const char* nBP = has_next ? (const char*)BP + (size_t)nxt.pn * tsP : cBP;
#pragma nounroll
        for (int t = 0; t < NT; t += 2) {
            if (t == 4) {
                EM(acc, cur, wr, wc, fr, fq);
#pragma unroll
                for (int a = 0; a < 2; ++a)
#pragma unroll
                    for (int b = 0; b < 2; ++b)
#pragma unroll
                        for (int m = 0; m < 4; ++m)
#pragma unroll
                            for (int n = 0; n < 2; ++n) acc[a][b][m][n] = (f32x4){0.f, 0.f, 0.f, 0.f};
            }
            const bool p1 = (t < 4), p23 = (t == 0) || (t == NT - 2);
            const char* a1 = p1 ? cAP + (size_t)(t + 1) * kstep : cAZ + (size_t)(t - 3) * kstep;
            const char* a2 = (t == 0) ? cAP + 2 * kstep : (t == NT - 2) ? nAP : cAZ + (size_t)(t - 2) * kstep;
            const char* b2 = (t == 0) ? cBP + 2 * kstep : (t == NT - 2) ? nBP : cBZ + (size_t)(t - 2) * kstep;
            const char* a3 = a2 + kstep; const char* b3 = b2 + kstep;
            const size_t hstep1 = p1 ? hsP : hsZ, hstep = p23 ? hsP : hsZ, hstepB = hstep;
            unsigned voffA1[2], voffA[2], voffB[2];
#pragma unroll
            for (int i = 0; i < 2; ++i) { voffA1[i] = p1 ? vAP[i] : vAZ[i]; voffA[i] = p23 ? vAP[i] : vAZ[i]; voffB[i] = p23 ? vBP[i] : vBZ[i]; }
            if (t == NT - 2 && has_next) S.a_ready(nxt);
            PG8_LDB(B0, 0, 0); PG8_LDB(B1, 0, 1); PG8_SCHED; PG8_LDA(At, 0, 0); PG8_STAGE(PG8_SA(1, 1), a1 + hstep1, voffA1);
            PG8_WAIT_V(8); PG8_WAIT_L(0); PG8_BAR; PG8_MMA(0, 0, At, B0); PG8_MMA(0, 1, At, B1); PG8_BAR; PG8_SCHED;
            PG8_LDA(At, 0, 1); PG8_STAGE(PG8_SB(0, 0), b2, voffB); PG8_STAGE(PG8_SB(0, 1), b2 + hstepB, voffB); PG8_STAGE(PG8_SA(0, 0), a2, voffA);
            PG8_WAIT_V(8); PG8_WAIT_L(0); PG8_BAR; PG8_MMA(1, 0, At, B0); PG8_MMA(1, 1, At, B1); PG8_BAR; PG8_SCHED;
            PG8_LDB(B0, 1, 0); PG8_LDB(B1, 1, 1); PG8_SCHED; PG8_LDA(At, 1, 0); PG8_STAGE(PG8_SA(0, 1), a2 + hstep, voffA);
            PG8_WAIT_V(8); PG8_WAIT_L(0); PG8_BAR; PG8_MMA(0, 0, At, B0); PG8_MMA(0, 1, At, B1); PG8_BAR; PG8_SCHED;
            PG8_LDA(At, 1, 1); PG8_STAGE(PG8_SB(1, 0), b3, voffB); PG8_STAGE(PG8_SB(1, 1), b3 + hstepB, voffB); PG8_STAGE(PG8_SA(1, 0), a3, voffA);
            PG8_WAIT_V(8); PG8_WAIT_L(0); PG8_BAR; PG8_MMA(1, 0, At, B0); PG8_MMA(1, 1, At, B1); PG8_BAR; PG8_SCHED;
        }
        if constexpr (ALIGN_EPI) { if (wr == 0) PG8_BAR; }
        E(acc, cur, wr, wc, fr, fq); S.done(cur);
        if (!has_next) break;
#pragma unroll
        for (int a = 0; a < 2; ++a)
#pragma unroll
            for (int b = 0; b < 2; ++b)
#pragma unroll
                for (int m = 0; m < 4; ++m)
#pragma unroll
                    for (int n = 0; n < 2; ++n) acc[a][b][m][n] = (f32x4){0.f, 0.f, 0.f, 0.f};
        cur = nxt; cAP = nAP; cBP = nBP; cAZ = (const char*)AZ + (size_t)cur.pm * tsZ; cBZ = (const char*)BZ + (size_t)cur.pn * tsZ; ++ui;
        if constexpr (ALIGN_EPI) { if (wr == 1) PG8_BAR; }
    }
    PG8_WAIT_V(0);
    if constexpr (!ALIGN_EPI) { if (wr == 0) PG8_BAR; }
    PG8_BAR;
#undef PG8_SA
#undef PG8_SB
#undef PG8_STAGE
#undef PG8_LDA
#undef PG8_LDB
#undef PG8_MMA
#undef PG8_WAIT_V
#undef PG8_WAIT_L
#undef PG8_BAR
#undef PG8_SCHED
}
}
#ifndef PG8_SP2
#define PG8_SP2 true
#endif
#ifndef PG8_ALIGN
#define PG8_ALIGN true
#endif
using pg8::bf16_t; using pg8::bf16x8; using pg8::f32x4; using pg8::u32x4;
#define LAS __attribute__((address_space(3)))
typedef float f32x2 __attribute__((ext_vector_type(2)));
typedef float f32x16 __attribute__((ext_vector_type(16)));
typedef unsigned u32x2 __attribute__((ext_vector_type(2)));
typedef __bf16 bf16x2_t __attribute__((ext_vector_type(2)));

constexpr int T_ = 65536, DM_ = 1024, SEQ_ = 8192, PJW = 2048, FF_ = 4096, PLE_ = 256, NUNIT_ATT = 1024, NUNIT_LRU = 256;
constexpr float EPS_ = 1e-6f, LOG2E = 1.4426950408889634f, QSCALE = 0.125f * 1.4426950408889634f;
constexpr int NWAVES = 8, NTHR = 512;
constexpr int RING_BYTES = 131072, SSL_OFF = RING_BYTES, MISC_OFF = 147456 - 64, LDS_BYTES = 147456;
constexpr size_t MiB = 1u << 20;
constexpr size_t WS_WIN = 0, WS_WOUT = 5 * MiB, WS_WUP = 7 * MiB, WS_WDN = 15 * MiB, WS_WPG = 23 * MiB, WS_WPP = 25 * MiB, WS_WG = 25 * MiB + 512 * 1024;
constexpr size_t WS_RSTD1 = 27 * MiB, WS_RSTD2 = 27 * MiB + 256 * 1024, WS_DUMMY = 27 * MiB + 512 * 1024, WS_RINV0 = 27 * MiB + 768 * 1024, WS_SUMM = 28 * MiB;
constexpr size_t WS_CTL = 31 * MiB, CTL_BYTES = 16384;
constexpr size_t WS_XN = 32 * MiB;
constexpr size_t WS_PP = 160 * MiB;
constexpr size_t WS_PB = 288 * MiB;
constexpr size_t WS_PROJ = 320 * MiB;
constexpr size_t WS_VT = 576 * MiB;
constexpr size_t WS_MERGED = 640 * MiB;
constexpr size_t WS_ACT = 320 * MiB;
constexpr size_t WS_END = 832 * MiB;

__device__ __forceinline__ unsigned cvtpk(float lo, float hi) { f32x2 v = {lo, hi}; bf16x2_t b = __builtin_convertvector(v, bf16x2_t); return __builtin_bit_cast(unsigned, b); }
__device__ __forceinline__ float bf2f(unsigned short u) { return __uint_as_float((unsigned)u << 16); }
__device__ __forceinline__ float bflo(unsigned w) { return __uint_as_float(w << 16); }
__device__ __forceinline__ float bfhi(unsigned w) { return __uint_as_float(w & 0xffff0000u); }
__device__ __forceinline__ float ex2(float x) { return __builtin_amdgcn_exp2f(x); }
__device__ __forceinline__ float rcpf_(float x) { return __builtin_amdgcn_rcpf(x); }
__device__ __forceinline__ float rsqf_(float x) { return __builtin_amdgcn_rsqf(x); }
__device__ __forceinline__ float sigm(float z) { return rcpf_(1.f + ex2(-LOG2E * z)); }
__device__ __forceinline__ float gelu_tanh(float g) { const float z = 0.7978845608028654f * (g + 0.044715f * g * g * g); return g * sigm(2.f * z); }
__device__ __forceinline__ float wave_sum(float v) {
#pragma unroll
    for (int o = 1; o < 64; o <<= 1) v += __shfl_xor(v, o);
    return v;
}
__device__ __forceinline__ float wave_max(float v) {
#pragma unroll
    for (int o = 1; o < 64; o <<= 1) v = fmaxf(v, __shfl_xor(v, o));
    return v;
}
__device__ __forceinline__ int crow(int r, int hi) { return (r & 3) + 8 * (r >> 2) + 4 * hi; }
#define MFMA32(a, b, c) __builtin_amdgcn_mfma_f32_32x32x16_bf16((a), (b), (c), 0, 0, 0)

#define RLX_AGENT __ATOMIC_RELAXED, __HIP_MEMORY_SCOPE_AGENT
#define XB_TMO      128
#define XB_XCNT(j)  (256  + 64 * (j))
#define XB_XSUB(j)  (1280 + 64 * (j))
#define XB_XGEN(j)  (2304 + 64 * (j))
#define XB_TOP      3328
#define XB_TOPGEN   3392
#define XCD_BAR_WORDS 3456
#define XB_SPIN_CAP (1u << 18)

__device__ __forceinline__ unsigned xb_ld(unsigned* p)              { return __hip_atomic_load(p, __ATOMIC_RELAXED, __HIP_MEMORY_SCOPE_AGENT); }
__device__ __forceinline__ unsigned xb_add(unsigned* p, unsigned v) { return __hip_atomic_fetch_add(p, v, __ATOMIC_RELAXED, __HIP_MEMORY_SCOPE_AGENT); }
__device__ __forceinline__ unsigned xb_xcc_id() { return (unsigned)__builtin_amdgcn_s_getreg((3 << 11) | 20) & 0xFu; }
#define XB_SPIN(cond, bar) do { unsigned _sp = 0; while (cond) { __builtin_amdgcn_s_sleep(1); \
    if ((++_sp & 255u) == 0u) { if (xb_ld(&(bar)[XB_TMO])) break; if (_sp > XB_SPIN_CAP) { atomicAdd(&(bar)[XB_TMO], 1u); break; } } } } while (0)

struct XcdBarrier {
    unsigned* bar; unsigned x;
    volatile LAS unsigned* st;
};

__device__ __forceinline__ XcdBarrier xcd_barrier_post(unsigned* bar, volatile LAS unsigned* st) {
    XcdBarrier b; b.bar = bar; b.x = xb_xcc_id(); b.st = st;
    if (threadIdx.x == 0) (void)xb_add(&bar[XB_XCNT(b.x)], 1u);
    return b;
}
__device__ __forceinline__ void xcd_barrier_complete(unsigned* bar, unsigned x, unsigned& nloc, unsigned& nx) {
    const unsigned G = gridDim.x * gridDim.y * gridDim.z;
    unsigned sum, cnt, mine, sp = 0u;
    for (;;) {
        sum = 0u; cnt = 0u; mine = 0u;
#pragma unroll
        for (unsigned j = 0; j < 16; ++j) { const unsigned c = xb_ld(&bar[XB_XCNT(j)]); sum += c; cnt += (c > 0u) ? 1u : 0u; mine = (j == x) ? c : mine; }
        if (sum == G) break;
        __builtin_amdgcn_s_sleep(1);
        if ((++sp & 255u) == 0u) { if (xb_ld(&bar[XB_TMO])) break; if (sp > XB_SPIN_CAP) { atomicAdd(&bar[XB_TMO], 1u); break; } }
    }
    nloc = mine > 0u ? mine : 1u; nx = cnt > 0u ? cnt : 1u;
}

__device__ __forceinline__ void xcd_barrier(const XcdBarrier& b) {
    asm volatile("s_waitcnt vmcnt(0)" ::: "memory");
    __syncthreads();
    if (threadIdx.x == 0) {
        unsigned* bar = b.bar;
        __builtin_amdgcn_s_waitcnt(0);
        unsigned nloc = b.st[0], nx = b.st[1];
        if (nloc == 0u) { xcd_barrier_complete(bar, b.x, nloc, nx); b.st[0] = nloc; b.st[1] = nx; }
        const unsigned old = xb_add(&bar[XB_XSUB(b.x)], 1u);
        const unsigned gen = old / nloc;
        if (old + 1u == (gen + 1u) * nloc) {
            __builtin_amdgcn_fence(__ATOMIC_RELEASE, "agent");
            asm volatile("s_waitcnt vmcnt(0)" ::: "memory");
            const unsigned og = xb_add(&bar[XB_TOP], 1u);
            const unsigned tg = og / nx;
            if (og + 1u == (tg + 1u) * nx) xb_add(&bar[XB_TOPGEN], 1u);
            else XB_SPIN(xb_ld(&bar[XB_TOPGEN]) == tg, bar);
            __builtin_amdgcn_fence(__ATOMIC_ACQUIRE, "agent");
            xb_add(&bar[XB_XGEN(b.x)], 1u);
            asm volatile("s_waitcnt vmcnt(0)" ::: "memory");
        } else {
            XB_SPIN(xb_ld(&bar[XB_XGEN(b.x)]) == gen, bar);
            __builtin_amdgcn_fence(__ATOMIC_ACQUIRE, "agent");
            asm volatile("s_waitcnt vmcnt(0)" ::: "memory");
        }
    }
    __syncthreads();
}

struct PanelOrder {
    int pm;
    __device__ bool next(int i, pg8::Unit& u) const { if (i >= 4) return false; u.pm = pm; u.pn = i; return true; }
    __device__ __forceinline__ void a_ready(const pg8::Unit&) const {}
    __device__ __forceinline__ void done(const pg8::Unit&) const {}
};

struct EpiPlain {
    static constexpr bool PERM = true, AFTER_DRAIN = false, HEADMAP = false;
    bf16_t* O; int ldc;
    __device__ __forceinline__ void operator()(const f32x4 (&acc)[2][2][4][2], const pg8::Unit& u, int wr, int wc, int fr, int fq) const {
        const int row0 = u.pm * 256 + wr * 64 + fr, col0 = u.pn * 256 + wc * 32 + 8 * fq;
#pragma unroll
        for (int ai = 0; ai < 2; ++ai)
#pragma unroll
            for (int m = 0; m < 4; ++m) { bf16_t* rowp = O + (size_t)(row0 + ai * 128 + m * 16) * ldc + col0;
#pragma unroll
                for (int bj = 0; bj < 2; ++bj) { const f32x4 v0 = acc[ai][bj][m][0], v1 = acc[ai][bj][m][1];
                    u32x4 w; w.x = cvtpk(v0[0], v0[1]); w.y = cvtpk(v0[2], v0[3]); w.z = cvtpk(v1[0], v1[1]); w.w = cvtpk(v1[2], v1[3]);
                    *(u32x4*)(rowp + bj * 128) = w; } }
    }
};
struct EpiVT {
    static constexpr bool PERM = true, AFTER_DRAIN = false, HEADMAP = false;
    bf16_t* O;
    __device__ __forceinline__ void operator()(const f32x4 (&acc)[2][2][4][2], const pg8::Unit& u, int wr, int wc, int fr, int fq) const {
        const int row0 = u.pm * 256 + wr * 64 + fr, col0 = u.pn * 256 + wc * 32 + 16 * (fq >> 1) + 4 * (fq & 1);
#pragma unroll
        for (int ai = 0; ai < 2; ++ai)
#pragma unroll
            for (int m = 0; m < 4; ++m) { bf16_t* rowp = O + (size_t)(row0 + ai * 128 + m * 16) * T_ + col0;
#pragma unroll
                for (int bj = 0; bj < 2; ++bj)
#pragma unroll
                    for (int n = 0; n < 2; ++n) { const f32x4 v = acc[ai][bj][m][n]; u32x2 w; w.x = cvtpk(v[0], v[1]); w.y = cvtpk(v[2], v[3]);
                        *(u32x2*)(rowp + bj * 128 + 8 * n) = w; } }
    }
};
struct EpiProj {
    static constexpr bool PERM = true, AFTER_DRAIN = false, HEADMAP = true;
    bf16_t* O; const float* gq; const float* gk;
    __device__ __forceinline__ void operator()(const f32x4 (&acc)[2][2][4][2], const pg8::Unit& u, int wr, int wc, int fr, int fq) const {
        const int row0 = u.pm * 256 + wr * 64 + fr, col0 = u.pn * 256 + wc * 64 + 8 * fq, kind = u.pn >> 1;
        f32x4 gv[2][2];
        if (kind >= 2) { const float* g = (kind == 2) ? gq : gk; const float sc = (kind == 2) ? QSCALE : 1.f;
#pragma unroll
            for (int bj = 0; bj < 2; ++bj)
#pragma unroll
                for (int n = 0; n < 2; ++n) gv[bj][n] = *(const f32x4*)(g + 32 * bj + 8 * fq + 4 * n) * sc; }
#pragma unroll
        for (int ai = 0; ai < 2; ++ai)
#pragma unroll
            for (int m = 0; m < 4; ++m) { bf16_t* rowp = O + (size_t)(row0 + ai * 128 + m * 16) * PJW + col0;
                f32x4 v[2][2];
#pragma unroll
                for (int bj = 0; bj < 2; ++bj)
#pragma unroll
                    for (int n = 0; n < 2; ++n) v[bj][n] = acc[ai][bj][m][n];
                if (kind == 1) {
#pragma unroll
                    for (int bj = 0; bj < 2; ++bj)
#pragma unroll
                        for (int n = 0; n < 2; ++n)
#pragma unroll
                            for (int e = 0; e < 4; ++e) v[bj][n][e] = gelu_tanh(v[bj][n][e]);
                } else if (kind >= 2) {
                    float ss = 0.f;
#pragma unroll
                    for (int bj = 0; bj < 2; ++bj)
#pragma unroll
                        for (int n = 0; n < 2; ++n) { const f32x4 x = v[bj][n]; ss += (x[0] * x[0] + x[1] * x[1]) + (x[2] * x[2] + x[3] * x[3]); }
                    ss += __shfl_xor(ss, 16); ss += __shfl_xor(ss, 32);
                    const float rstd = rsqf_(ss * (1.f / 64.f) + EPS_);
#pragma unroll
                    for (int bj = 0; bj < 2; ++bj)
#pragma unroll
                        for (int n = 0; n < 2; ++n) v[bj][n] = v[bj][n] * gv[bj][n] * rstd;
                }
#pragma unroll
                for (int bj = 0; bj < 2; ++bj) { const f32x4 v0 = v[bj][0], v1 = v[bj][1];
                    u32x4 w; w.x = cvtpk(v0[0], v0[1]); w.y = cvtpk(v0[2], v0[3]); w.z = cvtpk(v1[0], v1[1]); w.w = cvtpk(v1[2], v1[3]);
                    *(u32x4*)(rowp + bj * 32) = w; } }
    }
};
struct EpiRes {
    static constexpr bool PERM = true, AFTER_DRAIN = false, HEADMAP = false;
    const float* base; float* out; bf16_t* hb; float* ssq; int rowmask;
    __device__ __forceinline__ void operator()(const f32x4 (&acc)[2][2][4][2], const pg8::Unit& u, int wr, int wc, int fr, int fq) const {
        const int row0 = u.pm * 256 + wr * 64 + fr, col0 = u.pn * 256 + wc * 32 + 8 * fq;
#pragma unroll
        for (int ai = 0; ai < 2; ++ai)
#pragma unroll
            for (int m = 0; m < 4; ++m) { const size_t off = (size_t)(row0 + ai * 128 + m * 16) * DM_ + col0; const size_t ooff = (size_t)((row0 + ai * 128 + m * 16) & rowmask) * DM_ + col0; float ss = 0.f;
#pragma unroll
                for (int bj = 0; bj < 2; ++bj) {
                    const f32x4 b0 = *(const f32x4*)(base + off + bj * 128), b1 = *(const f32x4*)(base + off + bj * 128 + 4);
                    const f32x4 v0 = b0 + acc[ai][bj][m][0], v1 = b1 + acc[ai][bj][m][1];
                    ss += (v0[0] * v0[0] + v0[1] * v0[1]) + (v0[2] * v0[2] + v0[3] * v0[3]) + (v1[0] * v1[0] + v1[1] * v1[1]) + (v1[2] * v1[2] + v1[3] * v1[3]);
                    *(f32x4*)(out + ooff + bj * 128) = v0; *(f32x4*)(out + ooff + bj * 128 + 4) = v1;
                    u32x4 w; w.x = cvtpk(v0[0], v0[1]); w.y = cvtpk(v0[2], v0[3]); w.z = cvtpk(v1[0], v1[1]); w.w = cvtpk(v1[2], v1[3]);
                    *(u32x4*)(hb + off + bj * 128) = w; }
                ss += __shfl_xor(ss, 16); ss += __shfl_xor(ss, 32);
                if (fq == 0) __hip_atomic_fetch_add(ssq + row0 + ai * 128 + m * 16, ss, __ATOMIC_RELAXED, __HIP_MEMORY_SCOPE_AGENT);
                asm volatile("" ::: "memory"); }
    }
};
struct EpiUp {
    static constexpr bool PERM = true, AFTER_DRAIN = false, HEADMAP = false;
    bf16_t* O; const float* rstd;
    __device__ __forceinline__ void operator()(const f32x4 (&acc)[2][2][4][2], const pg8::Unit& u, int wr, int wc, int fr, int fq) const {
        const int row0 = u.pm * 256 + wr * 64 + fr, col0 = u.pn * 256 + wc * 32 + 8 * fq;
#pragma unroll
        for (int ai = 0; ai < 2; ++ai)
#pragma unroll
            for (int m = 0; m < 4; ++m) { const int row = row0 + ai * 128 + m * 16; const float rs = rsqf_(rstd[row] * (1.f / DM_) + EPS_); bf16_t* rowp = O + (size_t)row * FF_ + col0;
#pragma unroll
                for (int bj = 0; bj < 2; ++bj) { f32x4 v0 = acc[ai][bj][m][0] * rs, v1 = acc[ai][bj][m][1] * rs;
#pragma unroll
                    for (int e = 0; e < 4; ++e) { const float a = fmaxf(v0[e], 0.f), b = fmaxf(v1[e], 0.f); v0[e] = a * a; v1[e] = b * b; }
                    u32x4 w; w.x = cvtpk(v0[0], v0[1]); w.y = cvtpk(v0[2], v0[3]); w.z = cvtpk(v1[0], v1[1]); w.w = cvtpk(v1[2], v1[3]);
                    *(u32x4*)(rowp + bj * 128) = w; } }
    }
};
struct EpiFinal {
    static constexpr bool PERM = true, AFTER_DRAIN = false, HEADMAP = false;
    const float* hin; float* out; const bf16_t* pp; const float* rstd;
    __device__ __forceinline__ void operator()(const f32x4 (&acc)[2][2][4][2], const pg8::Unit& u, int wr, int wc, int fr, int fq) const {
        const int row0 = u.pm * 256 + wr * 64 + fr, col0 = u.pn * 256 + wc * 32 + 8 * fq;
#pragma unroll
        for (int ai = 0; ai < 2; ++ai)
#pragma unroll
            for (int m = 0; m < 4; ++m) { const int row = row0 + ai * 128 + m * 16; const float rs = rsqf_(rstd[row] * (1.f / DM_) + EPS_); const size_t off = (size_t)row * DM_ + col0;
#pragma unroll
                for (int bj = 0; bj < 2; ++bj) {
                    const f32x4 h0 = *(const f32x4*)(hin + off + bj * 128), h1 = *(const f32x4*)(hin + off + bj * 128 + 4);
                    const u32x4 pw = *(const u32x4*)(pp + off + bj * 128);
                    const f32x4 a0 = acc[ai][bj][m][0] * rs, a1 = acc[ai][bj][m][1] * rs;
                    f32x4 o0, o1;
                    o0[0] = h0[0] + sigm(a0[0]) * bflo(pw.x); o0[1] = h0[1] + sigm(a0[1]) * bfhi(pw.x); o0[2] = h0[2] + sigm(a0[2]) * bflo(pw.y); o0[3] = h0[3] + sigm(a0[3]) * bfhi(pw.y);
                    o1[0] = h1[0] + sigm(a1[0]) * bflo(pw.z); o1[1] = h1[1] + sigm(a1[1]) * bfhi(pw.z); o1[2] = h1[2] + sigm(a1[2]) * bflo(pw.w); o1[3] = h1[3] + sigm(a1[3]) * bfhi(pw.w);
                    *(f32x4*)(out + off + bj * 128) = o0; *(f32x4*)(out + off + bj * 128 + 4) = o1; }
                asm volatile("" ::: "memory"); }
    }
};


struct EpiRes4 {
    static constexpr bool PERM = true, AFTER_DRAIN = false, HEADMAP = false;
    const float* base; bf16_t* hb; float* ssq;
    __device__ __forceinline__ void operator()(const f32x4 (&acc)[2][2][4][2], const pg8::Unit& u, int wr, int wc, int fr, int fq) const {
        const int row0 = u.pm * 256 + wr * 64 + fr, col0 = u.pn * 256 + wc * 32 + 8 * fq;
        f32x4 X[8][2][2];
#define E4_LD(g) do { const size_t off_ = (size_t)(row0 + ((g) >> 2) * 128 + ((g) & 3) * 16) * DM_ + col0; \
        _Pragma("unroll") for (int bj = 0; bj < 2; ++bj) { X[g][bj][0] = *(const f32x4*)(base + off_ + bj * 128); X[g][bj][1] = *(const f32x4*)(base + off_ + bj * 128 + 4); } } while (0)
        E4_LD(0); E4_LD(1); E4_LD(2); E4_LD(3);
        asm volatile("" ::: "memory");
#pragma unroll
        for (int g = 0; g < 8; ++g) { const int ai = g >> 2, m = g & 3; const size_t off = (size_t)(row0 + ai * 128 + m * 16) * DM_ + col0; float ss = 0.f;
#pragma unroll
            for (int bj = 0; bj < 2; ++bj) {
                const f32x4 v0 = X[g][bj][0] + acc[ai][bj][m][0], v1 = X[g][bj][1] + acc[ai][bj][m][1];
                ss += (v0[0] * v0[0] + v0[1] * v0[1]) + (v0[2] * v0[2] + v0[3] * v0[3]) + (v1[0] * v1[0] + v1[1] * v1[1]) + (v1[2] * v1[2] + v1[3] * v1[3]);
                u32x4 w; w.x = cvtpk(v0[0], v0[1]); w.y = cvtpk(v0[2], v0[3]); w.z = cvtpk(v1[0], v1[1]); w.w = cvtpk(v1[2], v1[3]);
                *(u32x4*)(hb + off + bj * 128) = w; }
            ss += __shfl_xor(ss, 16); ss += __shfl_xor(ss, 32);
            if (fq == 0) __hip_atomic_fetch_add(ssq + row0 + ai * 128 + m * 16, ss, __ATOMIC_RELAXED, __HIP_MEMORY_SCOPE_AGENT);
            if (g + 4 < 8) { E4_LD(g + 4); }
            asm volatile("" ::: "memory"); }
#undef E4_LD
    }
};
struct EpiRes4b {
    static constexpr bool PERM = true, AFTER_DRAIN = false, HEADMAP = false;
    bf16_t* hb; const float* rinv0; const float* g1; float* ssq;
    __device__ __forceinline__ void operator()(const f32x4 (&acc)[2][2][4][2], const pg8::Unit& u, int wr, int wc, int fr, int fq) const {
        const int row0 = u.pm * 256 + wr * 64 + fr, col0 = u.pn * 256 + wc * 32 + 8 * fq;
        f32x4 gi[2][2];
#pragma unroll
        for (int bj = 0; bj < 2; ++bj)
#pragma unroll
            for (int n = 0; n < 2; ++n) { const f32x4 gv = *(const f32x4*)(g1 + col0 + bj * 128 + 4 * n); gi[bj][n] = (f32x4){rcpf_(gv[0]), rcpf_(gv[1]), rcpf_(gv[2]), rcpf_(gv[3])}; }
        u32x4 H[8][2]; float RI[8];
#define E4_LD(g) do { const int row_ = row0 + ((g) >> 2) * 128 + ((g) & 3) * 16; const size_t off_ = (size_t)row_ * DM_ + col0; RI[g] = rinv0[row_]; \
        _Pragma("unroll") for (int bj = 0; bj < 2; ++bj) H[g][bj] = *(const u32x4*)(hb + off_ + bj * 128); } while (0)
        E4_LD(0); E4_LD(1); E4_LD(2); E4_LD(3);
        asm volatile("" ::: "memory");
#pragma unroll
        for (int g = 0; g < 8; ++g) { const int ai = g >> 2, m = g & 3; const size_t off = (size_t)(row0 + ai * 128 + m * 16) * DM_ + col0; float ss = 0.f; const float ri = RI[g];
#pragma unroll
            for (int bj = 0; bj < 2; ++bj) { const u32x4 hw = H[g][bj];
                const f32x4 x0 = (f32x4){bflo(hw.x), bfhi(hw.x), bflo(hw.y), bfhi(hw.y)} * gi[bj][0] * ri, x1 = (f32x4){bflo(hw.z), bfhi(hw.z), bflo(hw.w), bfhi(hw.w)} * gi[bj][1] * ri;
                const f32x4 v0 = x0 + acc[ai][bj][m][0], v1 = x1 + acc[ai][bj][m][1];
                ss += (v0[0] * v0[0] + v0[1] * v0[1]) + (v0[2] * v0[2] + v0[3] * v0[3]) + (v1[0] * v1[0] + v1[1] * v1[1]) + (v1[2] * v1[2] + v1[3] * v1[3]);
                u32x4 w; w.x = cvtpk(v0[0], v0[1]); w.y = cvtpk(v0[2], v0[3]); w.z = cvtpk(v1[0], v1[1]); w.w = cvtpk(v1[2], v1[3]);
                *(u32x4*)(hb + off + bj * 128) = w; }
            ss += __shfl_xor(ss, 16); ss += __shfl_xor(ss, 32);
            if (fq == 0) __hip_atomic_fetch_add(ssq + row0 + ai * 128 + m * 16, ss, __ATOMIC_RELAXED, __HIP_MEMORY_SCOPE_AGENT);
            if (g + 4 < 8) { E4_LD(g + 4); }
            asm volatile("" ::: "memory"); }
#undef E4_LD
    }
};
struct EpiRes6 {
    static constexpr bool PERM = true, AFTER_DRAIN = false, HEADMAP = false;
    bf16_t* hb; float* ssq;
    __device__ __forceinline__ void operator()(const f32x4 (&acc)[2][2][4][2], const pg8::Unit& u, int wr, int wc, int fr, int fq) const {
        const int row0 = u.pm * 256 + wr * 64 + fr, col0 = u.pn * 256 + wc * 32 + 8 * fq;
        u32x4 H[8][2];
#define E6_LD(g) do { const size_t off_ = (size_t)(row0 + ((g) >> 2) * 128 + ((g) & 3) * 16) * DM_ + col0; \
        _Pragma("unroll") for (int bj = 0; bj < 2; ++bj) H[g][bj] = *(const u32x4*)(hb + off_ + bj * 128); } while (0)
        E6_LD(0); E6_LD(1); E6_LD(2); E6_LD(3);
        asm volatile("" ::: "memory");
#pragma unroll
        for (int g = 0; g < 8; ++g) { const int ai = g >> 2, m = g & 3; const size_t off = (size_t)(row0 + ai * 128 + m * 16) * DM_ + col0; float ss = 0.f;
#pragma unroll
            for (int bj = 0; bj < 2; ++bj) { const u32x4 hw = H[g][bj];
                const f32x4 b0 = {bflo(hw.x), bfhi(hw.x), bflo(hw.y), bfhi(hw.y)}, b1 = {bflo(hw.z), bfhi(hw.z), bflo(hw.w), bfhi(hw.w)};
                const f32x4 v0 = b0 + acc[ai][bj][m][0], v1 = b1 + acc[ai][bj][m][1];
                ss += (v0[0] * v0[0] + v0[1] * v0[1]) + (v0[2] * v0[2] + v0[3] * v0[3]) + (v1[0] * v1[0] + v1[1] * v1[1]) + (v1[2] * v1[2] + v1[3] * v1[3]);
                u32x4 w; w.x = cvtpk(v0[0], v0[1]); w.y = cvtpk(v0[2], v0[3]); w.z = cvtpk(v1[0], v1[1]); w.w = cvtpk(v1[2], v1[3]);
                *(u32x4*)(hb + off + bj * 128) = w; }
            ss += __shfl_xor(ss, 16); ss += __shfl_xor(ss, 32);
            if (fq == 0) __hip_atomic_fetch_add(ssq + row0 + ai * 128 + m * 16, ss, __ATOMIC_RELAXED, __HIP_MEMORY_SCOPE_AGENT);
            if (g + 4 < 8) { E6_LD(g + 4); }
            asm volatile("" ::: "memory"); }
#undef E6_LD
    }
};
struct EpiFinalB {
    static constexpr bool PERM = true, AFTER_DRAIN = false, HEADMAP = false;
    const bf16_t* hb; float* out; const bf16_t* pp; const float* rstd;
    __device__ __forceinline__ void operator()(const f32x4 (&acc)[2][2][4][2], const pg8::Unit& u, int wr, int wc, int fr, int fq) const {
        const int row0 = u.pm * 256 + wr * 64 + fr, col0 = u.pn * 256 + wc * 32 + 8 * fq;
        u32x4 H[8][2], P[8][2]; float RS[8];
#define EF_LD(g) do { const int row_ = row0 + ((g) >> 2) * 128 + ((g) & 3) * 16; const size_t off_ = (size_t)row_ * DM_ + col0; RS[g] = rstd[row_]; \
        _Pragma("unroll") for (int bj = 0; bj < 2; ++bj) { H[g][bj] = *(const u32x4*)(hb + off_ + bj * 128); P[g][bj] = *(const u32x4*)(pp + off_ + bj * 128); } } while (0)
        EF_LD(0); EF_LD(1); EF_LD(2); EF_LD(3);
        asm volatile("" ::: "memory");
#pragma unroll
        for (int g = 0; g < 8; ++g) { const int ai = g >> 2, m = g & 3; const size_t off = (size_t)(row0 + ai * 128 + m * 16) * DM_ + col0; const float rs = rsqf_(RS[g] * (1.f / DM_) + EPS_);
#pragma unroll
            for (int bj = 0; bj < 2; ++bj) { const u32x4 hw = H[g][bj], pw = P[g][bj];
                const f32x4 a0 = acc[ai][bj][m][0] * rs, a1 = acc[ai][bj][m][1] * rs;
                f32x4 o0, o1;
                o0[0] = bflo(hw.x) + sigm(a0[0]) * bflo(pw.x); o0[1] = bfhi(hw.x) + sigm(a0[1]) * bfhi(pw.x); o0[2] = bflo(hw.y) + sigm(a0[2]) * bflo(pw.y); o0[3] = bfhi(hw.y) + sigm(a0[3]) * bfhi(pw.y);
                o1[0] = bflo(hw.z) + sigm(a1[0]) * bflo(pw.z); o1[1] = bfhi(hw.z) + sigm(a1[1]) * bfhi(pw.z); o1[2] = bflo(hw.w) + sigm(a1[2]) * bflo(pw.w); o1[3] = bfhi(hw.w) + sigm(a1[3]) * bfhi(pw.w);
                *(f32x4*)(out + off + bj * 128) = o0; *(f32x4*)(out + off + bj * 128 + 4) = o1; }
            if (g + 4 < 8) { EF_LD(g + 4); }
            asm volatile("" ::: "memory"); }
#undef EF_LD
    }
};

struct EpiMidPP {
    u32x4* park;
    __device__ __forceinline__ void operator()(const f32x4 (&acc)[2][2][4][2], const pg8::Unit& u, int wr, int wc, int fr, int fq) const {
        asm volatile("" : "+v"(fr), "+v"(fq));
        const unsigned pko_ = (unsigned)((wr * 4 + wc) * 64 + fq * 16 + fr);
#pragma unroll
        for (int ai = 0; ai < 2; ++ai)
#pragma unroll
            for (int m = 0; m < 4; ++m)
#pragma unroll
                for (int bj = 0; bj < 2; ++bj) { const f32x4 v0 = acc[ai][bj][m][0], v1 = acc[ai][bj][m][1];
                    u32x4 w; w.x = cvtpk(v0[0], v0[1]); w.y = cvtpk(v0[2], v0[3]); w.z = cvtpk(v1[0], v1[1]); w.w = cvtpk(v1[2], v1[3]);
                    park[pko_ + (unsigned)((((ai * 4 + m) * 2 + bj) * 8) * 64)] = w; }
    }
};
struct EpiFinalC {
    const bf16_t* hb; float* out; const float* rstd; const u32x4* park;
    __device__ __forceinline__ void operator()(const f32x4 (&acc)[2][2][4][2], const pg8::Unit& u, int wr, int wc, int fr, int fq) const {
        asm volatile("" : "+v"(fr), "+v"(fq));
        const int row0 = u.pm * 256 + wr * 64 + fr, col0 = u.pn * 256 + wc * 32 + 8 * fq;
        const unsigned pko_ = (unsigned)((wr * 4 + wc) * 64 + fq * 16 + fr);
        u32x4 H[8][2], P[8][2]; float RS[8];
#define EF_LD(g) do { const int row_ = row0 + ((g) >> 2) * 128 + ((g) & 3) * 16; const size_t off_ = (size_t)row_ * DM_ + col0; RS[g] = rstd[row_]; \
        _Pragma("unroll") for (int bj = 0; bj < 2; ++bj) { H[g][bj] = *(const u32x4*)(hb + off_ + bj * 128); P[g][bj] = park[pko_ + (unsigned)((((g) * 2 + bj) * 8) * 64)]; } } while (0)
        EF_LD(0); EF_LD(1); EF_LD(2); EF_LD(3);
        asm volatile("" ::: "memory");
#pragma unroll
        for (int g = 0; g < 8; ++g) { const int ai = g >> 2, m = g & 3; const size_t off = (size_t)(row0 + ai * 128 + m * 16) * DM_ + col0; const float rs = rsqf_(RS[g] * (1.f / DM_) + EPS_);
#pragma unroll
            for (int bj = 0; bj < 2; ++bj) { const u32x4 hw = H[g][bj], pw = P[g][bj];
                const f32x4 a0 = acc[ai][bj][m][0] * rs, a1 = acc[ai][bj][m][1] * rs;
                f32x4 o0, o1;
                o0[0] = bflo(hw.x) + sigm(a0[0]) * bflo(pw.x); o0[1] = bfhi(hw.x) + sigm(a0[1]) * bfhi(pw.x); o0[2] = bflo(hw.y) + sigm(a0[2]) * bflo(pw.y); o0[3] = bfhi(hw.y) + sigm(a0[3]) * bfhi(pw.y);
                o1[0] = bflo(hw.z) + sigm(a1[0]) * bflo(pw.z); o1[1] = bfhi(hw.z) + sigm(a1[1]) * bfhi(pw.z); o1[2] = bflo(hw.w) + sigm(a1[2]) * bflo(pw.w); o1[3] = bfhi(hw.w) + sigm(a1[3]) * bfhi(pw.w);
                *(f32x4*)(out + off + bj * 128) = o0; *(f32x4*)(out + off + bj * 128 + 4) = o1; }
            if (g + 4 < 8) { EF_LD(g + 4); }
            asm volatile("" ::: "memory"); }
#undef EF_LD
    }
};

__device__ __forceinline__ void p0_transpose_item(const float* W, int K, int N, bf16_t* WT, const float* ks0, const float* ks1, int ksplit, LAS float* scr, int item, int lane) {
    const int nblk = N / 32, kb = item / nblk, nb = item % nblk, k0 = 64 * kb, n0 = 32 * nb;
#pragma unroll 8
    for (int i = 0; i < 32; ++i) { const int kk = 2 * i + (lane >> 5), k = k0 + kk; float s = 1.f; if (ks0) s = (k < ksplit) ? ks0[k] : ks1[k - ksplit];
        scr[kk * 33 + (lane & 31)] = W[(size_t)k * N + n0 + (lane & 31)] * s; }
    asm volatile("s_waitcnt lgkmcnt(0)" ::: "memory");
    const int c = lane & 7;
#pragma unroll
    for (int j = 0; j < 4; ++j) { const int n = (lane >> 3) + 8 * j; const LAS float* s = scr + (8 * c) * 33 + n;
        u32x4 o; o.x = cvtpk(s[0 * 33], s[1 * 33]); o.y = cvtpk(s[2 * 33], s[3 * 33]); o.z = cvtpk(s[4 * 33], s[5 * 33]); o.w = cvtpk(s[6 * 33], s[7 * 33]);
        *(u32x4*)(WT + (size_t)(n0 + n) * K + k0 + 8 * c) = o; }
    asm volatile("s_waitcnt lgkmcnt(0)" ::: "memory");
}
__device__ __forceinline__ void attn_phase(LAS unsigned char* lds, const bf16_t* PROJ, const bf16_t* VT, const float* gq, const float* gk, const float* rb, bf16_t* MERGED, int vcu, int G, const int wave_u) {
    int tid_ = wave_u * 64 + lane_id_v(); asm volatile("" : "+v"(tid_));
    const int tid = tid_, lane = tid & 63, h = __builtin_amdgcn_readfirstlane(tid >> 6), ql = lane & 31, hi = lane >> 5;
    LAS float* SQ = (LAS float*)lds;
    LAS float* EXT = (LAS float*)(lds + 2048) + h * 640;
    float mq = wave_max(fabsf(gq[lane])), mk = wave_max(fabsf(gk[lane])); float mb = -1e30f;
    for (int i = lane; i < 513; i += 64) mb = fmaxf(mb, rb[h * 513 + i]);
    mb = wave_max(mb);
    const float c512 = rb[h * 513 + 512]; (void)mq; (void)mk; (void)mb;
    for (int i = lane; i < 640; i += 64) { int rel = i - 64; rel = rel > 256 ? 256 : (rel < -256 ? -256 : rel); EXT[639 - i] = (rb[h * 513 + rel + 256] - c512) * LOG2E; }
    asm volatile("s_waitcnt lgkmcnt(0)" ::: "memory");
    __syncthreads();
    for (int unit = vcu; unit < NUNIT_ATT; unit += G) {
        const int b = unit >> 7, n = unit & 127; const long tok0 = (long)b * SEQ_ + n * 64;
        bf16x8 qf[2][4];
        { const bf16_t* qp = PROJ + (tok0 + ql) * PJW + 1024 + h * 64 + hi * 8;
#pragma unroll
          for (int qb = 0; qb < 2; ++qb)
#pragma unroll
              for (int d0 = 0; d0 < 4; ++d0) qf[qb][d0] = *(const bf16x8*)(qp + (long)qb * 32 * PJW + d0 * 16); }
        f32x16 o[2][2];
#pragma unroll
        for (int a = 0; a < 2; ++a)
#pragma unroll
            for (int c = 0; c < 2; ++c)
#pragma unroll
                for (int r = 0; r < 16; ++r) o[a][c][r] = 0.f;
        float lsum[2] = {0.f, 0.f};
        const int it0 = (n < 8) ? 2 * (8 - n) : 0;
        const bf16_t* kbase = PROJ + (tok0 - 512) * PJW + 1536 + h * 64;
        const bf16_t* vbase = VT + (long)(h * 64) * T_ + (tok0 - 512);
        const unsigned kgo = (unsigned)((lane >> 3) * PJW + (lane & 7) * 8), vgo = (unsigned)((lane >> 2) * T_ + (lane & 3) * 8);
        LAS unsigned char* kv = lds + 24576 + h * 8192;
        const unsigned wk = (unsigned)((lane >> 3) * 128 + (((lane & 7) ^ (lane >> 3)) * 16));
        const unsigned wv = (unsigned)(4096 + (lane >> 2) * 64 + (((lane & 3) ^ ((lane >> 3) & 3)) * 16));
        const unsigned rkb = (unsigned)(ql * 128), rks = (unsigned)(ql & 7), rvb = (unsigned)(4096 + ql * 64), rvs = (unsigned)((ql >> 1) & 3);
        bf16x8 kn[4], vn[4];
#define LOADKV(IT) do { const bf16_t* kp_ = kbase + (long)(IT) * 32 * PJW; const bf16_t* vp_ = vbase + (IT) * 32; \
        _Pragma("unroll") for (int i = 0; i < 4; ++i) { kn[i] = *(const bf16x8*)(kp_ + (kgo + (unsigned)(i * 8 * PJW))); vn[i] = *(const bf16x8*)(vp_ + (vgo + (unsigned)(i * 16 * T_))); } } while (0)
        LOADKV(it0);
        for (int it = it0; it < 18; ++it) {
#pragma unroll
            for (int i = 0; i < 4; ++i) { *(LAS bf16x8*)(kv + wk + i * 1024) = kn[i]; *(LAS bf16x8*)(kv + wv + i * 1024) = vn[i]; }
            { const int itn = (it + 1 < 18) ? it + 1 : it; LOADKV(itn); }
            bf16x8 kf[4], vf[2][2];
#pragma unroll
            for (int d0 = 0; d0 < 4; ++d0) kf[d0] = *(const LAS bf16x8*)(kv + rkb + (((unsigned)(2 * d0 + hi) ^ rks) * 16));
#pragma unroll
            for (int db = 0; db < 2; ++db)
#pragma unroll
                for (int ks = 0; ks < 2; ++ks) vf[db][ks] = *(const LAS bf16x8*)(kv + rvb + db * 2048 + (((unsigned)(2 * ks + hi) ^ rvs) * 16));
            const bool tab = (it >= 8);
#pragma unroll
            for (int qb = 0; qb < 2; ++qb) {
                f32x16 s;
                if (tab) { const LAS float* e = EXT + (63 - 32 * qb - ql + 32 * it + 4 * hi); f32x16 cin;
#pragma unroll
                    for (int r = 0; r < 16; ++r) cin[r] = e[(r & 3) + 8 * (r >> 2)];
                    s = MFMA32(kf[0], qf[qb][0], cin); }
                else { f32x16 z_;
#pragma unroll
                    for (int r = 0; r < 16; ++r) z_[r] = 0.f;
                    s = MFMA32(kf[0], qf[qb][0], z_); }
#pragma unroll
                for (int d0 = 1; d0 < 4; ++d0) s = MFMA32(kf[d0], qf[qb][d0], s);
                float ps = 0.f;
#pragma unroll
                for (int r = 0; r < 16; ++r) { s[r] = ex2(s[r]); ps += s[r]; }
                lsum[qb] += ps;
                bf16x8 pk[2];
#pragma unroll
                for (int ks = 0; ks < 2; ++ks) { u32x4 w; w.x = cvtpk(s[8 * ks], s[8 * ks + 1]); w.y = cvtpk(s[8 * ks + 2], s[8 * ks + 3]); w.z = cvtpk(s[8 * ks + 4], s[8 * ks + 5]); w.w = cvtpk(s[8 * ks + 6], s[8 * ks + 7]);
                    pk[ks] = __builtin_bit_cast(bf16x8, w); }
#pragma unroll
                for (int db = 0; db < 2; ++db)
#pragma unroll
                    for (int ks = 0; ks < 2; ++ks) o[db][qb] = MFMA32(vf[db][ks], pk[ks], o[db][qb]);
            }
        }
#undef LOADKV
        float inv[2], sq[2];
#pragma unroll
        for (int qb = 0; qb < 2; ++qb) { float l = lsum[qb]; l += __shfl_xor(l, 32); inv[qb] = 1.f / l; float q2 = 0.f;
#pragma unroll
            for (int db = 0; db < 2; ++db)
#pragma unroll
                for (int r = 0; r < 16; ++r) { const float v = o[db][qb][r] * inv[qb]; o[db][qb][r] = v; q2 += v * v; }
            q2 += __shfl_xor(q2, 32); sq[qb] = q2;
            if (hi == 0) SQ[h * 64 + 32 * qb + ql] = q2; }
        asm volatile("s_waitcnt lgkmcnt(0)" ::: "memory");
        __syncthreads();
#pragma unroll
        for (int qb = 0; qb < 2; ++qb) { float tot = 0.f;
#pragma unroll
            for (int hh = 0; hh < 8; ++hh) tot += SQ[hh * 64 + 32 * qb + ql];
            const float rstd = rsqf_(tot * (1.f / 512.f) + EPS_);
            bf16_t* op = MERGED + (tok0 + 32 * qb + ql) * DM_ + 512 + h * 64 + 4 * hi;
#pragma unroll
            for (int db = 0; db < 2; ++db)
#pragma unroll
                for (int r4 = 0; r4 < 4; ++r4) { u32x2 w; w.x = cvtpk(o[db][qb][4 * r4] * rstd, o[db][qb][4 * r4 + 1] * rstd); w.y = cvtpk(o[db][qb][4 * r4 + 2] * rstd, o[db][qb][4 * r4 + 3] * rstd);
                    *(u32x2*)(op + 32 * db + 8 * r4) = w; } }
        __syncthreads();
    }
}

template <bool PASS2>
__device__ __forceinline__ void lru_unit(LAS unsigned char* lds, int unit, const bf16_t* PROJ, const bf16_t* WGT, const float* conv_w, const float* conv_b, const float* b_rg, const float* b_ig,
                                         const float* lam, f32x2* SUMM, bf16_t* MERGED, const int wave_u) {
    int tid_ = wave_u * 64 + lane_id_v(); asm volatile("" : "+v"(tid_));
    const int tid = tid_, lane = tid & 63, w = __builtin_amdgcn_readfirstlane(tid >> 6), ql = lane & 31, hi = lane >> 5;
    const int b = unit >> 5, seg = unit & 31; const long tok0 = (long)b * SEQ_ + seg * 256;
    LAS bf16_t* XC = (LAS bf16_t*)lds + w * (64 * 72);
    LAS bf16_t* YT = (LAS bf16_t*)(lds + 73728);
    const int chc = 64 * w + lane;
    const float cw0 = conv_w[chc], cw1 = conv_w[512 + chc], cw2 = conv_w[1024 + chc], cw3 = conv_w[1536 + chc], cbv = conv_b[chc];
    float brg[2], big[2], sp[2];
#pragma unroll
    for (int nb = 0; nb < 2; ++nb) { const int ch = 64 * w + 32 * nb + ql; brg[nb] = b_rg[ch]; big[nb] = b_ig[ch];
        sp[nb] = -8.f * LOG2E * log1pf(expf(-lam[ch])); }
    float carry[2] = {0.f, 0.f}, ptot[2] = {1.f, 1.f};
    if (PASS2) {
#pragma unroll
        for (int nb = 0; nb < 2; ++nb) { float c = 0.f; const f32x2* sp_ = SUMM + (size_t)(b * 32) * 512 + 64 * w + 32 * nb + ql;
            for (int s0 = 0; s0 < seg; s0 += 8) { f32x2 v[8];
#pragma unroll
                for (int j = 0; j < 8; ++j) v[j] = (s0 + j < seg) ? sp_[(size_t)(s0 + j) * 512] : (f32x2){1.f, 0.f};
#pragma unroll
                for (int j = 0; j < 8; ++j) c = v[j].x * c + v[j].y; }
            carry[nb] = c; }
    }
#pragma nounroll
    for (int st = 0; st < 4; ++st) {
        const long t0 = tok0 + 64 * st;
        {
            const bf16_t* xp = PROJ + t0 * PJW + chc;
            float x1 = 0.f, x2 = 0.f, x3 = 0.f;
            if (seg != 0 || st != 0) { x1 = bf2f(xp[-1 * PJW]); x2 = bf2f(xp[-2 * PJW]); x3 = bf2f(xp[-3 * PJW]); }
#pragma unroll 16
            for (int t = 0; t < 64; ++t) { const float xv = bf2f(xp[(long)t * PJW]); const float xc = cbv + cw0 * x3 + cw1 * x2 + cw2 * x1 + cw3 * xv;
                XC[t * 72 + lane] = (bf16_t)(cvtpk(xc, 0.f) & 0xffffu); x3 = x2; x2 = x1; x1 = xv; }
        }
        asm volatile("s_waitcnt lgkmcnt(0)" ::: "memory");
#pragma unroll
        for (int nb = 0; nb < 2; ++nb) {
            bf16x8 wrf[4], wif[4];
            { int woff = ((w * 64 + 32 * nb + ql) * 64 + 8 * hi); asm volatile("" : "+v"(woff));
#pragma unroll
              for (int ks = 0; ks < 4; ++ks) { wrf[ks] = *(const bf16x8*)(WGT + woff + 16 * ks); wif[ks] = *(const bf16x8*)(WGT + 8 * 4096 + woff + 16 * ks); } }
#pragma unroll
            for (int tb = 0; tb < 2; ++tb) {
                bf16x8 af[4];
#pragma unroll
                for (int ks = 0; ks < 4; ++ks) af[ks] = *(const LAS bf16x8*)(XC + (32 * tb + ql) * 72 + 16 * ks + 8 * hi);
                f32x16 dr, di;
#pragma unroll
                for (int r = 0; r < 16; ++r) { dr[r] = 0.f; di[r] = 0.f; }
#pragma unroll
                for (int ks = 0; ks < 4; ++ks) { dr = MFMA32(af[ks], wrf[ks], dr); di = MFMA32(af[ks], wif[ks], di); }
                float A[16], U[16];
#pragma unroll
                for (int r = 0; r < 16; ++r) { const int tok = 32 * tb + crow(r, hi); const float xcv = bf2f(XC[tok * 72 + 32 * nb + ql]);
                    const float rg = sigm(dr[r] + brg[nb]), ig = sigm(di[r] + big[nb]); const float a = ex2(rg * sp[nb]);
                    const float mult = __builtin_amdgcn_sqrtf(fmaxf(1.f - a * a, 0.f)); A[r] = a; U[r] = mult * ig * xcv; }
#pragma unroll
                for (int q4 = 0; q4 < 4; ++q4)
#pragma unroll
                    for (int e = 1; e < 4; ++e) { U[4 * q4 + e] = A[4 * q4 + e] * U[4 * q4 + e - 1] + U[4 * q4 + e]; A[4 * q4 + e] = A[4 * q4 + e - 1] * A[4 * q4 + e]; }
                float c = carry[nb], HIN[4];
#pragma unroll
                for (int q4 = 0; q4 < 4; ++q4) { const float e0 = A[4 * q4 + 3] * c + U[4 * q4 + 3]; const float p = __shfl_xor(e0, 32); const float hin = hi ? p : c; HIN[q4] = hin;
                    const float e1 = A[4 * q4 + 3] * hin + U[4 * q4 + 3]; const float q = __shfl_xor(e1, 32); c = hi ? e1 : q; }
                carry[nb] = c;
                if (!PASS2) { const float po = (A[3] * A[7]) * (A[11] * A[15]); ptot[nb] *= po * __shfl_xor(po, 32); }
                else {
                    const bf16_t* gb = PROJ + t0 * PJW + 512 + 64 * w + 32 * nb + (32 * tb) * PJW;
                    const unsigned goff = (unsigned)(4 * hi) * PJW + ql;
#pragma unroll
                    for (int r = 0; r < 16; ++r) { const int tok = 32 * tb + crow(r, hi); const float hval = U[r] + A[r] * HIN[r >> 2]; const float gl = bf2f(gb[goff + (unsigned)((r & 3) + 8 * (r >> 2)) * PJW]);
                        YT[tok * 520 + 64 * w + 32 * nb + ql] = (bf16_t)(cvtpk(hval * gl, 0.f) & 0xffffu); }
                }
            }
        }
        if (PASS2) {
            asm volatile("s_waitcnt lgkmcnt(0)" ::: "memory");
            __syncthreads();
#pragma unroll
            for (int i = 0; i < 8; ++i) { const int tok = 8 * w + i; const u32x4 v = *(const LAS u32x4*)(YT + tok * 520 + 8 * lane);
                const float f0 = bflo(v.x), f1 = bfhi(v.x), f2 = bflo(v.y), f3 = bfhi(v.y), f4 = bflo(v.z), f5 = bfhi(v.z), f6 = bflo(v.w), f7 = bfhi(v.w);
                float ss = (f0 * f0 + f1 * f1) + (f2 * f2 + f3 * f3) + (f4 * f4 + f5 * f5) + (f6 * f6 + f7 * f7); ss = wave_sum(ss);
                const float rs = rsqf_(ss * (1.f / 512.f) + EPS_);
                u32x4 o; o.x = cvtpk(f0 * rs, f1 * rs); o.y = cvtpk(f2 * rs, f3 * rs); o.z = cvtpk(f4 * rs, f5 * rs); o.w = cvtpk(f6 * rs, f7 * rs);
                *(u32x4*)(MERGED + (t0 + tok) * DM_ + 8 * lane) = o; }
            __syncthreads();
        }
        asm volatile("" ::: "memory");
    }
    if (!PASS2) { if (hi == 0) {
#pragma unroll
        for (int nb = 0; nb < 2; ++nb) SUMM[(size_t)unit * 512 + 64 * w + 32 * nb + ql] = (f32x2){ptot[nb], carry[nb]}; } }
}

#ifndef PROBE_MASK
#define PROBE_MASK 0
#endif
#ifndef RES_BF16
#define RES_BF16 1
#endif
struct Args { const float* in[23]; float* out; unsigned char* ws; };
__global__ void __launch_bounds__(NTHR, 2) fwd_megakernel(Args args) {
    extern __shared__ __attribute__((aligned(16))) unsigned char lds_raw[];
    cg::grid_group grid = cg::this_grid();
    LAS unsigned char* lds = (LAS unsigned char*)lds_raw;
    const int wave = __builtin_amdgcn_readfirstlane(threadIdx.x >> 6);
#define tid (wave * 64 + lane_id_v())
#define lane (lane_id_v())
    const int G = gridDim.x, bx = blockIdx.x, vcu = (G % 8 == 0) ? (bx % 8) * (G / 8) + bx / 8 : bx;
    unsigned char* ws = args.ws;
    volatile LAS unsigned* MISC = (volatile LAS unsigned*)(lds + MISC_OFF);
    if (threadIdx.x < 16) MISC[threadIdx.x] = 0u;
    __syncthreads();
    XcdBarrier bar; bar.bar = (unsigned*)(ws + WS_CTL); bar.x = xb_xcc_id(); bar.st = MISC;
    if (blockIdx.x == 0) for (int i = threadIdx.x; i < (int)(CTL_BYTES / 4); i += NTHR) bar.bar[i] = 0u;
    const float* x = args.in[0]; const float* p = args.in[1]; float* out = args.out;
    bf16_t* WT_IN = (bf16_t*)(ws + WS_WIN); bf16_t* WT_OUT = (bf16_t*)(ws + WS_WOUT); bf16_t* WT_UP = (bf16_t*)(ws + WS_WUP); bf16_t* WT_DN = (bf16_t*)(ws + WS_WDN);
    bf16_t* WT_PG = (bf16_t*)(ws + WS_WPG); bf16_t* WT_PP = (bf16_t*)(ws + WS_WPP); bf16_t* WGT = (bf16_t*)(ws + WS_WG);
    float* RINV0 = (float*)(ws + WS_RINV0);
    float* RSTD1 = (float*)(ws + WS_RSTD1); float* RSTD2 = (float*)(ws + WS_RSTD2); f32x2* SUMM = (f32x2*)(ws + WS_SUMM);
    bf16_t* XN = (bf16_t*)(ws + WS_XN); bf16_t* PP = (bf16_t*)(ws + WS_PP); bf16_t* PB = (bf16_t*)(ws + WS_PB);
    bf16_t* PROJ = (bf16_t*)(ws + WS_PROJ); bf16_t* VT = (bf16_t*)(ws + WS_VT); bf16_t* MERGED = (bf16_t*)(ws + WS_MERGED); bf16_t* ACT = (bf16_t*)(ws + WS_ACT);

    for (int rep_ = 0; rep_ < 1 + ((PROBE_MASK >> 0) & 1); ++rep_) {
        LAS float* scr = (LAS float*)(lds + wave * 16384);
        const int gw = vcu * NWAVES + wave, NGW = G * NWAVES;
        constexpr int I_IN = 16 * 80, I_OUT = 16 * 32, I_UP = 16 * 128, I_DN = 64 * 32, I_PG = 16 * 32, I_PP = 4 * 32;
        constexpr int NITEMS = I_IN + I_OUT + I_UP + I_DN + I_PG + I_PP;
        for (int it = gw; it < NITEMS; it += NGW) {
            int r = it;
            if (r < I_IN) { p0_transpose_item(args.in[3], 1024, 2560, WT_IN, nullptr, nullptr, 0, scr, r, lane); continue; } r -= I_IN;
            if (r < I_OUT) { p0_transpose_item(args.in[16], 1024, 1024, WT_OUT, args.in[14], args.in[15], 512, scr, r, lane); continue; } r -= I_OUT;
            if (r < I_UP) { p0_transpose_item(args.in[18], 1024, 4096, WT_UP, args.in[17], args.in[17], 1 << 30, scr, r, lane); continue; } r -= I_UP;
            if (r < I_DN) { p0_transpose_item(args.in[19], 4096, 1024, WT_DN, nullptr, nullptr, 0, scr, r, lane); continue; } r -= I_DN;
            if (r < I_PG) { p0_transpose_item(args.in[21], 1024, 1024, WT_PG, args.in[20], args.in[20], 1 << 30, scr, r, lane); continue; } r -= I_PG;
            p0_transpose_item(args.in[22], 256, 1024, WT_PP, nullptr, nullptr, 0, scr, r, lane);
        }
        for (int i = bx * NTHR + tid; i < T_; i += G * NTHR) { RSTD1[i] = 0.f; RSTD2[i] = 0.f; }
        for (int i = bx * NTHR + tid; i < 65536; i += G * NTHR) { const int k = i & 63, n = (i >> 6) & 63, blk = (i >> 12) & 7, gate = i >> 15;
            const float v = (gate ? args.in[8] : args.in[6])[blk * 4096 + k * 64 + n]; WGT[i] = (bf16_t)(cvtpk(v, 0.f) & 0xffffu); }
        const float* g1 = args.in[2];
        f32x4 gv[4];
#pragma unroll
        for (int j = 0; j < 4; ++j) gv[j] = *((const f32x4*)g1 + lane + 64 * j);
        for (int m = gw; m < T_; m += NGW) {
            const f32x4* xr = (const f32x4*)(x + (size_t)m * DM_) + lane; f32x4 v[4]; float s = 0.f;
#pragma unroll
            for (int j = 0; j < 4; ++j) { v[j] = __builtin_nontemporal_load(xr + 64 * j); s += (v[j].x * v[j].x + v[j].y * v[j].y) + (v[j].z * v[j].z + v[j].w * v[j].w); }
            const float ms_ = wave_sum(s) * (1.f / DM_) + EPS_; const float rstd = rsqf_(ms_);
            if (lane == 0) RINV0[m] = ms_ * rstd;
            u32x2* o8 = (u32x2*)(XN + (size_t)m * DM_) + lane;
#pragma unroll
            for (int j = 0; j < 4; ++j) { const f32x4 y = v[j] * gv[j] * rstd; u32x2 w; w.x = cvtpk(y.x, y.y); w.y = cvtpk(y.z, y.w); o8[64 * j] = w; }
            const f32x4 pv = __builtin_nontemporal_load((const f32x4*)(p + (size_t)m * PLE_) + lane); u32x2 pw; pw.x = cvtpk(pv.x, pv.y); pw.y = cvtpk(pv.z, pv.w);
            *((u32x2*)(PB + (size_t)m * PLE_) + lane) = pw;
        }
    }
    grid.sync();
    if (threadIdx.x == 0) MISC[2] = xb_add(&bar.bar[XB_XCNT(bar.x)], 1u);
    int cid = bx, vcu2 = vcu;
#define CENSUS_IDS() do { \
    if (threadIdx.x == 0) { unsigned okc = 1u; \
        for (unsigned j = 0; j < 16; ++j) { const unsigned c_ = xb_ld(&bar.bar[XB_XCNT(j)]); okc &= (j < 8 ? (c_ == (unsigned)G / 8u) : (c_ == 0u)) ? 1u : 0u; } \
        MISC[3] = (okc && (G % 8 == 0)) ? 1u : 0u; } \
    __syncthreads(); \
    { const bool okmap = MISC[3] != 0u; \
      cid = __builtin_amdgcn_readfirstlane(okmap ? (int)(MISC[2] * 8u + bar.x) : bx); \
      vcu2 = __builtin_amdgcn_readfirstlane(okmap ? (int)(bar.x * (unsigned)(G / 8) + MISC[2]) : vcu); } } while (0)
#if 0
    if (threadIdx.x == 0) { unsigned okc = 1u;
        for (unsigned j = 0; j < 16; ++j) { const unsigned c_ = xb_ld(&bar.bar[XB_XCNT(j)]); okc &= (j < 8 ? (c_ == (unsigned)G / 8u) : (c_ == 0u)) ? 1u : 0u; }
        MISC[3] = (okc && (G % 8 == 0)) ? 1u : 0u; }
    __syncthreads();
    const bool okmap = MISC[3] != 0u;
    const int cid = __builtin_amdgcn_readfirstlane(okmap ? (int)(MISC[2] * 8u + bar.x) : bx);
    const int vcu2 = __builtin_amdgcn_readfirstlane(okmap ? (int)(bar.x * (unsigned)(G / 8) + MISC[2]) : vcu);
#endif
    for (int rep_ = 0; rep_ < 1 + ((PROBE_MASK >> 1) & 1); ++rep_) {
        { pg8::Gemm g{XN, WT_IN, T_, 2048, 1024}; pg8::StaticOrder S; S.init(T_, 2048, G, cid); EpiProj E{PROJ, args.in[11], args.in[12]};
          pg8::gemm_phase<EpiProj, pg8::StaticOrder, PG8_ALIGN, PG8_SP2>(lds, g, S, E, wave); }
        { pg8::Gemm g{WT_IN + (size_t)2048 * 1024, XN, 512, T_, 1024}; pg8::StaticOrder S; S.init(512, T_, G, cid); EpiVT E{VT};
          pg8::gemm_phase<EpiVT, pg8::StaticOrder, PG8_ALIGN, PG8_SP2>(lds, g, S, E, wave); }
    }
    xcd_barrier(bar);
    CENSUS_IDS();
    for (int rep_ = 0; rep_ < 1 + ((PROBE_MASK >> 2) & 1); ++rep_)
    attn_phase(lds, PROJ, VT, args.in[11]  , args.in[12], args.in[13], MERGED, vcu2, G, wave);
    for (int rep_ = 0; rep_ < 1 + ((PROBE_MASK >> 3) & 1); ++rep_)
    for (int unit = vcu2; unit < NUNIT_LRU; unit += G)
        lru_unit<false>(lds, unit, PROJ, WGT, args.in[4], args.in[5], args.in[7], args.in[9], args.in[10], SUMM, MERGED, wave);
    xcd_barrier(bar);
    for (int rep_ = 0; rep_ < 1 + ((PROBE_MASK >> 4) & 1); ++rep_)
    for (int unit = vcu2; unit < NUNIT_LRU; unit += G)
        lru_unit<true>(lds, unit, PROJ, WGT, args.in[4], args.in[5], args.in[7], args.in[9], args.in[10], SUMM, MERGED, wave);
    xcd_barrier(bar);
#if RES_BF16
    { pg8::Gemm g{MERGED, WT_OUT, T_, 1024, 1024}; pg8::StaticOrder S; S.init(T_, 1024, G, cid); EpiRes4b E{XN, RINV0, args.in[2], RSTD1};
      pg8::gemm_phase<EpiRes4b, pg8::StaticOrder, PG8_ALIGN, PG8_SP2>(lds, g, S, E, wave); }
#else
    for (int rep_ = ((PROBE_MASK >> 5) & 1) ? 0 : 1; rep_ < 2; ++rep_)
    { pg8::Gemm g{MERGED, WT_OUT, T_, 1024, 1024}; pg8::StaticOrder S; S.init(T_, 1024, G, cid); EpiRes E{x, out, XN, rep_ ? RSTD1 : (float*)(ws + WS_DUMMY), 0xFFFF};
      pg8::gemm_phase<EpiRes, pg8::StaticOrder, PG8_ALIGN, PG8_SP2>(lds, g, S, E, wave); }
#endif
    xcd_barrier(bar);
    for (int rep_ = 0; rep_ < 1 + ((PROBE_MASK >> 6) & 1); ++rep_) { pg8::Gemm g{XN, WT_UP, T_, 4096, 1024}; pg8::StaticOrder S; S.init(T_, 4096, G, cid); EpiUp E{ACT, RSTD1};
      pg8::gemm_phase<EpiUp, pg8::StaticOrder, PG8_ALIGN, PG8_SP2, (PROBE_MASK >> 9) & 1>(lds, g, S, E, wave); }
    xcd_barrier(bar);
#if RES_BF16
    { pg8::Gemm g{ACT, WT_DN, T_, 1024, 4096}; pg8::StaticOrder S; S.init(T_, 1024, G, cid); EpiRes6 E{XN, RSTD2};
      pg8::gemm_phase<EpiRes6, pg8::StaticOrder, PG8_ALIGN, PG8_SP2>(lds, g, S, E, wave); }
#else
    for (int rep_ = ((PROBE_MASK >> 7) & 1) ? 0 : 1; rep_ < 2; ++rep_)
    { pg8::Gemm g{ACT, WT_DN, T_, 1024, 4096}; pg8::StaticOrder S; S.init(T_, 1024, G, cid);
      EpiRes E{out, rep_ ? out : (float*)(ws + WS_END), XN, rep_ ? RSTD2 : (float*)(ws + WS_DUMMY), rep_ ? 0xFFFF : 0x7FFF};
      pg8::gemm_phase<EpiRes, pg8::StaticOrder, PG8_ALIGN, PG8_SP2>(lds, g, S, E, wave); }
#endif
    xcd_barrier(bar);
#if RES_BF16
    { pg8::StaticOrder S; S.init(T_, 1024, G, cid); EpiMidPP EM{(u32x4*)(ws + WS_PP) + (size_t)bx * 8192}; EpiFinalC EF{XN, out, RSTD2, (const u32x4*)(ws + WS_PP) + (size_t)bx * 8192};
      pg8::gemm_phase_ple<EpiMidPP, EpiFinalC, pg8::StaticOrder>(lds, PB, WT_PP, XN, WT_PG, S, EM, EF, wave); }
#else
    for (int rep_ = ((PROBE_MASK >> 8) & 1) ? 0 : 1; rep_ < 2; ++rep_)
    { pg8::Gemm g{XN, WT_PG, T_, 1024, 1024}; pg8::StaticOrder S; S.init(T_, 1024, G, cid); EpiFinal E{out, rep_ ? out : (float*)ACT, PP, RSTD2};
      pg8::gemm_phase<EpiFinal, pg8::StaticOrder, PG8_ALIGN, PG8_SP2>(lds, g, S, E, wave); }
#endif
}

#undef tid
#undef lane
extern "C" void kernel_launch(void* const* d_in, const int* in_sizes, int n_in, void* d_out, int out_size, void* d_ws, size_t ws_size, hipStream_t stream) {
    static int grid = 0;
    if (grid == 0) {
        if (n_in != 23 || in_sizes[0] != T_ * DM_ || out_size != T_ * DM_ || ws_size < WS_END) { fprintf(stderr, "kernel_launch: unexpected shapes (n_in %d, in0 %d, out %d, ws %zu)\n", n_in, n_in > 0 ? in_sizes[0] : -1, out_size, ws_size); grid = -1; return; }
        int dev = 0, cus = 0, per_cu = 0;
        (void)hipGetDevice(&dev); (void)hipDeviceGetAttribute(&cus, hipDeviceAttributeMultiprocessorCount, dev);
        (void)hipFuncSetAttribute((const void*)fwd_megakernel, hipFuncAttributeMaxDynamicSharedMemorySize, LDS_BYTES);
        if (hipOccupancyMaxActiveBlocksPerMultiprocessor(&per_cu, (const void*)fwd_megakernel, NTHR, LDS_BYTES) != hipSuccess || per_cu < 1) per_cu = 1;
        (void)hipGetLastError();
        grid = cus * per_cu;
        if (grid > 256) grid = 256;
        fprintf(stderr, "kernel_launch: cus %d per_cu %d grid %d\n", cus, per_cu, grid);
    }
    if (grid < 0) return;
    Args a{};
    for (int i = 0; i < 23; ++i) a.in[i] = (const float*)d_in[i];
    a.out = (float*)d_out; a.ws = (unsigned char*)d_ws;
    void* kargs[] = {&a};
    hipError_t e = hipLaunchCooperativeKernel((const void*)fwd_megakernel, dim3(grid), dim3(NTHR), kargs, LDS_BYTES, stream);
    if (e != hipSuccess) fprintf(stderr, "kernel_launch: cooperative launch failed: %s (grid %d)\n", hipGetErrorString(e), grid);
}
```

```cpp
#include <hip/hip_runtime.h>
#include <hip/hip_cooperative_groups.h>
#include <cstdio>
#include <cstdint>
namespace cg = cooperative_groups;
__device__ __forceinline__ int lane_id_v() { int l; asm volatile("v_mbcnt_lo_u32_b32 %0, -1, 0\n\tv_mbcnt_hi_u32_b32 %0, -1, %0" : "=v"(l)); return l; }
namespace pg8 {
#define PG8_LAS __attribute__((address_space(3)))
typedef unsigned short bf16_t;
typedef short bf16x8 __attribute__((ext_vector_type(8)));
typedef float f32x4 __attribute__((ext_vector_type(4)));
typedef unsigned u32x4 __attribute__((ext_vector_type(4)));
constexpr int BM = 256, BK = 64, HALF = 128, HTB = HALF * BK * 2  , STAGE_BYTES = 8 * HTB, NXCD = 8, WGM = 8;

__host__ __device__ __forceinline__ int lds_byte(int r, int c) { const int st = (r >> 4) * 2 + (c >> 5), rr = r & 15, cc = c & 31, ob = rr * 64 + cc * 2; return st * 1024 + (ob ^ (((ob >> 9) & 1) << 5)); }
__host__ __device__ __forceinline__ void stage_rc(int b, int& R, int& C) { const int st = b / 1024, sb = b % 1024, swz = sb ^ (((sb >> 9) & 1) << 5); R = (st >> 1) * 16 + swz / 64; C = (st & 1) * 32 + (swz % 64) / 2; }
__host__ __device__ __forceinline__ int perm32(int rho) { const int n = rho >> 4, i = rho & 15; return 8 * (i >> 2) + 4 * n + (i & 3); }

struct Unit { int pm, pn; };
struct Gemm { const bf16_t* A; const bf16_t* Bt; int M, N, K; };

struct StaticOrder {
    int nM, nN, nwg, G, c;
    __host__ __device__ void init(int M, int N, int G_, int c_) { nM = M / BM; nN = N / BM; nwg = nM * nN; G = G_; c = c_; }
    __host__ __device__ bool next(int i, Unit& u) const {
        const long L = (long)i * G + c; if (L >= nwg) return false;
        int wgid = (int)L; { const int q = nwg / NXCD, r = nwg % NXCD, xcd = wgid % NXCD, off = wgid / NXCD; wgid = (xcd < r ? xcd * (q + 1) : r * (q + 1) + (xcd - r) * q) + off; }
        const int nig = WGM * nN, gid = wgid / nig, fm = gid * WGM, gsz = (nM - fm) < WGM ? (nM - fm) : WGM;
        u.pm = fm + ((wgid % nig) % gsz); u.pn = (wgid % nig) / gsz; return true;
    }
    __device__ __forceinline__ void a_ready(const Unit&) const {}
    __device__ __forceinline__ void done(const Unit&) const {}
};

__device__ __forceinline__ unsigned cvt_pk_bf16(float lo, float hi) { unsigned r; asm volatile("v_cvt_pk_bf16_f32 %0, %1, %2" : "=v"(r) : "v"(lo), "v"(hi)); return r; }
typedef float f32x2 __attribute__((ext_vector_type(2)));
template <class Epi, class Sched, bool ALIGN_EPI = false, bool SP2 = false, bool EPI2 = false>
__device__ __forceinline__ void gemm_phase(PG8_LAS unsigned char* lds, const Gemm g, const Sched& S, const Epi& E, const int wave_u) {
    int tid_ = wave_u * 64 + lane_id_v(); asm volatile("" : "+v"(tid_));
    const int tid = tid_, wid = __builtin_amdgcn_readfirstlane(tid >> 6), lane = tid & 63, wr = wid >> 2, wc = wid & 3, fr = lane & 15, fq = lane >> 4;
    const int K = g.K, nt = K / BK;
    unsigned voffA[2], voffB[2];
#pragma unroll
    for (int i = 0; i < 2; ++i) { int R, C; stage_rc(tid * 16 + i * 8192, R, C); const int Rp = Epi::PERM ? perm32(R & 31) : (R & 31); const int Rb = Epi::HEADMAP ? (64 * (R >> 5) + Rp) : ((R & ~31) + Rp);
        voffA[i] = (unsigned)(R * K + C) * 2u; voffB[i] = (unsigned)(Rb * K + C) * 2u; }
    const size_t kstep = (size_t)(BK * 2);
    const size_t hstep = (size_t)HALF * K * 2;
    const size_t hstepB = Epi::HEADMAP ? (size_t)32 * K * 2 : hstep;
    const size_t tstep = 2 * hstep;
    const unsigned ldsw = (unsigned)wid * 1024u;
    const int aoff = lds_byte(wr * 64 + fr, fq * 8), boff = lds_byte(wc * 32 + fr, fq * 8);
#define PG8_SA(b, h) (((b) * 2 + (h)) * HTB)
#define PG8_SB(b, h) ((4 + (b) * 2 + (h)) * HTB)
#define PG8_STAGE(bufoff, gbase, voff) do { _Pragma("unroll") for (int _i = 0; _i < 2; ++_i) \
        __builtin_amdgcn_global_load_lds((const unsigned*)((const char*)(gbase) + (voff)[_i]), (PG8_LAS unsigned*)(lds + (bufoff) + ldsw + _i * 8192), 16, 0, 0); } while (0)
#define PG8_LDA(dst, b, h) do { _Pragma("unroll") for (int m = 0; m < 4; ++m) _Pragma("unroll") for (int k = 0; k < 2; ++k) dst[m][k] = *(const PG8_LAS bf16x8*)(lds + PG8_SA(b, h) + aoff + m * 2048 + k * 1024); } while (0)
#define PG8_LDB(dst, b, h) do { _Pragma("unroll") for (int n = 0; n < 2; ++n) _Pragma("unroll") for (int k = 0; k < 2; ++k) dst[n][k] = *(const PG8_LAS bf16x8*)(lds + PG8_SB(b, h) + boff + n * 2048 + k * 1024); } while (0)
#define PG8_MMA(ai, bj, At, Bt) do { __builtin_amdgcn_s_setprio(1); _Pragma("unroll") for (int m = 0; m < 4; ++m) _Pragma("unroll") for (int n = 0; n < 2; ++n) _Pragma("unroll") for (int k = 0; k < 2; ++k) \
        acc[ai][bj][m][n] = __builtin_amdgcn_mfma_f32_16x16x32_bf16(Bt[n][k], At[m][k], acc[ai][bj][m][n], 0, 0, 0); __builtin_amdgcn_s_setprio(0); } while (0)
#define PG8_WAIT_V(n) asm volatile("s_waitcnt vmcnt(" #n ")" ::: "memory")
#define PG8_WAIT_L(n) asm volatile("s_waitcnt lgkmcnt(" #n ")" ::: "memory")
#define PG8_BAR __builtin_amdgcn_s_barrier()
#define PG8_SCHED __builtin_amdgcn_sched_barrier(0)
    Unit cur, nxt; int ui = 0;
    if (!S.next(0, cur)) return;
    f32x4 acc[2][2][4][2];
#pragma unroll
    for (int a = 0; a < 2; ++a)
#pragma unroll
        for (int b = 0; b < 2; ++b)
#pragma unroll
            for (int m = 0; m < 4; ++m)
#pragma unroll
                for (int n = 0; n < 2; ++n) acc[a][b][m][n] = (f32x4){0.f, 0.f, 0.f, 0.f};
    bf16x8 At[4][2], B0[2][2], B1[2][2];
    const char* cA = (const char*)g.A + (size_t)cur.pm * tstep; const char* cB = (const char*)g.Bt + (size_t)cur.pn * tstep;
    S.a_ready(cur);
    if constexpr (SP2) {
        PG8_STAGE(PG8_SB(0, 0), cB, voffB); PG8_STAGE(PG8_SB(0, 1), cB + hstepB, voffB); PG8_STAGE(PG8_SA(0, 0), cA, voffA); PG8_STAGE(PG8_SA(0, 1), cA + hstep, voffA);
        if (wr == 1) PG8_BAR;
        PG8_WAIT_V(2); PG8_BAR;
        PG8_STAGE(PG8_SB(1, 0), cB + kstep, voffB); PG8_STAGE(PG8_SA(1, 0), cA + kstep, voffA); PG8_STAGE(PG8_SB(1, 1), cB + hstepB + kstep, voffB);
        PG8_WAIT_V(6); PG8_BAR;
    } else {
        PG8_STAGE(PG8_SB(0, 0), cB, voffB); PG8_STAGE(PG8_SA(0, 0), cA, voffA); PG8_STAGE(PG8_SB(0, 1), cB + hstepB, voffB); PG8_STAGE(PG8_SA(0, 1), cA + hstep, voffA);
        if (wr == 1) PG8_BAR;
        PG8_WAIT_V(4); PG8_BAR;
        PG8_STAGE(PG8_SB(1, 0), cB + kstep, voffB); PG8_STAGE(PG8_SA(1, 0), cA + kstep, voffA); PG8_STAGE(PG8_SB(1, 1), cB + hstepB + kstep, voffB);
        PG8_WAIT_V(6); PG8_BAR;
    }
    for (;;) {
        const bool has_next = S.next(ui + 1, nxt);
        const char* nA = has_next ? (const char*)g.A + (size_t)nxt.pm * tstep : cA; const char* nB = has_next ? (const char*)g.Bt + (size_t)nxt.pn * tstep : cB;
#pragma nounroll
        for (int t = 0; t < nt; t += 2) {
            const bool last = (t == nt - 2);
            const char* a1 = cA + (size_t)(t + 1) * kstep;
            const char* a2 = last ? nA : cA + (size_t)(t + 2) * kstep; const char* b2 = last ? nB : cB + (size_t)(t + 2) * kstep;
            const char* a3 = a2 + kstep; const char* b3 = b2 + kstep;
            if (last && has_next) S.a_ready(nxt);
            if constexpr (SP2) {
            PG8_LDB(B0, 0, 0); PG8_LDB(B1, 0, 1); PG8_SCHED; PG8_LDA(At, 0, 0); PG8_STAGE(PG8_SA(1, 1), a1 + hstep, voffA);
            PG8_WAIT_V(8); PG8_WAIT_L(0); PG8_BAR; PG8_MMA(0, 0, At, B0); PG8_MMA(0, 1, At, B1); PG8_BAR; PG8_SCHED;
            PG8_LDA(At, 0, 1); PG8_STAGE(PG8_SB(0, 0), b2, voffB); PG8_STAGE(PG8_SB(0, 1), b2 + hstepB, voffB); PG8_STAGE(PG8_SA(0, 0), a2, voffA);
            PG8_WAIT_V(8); PG8_WAIT_L(0); PG8_BAR; PG8_MMA(1, 0, At, B0); PG8_MMA(1, 1, At, B1); PG8_BAR; PG8_SCHED;
            PG8_LDB(B0, 1, 0); PG8_LDB(B1, 1, 1); PG8_SCHED; PG8_LDA(At, 1, 0); PG8_STAGE(PG8_SA(0, 1), a2 + hstep, voffA);
            PG8_WAIT_V(8); PG8_WAIT_L(0); PG8_BAR; PG8_MMA(0, 0, At, B0); PG8_MMA(0, 1, At, B1); PG8_BAR; PG8_SCHED;
            PG8_LDA(At, 1, 1); PG8_STAGE(PG8_SB(1, 0), b3, voffB); PG8_STAGE(PG8_SB(1, 1), b3 + hstepB, voffB); PG8_STAGE(PG8_SA(1, 0), a3, voffA);
            PG8_WAIT_V(8); PG8_WAIT_L(0); PG8_BAR; PG8_MMA(1, 0, At, B0); PG8_MMA(1, 1, At, B1); PG8_BAR; PG8_SCHED;
            } else {
            PG8_LDB(B0, 0, 0); PG8_SCHED; PG8_LDA(At, 0, 0); PG8_STAGE(PG8_SA(1, 1), a1 + hstep, voffA);
            PG8_WAIT_L(8); PG8_BAR; PG8_WAIT_L(0); PG8_MMA(0, 0, At, B0); PG8_BAR; PG8_SCHED;
            PG8_LDB(B1, 0, 1); PG8_STAGE(PG8_SB(0, 0), b2, voffB);
            PG8_BAR; PG8_WAIT_L(0); PG8_MMA(0, 1, At, B1); PG8_BAR;
            PG8_LDA(At, 0, 1); PG8_STAGE(PG8_SA(0, 0), a2, voffA);
            PG8_BAR; PG8_WAIT_L(0); PG8_MMA(1, 0, At, B0); PG8_BAR; PG8_SCHED;
            PG8_STAGE(PG8_SB(0, 1), b2 + hstepB, voffB);
            PG8_WAIT_V(6); PG8_BAR; PG8_MMA(1, 1, At, B1); PG8_BAR;
            PG8_LDB(B0, 1, 0); PG8_SCHED; PG8_LDA(At, 1, 0); PG8_STAGE(PG8_SA(0, 1), a2 + hstep, voffA);
            PG8_WAIT_L(8); PG8_BAR; PG8_WAIT_L(0); PG8_MMA(0, 0, At, B0); PG8_BAR; PG8_SCHED;
            PG8_LDB(B1, 1, 1); PG8_STAGE(PG8_SB(1, 0), b3, voffB);
            PG8_BAR; PG8_WAIT_L(0); PG8_MMA(0, 1, At, B1); PG8_BAR;
            PG8_LDA(At, 1, 1); PG8_STAGE(PG8_SA(1, 0), a3, voffA);
            PG8_BAR; PG8_WAIT_L(0); PG8_MMA(1, 0, At, B0); PG8_BAR; PG8_SCHED;
            PG8_STAGE(PG8_SB(1, 1), b3 + hstepB, voffB);
            PG8_WAIT_V(6); PG8_BAR; PG8_MMA(1, 1, At, B1); PG8_BAR;
            }
        }
        if constexpr (ALIGN_EPI) { if (wr == 0) PG8_BAR; }
        if constexpr (!Epi::AFTER_DRAIN) { E(acc, cur, wr, wc, fr, fq); if constexpr (EPI2) { asm volatile("" ::: "memory"); E(acc, cur, wr, wc, fr, fq); } S.done(cur); }
        if (!has_next) break;
#pragma unroll
        for (int a = 0; a < 2; ++a)
#pragma unroll
            for (int b = 0; b < 2; ++b)
#pragma unroll
                for (int m = 0; m < 4; ++m)
#pragma unroll
                    for (int n = 0; n < 2; ++n) acc[a][b][m][n] = (f32x4){0.f, 0.f, 0.f, 0.f};
        cur = nxt; cA = nA; cB = nB; ++ui;
        if constexpr (ALIGN_EPI) { if (wr == 1) PG8_BAR; }
    }
    PG8_WAIT_V(0);
    if constexpr (!ALIGN_EPI) { if (wr == 0) PG8_BAR; }
    PG8_BAR;
    if constexpr (Epi::AFTER_DRAIN) { E.fused(acc, cur, wr, wc, fr, fq, lds, wid, lane); S.done(cur); }
#undef PG8_SA
#undef PG8_SB
#undef PG8_STAGE
#undef PG8_LDA
#undef PG8_LDB
#undef PG8_MMA
#undef PG8_WAIT_V
#undef PG8_WAIT_L
#undef PG8_BAR
#undef PG8_SCHED
}

template <class EpiMid, class EpiFin, class Sched>
__device__ __forceinline__ void gemm_phase_ple(PG8_LAS unsigned char* lds, const bf16_t* AP, const bf16_t* BP, const bf16_t* AZ, const bf16_t* BZ, const Sched& S, const EpiMid& EM, const EpiFin& E, const int wave_u) {
    constexpr bool ALIGN_EPI = true;
    int tid_ = wave_u * 64 + lane_id_v(); asm volatile("" : "+v"(tid_));
    const int tid = tid_, wid = __builtin_amdgcn_readfirstlane(tid >> 6), lane = tid & 63, wr = wid >> 2, wc = wid & 3, fr = lane & 15, fq = lane >> 4;
    constexpr int KP = 256, KZ = 1024, NT = 20;
    unsigned vAP[2], vBP[2], vAZ[2], vBZ[2];
#pragma unroll
    for (int i = 0; i < 2; ++i) { int R, C; stage_rc(tid * 16 + i * 8192, R, C); const int Rb = (R & ~31) + perm32(R & 31);
        vAP[i] = (unsigned)(R * KP + C) * 2u; vBP[i] = (unsigned)(Rb * KP + C) * 2u; vAZ[i] = (unsigned)(R * KZ + C) * 2u; vBZ[i] = (unsigned)(Rb * KZ + C) * 2u; }
    const size_t kstep = (size_t)(BK * 2);
    const size_t hsP = (size_t)HALF * KP * 2, hsZ = (size_t)HALF * KZ * 2, tsP = 2 * hsP, tsZ = 2 * hsZ;
    const unsigned ldsw = (unsigned)wid * 1024u;
    const int aoff = lds_byte(wr * 64 + fr, fq * 8), boff = lds_byte(wc * 32 + fr, fq * 8);
#define PG8_SA(b, h) (((b) * 2 + (h)) * HTB)
#define PG8_SB(b, h) ((4 + (b) * 2 + (h)) * HTB)
#define PG8_STAGE(bufoff, gbase, voff) do { _Pragma("unroll") for (int _i = 0; _i < 2; ++_i) \
        __builtin_amdgcn_global_load_lds((const unsigned*)((const char*)(gbase) + (voff)[_i]), (PG8_LAS unsigned*)(lds + (bufoff) + ldsw + _i * 8192), 16, 0, 0); } while (0)
#define PG8_LDA(dst, b, h) do { _Pragma("unroll") for (int m = 0; m < 4; ++m) _Pragma("unroll") for (int k = 0; k < 2; ++k) dst[m][k] = *(const PG8_LAS bf16x8*)(lds + PG8_SA(b, h) + aoff + m * 2048 + k * 1024); } while (0)
#define PG8_LDB(dst, b, h) do { _Pragma("unroll") for (int n = 0; n < 2; ++n) _Pragma("unroll") for (int k = 0; k < 2; ++k) dst[n][k] = *(const PG8_LAS bf16x8*)(lds + PG8_SB(b, h) + boff + n * 2048 + k * 1024); } while (0)
#define PG8_MMA(ai, bj, At, Bt) do { __builtin_amdgcn_s_setprio(1); _Pragma("unroll") for (int m = 0; m < 4; ++m) _Pragma("unroll") for (int n = 0; n < 2; ++n) _Pragma("unroll") for (int k = 0; k < 2; ++k) \
        acc[ai][bj][m][n] = __builtin_amdgcn_mfma_f32_16x16x32_bf16(Bt[n][k], At[m][k], acc[ai][bj][m][n], 0, 0, 0); __builtin_amdgcn_s_setprio(0); } while (0)
#define PG8_WAIT_V(n) asm volatile("s_waitcnt vmcnt(" #n ")" ::: "memory")
#define PG8_WAIT_L(n) asm volatile("s_waitcnt lgkmcnt(" #n ")" ::: "memory")
#define PG8_BAR __builtin_amdgcn_s_barrier()
#define PG8_SCHED __builtin_amdgcn_sched_barrier(0)
    Unit cur, nxt; int ui = 0;
    if (!S.next(0, cur)) return;
    f32x4 acc[2][2][4][2];
#pragma unroll
    for (int a = 0; a < 2; ++a)
#pragma unroll
        for (int b = 0; b < 2; ++b)
#pragma unroll
            for (int m = 0; m < 4; ++m)
#pragma unroll
                for (int n = 0; n < 2; ++n) acc[a][b][m][n] = (f32x4){0.f, 0.f, 0.f, 0.f};
    bf16x8 At[4][2], B0[2][2], B1[2][2];
    const char* cAP = (const char*)AP + (size_t)cur.pm * tsP; const char* cBP = (const char*)BP + (size_t)cur.pn * tsP;
    const char* cAZ = (const char*)AZ + (size_t)cur.pm * tsZ; const char* cBZ = (const char*)BZ + (size_t)cur.pn * tsZ;
    S.a_ready(cur);
    PG8_STAGE(PG8_SB(0, 0), cBP, vBP); PG8_STAGE(PG8_SB(0, 1), cBP + hsP, vBP); PG8_STAGE(PG8_SA(0, 0), cAP, vAP); PG8_STAGE(PG8_SA(0, 1), cAP + hsP, vAP);
    if (wr == 1) PG8_BAR;
    PG8_WAIT_V(2); PG8_BAR;
    PG8_STAGE(PG8_SB(1, 0), cBP + kstep, vBP); PG8_STAGE(PG8_SA(1, 0), cAP + kstep, vAP); PG8_STAGE(PG8_SB(1, 1), cBP + hsP + kstep, vBP);
    PG8_WAIT_V(6); PG8_BAR;
    for (;;) {
        const bool has_next = S.next(ui + 1, nxt);
        const char* nAP = has_next ? (const char*)AP + (size_t)nxt.pm * tsP : cAP; const char* nBP = has_next ? (const char*)BP + (size_t)nxt.pn * tsP : cBP;
#pragma nounroll
        for (int t = 0; t < NT; t += 2) {
            if (t == 4) {
                EM(acc, cur, wr, wc, fr, fq);
#pragma unroll
                for (int a = 0; a < 2; ++a)
#pragma unroll
                    for (int b = 0; b < 2; ++b)
#pragma unroll
                        for (int m = 0; m < 4; ++m)
#pragma unroll
                            for (int n = 0; n < 2; ++n) acc[a][b][m][n] = (f32x4){0.f, 0.f, 0.f, 0.f};
            }
            const bool p1 = (t < 4), p23 = (t == 0) || (t == NT - 2);
            const char* a1 = p1 ? cAP + (size_t)(t + 1) * kstep : cAZ + (size_t)(t - 3) * kstep;
            const char* a2 = (t == 0) ? cAP + 2 * kstep : (t == NT - 2) ? nAP : cAZ + (size_t)(t - 2) * kstep;
            const char* b2 = (t == 0) ? cBP + 2 * kstep : (t == NT - 2) ? nBP : cBZ + (size_t)(t - 2) * kstep;
            const char* a3 = a2 + kstep; const char* b3 = b2 + kstep;
            const size_t hstep1 = p1 ? hsP : hsZ, hstep = p23 ? hsP : hsZ, hstepB = hstep;
            unsigned voffA1[2], voffA[2], voffB[2];
#pragma unroll
            for (int i = 0; i < 2; ++i) { voffA1[i] = p1 ? vAP[i] : vAZ[i]; voffA[i] = p23 ? vAP[i] : vAZ[i]; voffB[i] = p23 ? vBP[i] : vBZ[i]; }
            if (t == NT - 2 && has_next) S.a_ready(nxt);
            PG8_LDB(B0, 0, 0); PG8_LDB(B1, 0, 1); PG8_SCHED; PG8_LDA(At, 0, 0); PG8_STAGE(PG8_SA(1, 1), a1 + hstep1, voffA1);
            PG8_WAIT_V(8); PG8_WAIT_L(0); PG8_BAR; PG8_MMA(0, 0, At, B0); PG8_MMA(0, 1, At, B1); PG8_BAR; PG8_SCHED;
            PG8_LDA(At, 0, 1); PG8_STAGE(PG8_SB(0, 0), b2, voffB); PG8_STAGE(PG8_SB(0, 1), b2 + hstepB, voffB); PG8_STAGE(PG8_SA(0, 0), a2, voffA);
            PG8_WAIT_V(8); PG8_WAIT_L(0); PG8_BAR; PG8_MMA(1, 0, At, B0); PG8_MMA(1, 1, At, B1); PG8_BAR; PG8_SCHED;
            PG8_LDB(B0, 1, 0); PG8_LDB(B1, 1, 1); PG8_SCHED; PG8_LDA(At, 1, 0); PG8_STAGE(PG8_SA(0, 1), a2 + hstep, voffA);
            PG8_WAIT_V(8); PG8_WAIT_L(0); PG8_BAR; PG8_MMA(0, 0, At, B0); PG8_MMA(0, 1, At, B1); PG8_BAR; PG8_SCHED;
            PG8_LDA(At, 1, 1); PG8_STAGE(PG8_SB(1, 0), b3, voffB); PG8_STAGE(PG8_SB(1, 1), b3 + hstepB, voffB); PG8_STAGE(PG8_SA(1, 0), a3, voffA);
            PG8_WAIT_V(8); PG8_WAIT_L(0); PG8_BAR; PG8_MMA(1, 0, At, B0); PG8_MMA(1, 1, At, B1); PG8_BAR; PG8_SCHED;
        }
        if constexpr (ALIGN_EPI) { if (wr == 0) PG8_BAR; }
        E(acc, cur, wr, wc, fr, fq); S.done(cur);
        if (!has_next) break;
#pragma unroll
        for (int a = 0; a < 2; ++a)
#pragma unroll
            for (int b = 0; b < 2; ++b)
#pragma unroll
                for (int m = 0; m < 4; ++m)
#pragma unroll
                    for (int n = 0; n < 2; ++n) acc[a][b][m][n] = (f32x4){0.f, 0.f, 0.f, 0.f};
        cur = nxt; cAP = nAP; cBP = nBP; cAZ = (const char*)AZ + (size_t)cur.pm * tsZ; cBZ = (const char*)BZ + (size_t)cur.pn * tsZ; ++ui;
        if constexpr (ALIGN_EPI) { if (wr == 1) PG8_BAR; }
    }
    PG8_WAIT_V(0);
    if constexpr (!ALIGN_EPI) { if (wr == 0) PG8_BAR; }
    PG8_BAR;
#undef PG8_SA
#undef PG8_SB
#undef PG8_STAGE
#undef PG8_LDA
#undef PG8_LDB
#undef PG8_MMA
#undef PG8_WAIT_V
#undef PG8_WAIT_L
#undef PG8_BAR
#undef PG8_SCHED
}
}
#ifndef PG8_SP2
#define PG8_SP2 true
#endif
#ifndef PG8_ALIGN
#define PG8_ALIGN true
#endif
using pg8::bf16_t; using pg8::bf16x8; using pg8::f32x4; using pg8::u32x4;
#define LAS __attribute__((address_space(3)))
typedef float f32x2 __attribute__((ext_vector_type(2)));
typedef float f32x16 __attribute__((ext_vector_type(16)));
typedef unsigned u32x2 __attribute__((ext_vector_type(2)));
typedef __bf16 bf16x2_t __attribute__((ext_vector_type(2)));

constexpr int T_ = 65536, DM_ = 1024, SEQ_ = 8192, PJW = 2048, FF_ = 4096, PLE_ = 256, NUNIT_ATT = 1024, NUNIT_LRU = 256;
constexpr float EPS_ = 1e-6f, LOG2E = 1.4426950408889634f, QSCALE = 0.125f * 1.4426950408889634f;
constexpr int NWAVES = 8, NTHR = 512;
constexpr int RING_BYTES = 131072, SSL_OFF = RING_BYTES, MISC_OFF = 147456 - 64, LDS_BYTES = 147456;
constexpr size_t MiB = 1u << 20;
constexpr size_t WS_WIN = 0, WS_WOUT = 5 * MiB, WS_WUP = 7 * MiB, WS_WDN = 15 * MiB, WS_WPG = 23 * MiB, WS_WPP = 25 * MiB, WS_WG = 25 * MiB + 512 * 1024;
constexpr size_t WS_RSTD1 = 27 * MiB, WS_RSTD2 = 27 * MiB + 256 * 1024, WS_DUMMY = 27 * MiB + 512 * 1024, WS_RINV0 = 27 * MiB + 768 * 1024, WS_SUMM = 28 * MiB;
constexpr size_t WS_CTL = 31 * MiB, CTL_BYTES = 16384;
constexpr size_t WS_XN = 32 * MiB;
constexpr size_t WS_PP = 160 * MiB;
constexpr size_t WS_PB = 288 * MiB;
constexpr size_t WS_PROJ = 320 * MiB;
constexpr size_t WS_VT = 576 * MiB;
constexpr size_t WS_MERGED = 640 * MiB;
constexpr size_t WS_ACT = 320 * MiB;
constexpr size_t WS_END = 832 * MiB;

__device__ __forceinline__ unsigned cvtpk(float lo, float hi) { f32x2 v = {lo, hi}; bf16x2_t b = __builtin_convertvector(v, bf16x2_t); return __builtin_bit_cast(unsigned, b); }
__device__ __forceinline__ float bf2f(unsigned short u) { return __uint_as_float((unsigned)u << 16); }
__device__ __forceinline__ float bflo(unsigned w) { return __uint_as_float(w << 16); }
__device__ __forceinline__ float bfhi(unsigned w) { return __uint_as_float(w & 0xffff0000u); }
__device__ __forceinline__ float ex2(float x) { return __builtin_amdgcn_exp2f(x); }
__device__ __forceinline__ float rcpf_(float x) { return __builtin_amdgcn_rcpf(x); }
__device__ __forceinline__ float rsqf_(float x) { return __builtin_amdgcn_rsqf(x); }
__device__ __forceinline__ float sigm(float z) { return rcpf_(1.f + ex2(-LOG2E * z)); }
__device__ __forceinline__ float gelu_tanh(float g) { const float z = 0.7978845608028654f * (g + 0.044715f * g * g * g); return g * sigm(2.f * z); }
__device__ __forceinline__ float wave_sum(float v) {
#pragma unroll
    for (int o = 1; o < 64; o <<= 1) v += __shfl_xor(v, o);
    return v;
}
__device__ __forceinline__ float wave_max(float v) {
#pragma unroll
    for (int o = 1; o < 64; o <<= 1) v = fmaxf(v, __shfl_xor(v, o));
    return v;
}
__device__ __forceinline__ int crow(int r, int hi) { return (r & 3) + 8 * (r >> 2) + 4 * hi; }
#define MFMA32(a, b, c) __builtin_amdgcn_mfma_f32_32x32x16_bf16((a), (b), (c), 0, 0, 0)

#define RLX_AGENT __ATOMIC_RELAXED, __HIP_MEMORY_SCOPE_AGENT
#define XB_TMO      128
#define XB_XCNT(j)  (256  + 64 * (j))
#define XB_XSUB(j)  (1280 + 64 * (j))
#define XB_XGEN(j)  (2304 + 64 * (j))
#define XB_TOP      3328
#define XB_TOPGEN   3392
#define XCD_BAR_WORDS 3456
#define XB_SPIN_CAP (1u << 18)

__device__ __forceinline__ unsigned xb_ld(unsigned* p)              { return __hip_atomic_load(p, __ATOMIC_RELAXED, __HIP_MEMORY_SCOPE_AGENT); }
__device__ __forceinline__ unsigned xb_add(unsigned* p, unsigned v) { return __hip_atomic_fetch_add(p, v, __ATOMIC_RELAXED, __HIP_MEMORY_SCOPE_AGENT); }
__device__ __forceinline__ unsigned xb_xcc_id() { return (unsigned)__builtin_amdgcn_s_getreg((3 << 11) | 20) & 0xFu; }
#define XB_SPIN(cond, bar) do { unsigned _sp = 0; while (cond) { __builtin_amdgcn_s_sleep(1); \
    if ((++_sp & 255u) == 0u) { if (xb_ld(&(bar)[XB_TMO])) break; if (_sp > XB_SPIN_CAP) { atomicAdd(&(bar)[XB_TMO], 1u); break; } } } } while (0)

struct XcdBarrier {
    unsigned* bar; unsigned x;
    volatile LAS unsigned* st;
};

__device__ __forceinline__ XcdBarrier xcd_barrier_post(unsigned* bar, volatile LAS unsigned* st) {
    XcdBarrier b; b.bar = bar; b.x = xb_xcc_id(); b.st = st;
    if (threadIdx.x == 0) (void)xb_add(&bar[XB_XCNT(b.x)], 1u);
    return b;
}
__device__ __forceinline__ void xcd_barrier_complete(unsigned* bar, unsigned x, unsigned& nloc, unsigned& nx) {
    const unsigned G = gridDim.x * gridDim.y * gridDim.z;
    unsigned sum, cnt, mine, sp = 0u;
    for (;;) {
        sum = 0u; cnt = 0u; mine = 0u;
#pragma unroll
        for (unsigned j = 0; j < 16; ++j) { const unsigned c = xb_ld(&bar[XB_XCNT(j)]); sum += c; cnt += (c > 0u) ? 1u : 0u; mine = (j == x) ? c : mine; }
        if (sum == G) break;
        __builtin_amdgcn_s_sleep(1);
        if ((++sp & 255u) == 0u) { if (xb_ld(&bar[XB_TMO])) break; if (sp > XB_SPIN_CAP) { atomicAdd(&bar[XB_TMO], 1u); break; } }
    }
    nloc = mine > 0u ? mine : 1u; nx = cnt > 0u ? cnt : 1u;
}

__device__ __forceinline__ void xcd_barrier(const XcdBarrier& b) {
    asm volatile("s_waitcnt vmcnt(0)" ::: "memory");
    __syncthreads();
    if (threadIdx.x == 0) {
        unsigned* bar = b.bar;
        __builtin_amdgcn_s_waitcnt(0);
        unsigned nloc = b.st[0], nx = b.st[1];
        if (nloc == 0u) { xcd_barrier_complete(bar, b.x, nloc, nx); b.st[0] = nloc; b.st[1] = nx; }
        const unsigned old = xb_add(&bar[XB_XSUB(b.x)], 1u);
        const unsigned gen = old / nloc;
        if (old + 1u == (gen + 1u) * nloc) {
            __builtin_amdgcn_fence(__ATOMIC_RELEASE, "agent");
            asm volatile("s_waitcnt vmcnt(0)" ::: "memory");
            const unsigned og = xb_add(&bar[XB_TOP], 1u);
            const unsigned tg = og / nx;
            if (og + 1u == (tg + 1u) * nx) xb_add(&bar[XB_TOPGEN], 1u);
            else XB_SPIN(xb_ld(&bar[XB_TOPGEN]) == tg, bar);
            __builtin_amdgcn_fence(__ATOMIC_ACQUIRE, "agent");
            xb_add(&bar[XB_XGEN(b.x)], 1u);
            asm volatile("s_waitcnt vmcnt(0)" ::: "memory");
        } else {
            XB_SPIN(xb_ld(&bar[XB_XGEN(b.x)]) == gen, bar);
            __builtin_amdgcn_fence(__ATOMIC_ACQUIRE, "agent");
            asm volatile("s_waitcnt vmcnt(0)" ::: "memory");
        }
    }
    __syncthreads();
}

struct PanelOrder {
    int pm;
    __device__ bool next(int i, pg8::Unit& u) const { if (i >= 4) return false; u.pm = pm; u.pn = i; return true; }
    __device__ __forceinline__ void a_ready(const pg8::Unit&) const {}
    __device__ __forceinline__ void done(const pg8::Unit&) const {}
};

struct EpiPlain {
    static constexpr bool PERM = true, AFTER_DRAIN = false, HEADMAP = false;
    bf16_t* O; int ldc;
    __device__ __forceinline__ void operator()(const f32x4 (&acc)[2][2][4][2], const pg8::Unit& u, int wr, int wc, int fr, int fq) const {
        const int row0 = u.pm * 256 + wr * 64 + fr, col0 = u.pn * 256 + wc * 32 + 8 * fq;
#pragma unroll
        for (int ai = 0; ai < 2; ++ai)
#pragma unroll
            for (int m = 0; m < 4; ++m) { bf16_t* rowp = O + (size_t)(row0 + ai * 128 + m * 16) * ldc + col0;
#pragma unroll
                for (int bj = 0; bj < 2; ++bj) { const f32x4 v0 = acc[ai][bj][m][0], v1 = acc[ai][bj][m][1];
                    u32x4 w; w.x = cvtpk(v0[0], v0[1]); w.y = cvtpk(v0[2], v0[3]); w.z = cvtpk(v1[0], v1[1]); w.w = cvtpk(v1[2], v1[3]);
                    *(u32x4*)(rowp + bj * 128) = w; } }
    }
};
struct EpiVT {
    static constexpr bool PERM = true, AFTER_DRAIN = false, HEADMAP = false;
    bf16_t* O;
    __device__ __forceinline__ void operator()(const f32x4 (&acc)[2][2][4][2], const pg8::Unit& u, int wr, int wc, int fr, int fq) const {
        const int row0 = u.pm * 256 + wr * 64 + fr, col0 = u.pn * 256 + wc * 32 + 16 * (fq >> 1) + 4 * (fq & 1);
#pragma unroll
        for (int ai = 0; ai < 2; ++ai)
#pragma unroll
            for (int m = 0; m < 4; ++m) { bf16_t* rowp = O + (size_t)(row0 + ai * 128 + m * 16) * T_ + col0;
#pragma unroll
                for (int bj = 0; bj < 2; ++bj)
#pragma unroll
                    for (int n = 0; n < 2; ++n) { const f32x4 v = acc[ai][bj][m][n]; u32x2 w; w.x = cvtpk(v[0], v[1]); w.y = cvtpk(v[2], v[3]);
                        *(u32x2*)(rowp + bj * 128 + 8 * n) = w; } }
    }
};
struct EpiProj {
    static constexpr bool PERM = true, AFTER_DRAIN = false, HEADMAP = true;
    bf16_t* O; const float* gq; const float* gk;
    __device__ __forceinline__ void operator()(const f32x4 (&acc)[2][2][4][2], const pg8::Unit& u, int wr, int wc, int fr, int fq) const {
        const int row0 = u.pm * 256 + wr * 64 + fr, col0 = u.pn * 256 + wc * 64 + 8 * fq, kind = u.pn >> 1;
        f32x4 gv[2][2];
        if (kind >= 2) { const float* g = (kind == 2) ? gq : gk; const float sc = (kind == 2) ? QSCALE : 1.f;
#pragma unroll
            for (int bj = 0; bj < 2; ++bj)
#pragma unroll
                for (int n = 0; n < 2; ++n) gv[bj][n] = *(const f32x4*)(g + 32 * bj + 8 * fq + 4 * n) * sc; }
#pragma unroll
        for (int ai = 0; ai < 2; ++ai)
#pragma unroll
            for (int m = 0; m < 4; ++m) { bf16_t* rowp = O + (size_t)(row0 + ai * 128 + m * 16) * PJW + col0;
                f32x4 v[2][2];
#pragma unroll
                for (int bj = 0; bj < 2; ++bj)
#pragma unroll
                    for (int n = 0; n < 2; ++n) v[bj][n] = acc[ai][bj][m][n];
                if (kind == 1) {
#pragma unroll
                    for (int bj = 0; bj < 2; ++bj)
#pragma unroll
                        for (int n = 0; n < 2; ++n)
#pragma unroll
                            for (int e = 0; e < 4; ++e) v[bj][n][e] = gelu_tanh(v[bj][n][e]);
                } else if (kind >= 2) {
                    float ss = 0.f;
#pragma unroll
                    for (int bj = 0; bj < 2; ++bj)
#pragma unroll
                        for (int n = 0; n < 2; ++n) { const f32x4 x = v[bj][n]; ss += (x[0] * x[0] + x[1] * x[1]) + (x[2] * x[2] + x[3] * x[3]); }
                    ss += __shfl_xor(ss, 16); ss += __shfl_xor(ss, 32);
                    const float rstd = rsqf_(ss * (1.f / 64.f) + EPS_);
#pragma unroll
                    for (int bj = 0; bj < 2; ++bj)
#pragma unroll
                        for (int n = 0; n < 2; ++n) v[bj][n] = v[bj][n] * gv[bj][n] * rstd;
                }
#pragma unroll
                for (int bj = 0; bj < 2; ++bj) { const f32x4 v0 = v[bj][0], v1 = v[bj][1];
                    u32x4 w; w.x = cvtpk(v0[0], v0[1]); w.y = cvtpk(v0[2], v0[3]); w.z = cvtpk(v1[0], v1[1]); w.w = cvtpk(v1[2], v1[3]);
                    *(u32x4*)(rowp + bj * 32) = w; } }
    }
};
struct EpiRes {
    static constexpr bool PERM = true, AFTER_DRAIN = false, HEADMAP = false;
    const float* base; float* out; bf16_t* hb; float* ssq; int rowmask;
    __device__ __forceinline__ void operator()(const f32x4 (&acc)[2][2][4][2], const pg8::Unit& u, int wr, int wc, int fr, int fq) const {
        const int row0 = u.pm * 256 + wr * 64 + fr, col0 = u.pn * 256 + wc * 32 + 8 * fq;
#pragma unroll
        for (int ai = 0; ai < 2; ++ai)
#pragma unroll
            for (int m = 0; m < 4; ++m) { const size_t off = (size_t)(row0 + ai * 128 + m * 16) * DM_ + col0; const size_t ooff = (size_t)((row0 + ai * 128 + m * 16) & rowmask) * DM_ + col0; float ss = 0.f;
#pragma unroll
                for (int bj = 0; bj < 2; ++bj) {
                    const f32x4 b0 = *(const f32x4*)(base + off + bj * 128), b1 = *(const f32x4*)(base + off + bj * 128 + 4);
                    const f32x4 v0 = b0 + acc[ai][bj][m][0], v1 = b1 + acc[ai][bj][m][1];
                    ss += (v0[0] * v0[0] + v0[1] * v0[1]) + (v0[2] * v0[2] + v0[3] * v0[3]) + (v1[0] * v1[0] + v1[1] * v1[1]) + (v1[2] * v1[2] + v1[3] * v1[3]);
                    *(f32x4*)(out + ooff + bj * 128) = v0; *(f32x4*)(out + ooff + bj * 128 + 4) = v1;
                    u32x4 w; w.x = cvtpk(v0[0], v0[1]); w.y = cvtpk(v0[2], v0[3]); w.z = cvtpk(v1[0], v1[1]); w.w = cvtpk(v1[2], v1[3]);
                    *(u32x4*)(hb + off + bj * 128) = w; }
                ss += __shfl_xor(ss, 16); ss += __shfl_xor(ss, 32);
                if (fq == 0) __hip_atomic_fetch_add(ssq + row0 + ai * 128 + m * 16, ss, __ATOMIC_RELAXED, __HIP_MEMORY_SCOPE_AGENT);
                asm volatile("" ::: "memory"); }
    }
};
struct EpiUp {
    static constexpr bool PERM = true, AFTER_DRAIN = false, HEADMAP = false;
    bf16_t* O; const float* rstd;
    __device__ __forceinline__ void operator()(const f32x4 (&acc)[2][2][4][2], const pg8::Unit& u, int wr, int wc, int fr, int fq) const {
        const int row0 = u.pm * 256 + wr * 64 + fr, col0 = u.pn * 256 + wc * 32 + 8 * fq;
#pragma unroll
        for (int ai = 0; ai < 2; ++ai)
#pragma unroll
            for (int m = 0; m < 4; ++m) { const int row = row0 + ai * 128 + m * 16; const float rs = rsqf_(rstd[row] * (1.f / DM_) + EPS_); bf16_t* rowp = O + (size_t)row * FF_ + col0;
#pragma unroll
                for (int bj = 0; bj < 2; ++bj) { f32x4 v0 = acc[ai][bj][m][0] * rs, v1 = acc[ai][bj][m][1] * rs;
#pragma unroll
                    for (int e = 0; e < 4; ++e) { const float a = fmaxf(v0[e], 0.f), b = fmaxf(v1[e], 0.f); v0[e] = a * a; v1[e] = b * b; }
                    u32x4 w; w.x = cvtpk(v0[0], v0[1]); w.y = cvtpk(v0[2], v0[3]); w.z = cvtpk(v1[0], v1[1]); w.w = cvtpk(v1[2], v1[3]);
                    *(u32x4*)(rowp + bj * 128) = w; } }
    }
};
struct EpiFinal {
    static constexpr bool PERM = true, AFTER_DRAIN = false, HEADMAP = false;
    const float* hin; float* out; const bf16_t* pp; const float* rstd;
    __device__ __forceinline__ void operator()(const f32x4 (&acc)[2][2][4][2], const pg8::Unit& u, int wr, int wc, int fr, int fq) const {
        const int row0 = u.pm * 256 + wr * 64 + fr, col0 = u.pn * 256 + wc * 32 + 8 * fq;
#pragma unroll
        for (int ai = 0; ai < 2; ++ai)
#pragma unroll
            for (int m = 0; m < 4; ++m) { const int row = row0 + ai * 128 + m * 16; const float rs = rsqf_(rstd[row] * (1.f / DM_) + EPS_); const size_t off = (size_t)row * DM_ + col0;
#pragma unroll
                for (int bj = 0; bj < 2; ++bj) {
                    const f32x4 h0 = *(const f32x4*)(hin + off + bj * 128), h1 = *(const f32x4*)(hin + off + bj * 128 + 4);
                    const u32x4 pw = *(const u32x4*)(pp + off + bj * 128);
                    const f32x4 a0 = acc[ai][bj][m][0] * rs, a1 = acc[ai][bj][m][1] * rs;
                    f32x4 o0, o1;
                    o0[0] = h0[0] + sigm(a0[0]) * bflo(pw.x); o0[1] = h0[1] + sigm(a0[1]) * bfhi(pw.x); o0[2] = h0[2] + sigm(a0[2]) * bflo(pw.y); o0[3] = h0[3] + sigm(a0[3]) * bfhi(pw.y);
                    o1[0] = h1[0] + sigm(a1[0]) * bflo(pw.z); o1[1] = h1[1] + sigm(a1[1]) * bfhi(pw.z); o1[2] = h1[2] + sigm(a1[2]) * bflo(pw.w); o1[3] = h1[3] + sigm(a1[3]) * bfhi(pw.w);
                    *(f32x4*)(out + off + bj * 128) = o0; *(f32x4*)(out + off + bj * 128 + 4) = o1; }
                asm volatile("" ::: "memory"); }
    }
};


struct EpiRes4 {
    static constexpr bool PERM = true, AFTER_DRAIN = false, HEADMAP = false;
    const float* base; bf16_t* hb; float* ssq;
    __device__ __forceinline__ void operator()(const f32x4 (&acc)[2][2][4][2], const pg8::Unit& u, int wr, int wc, int fr, int fq) const {
        const int row0 = u.pm * 256 + wr * 64 + fr, col0 = u.pn * 256 + wc * 32 + 8 * fq;
        f32x4 X[8][2][2];
#define E4_LD(g) do { const size_t off_ = (size_t)(row0 + ((g) >> 2) * 128 + ((g) & 3) * 16) * DM_ + col0; \
        _Pragma("unroll") for (int bj = 0; bj < 2; ++bj) { X[g][bj][0] = *(const f32x4*)(base + off_ + bj * 128); X[g][bj][1] = *(const f32x4*)(base + off_ + bj * 128 + 4); } } while (0)
        E4_LD(0); E4_LD(1); E4_LD(2); E4_LD(3);
        asm volatile("" ::: "memory");
#pragma unroll
        for (int g = 0; g < 8; ++g) { const int ai = g >> 2, m = g & 3; const size_t off = (size_t)(row0 + ai * 128 + m * 16) * DM_ + col0; float ss = 0.f;
#pragma unroll
            for (int bj = 0; bj < 2; ++bj) {
                const f32x4 v0 = X[g][bj][0] + acc[ai][bj][m][0], v1 = X[g][bj][1] + acc[ai][bj][m][1];
                ss += (v0[0] * v0[0] + v0[1] * v0[1]) + (v0[2] * v0[2] + v0[3] * v0[3]) + (v1[0] * v1[0] + v1[1] * v1[1]) + (v1[2] * v1[2] + v1[3] * v1[3]);
                u32x4 w; w.x = cvtpk(v0[0], v0[1]); w.y = cvtpk(v0[2], v0[3]); w.z = cvtpk(v1[0], v1[1]); w.w = cvtpk(v1[2], v1[3]);
                *(u32x4*)(hb + off + bj * 128) = w; }
            ss += __shfl_xor(ss, 16); ss += __shfl_xor(ss, 32);
            if (fq == 0) __hip_atomic_fetch_add(ssq + row0 + ai * 128 + m * 16, ss, __ATOMIC_RELAXED, __HIP_MEMORY_SCOPE_AGENT);
            if (g + 4 < 8) { E4_LD(g + 4); }
            asm volatile("" ::: "memory"); }
#undef E4_LD
    }
};
struct EpiRes4b {
    static constexpr bool PERM = true, AFTER_DRAIN = false, HEADMAP = false;
    bf16_t* hb; const float* rinv0; const float* g1; float* ssq;
    __device__ __forceinline__ void operator()(const f32x4 (&acc)[2][2][4][2], const pg8::Unit& u, int wr, int wc, int fr, int fq) const {
        const int row0 = u.pm * 256 + wr * 64 + fr, col0 = u.pn * 256 + wc * 32 + 8 * fq;
        f32x4 gi[2][2];
#pragma unroll
        for (int bj = 0; bj < 2; ++bj)
#pragma unroll
            for (int n = 0; n < 2; ++n) { const f32x4 gv = *(const f32x4*)(g1 + col0 + bj * 128 + 4 * n); gi[bj][n] = (f32x4){rcpf_(gv[0]), rcpf_(gv[1]), rcpf_(gv[2]), rcpf_(gv[3])}; }
        u32x4 H[8][2]; float RI[8];
#define E4_LD(g) do { const int row_ = row0 + ((g) >> 2) * 128 + ((g) & 3) * 16; const size_t off_ = (size_t)row_ * DM_ + col0; RI[g] = rinv0[row_]; \
        _Pragma("unroll") for (int bj = 0; bj < 2; ++bj) H[g][bj] = *(const u32x4*)(hb + off_ + bj * 128); } while (0)
        E4_LD(0); E4_LD(1); E4_LD(2); E4_LD(3);
        asm volatile("" ::: "memory");
#pragma unroll
        for (int g = 0; g < 8; ++g) { const int ai = g >> 2, m = g & 3; const size_t off = (size_t)(row0 + ai * 128 + m * 16) * DM_ + col0; float ss = 0.f; const float ri = RI[g];
#pragma unroll
            for (int bj = 0; bj < 2; ++bj) { const u32x4 hw = H[g][bj];
                const f32x4 x0 = (f32x4){bflo(hw.x), bfhi(hw.x), bflo(hw.y), bfhi(hw.y)} * gi[bj][0] * ri, x1 = (f32x4){bflo(hw.z), bfhi(hw.z), bflo(hw.w), bfhi(hw.w)} * gi[bj][1] * ri;
                const f32x4 v0 = x0 + acc[ai][bj][m][0], v1 = x1 + acc[ai][bj][m][1];
                ss += (v0[0] * v0[0] + v0[1] * v0[1]) + (v0[2] * v0[2] + v0[3] * v0[3]) + (v1[0] * v1[0] + v1[1] * v1[1]) + (v1[2] * v1[2] + v1[3] * v1[3]);
                u32x4 w; w.x = cvtpk(v0[0], v0[1]); w.y = cvtpk(v0[2], v0[3]); w.z = cvtpk(v1[0], v1[1]); w.w = cvtpk(v1[2], v1[3]);
                *(u32x4*)(hb + off + bj * 128) = w; }
            ss += __shfl_xor(ss, 16); ss += __shfl_xor(ss, 32);
            if (fq == 0) __hip_atomic_fetch_add(ssq + row0 + ai * 128 + m * 16, ss, __ATOMIC_RELAXED, __HIP_MEMORY_SCOPE_AGENT);
            if (g + 4 < 8) { E4_LD(g + 4); }
            asm volatile("" ::: "memory"); }
#undef E4_LD
    }
};
struct EpiRes6 {
    static constexpr bool PERM = true, AFTER_DRAIN = false, HEADMAP = false;
    bf16_t* hb; float* ssq;
    __device__ __forceinline__ void operator()(const f32x4 (&acc)[2][2][4][2], const pg8::Unit& u, int wr, int wc, int fr, int fq) const {
        const int row0 = u.pm * 256 + wr * 64 + fr, col0 = u.pn * 256 + wc * 32 + 8 * fq;
        u32x4 H[8][2];
#define E6_LD(g) do { const size_t off_ = (size_t)(row0 + ((g) >> 2) * 128 + ((g) & 3) * 16) * DM_ + col0; \
        _Pragma("unroll") for (int bj = 0; bj < 2; ++bj) H[g][bj] = *(const u32x4*)(hb + off_ + bj * 128); } while (0)
        E6_LD(0); E6_LD(1); E6_LD(2); E6_LD(3);
        asm volatile("" ::: "memory");
#pragma unroll
        for (int g = 0; g < 8; ++g) { const int ai = g >> 2, m = g & 3; const size_t off = (size_t)(row0 + ai * 128 + m * 16) * DM_ + col0; float ss = 0.f;
#pragma unroll
            for (int bj = 0; bj < 2; ++bj) { const u32x4 hw = H[g][bj];
                const f32x4 b0 = {bflo(hw.x), bfhi(hw.x), bflo(hw.y), bfhi(hw.y)}, b1 = {bflo(hw.z), bfhi(hw.z), bflo(hw.w), bfhi(hw.w)};
                const f32x4 v0 = b0 + acc[ai][bj][m][0], v1 = b1 + acc[ai][bj][m][1];
                ss += (v0[0] * v0[0] + v0[1] * v0[1]) + (v0[2] * v0[2] + v0[3] * v0[3]) + (v1[0] * v1[0] + v1[1] * v1[1]) + (v1[2] * v1[2] + v1[3] * v1[3]);
                u32x4 w; w.x = cvtpk(v0[0], v0[1]); w.y = cvtpk(v0[2], v0[3]); w.z = cvtpk(v1[0], v1[1]); w.w = cvtpk(v1[2], v1[3]);
                *(u32x4*)(hb + off + bj * 128) = w; }
            ss += __shfl_xor(ss, 16); ss += __shfl_xor(ss, 32);
            if (fq == 0) __hip_atomic_fetch_add(ssq + row0 + ai * 128 + m * 16, ss, __ATOMIC_RELAXED, __HIP_MEMORY_SCOPE_AGENT);
            if (g + 4 < 8) { E6_LD(g + 4); }
            asm volatile("" ::: "memory"); }
#undef E6_LD
    }
};
struct EpiFinalB {
    static constexpr bool PERM = true, AFTER_DRAIN = false, HEADMAP = false;
    const bf16_t* hb; float* out; const bf16_t* pp; const float* rstd;
    __device__ __forceinline__ void operator()(const f32x4 (&acc)[2][2][4][2], const pg8::Unit& u, int wr, int wc, int fr, int fq) const {
        const int row0 = u.pm * 256 + wr * 64 + fr, col0 = u.pn * 256 + wc * 32 + 8 * fq;
        u32x4 H[8][2], P[8][2]; float RS[8];
#define EF_LD(g) do { const int row_ = row0 + ((g) >> 2) * 128 + ((g) & 3) * 16; const size_t off_ = (size_t)row_ * DM_ + col0; RS[g] = rstd[row_]; \
        _Pragma("unroll") for (int bj = 0; bj < 2; ++bj) { H[g][bj] = *(const u32x4*)(hb + off_ + bj * 128); P[g][bj] = *(const u32x4*)(pp + off_ + bj * 128); } } while (0)
        EF_LD(0); EF_LD(1); EF_LD(2); EF_LD(3);
        asm volatile("" ::: "memory");
#pragma unroll
        for (int g = 0; g < 8; ++g) { const int ai = g >> 2, m = g & 3; const size_t off = (size_t)(row0 + ai * 128 + m * 16) * DM_ + col0; const float rs = rsqf_(RS[g] * (1.f / DM_) + EPS_);
#pragma unroll
            for (int bj = 0; bj < 2; ++bj) { const u32x4 hw = H[g][bj], pw = P[g][bj];
                const f32x4 a0 = acc[ai][bj][m][0] * rs, a1 = acc[ai][bj][m][1] * rs;
                f32x4 o0, o1;
                o0[0] = bflo(hw.x) + sigm(a0[0]) * bflo(pw.x); o0[1] = bfhi(hw.x) + sigm(a0[1]) * bfhi(pw.x); o0[2] = bflo(hw.y) + sigm(a0[2]) * bflo(pw.y); o0[3] = bfhi(hw.y) + sigm(a0[3]) * bfhi(pw.y);
                o1[0] = bflo(hw.z) + sigm(a1[0]) * bflo(pw.z); o1[1] = bfhi(hw.z) + sigm(a1[1]) * bfhi(pw.z); o1[2] = bflo(hw.w) + sigm(a1[2]) * bflo(pw.w); o1[3] = bfhi(hw.w) + sigm(a1[3]) * bfhi(pw.w);
                *(f32x4*)(out + off + bj * 128) = o0; *(f32x4*)(out + off + bj * 128 + 4) = o1; }
            if (g + 4 < 8) { EF_LD(g + 4); }
            asm volatile("" ::: "memory"); }
#undef EF_LD
    }
};

struct EpiMidPP {
    u32x4* park;
    __device__ __forceinline__ void operator()(const f32x4 (&acc)[2][2][4][2], const pg8::Unit& u, int wr, int wc, int fr, int fq) const {
        asm volatile("" : "+v"(fr), "+v"(fq));
        const unsigned pko_ = (unsigned)((wr * 4 + wc) * 64 + fq * 16 + fr);
#pragma unroll
        for (int ai = 0; ai < 2; ++ai)
#pragma unroll
            for (int m = 0; m < 4; ++m)
#pragma unroll
                for (int bj = 0; bj < 2; ++bj) { const f32x4 v0 = acc[ai][bj][m][0], v1 = acc[ai][bj][m][1];
                    u32x4 w; w.x = cvtpk(v0[0], v0[1]); w.y = cvtpk(v0[2], v0[3]); w.z = cvtpk(v1[0], v1[1]); w.w = cvtpk(v1[2], v1[3]);
                    park[pko_ + (unsigned)((((ai * 4 + m) * 2 + bj) * 8) * 64)] = w; }
    }
};
struct EpiFinalC {
    const bf16_t* hb; float* out; const float* rstd; const u32x4* park;
    __device__ __forceinline__ void operator()(const f32x4 (&acc)[2][2][4][2], const pg8::Unit& u, int wr, int wc, int fr, int fq) const {
        asm volatile("" : "+v"(fr), "+v"(fq));
        const int row0 = u.pm * 256 + wr * 64 + fr, col0 = u.pn * 256 + wc * 32 + 8 * fq;
        const unsigned pko_ = (unsigned)((wr * 4 + wc) * 64 + fq * 16 + fr);
        u32x4 H[8][2], P[8][2]; float RS[8];
#define EF_LD(g) do { const int row_ = row0 + ((g) >> 2) * 128 + ((g) & 3) * 16; const size_t off_ = (size_t)row_ * DM_ + col0; RS[g] = rstd[row_]; \
        _Pragma("unroll") for (int bj = 0; bj < 2; ++bj) { H[g][bj] = *(const u32x4*)(hb + off_ + bj * 128); P[g][bj] = park[pko_ + (unsigned)((((g) * 2 + bj) * 8) * 64)]; } } while (0)
        EF_LD(0); EF_LD(1); EF_LD(2); EF_LD(3);
        asm volatile("" ::: "memory");
#pragma unroll
        for (int g = 0; g < 8; ++g) { const int ai = g >> 2, m = g & 3; const size_t off = (size_t)(row0 + ai * 128 + m * 16) * DM_ + col0; const float rs = rsqf_(RS[g] * (1.f / DM_) + EPS_);
#pragma unroll
            for (int bj = 0; bj < 2; ++bj) { const u32x4 hw = H[g][bj], pw = P[g][bj];
                const f32x4 a0 = acc[ai][bj][m][0] * rs, a1 = acc[ai][bj][m][1] * rs;
                f32x4 o0, o1;
                o0[0] = bflo(hw.x) + sigm(a0[0]) * bflo(pw.x); o0[1] = bfhi(hw.x) + sigm(a0[1]) * bfhi(pw.x); o0[2] = bflo(hw.y) + sigm(a0[2]) * bflo(pw.y); o0[3] = bfhi(hw.y) + sigm(a0[3]) * bfhi(pw.y);
                o1[0] = bflo(hw.z) + sigm(a1[0]) * bflo(pw.z); o1[1] = bfhi(hw.z) + sigm(a1[1]) * bfhi(pw.z); o1[2] = bflo(hw.w) + sigm(a1[2]) * bflo(pw.w); o1[3] = bfhi(hw.w) + sigm(a1[3]) * bfhi(pw.w);
                *(f32x4*)(out + off + bj * 128) = o0; *(f32x4*)(out + off + bj * 128 + 4) = o1; }
            if (g + 4 < 8) { EF_LD(g + 4); }
            asm volatile("" ::: "memory"); }
#undef EF_LD
    }
};

__device__ __forceinline__ void p0_transpose_item(const float* W, int K, int N, bf16_t* WT, const float* ks0, const float* ks1, int ksplit, LAS float* scr, int item, int lane) {
    const int nblk = N / 32, kb = item / nblk, nb = item % nblk, k0 = 64 * kb, n0 = 32 * nb;
#pragma unroll 8
    for (int i = 0; i < 32; ++i) { const int kk = 2 * i + (lane >> 5), k = k0 + kk; float s = 1.f; if (ks0) s = (k < ksplit) ? ks0[k] : ks1[k - ksplit];
        scr[kk * 33 + (lane & 31)] = W[(size_t)k * N + n0 + (lane & 31)] * s; }
    asm volatile("s_waitcnt lgkmcnt(0)" ::: "memory");
    const int c = lane & 7;
#pragma unroll
    for (int j = 0; j < 4; ++j) { const int n = (lane >> 3) + 8 * j; const LAS float* s = scr + (8 * c) * 33 + n;
        u32x4 o; o.x = cvtpk(s[0 * 33], s[1 * 33]); o.y = cvtpk(s[2 * 33], s[3 * 33]); o.z = cvtpk(s[4 * 33], s[5 * 33]); o.w = cvtpk(s[6 * 33], s[7 * 33]);
        *(u32x4*)(WT + (size_t)(n0 + n) * K + k0 + 8 * c) = o; }
    asm volatile("s_waitcnt lgkmcnt(0)" ::: "memory");
}
__device__ __forceinline__ void attn_phase(LAS unsigned char* lds, const bf16_t* PROJ, const bf16_t* VT, const float* gq, const float* gk, const float* rb, bf16_t* MERGED, int vcu, int G, const int wave_u) {
    int tid_ = wave_u * 64 + lane_id_v(); asm volatile("" : "+v"(tid_));
    const int tid = tid_, lane = tid & 63, h = __builtin_amdgcn_readfirstlane(tid >> 6), ql = lane & 31, hi = lane >> 5;
    LAS float* SQ = (LAS float*)lds;
    LAS float* EXT = (LAS float*)(lds + 2048) + h * 640;
    float mq = wave_max(fabsf(gq[lane])), mk = wave_max(fabsf(gk[lane])); float mb = -1e30f;
    for (int i = lane; i < 513; i += 64) mb = fmaxf(mb, rb[h * 513 + i]);
    mb = wave_max(mb);
    const float c512 = rb[h * 513 + 512]; (void)mq; (void)mk; (void)mb;
    for (int i = lane; i < 640; i += 64) { int rel = i - 64; rel = rel > 256 ? 256 : (rel < -256 ? -256 : rel); EXT[639 - i] = (rb[h * 513 + rel + 256] - c512) * LOG2E; }
    asm volatile("s_waitcnt lgkmcnt(0)" ::: "memory");
    __syncthreads();
    for (int unit = vcu; unit < NUNIT_ATT; unit += G) {
        const int b = unit >> 7, n = unit & 127; const long tok0 = (long)b * SEQ_ + n * 64;
        bf16x8 qf[2][4];
        { const bf16_t* qp = PROJ + (tok0 + ql) * PJW + 1024 + h * 64 + hi * 8;
#pragma unroll
          for (int qb = 0; qb < 2; ++qb)
#pragma unroll
              for (int d0 = 0; d0 < 4; ++d0) qf[qb][d0] = *(const bf16x8*)(qp + (long)qb * 32 * PJW + d0 * 16); }
        f32x16 o[2][2];
#pragma unroll
        for (int a = 0; a < 2; ++a)
#pragma unroll
            for (int c = 0; c < 2; ++c)
#pragma unroll
                for (int r = 0; r < 16; ++r) o[a][c][r] = 0.f;
        float lsum[2] = {0.f, 0.f};
        const int it0 = (n < 8) ? 2 * (8 - n) : 0;
        const bf16_t* kbase = PROJ + (tok0 - 512) * PJW + 1536 + h * 64;
        const bf16_t* vbase = VT + (long)(h * 64) * T_ + (tok0 - 512);
        const unsigned kgo = (unsigned)((lane >> 3) * PJW + (lane & 7) * 8), vgo = (unsigned)((lane >> 2) * T_ + (lane & 3) * 8);
        LAS unsigned char* kv = lds + 24576 + h * 8192;
        const unsigned wk = (unsigned)((lane >> 3) * 128 + (((lane & 7) ^ (lane >> 3)) * 16));
        const unsigned wv = (unsigned)(4096 + (lane >> 2) * 64 + (((lane & 3) ^ ((lane >> 3) & 3)) * 16));
        const unsigned rkb = (unsigned)(ql * 128), rks = (unsigned)(ql & 7), rvb = (unsigned)(4096 + ql * 64), rvs = (unsigned)((ql >> 1) & 3);
        bf16x8 kn[4], vn[4];
#define LOADKV(IT) do { const bf16_t* kp_ = kbase + (long)(IT) * 32 * PJW; const bf16_t* vp_ = vbase + (IT) * 32; \
        _Pragma("unroll") for (int i = 0; i < 4; ++i) { kn[i] = *(const bf16x8*)(kp_ + (kgo + (unsigned)(i * 8 * PJW))); vn[i] = *(const bf16x8*)(vp_ + (vgo + (unsigned)(i * 16 * T_))); } } while (0)
        LOADKV(it0);
        for (int it = it0; it < 18; ++it) {
#pragma unroll
            for (int i = 0; i < 4; ++i) { *(LAS bf16x8*)(kv + wk + i * 1024) = kn[i]; *(LAS bf16x8*)(kv + wv + i * 1024) = vn[i]; }
            { const int itn = (it + 1 < 18) ? it + 1 : it; LOADKV(itn); }
            bf16x8 kf[4], vf[2][2];
#pragma unroll
            for (int d0 = 0; d0 < 4; ++d0) kf[d0] = *(const LAS bf16x8*)(kv + rkb + (((unsigned)(2 * d0 + hi) ^ rks) * 16));
#pragma unroll
            for (int db = 0; db < 2; ++db)
#pragma unroll
                for (int ks = 0; ks < 2; ++ks) vf[db][ks] = *(const LAS bf16x8*)(kv + rvb + db * 2048 + (((unsigned)(2 * ks + hi) ^ rvs) * 16));
            const bool tab = (it >= 8);
#pragma unroll
            for (int qb = 0; qb < 2; ++qb) {
                f32x16 s;
                if (tab) { const LAS float* e = EXT + (63 - 32 * qb - ql + 32 * it + 4 * hi); f32x16 cin;
#pragma unroll
                    for (int r = 0; r < 16; ++r) cin[r] = e[(r & 3) + 8 * (r >> 2)];
                    s = MFMA32(kf[0], qf[qb][0], cin); }
                else { f32x16 z_;
#pragma unroll
                    for (int r = 0; r < 16; ++r) z_[r] = 0.f;
                    s = MFMA32(kf[0], qf[qb][0], z_); }
#pragma unroll
                for (int d0 = 1; d0 < 4; ++d0) s = MFMA32(kf[d0], qf[qb][d0], s);
                float ps = 0.f;
#pragma unroll
                for (int r = 0; r < 16; ++r) { s[r] = ex2(s[r]); ps += s[r]; }
                lsum[qb] += ps;
                bf16x8 pk[2];
#pragma unroll
                for (int ks = 0; ks < 2; ++ks) { u32x4 w; w.x = cvtpk(s[8 * ks], s[8 * ks + 1]); w.y = cvtpk(s[8 * ks + 2], s[8 * ks + 3]); w.z = cvtpk(s[8 * ks + 4], s[8 * ks + 5]); w.w = cvtpk(s[8 * ks + 6], s[8 * ks + 7]);
                    pk[ks] = __builtin_bit_cast(bf16x8, w); }
#pragma unroll
                for (int db = 0; db < 2; ++db)
#pragma unroll
                    for (int ks = 0; ks < 2; ++ks) o[db][qb] = MFMA32(vf[db][ks], pk[ks], o[db][qb]);
            }
        }
#undef LOADKV
        float inv[2], sq[2];
#pragma unroll
        for (int qb = 0; qb < 2; ++qb) { float l = lsum[qb]; l += __shfl_xor(l, 32); inv[qb] = 1.f / l; float q2 = 0.f;
#pragma unroll
            for (int db = 0; db < 2; ++db)
#pragma unroll
                for (int r = 0; r < 16; ++r) { const float v = o[db][qb][r] * inv[qb]; o[db][qb][r] = v; q2 += v * v; }
            q2 += __shfl_xor(q2, 32); sq[qb] = q2;
            if (hi == 0) SQ[h * 64 + 32 * qb + ql] = q2; }
        asm volatile("s_waitcnt lgkmcnt(0)" ::: "memory");
        __syncthreads();
#pragma unroll
        for (int qb = 0; qb < 2; ++qb) { float tot = 0.f;
#pragma unroll
            for (int hh = 0; hh < 8; ++hh) tot += SQ[hh * 64 + 32 * qb + ql];
            const float rstd = rsqf_(tot * (1.f / 512.f) + EPS_);
            bf16_t* op = MERGED + (tok0 + 32 * qb + ql) * DM_ + 512 + h * 64 + 4 * hi;
#pragma unroll
            for (int db = 0; db < 2; ++db)
#pragma unroll
                for (int r4 = 0; r4 < 4; ++r4) { u32x2 w; w.x = cvtpk(o[db][qb][4 * r4] * rstd, o[db][qb][4 * r4 + 1] * rstd); w.y = cvtpk(o[db][qb][4 * r4 + 2] * rstd, o[db][qb][4 * r4 + 3] * rstd);
                    *(u32x2*)(op + 32 * db + 8 * r4) = w; } }
        __syncthreads();
    }
}

template <bool PASS2>
__device__ __forceinline__ void lru_unit(LAS unsigned char* lds, int unit, const bf16_t* PROJ, const bf16_t* WGT, const float* conv_w, const float* conv_b, const float* b_rg, const float* b_ig,
                                         const float* lam, f32x2* SUMM, bf16_t* MERGED, const int wave_u) {
    int tid_ = wave_u * 64 + lane_id_v(); asm volatile("" : "+v"(tid_));
    const int tid = tid_, lane = tid & 63, w = __builtin_amdgcn_readfirstlane(tid >> 6), ql = lane & 31, hi = lane >> 5;
    const int b = unit >> 5, seg = unit & 31; const long tok0 = (long)b * SEQ_ + seg * 256;
    LAS bf16_t* XC = (LAS bf16_t*)lds + w * (64 * 72);
    LAS bf16_t* YT = (LAS bf16_t*)(lds + 73728);
    const int chc = 64 * w + lane;
    const float cw0 = conv_w[chc], cw1 = conv_w[512 + chc], cw2 = conv_w[1024 + chc], cw3 = conv_w[1536 + chc], cbv = conv_b[chc];
    float brg[2], big[2], sp[2];
#pragma unroll
    for (int nb = 0; nb < 2; ++nb) { const int ch = 64 * w + 32 * nb + ql; brg[nb] = b_rg[ch]; big[nb] = b_ig[ch];
        sp[nb] = -8.f * LOG2E * log1pf(expf(-lam[ch])); }
    float carry[2] = {0.f, 0.f}, ptot[2] = {1.f, 1.f};
    if (PASS2) {
#pragma unroll
        for (int nb = 0; nb < 2; ++nb) { float c = 0.f; const f32x2* sp_ = SUMM + (size_t)(b * 32) * 512 + 64 * w + 32 * nb + ql;
            for (int s0 = 0; s0 < seg; s0 += 8) { f32x2 v[8];
#pragma unroll
                for (int j = 0; j < 8; ++j) v[j] = (s0 + j < seg) ? sp_[(size_t)(s0 + j) * 512] : (f32x2){1.f, 0.f};
#pragma unroll
                for (int j = 0; j < 8; ++j) c = v[j].x * c + v[j].y; }
            carry[nb] = c; }
    }
#pragma nounroll
    for (int st = 0; st < 4; ++st) {
        const long t0 = tok0 + 64 * st;
        {
            const bf16_t* xp = PROJ + t0 * PJW + chc;
            float x1 = 0.f, x2 = 0.f, x3 = 0.f;
            if (seg != 0 || st != 0) { x1 = bf2f(xp[-1 * PJW]); x2 = bf2f(xp[-2 * PJW]); x3 = bf2f(xp[-3 * PJW]); }
#pragma unroll 16
            for (int t = 0; t < 64; ++t) { const float xv = bf2f(xp[(long)t * PJW]); const float xc = cbv + cw0 * x3 + cw1 * x2 + cw2 * x1 + cw3 * xv;
                XC[t * 72 + lane] = (bf16_t)(cvtpk(xc, 0.f) & 0xffffu); x3 = x2; x2 = x1; x1 = xv; }
        }
        asm volatile("s_waitcnt lgkmcnt(0)" ::: "memory");
#pragma unroll
        for (int nb = 0; nb < 2; ++nb) {
            bf16x8 wrf[4], wif[4];
            { int woff = ((w * 2 + nb) * 4 * 64 + lane) * 8; asm volatile("" : "+v"(woff));
#pragma unroll
              for (int ks = 0; ks < 4; ++ks) { wrf[ks] = *(const bf16x8*)(WGT + woff + ks * 512); wif[ks] = *(const bf16x8*)(WGT + 8 * 4096 + woff + ks * 512); } }
#pragma unroll
            for (int tb = 0; tb < 2; ++tb) {
                bf16x8 af[4];
#pragma unroll
                for (int ks = 0; ks < 4; ++ks) af[ks] = *(const LAS bf16x8*)(XC + (32 * tb + ql) * 72 + 16 * ks + 8 * hi);
                f32x16 dr, di;
#pragma unroll
                for (int r = 0; r < 16; ++r) { dr[r] = 0.f; di[r] = 0.f; }
#pragma unroll
                for (int ks = 0; ks < 4; ++ks) { dr = MFMA32(af[ks], wrf[ks], dr); di = MFMA32(af[ks], wif[ks], di); }
                float A[16], U[16];
#pragma unroll
                for (int r = 0; r < 16; ++r) { const int tok = 32 * tb + crow(r, hi); const float xcv = bf2f(XC[tok * 72 + 32 * nb + ql]);
                    const float rg = sigm(dr[r] + brg[nb]), ig = sigm(di[r] + big[nb]); const float a = ex2(rg * sp[nb]);
                    const float mult = __builtin_amdgcn_sqrtf(fmaxf(1.f - a * a, 0.f)); A[r] = a; U[r] = mult * ig * xcv; }
#pragma unroll
                for (int q4 = 0; q4 < 4; ++q4)
#pragma unroll
                    for (int e = 1; e < 4; ++e) { U[4 * q4 + e] = A[4 * q4 + e] * U[4 * q4 + e - 1] + U[4 * q4 + e]; A[4 * q4 + e] = A[4 * q4 + e - 1] * A[4 * q4 + e]; }
                float c = carry[nb], HIN[4];
#pragma unroll
                for (int q4 = 0; q4 < 4; ++q4) { const float e0 = A[4 * q4 + 3] * c + U[4 * q4 + 3]; const float p = __shfl_xor(e0, 32); const float hin = hi ? p : c; HIN[q4] = hin;
                    const float e1 = A[4 * q4 + 3] * hin + U[4 * q4 + 3]; const float q = __shfl_xor(e1, 32); c = hi ? e1 : q; }
                carry[nb] = c;
                if (!PASS2) { const float po = (A[3] * A[7]) * (A[11] * A[15]); ptot[nb] *= po * __shfl_xor(po, 32); }
                else {
                    const bf16_t* gb = PROJ + t0 * PJW + 512 + 64 * w + 32 * nb + (32 * tb) * PJW;
                    const unsigned goff = (unsigned)(4 * hi) * PJW + ql;
#pragma unroll
                    for (int r = 0; r < 16; ++r) { const int tok = 32 * tb + crow(r, hi); const float hval = U[r] + A[r] * HIN[r >> 2]; const float gl = bf2f(gb[goff + (unsigned)((r & 3) + 8 * (r >> 2)) * PJW]);
                        YT[tok * 520 + 64 * w + 32 * nb + ql] = (bf16_t)(cvtpk(hval * gl, 0.f) & 0xffffu); }
                }
            }
        }
        if (PASS2) {
            asm volatile("s_waitcnt lgkmcnt(0)" ::: "memory");
            __syncthreads();
#pragma unroll
            for (int i = 0; i < 8; ++i) { const int tok = 8 * w + i; const u32x4 v = *(const LAS u32x4*)(YT + tok * 520 + 8 * lane);
                const float f0 = bflo(v.x), f1 = bfhi(v.x), f2 = bflo(v.y), f3 = bfhi(v.y), f4 = bflo(v.z), f5 = bfhi(v.z), f6 = bflo(v.w), f7 = bfhi(v.w);
                float ss = (f0 * f0 + f1 * f1) + (f2 * f2 + f3 * f3) + (f4 * f4 + f5 * f5) + (f6 * f6 + f7 * f7); ss = wave_sum(ss);
                const float rs = rsqf_(ss * (1.f / 512.f) + EPS_);
                u32x4 o; o.x = cvtpk(f0 * rs, f1 * rs); o.y = cvtpk(f2 * rs, f3 * rs); o.z = cvtpk(f4 * rs, f5 * rs); o.w = cvtpk(f6 * rs, f7 * rs);
                *(u32x4*)(MERGED + (t0 + tok) * DM_ + 8 * lane) = o; }
            __syncthreads();
        }
        asm volatile("" ::: "memory");
    }
    if (!PASS2) { if (hi == 0) {
#pragma unroll
        for (int nb = 0; nb < 2; ++nb) SUMM[(size_t)unit * 512 + 64 * w + 32 * nb + ql] = (f32x2){ptot[nb], carry[nb]}; } }
}

#ifndef PROBE_MASK
#define PROBE_MASK 0
#endif
#ifndef RES_BF16
#define RES_BF16 1
#endif
struct Args { const float* in[23]; float* out; unsigned char* ws; };
__global__ void __launch_bounds__(NTHR, 2) fwd_megakernel(Args args) {
    extern __shared__ __attribute__((aligned(16))) unsigned char lds_raw[];
    cg::grid_group grid = cg::this_grid();
    LAS unsigned char* lds = (LAS unsigned char*)lds_raw;
    const int wave = __builtin_amdgcn_readfirstlane(threadIdx.x >> 6);
#define tid (wave * 64 + lane_id_v())
#define lane (lane_id_v())
    const int G = gridDim.x, bx = blockIdx.x, vcu = (G % 8 == 0) ? (bx % 8) * (G / 8) + bx / 8 : bx;
    unsigned char* ws = args.ws;
    volatile LAS unsigned* MISC = (volatile LAS unsigned*)(lds + MISC_OFF);
    if (threadIdx.x < 16) MISC[threadIdx.x] = 0u;
    __syncthreads();
    XcdBarrier bar; bar.bar = (unsigned*)(ws + WS_CTL); bar.x = xb_xcc_id(); bar.st = MISC;
    if (blockIdx.x == 0) for (int i = threadIdx.x; i < (int)(CTL_BYTES / 4); i += NTHR) bar.bar[i] = 0u;
    const float* x = args.in[0]; const float* p = args.in[1]; float* out = args.out;
    bf16_t* WT_IN = (bf16_t*)(ws + WS_WIN); bf16_t* WT_OUT = (bf16_t*)(ws + WS_WOUT); bf16_t* WT_UP = (bf16_t*)(ws + WS_WUP); bf16_t* WT_DN = (bf16_t*)(ws + WS_WDN);
    bf16_t* WT_PG = (bf16_t*)(ws + WS_WPG); bf16_t* WT_PP = (bf16_t*)(ws + WS_WPP); bf16_t* WGT = (bf16_t*)(ws + WS_WG);
    float* RINV0 = (float*)(ws + WS_RINV0);
    float* RSTD1 = (float*)(ws + WS_RSTD1); float* RSTD2 = (float*)(ws + WS_RSTD2); f32x2* SUMM = (f32x2*)(ws + WS_SUMM);
    bf16_t* XN = (bf16_t*)(ws + WS_XN); bf16_t* PP = (bf16_t*)(ws + WS_PP); bf16_t* PB = (bf16_t*)(ws + WS_PB);
    bf16_t* PROJ = (bf16_t*)(ws + WS_PROJ); bf16_t* VT = (bf16_t*)(ws + WS_VT); bf16_t* MERGED = (bf16_t*)(ws + WS_MERGED); bf16_t* ACT = (bf16_t*)(ws + WS_ACT);

    for (int rep_ = 0; rep_ < 1 + ((PROBE_MASK >> 0) & 1); ++rep_) {
        LAS float* scr = (LAS float*)(lds + wave * 16384);
        const int gw = vcu * NWAVES + wave, NGW = G * NWAVES;
        constexpr int I_IN = 16 * 80, I_OUT = 16 * 32, I_UP = 16 * 128, I_DN = 64 * 32, I_PG = 16 * 32, I_PP = 4 * 32;
        constexpr int NITEMS = I_IN + I_OUT + I_UP + I_DN + I_PG + I_PP;
        for (int it = gw; it < NITEMS; it += NGW) {
            int r = it;
            if (r < I_IN) { p0_transpose_item(args.in[3], 1024, 2560, WT_IN, nullptr, nullptr, 0, scr, r, lane); continue; } r -= I_IN;
            if (r < I_OUT) { p0_transpose_item(args.in[16], 1024, 1024, WT_OUT, args.in[14], args.in[15], 512, scr, r, lane); continue; } r -= I_OUT;
            if (r < I_UP) { p0_transpose_item(args.in[18], 1024, 4096, WT_UP, args.in[17], args.in[17], 1 << 30, scr, r, lane); continue; } r -= I_UP;
            if (r < I_DN) { p0_transpose_item(args.in[19], 4096, 1024, WT_DN, nullptr, nullptr, 0, scr, r, lane); continue; } r -= I_DN;
            if (r < I_PG) { p0_transpose_item(args.in[21], 1024, 1024, WT_PG, args.in[20], args.in[20], 1 << 30, scr, r, lane); continue; } r -= I_PG;
            p0_transpose_item(args.in[22], 256, 1024, WT_PP, nullptr, nullptr, 0, scr, r, lane);
        }
        for (int i = bx * NTHR + tid; i < T_; i += G * NTHR) { RSTD1[i] = 0.f; RSTD2[i] = 0.f; }
        for (int i = bx * NTHR + tid; i < 65536; i += G * NTHR) { const int e = i & 7, ln = (i >> 3) & 63, ks = (i >> 9) & 3, nb = (i >> 11) & 1, blk = (i >> 12) & 7, gate = i >> 15;
            const int k = 16 * ks + 8 * (ln >> 5) + e, n = 32 * nb + (ln & 31);
            const float v = (gate ? args.in[8] : args.in[6])[blk * 4096 + k * 64 + n]; WGT[i] = (bf16_t)(cvtpk(v, 0.f) & 0xffffu); }
        const float* g1 = args.in[2];
        f32x4 gv[4];
#pragma unroll
        for (int j = 0; j < 4; ++j) gv[j] = *((const f32x4*)g1 + lane + 64 * j);
        for (int m = gw; m < T_; m += NGW) {
            const f32x4* xr = (const f32x4*)(x + (size_t)m * DM_) + lane; f32x4 v[4]; float s = 0.f;
#pragma unroll
            for (int j = 0; j < 4; ++j) { v[j] = __builtin_nontemporal_load(xr + 64 * j); s += (v[j].x * v[j].x + v[j].y * v[j].y) + (v[j].z * v[j].z + v[j].w * v[j].w); }
            const float ms_ = wave_sum(s) * (1.f / DM_) + EPS_; const float rstd = rsqf_(ms_);
            if (lane == 0) RINV0[m] = ms_ * rstd;
            u32x2* o8 = (u32x2*)(XN + (size_t)m * DM_) + lane;
#pragma unroll
            for (int j = 0; j < 4; ++j) { const f32x4 y = v[j] * gv[j] * rstd; u32x2 w; w.x = cvtpk(y.x, y.y); w.y = cvtpk(y.z, y.w); o8[64 * j] = w; }
            const f32x4 pv = __builtin_nontemporal_load((const f32x4*)(p + (size_t)m * PLE_) + lane); u32x2 pw; pw.x = cvtpk(pv.x, pv.y); pw.y = cvtpk(pv.z, pv.w);
            *((u32x2*)(PB + (size_t)m * PLE_) + lane) = pw;
        }
    }
    grid.sync();
    if (threadIdx.x == 0) MISC[2] = xb_add(&bar.bar[XB_XCNT(bar.x)], 1u);
    int cid = bx, vcu2 = vcu;
#define CENSUS_IDS() do { \
    if (threadIdx.x == 0) { unsigned okc = 1u; \
        for (unsigned j = 0; j < 16; ++j) { const unsigned c_ = xb_ld(&bar.bar[XB_XCNT(j)]); okc &= (j < 8 ? (c_ == (unsigned)G / 8u) : (c_ == 0u)) ? 1u : 0u; } \
        MISC[3] = (okc && (G % 8 == 0)) ? 1u : 0u; } \
    __syncthreads(); \
    { const bool okmap = MISC[3] != 0u; \
      cid = __builtin_amdgcn_readfirstlane(okmap ? (int)(MISC[2] * 8u + bar.x) : bx); \
      vcu2 = __builtin_amdgcn_readfirstlane(okmap ? (int)(bar.x * (unsigned)(G / 8) + MISC[2]) : vcu); } } while (0)
#if 0
    if (threadIdx.x == 0) { unsigned okc = 1u;
        for (unsigned j = 0; j < 16; ++j) { const unsigned c_ = xb_ld(&bar.bar[XB_XCNT(j)]); okc &= (j < 8 ? (c_ == (unsigned)G / 8u) : (c_ == 0u)) ? 1u : 0u; }
        MISC[3] = (okc && (G % 8 == 0)) ? 1u : 0u; }
    __syncthreads();
    const bool okmap = MISC[3] != 0u;
    const int cid = __builtin_amdgcn_readfirstlane(okmap ? (int)(MISC[2] * 8u + bar.x) : bx);
    const int vcu2 = __builtin_amdgcn_readfirstlane(okmap ? (int)(bar.x * (unsigned)(G / 8) + MISC[2]) : vcu);
#endif
    for (int rep_ = 0; rep_ < 1 + ((PROBE_MASK >> 1) & 1); ++rep_) {
        { pg8::Gemm g{XN, WT_IN, T_, 2048, 1024}; pg8::StaticOrder S; S.init(T_, 2048, G, cid); EpiProj E{PROJ, args.in[11], args.in[12]};
          pg8::gemm_phase<EpiProj, pg8::StaticOrder, PG8_ALIGN, PG8_SP2>(lds, g, S, E, wave); }
        { pg8::Gemm g{WT_IN + (size_t)2048 * 1024, XN, 512, T_, 1024}; pg8::StaticOrder S; S.init(512, T_, G, cid); EpiVT E{VT};
          pg8::gemm_phase<EpiVT, pg8::StaticOrder, PG8_ALIGN, PG8_SP2>(lds, g, S, E, wave); }
    }
    xcd_barrier(bar);
    CENSUS_IDS();
    for (int rep_ = 0; rep_ < 1 + ((PROBE_MASK >> 2) & 1); ++rep_)
    attn_phase(lds, PROJ, VT, args.in[11]  , args.in[12], args.in[13], MERGED, vcu2, G, wave);
    for (int rep_ = 0; rep_ < 1 + ((PROBE_MASK >> 3) & 1); ++rep_)
    for (int unit = vcu2; unit < NUNIT_LRU; unit += G)
        lru_unit<false>(lds, unit, PROJ, WGT, args.in[4], args.in[5], args.in[7], args.in[9], args.in[10], SUMM, MERGED, wave);
    xcd_barrier(bar);
    for (int rep_ = 0; rep_ < 1 + ((PROBE_MASK >> 4) & 1); ++rep_)
    for (int unit = vcu2; unit < NUNIT_LRU; unit += G)
        lru_unit<true>(lds, unit, PROJ, WGT, args.in[4], args.in[5], args.in[7], args.in[9], args.in[10], SUMM, MERGED, wave);
    xcd_barrier(bar);
#if RES_BF16
    { pg8::Gemm g{MERGED, WT_OUT, T_, 1024, 1024}; pg8::StaticOrder S; S.init(T_, 1024, G, cid); EpiRes4b E{XN, RINV0, args.in[2], RSTD1};
      pg8::gemm_phase<EpiRes4b, pg8::StaticOrder, PG8_ALIGN, PG8_SP2>(lds, g, S, E, wave); }
#else
    for (int rep_ = ((PROBE_MASK >> 5) & 1) ? 0 : 1; rep_ < 2; ++rep_)
    { pg8::Gemm g{MERGED, WT_OUT, T_, 1024, 1024}; pg8::StaticOrder S; S.init(T_, 1024, G, cid); EpiRes E{x, out, XN, rep_ ? RSTD1 : (float*)(ws + WS_DUMMY), 0xFFFF};
      pg8::gemm_phase<EpiRes, pg8::StaticOrder, PG8_ALIGN, PG8_SP2>(lds, g, S, E, wave); }
#endif
    xcd_barrier(bar);
    for (int rep_ = 0; rep_ < 1 + ((PROBE_MASK >> 6) & 1); ++rep_) { pg8::Gemm g{XN, WT_UP, T_, 4096, 1024}; pg8::StaticOrder S; S.init(T_, 4096, G, cid); EpiUp E{ACT, RSTD1};
      pg8::gemm_phase<EpiUp, pg8::StaticOrder, PG8_ALIGN, PG8_SP2, (PROBE_MASK >> 9) & 1>(lds, g, S, E, wave); }
    xcd_barrier(bar);
#if RES_BF16
    { pg8::Gemm g{ACT, WT_DN, T_, 1024, 4096}; pg8::StaticOrder S; S.init(T_, 1024, G, cid); EpiRes6 E{XN, RSTD2};
      pg8::gemm_phase<EpiRes6, pg8::StaticOrder, PG8_ALIGN, PG8_SP2>(lds, g, S, E, wave); }
#else
    for (int rep_ = ((PROBE_MASK >> 7) & 1) ? 0 : 1; rep_ < 2; ++rep_)
    { pg8::Gemm g{ACT, WT_DN, T_, 1024, 4096}; pg8::StaticOrder S; S.init(T_, 1024, G, cid);
      EpiRes E{out, rep_ ? out : (float*)(ws + WS_END), XN, rep_ ? RSTD2 : (float*)(ws + WS_DUMMY), rep_ ? 0xFFFF : 0x7FFF};
      pg8::gemm_phase<EpiRes, pg8::StaticOrder, PG8_ALIGN, PG8_SP2>(lds, g, S, E, wave); }
#endif
    xcd_barrier(bar);
#if RES_BF16
    { pg8::StaticOrder S; S.init(T_, 1024, G, cid); EpiMidPP EM{(u32x4*)(ws + WS_PP) + (size_t)bx * 8192}; EpiFinalC EF{XN, out, RSTD2, (const u32x4*)(ws + WS_PP) + (size_t)bx * 8192};
      pg8::gemm_phase_ple<EpiMidPP, EpiFinalC, pg8::StaticOrder>(lds, PB, WT_PP, XN, WT_PG, S, EM, EF, wave); }
#else
    for (int rep_ = ((PROBE_MASK >> 8) & 1) ? 0 : 1; rep_ < 2; ++rep_)
    { pg8::Gemm g{XN, WT_PG, T_, 1024, 1024}; pg8::StaticOrder S; S.init(T_, 1024, G, cid); EpiFinal E{out, rep_ ? out : (float*)ACT, PP, RSTD2};
      pg8::gemm_phase<EpiFinal, pg8::StaticOrder, PG8_ALIGN, PG8_SP2>(lds, g, S, E, wave); }
#endif
}

#undef tid
#undef lane
extern "C" void kernel_launch(void* const* d_in, const int* in_sizes, int n_in, void* d_out, int out_size, void* d_ws, size_t ws_size, hipStream_t stream) {
    static int grid = 0;
    if (grid == 0) {
        if (n_in != 23 || in_sizes[0] != T_ * DM_ || out_size != T_ * DM_ || ws_size < WS_END) { fprintf(stderr, "kernel_launch: unexpected shapes (n_in %d, in0 %d, out %d, ws %zu)\n", n_in, n_in > 0 ? in_sizes[0] : -1, out_size, ws_size); grid = -1; return; }
        int dev = 0, cus = 0, per_cu = 0;
        (void)hipGetDevice(&dev); (void)hipDeviceGetAttribute(&cus, hipDeviceAttributeMultiprocessorCount, dev);
        (void)hipFuncSetAttribute((const void*)fwd_megakernel, hipFuncAttributeMaxDynamicSharedMemorySize, LDS_BYTES);
        if (hipOccupancyMaxActiveBlocksPerMultiprocessor(&per_cu, (const void*)fwd_megakernel, NTHR, LDS_BYTES) != hipSuccess || per_cu < 1) per_cu = 1;
        (void)hipGetLastError();
        grid = cus * per_cu;
        if (grid > 256) grid = 256;
        fprintf(stderr, "kernel_launch: cus %d per_cu %d grid %d\n", cus, per_cu, grid);
    }
    if (grid < 0) return;
    Args a{};
    for (int i = 0; i < 23; ++i) a.in[i] = (const float*)d_in[i];
    a.out = (float*)d_out; a.ws = (unsigned char*)d_ws;
    void* kargs[] = {&a};
    hipError_t e = hipLaunchCooperativeKernel((const void*)fwd_megakernel, dim3(grid), dim3(NTHR), kargs, LDS_BYTES, stream);
    if (e != hipSuccess) fprintf(stderr, "kernel_launch: cooperative launch failed: %s (grid %d)\n", hipGetErrorString(e), grid);
}
```

```cpp
#include <hip/hip_runtime.h>
#include <hip/hip_cooperative_groups.h>
#include <cstdio>
#include <cstdint>
namespace cg = cooperative_groups;
__device__ __forceinline__ int lane_id_v() { int l; asm volatile("v_mbcnt_lo_u32_b32 %0, -1, 0\n\tv_mbcnt_hi_u32_b32 %0, -1, %0" : "=v"(l)); return l; }
namespace pg8 {
#define PG8_LAS __attribute__((address_space(3)))
typedef unsigned short bf16_t;
typedef short bf16x8 __attribute__((ext_vector_type(8)));
typedef float f32x4 __attribute__((ext_vector_type(4)));
typedef unsigned u32x4 __attribute__((ext_vector_type(4)));
constexpr int BM = 256, BK = 64, HALF = 128, HTB = HALF * BK * 2  , STAGE_BYTES = 8 * HTB, NXCD = 8, WGM = 8;

__host__ __device__ __forceinline__ int lds_byte(int r, int c) { const int st = (r >> 4) * 2 + (c >> 5), rr = r & 15, cc = c & 31, ob = rr * 64 + cc * 2; return st * 1024 + (ob ^ (((ob >> 9) & 1) << 5)); }
__host__ __device__ __forceinline__ void stage_rc(int b, int& R, int& C) { const int st = b / 1024, sb = b % 1024, swz = sb ^ (((sb >> 9) & 1) << 5); R = (st >> 1) * 16 + swz / 64; C = (st & 1) * 32 + (swz % 64) / 2; }
__host__ __device__ __forceinline__ int perm32(int rho) { const int n = rho >> 4, i = rho & 15; return 8 * (i >> 2) + 4 * n + (i & 3); }

struct Unit { int pm, pn; };
struct Gemm { const bf16_t* A; const bf16_t* Bt; int M, N, K; };

struct StaticOrder {
    int nM, nN, nwg, G, c;
    __host__ __device__ void init(int M, int N, int G_, int c_) { nM = M / BM; nN = N / BM; nwg = nM * nN; G = G_; c = c_; }
    __host__ __device__ bool next(int i, Unit& u) const {
        const long L = (long)i * G + c; if (L >= nwg) return false;
        int wgid = (int)L; { const int q = nwg / NXCD, r = nwg % NXCD, xcd = wgid % NXCD, off = wgid / NXCD; wgid = (xcd < r ? xcd * (q + 1) : r * (q + 1) + (xcd - r) * q) + off; }
        const int nig = WGM * nN, gid = wgid / nig, fm = gid * WGM, gsz = (nM - fm) < WGM ? (nM - fm) : WGM;
        u.pm = fm + ((wgid % nig) % gsz); u.pn = (wgid % nig) / gsz; return true;
    }
    __device__ __forceinline__ void a_ready(const Unit&) const {}
    __device__ __forceinline__ void done(const Unit&) const {}
};

__device__ __forceinline__ unsigned cvt_pk_bf16(float lo, float hi) { unsigned r; asm volatile("v_cvt_pk_bf16_f32 %0, %1, %2" : "=v"(r) : "v"(lo), "v"(hi)); return r; }
typedef float f32x2 __attribute__((ext_vector_type(2)));
template <class Epi, class Sched, bool ALIGN_EPI = false, bool SP2 = false, bool EPI2 = false>
__device__ __forceinline__ void gemm_phase(PG8_LAS unsigned char* lds, const Gemm g, const Sched& S, const Epi& E, const int wave_u) {
    int tid_ = wave_u * 64 + lane_id_v(); asm volatile("" : "+v"(tid_));
    const int tid = tid_, wid = __builtin_amdgcn_readfirstlane(tid >> 6), lane = tid & 63, wr = wid >> 2, wc = wid & 3, fr = lane & 15, fq = lane >> 4;
    const int K = g.K, nt = K / BK;
    unsigned voffA[2], voffB[2];
#pragma unroll
    for (int i = 0; i < 2; ++i) { int R, C; stage_rc(tid * 16 + i * 8192, R, C); const int Rp = Epi::PERM ? perm32(R & 31) : (R & 31); const int Rb = Epi::HEADMAP ? (64 * (R >> 5) + Rp) : ((R & ~31) + Rp);
        voffA[i] = (unsigned)(R * K + C) * 2u; voffB[i] = (unsigned)(Rb * K + C) * 2u; }
    const size_t kstep = (size_t)(BK * 2);
    const size_t hstep = (size_t)HALF * K * 2;
    const size_t hstepB = Epi::HEADMAP ? (size_t)32 * K * 2 : hstep;
    const size_t tstep = 2 * hstep;
    const unsigned ldsw = (unsigned)wid * 1024u;
    const int aoff = lds_byte(wr * 64 + fr, fq * 8), boff = lds_byte(wc * 32 + fr, fq * 8);
#define PG8_SA(b, h) (((b) * 2 + (h)) * HTB)
#define PG8_SB(b, h) ((4 + (b) * 2 + (h)) * HTB)
#define PG8_STAGE(bufoff, gbase, voff) do { _Pragma("unroll") for (int _i = 0; _i < 2; ++_i) \
        __builtin_amdgcn_global_load_lds((const unsigned*)((const char*)(gbase) + (voff)[_i]), (PG8_LAS unsigned*)(lds + (bufoff) + ldsw + _i * 8192), 16, 0, 0); } while (0)
#define PG8_LDA(dst, b, h) do { _Pragma("unroll") for (int m = 0; m < 4; ++m) _Pragma("unroll") for (int k = 0; k < 2; ++k) dst[m][k] = *(const PG8_LAS bf16x8*)(lds + PG8_SA(b, h) + aoff + m * 2048 + k * 1024); } while (0)
#define PG8_LDB(dst, b, h) do { _Pragma("unroll") for (int n = 0; n < 2; ++n) _Pragma("unroll") for (int k = 0; k < 2; ++k) dst[n][k] = *(const PG8_LAS bf16x8*)(lds + PG8_SB(b, h) + boff + n * 2048 + k * 1024); } while (0)
#define PG8_MMA(ai, bj, At, Bt) do { __builtin_amdgcn_s_setprio(1); _Pragma("unroll") for (int m = 0; m < 4; ++m) _Pragma("unroll") for (int n = 0; n < 2; ++n) _Pragma("unroll") for (int k = 0; k < 2; ++k) \
        acc[ai][bj][m][n] = __builtin_amdgcn_mfma_f32_16x16x32_bf16(Bt[n][k], At[m][k], acc[ai][bj][m][n], 0, 0, 0); __builtin_amdgcn_s_setprio(0); } while (0)
#define PG8_WAIT_V(n) asm volatile("s_waitcnt vmcnt(" #n ")" ::: "memory")
#define PG8_WAIT_L(n) asm volatile("s_waitcnt lgkmcnt(" #n ")" ::: "memory")
#define PG8_BAR __builtin_amdgcn_s_barrier()
#define PG8_SCHED __builtin_amdgcn_sched_barrier(0)
    Unit cur, nxt; int ui = 0;
    if (!S.next(0, cur)) return;
    f32x4 acc[2][2][4][2];
#pragma unroll
    for (int a = 0; a < 2; ++a)
#pragma unroll
        for (int b = 0; b < 2; ++b)
#pragma unroll
            for (int m = 0; m < 4; ++m)
#pragma unroll
                for (int n = 0; n < 2; ++n) acc[a][b][m][n] = (f32x4){0.f, 0.f, 0.f, 0.f};
    bf16x8 At[4][2], B0[2][2], B1[2][2];
    const char* cA = (const char*)g.A + (size_t)cur.pm * tstep; const char* cB = (const char*)g.Bt + (size_t)cur.pn * tstep;
    S.a_ready(cur);
    if constexpr (SP2) {
        PG8_STAGE(PG8_SB(0, 0), cB, voffB); PG8_STAGE(PG8_SB(0, 1), cB + hstepB, voffB); PG8_STAGE(PG8_SA(0, 0), cA, voffA); PG8_STAGE(PG8_SA(0, 1), cA + hstep, voffA);
        if (wr == 1) PG8_BAR;
        PG8_WAIT_V(2); PG8_BAR;
        PG8_STAGE(PG8_SB(1, 0), cB + kstep, voffB); PG8_STAGE(PG8_SA(1, 0), cA + kstep, voffA); PG8_STAGE(PG8_SB(1, 1), cB + hstepB + kstep, voffB);
        PG8_WAIT_V(6); PG8_BAR;
    } else {
        PG8_STAGE(PG8_SB(0, 0), cB, voffB); PG8_STAGE(PG8_SA(0, 0), cA, voffA); PG8_STAGE(PG8_SB(0, 1), cB + hstepB, voffB); PG8_STAGE(PG8_SA(0, 1), cA + hstep, voffA);
        if (wr == 1) PG8_BAR;
        PG8_WAIT_V(4); PG8_BAR;
        PG8_STAGE(PG8_SB(1, 0), cB + kstep, voffB); PG8_STAGE(PG8_SA(1, 0), cA + kstep, voffA); PG8_STAGE(PG8_SB(1, 1), cB + hstepB + kstep, voffB);
        PG8_WAIT_V(6); PG8_BAR;
    }
    for (;;) {
        const bool has_next = S.next(ui + 1, nxt);
        const char* nA = has_next ? (const char*)g.A + (size_t)nxt.pm * tstep : cA; const char* nB = has_next ? (const char*)g.Bt + (size_t)nxt.pn * tstep : cB;
#pragma nounroll
        for (int t = 0; t < nt; t += 2) {
            const bool last = (t == nt - 2);
            const char* a1 = cA + (size_t)(t + 1) * kstep;
            const char* a2 = last ? nA : cA + (size_t)(t + 2) * kstep; const char* b2 = last ? nB : cB + (size_t)(t + 2) * kstep;
            const char* a3 = a2 + kstep; const char* b3 = b2 + kstep;
            if (last && has_next) S.a_ready(nxt);
            if constexpr (SP2) {
            PG8_LDB(B0, 0, 0); PG8_LDB(B1, 0, 1); PG8_SCHED; PG8_LDA(At, 0, 0); PG8_STAGE(PG8_SA(1, 1), a1 + hstep, voffA);
            PG8_WAIT_V(8); PG8_WAIT_L(0); PG8_BAR; PG8_MMA(0, 0, At, B0); PG8_MMA(0, 1, At, B1); PG8_BAR; PG8_SCHED;
            PG8_LDA(At, 0, 1); PG8_STAGE(PG8_SB(0, 0), b2, voffB); PG8_STAGE(PG8_SB(0, 1), b2 + hstepB, voffB); PG8_STAGE(PG8_SA(0, 0), a2, voffA);
            PG8_WAIT_V(8); PG8_WAIT_L(0); PG8_BAR; PG8_MMA(1, 0, At, B0); PG8_MMA(1, 1, At, B1); PG8_BAR; PG8_SCHED;
            PG8_LDB(B0, 1, 0); PG8_LDB(B1, 1, 1); PG8_SCHED; PG8_LDA(At, 1, 0); PG8_STAGE(PG8_SA(0, 1), a2 + hstep, voffA);
            PG8_WAIT_V(8); PG8_WAIT_L(0); PG8_BAR; PG8_MMA(0, 0, At, B0); PG8_MMA(0, 1, At, B1); PG8_BAR; PG8_SCHED;
            PG8_LDA(At, 1, 1); PG8_STAGE(PG8_SB(1, 0), b3, voffB); PG8_STAGE(PG8_SB(1, 1), b3 + hstepB, voffB); PG8_STAGE(PG8_SA(1, 0), a3, voffA);
            PG8_WAIT_V(8); PG8_WAIT_L(0); PG8_BAR; PG8_MMA(1, 0, At, B0); PG8_MMA(1, 1, At, B1); PG8_BAR; PG8_SCHED;
            } else {
            PG8_LDB(B0, 0, 0); PG8_SCHED; PG8_LDA(At, 0, 0); PG8_STAGE(PG8_SA(1, 1), a1 + hstep, voffA);
            PG8_WAIT_L(8); PG8_BAR; PG8_WAIT_L(0); PG8_MMA(0, 0, At, B0); PG8_BAR; PG8_SCHED;
            PG8_LDB(B1, 0, 1); PG8_STAGE(PG8_SB(0, 0), b2, voffB);
            PG8_BAR; PG8_WAIT_L(0); PG8_MMA(0, 1, At, B1); PG8_BAR;
            PG8_LDA(At, 0, 1); PG8_STAGE(PG8_SA(0, 0), a2, voffA);
            PG8_BAR; PG8_WAIT_L(0); PG8_MMA(1, 0, At, B0); PG8_BAR; PG8_SCHED;
            PG8_STAGE(PG8_SB(0, 1), b2 + hstepB, voffB);
            PG8_WAIT_V(6); PG8_BAR; PG8_MMA(1, 1, At, B1); PG8_BAR;
            PG8_LDB(B0, 1, 0); PG8_SCHED; PG8_LDA(At, 1, 0); PG8_STAGE(PG8_SA(0, 1), a2 + hstep, voffA);
            PG8_WAIT_L(8); PG8_BAR; PG8_WAIT_L(0); PG8_MMA(0, 0, At, B0); PG8_BAR; PG8_SCHED;
            PG8_LDB(B1, 1, 1); PG8_STAGE(PG8_SB(1, 0), b3, voffB);
            PG8_BAR; PG8_WAIT_L(0); PG8_MMA(0, 1, At, B1); PG8_BAR;
            PG8_LDA(At, 1, 1); PG8_STAGE(PG8_SA(1, 0), a3, voffA);
            PG8_BAR; PG8_WAIT_L(0); PG8_MMA(1, 0, At, B0); PG8_BAR; PG8_SCHED;
            PG8_STAGE(PG8_SB(1, 1), b3 + hstepB, voffB);
            PG8_WAIT_V(6); PG8_BAR; PG8_MMA(1, 1, At, B1); PG8_BAR;
            }
        }
        if constexpr (ALIGN_EPI) { if (wr == 0) PG8_BAR; }
        if constexpr (!Epi::AFTER_DRAIN) { E(acc, cur, wr, wc, fr, fq); if constexpr (EPI2) { asm volatile("" ::: "memory"); E(acc, cur, wr, wc, fr, fq); } S.done(cur); }
        if (!has_next) break;
#pragma unroll
        for (int a = 0; a < 2; ++a)
#pragma unroll
            for (int b = 0; b < 2; ++b)
#pragma unroll
                for (int m = 0; m < 4; ++m)
#pragma unroll
                    for (int n = 0; n < 2; ++n) acc[a][b][m][n] = (f32x4){0.f, 0.f, 0.f, 0.f};
        cur = nxt; cA = nA; cB = nB; ++ui;
        if constexpr (ALIGN_EPI) { if (wr == 1) PG8_BAR; }
    }
    PG8_WAIT_V(0);
    if constexpr (!ALIGN_EPI) { if (wr == 0) PG8_BAR; }
    PG8_BAR;
    if constexpr (Epi::AFTER_DRAIN) { E.fused(acc, cur, wr, wc, fr, fq, lds, wid, lane); S.done(cur); }
#undef PG8_SA
#undef PG8_SB
#undef PG8_STAGE
#undef PG8_LDA
#undef PG8_LDB
#undef PG8_MMA
#undef PG8_WAIT_V
#undef PG8_WAIT_L
#undef PG8_BAR
#undef PG8_SCHED
}

template <class EpiMid, class EpiFin, class Sched>
__device__ __forceinline__ void gemm_phase_ple(PG8_LAS unsigned char* lds, const bf16_t* AP, const bf16_t* BP, const bf16_t* AZ, const bf16_t* BZ, const Sched& S, const EpiMid& EM, const EpiFin& E, const int wave_u) {
    constexpr bool ALIGN_EPI = true;
    int tid_ = wave_u * 64 + lane_id_v(); asm volatile("" : "+v"(tid_));
    const int tid = tid_, wid = __builtin_amdgcn_readfirstlane(tid >> 6), lane = tid & 63, wr = wid >> 2, wc = wid & 3, fr = lane & 15, fq = lane >> 4;
    constexpr int KP = 256, KZ = 1024, NT = 20;
    unsigned vAP[2], vBP[2], vAZ[2], vBZ[2];
#pragma unroll
    for (int i = 0; i < 2; ++i) { int R, C; stage_rc(tid * 16 + i * 8192, R, C); const int Rb = (R & ~31) + perm32(R & 31);
        vAP[i] = (unsigned)(R * KP + C) * 2u; vBP[i] = (unsigned)(Rb * KP + C) * 2u; vAZ[i] = (unsigned)(R * KZ + C) * 2u; vBZ[i] = (unsigned)(Rb * KZ + C) * 2u; }
    const size_t kstep = (size_t)(BK * 2);
    const size_t hsP = (size_t)HALF * KP * 2, hsZ = (size_t)HALF * KZ * 2, tsP = 2 * hsP, tsZ = 2 * hsZ;
    const unsigned ldsw = (unsigned)wid * 1024u;
    const int aoff = lds_byte(wr * 64 + fr, fq * 8), boff = lds_byte(wc * 32 + fr, fq * 8);
#define PG8_SA(b, h) (((b) * 2 + (h)) * HTB)
#define PG8_SB(b, h) ((4 + (b) * 2 + (h)) * HTB)
#define PG8_STAGE(bufoff, gbase, voff) do { _Pragma("unroll") for (int _i = 0; _i < 2; ++_i) \
        __builtin_amdgcn_global_load_lds((const unsigned*)((const char*)(gbase) + (voff)[_i]), (PG8_LAS unsigned*)(lds + (bufoff) + ldsw + _i * 8192), 16, 0, 0); } while (0)
#define PG8_LDA(dst, b, h) do { _Pragma("unroll") for (int m = 0; m < 4; ++m) _Pragma("unroll") for (int k = 0; k < 2; ++k) dst[m][k] = *(const PG8_LAS bf16x8*)(lds + PG8_SA(b, h) + aoff + m * 2048 + k * 1024); } while (0)
#define PG8_LDB(dst, b, h) do { _Pragma("unroll") for (int n = 0; n < 2; ++n) _Pragma("unroll") for (int k = 0; k < 2; ++k) dst[n][k] = *(const PG8_LAS bf16x8*)(lds + PG8_SB(b, h) + boff + n * 2048 + k * 1024); } while (0)
#define PG8_MMA(ai, bj, At, Bt) do { __builtin_amdgcn_s_setprio(1); _Pragma("unroll") for (int m = 0; m < 4; ++m) _Pragma("unroll") for (int n = 0; n < 2; ++n) _Pragma("unroll") for (int k = 0; k < 2; ++k) \
        acc[ai][bj][m][n] = __builtin_amdgcn_mfma_f32_16x16x32_bf16(Bt[n][k], At[m][k], acc[ai][bj][m][n], 0, 0, 0); __builtin_amdgcn_s_setprio(0); } while (0)
#define PG8_WAIT_V(n) asm volatile("s_waitcnt vmcnt(" #n ")" ::: "memory")
#define PG8_WAIT_L(n) asm volatile("s_waitcnt lgkmcnt(" #n ")" ::: "memory")
#define PG8_BAR __builtin_amdgcn_s_barrier()
#define PG8_SCHED __builtin_amdgcn_sched_barrier(0)
    Unit cur, nxt; int ui = 0;
    if (!S.next(0, cur)) return;
    f32x4 acc[2][2][4][2];
#pragma unroll
    for (int a = 0; a < 2; ++a)
#pragma unroll
        for (int b = 0; b < 2; ++b)
#pragma unroll
            for (int m = 0; m < 4; ++m)
#pragma unroll
                for (int n = 0; n < 2; ++n) acc[a][b][m][n] = (f32x4){0.f, 0.f, 0.f, 0.f};
    bf16x8 At[4][2], B0[2][2], B1[2][2];
    const char* cAP = (const char*)AP + (size_t)cur.pm * tsP; const char* cBP = (const char*)BP + (size_t)cur.pn * tsP;
    const char* cAZ = (const char*)AZ + (size_t)cur.pm * tsZ; const char* cBZ = (const char*)BZ + (size_t)cur.pn * tsZ;
    S.a_ready(cur);
    PG8_STAGE(PG8_SB(0, 0), cBP, vBP); PG8_STAGE(PG8_SB(0, 1), cBP + hsP, vBP); PG8_STAGE(PG8_SA(0, 0), cAP, vAP); PG8_STAGE(PG8_SA(0, 1), cAP + hsP, vAP);
    if (wr == 1) PG8_BAR;
    PG8_WAIT_V(2); PG8_BAR;
    PG8_STAGE(PG8_SB(1, 0), cBP + kstep, vBP); PG8_STAGE(PG8_SA(1, 0), cAP + kstep, vAP); PG8_STAGE(PG8_SB(1, 1), cBP + hsP + kstep, vBP);
    PG8_WAIT_V(6); PG8_BAR;
    for (;;) {
        const bool has_next = S.next(ui + 1, nxt);
        const char* nAP = has_next ? (const char*)AP + (size_t)nxt.pm * tsP : cAP; const char* nBP = has_next ? (const char*)BP + (size_t)nxt.pn * tsP : cBP;
#pragma nounroll
        for (int t = 0; t < NT; t += 2) {
            if (t == 4) {
                EM(acc, cur, wr, wc, fr, fq);
#pragma unroll
                for (int a = 0; a < 2; ++a)
#pragma unroll
                    for (int b = 0; b < 2; ++b)
#pragma unroll
                        for (int m = 0; m < 4; ++m)
#pragma unroll
                            for (int n = 0; n < 2; ++n) acc[a][b][m][n] = (f32x4){0.f, 0.f, 0.f, 0.f};
            }
            const bool p1 = (t < 4), p23 = (t == 0) || (t == NT - 2);
            const char* a1 = p1 ? cAP + (size_t)(t + 1) * kstep : cAZ + (size_t)(t - 3) * kstep;
            const char* a2 = (t == 0) ? cAP + 2 * kstep : (t == NT - 2) ? nAP : cAZ + (size_t)(t - 2) * kstep;
            const char* b2 = (t == 0) ? cBP + 2 * kstep : (t == NT - 2) ? nBP : cBZ + (size_t)(t - 2) * kstep;
            const char* a3 = a2 + kstep; const char* b3 = b2 + kstep;
            const size_t hstep1 = p1 ? hsP : hsZ, hstep = p23 ? hsP : hsZ, hstepB = hstep;
            unsigned voffA1[2], voffA[2], voffB[2];
#pragma unroll
            for (int i = 0; i < 2; ++i) { voffA1[i] = p1 ? vAP[i] : vAZ[i]; voffA[i] = p23 ? vAP[i] : vAZ[i]; voffB[i] = p23 ? vBP[i] : vBZ[i]; }
            if (t == NT - 2 && has_next) S.a_ready(nxt);
            PG8_LDB(B0, 0, 0); PG8_LDB(B1, 0, 1); PG8_SCHED; PG8_LDA(At, 0, 0); PG8_STAGE(PG8_SA(1, 1), a1 + hstep1, voffA1);
            PG8_WAIT_V(8); PG8_WAIT_L(0); PG8_BAR; PG8_MMA(0, 0, At, B0); PG8_MMA(0, 1, At, B1); PG8_BAR; PG8_SCHED;
            PG8_LDA(At, 0, 1); PG8_STAGE(PG8_SB(0, 0), b2, voffB); PG8_STAGE(PG8_SB(0, 1), b2 + hstepB, voffB); PG8_STAGE(PG8_SA(0, 0), a2, voffA);
            PG8_WAIT_V(8); PG8_WAIT_L(0); PG8_BAR; PG8_MMA(1, 0, At, B0); PG8_MMA(1, 1, At, B1); PG8_BAR; PG8_SCHED;
            PG8_LDB(B0, 1, 0); PG8_LDB(B1, 1, 1); PG8_SCHED; PG8_LDA(At, 1, 0); PG8_STAGE(PG8_SA(0, 1), a2 + hstep, voffA);
            PG8_WAIT_V(8); PG8_WAIT_L(0); PG8_BAR; PG8_MMA(0, 0, At, B0); PG8_MMA(0, 1, At, B1); PG8_BAR; PG8_SCHED;
            PG8_LDA(At, 1, 1); PG8_STAGE(PG8_SB(1, 0), b3, voffB); PG8_STAGE(PG8_SB(1, 1), b3 + hstepB, voffB); PG8_STAGE(PG8_SA(1, 0), a3, voffA);
            PG8_WAIT_V(8); PG8_WAIT_L(0); PG8_BAR; PG8_MMA(1, 0, At, B0); PG8_MMA(1, 1, At, B1); PG8_BAR; PG8_SCHED;
        }
        if constexpr (ALIGN_EPI) { if (wr == 0) PG8_BAR; }
        E(acc, cur, wr, wc, fr, fq); S.done(cur);
        if (!has_next) break;
#pragma unroll
        for (int a = 0; a < 2; ++a)
#pragma unroll
            for (int b = 0; b < 2; ++b)
#pragma unroll
                for (int m = 0; m < 4; ++m)
#pragma unroll
                    for (int n = 0; n < 2; ++n) acc[a][b][m][n] = (f32x4){0.f, 0.f, 0.f, 0.f};
        cur = nxt; cAP = nAP; cBP = nBP; cAZ = (const char*)AZ + (size_t)cur.pm * tsZ; cBZ = (const char*)BZ + (size_t)cur.pn * tsZ; ++ui;
        if constexpr (ALIGN_EPI) { if (wr == 1) PG8_BAR; }
    }
    PG8_WAIT_V(0);
    if constexpr (!ALIGN_EPI) { if (wr == 0) PG8_BAR; }
    PG8_BAR;
#undef PG8_SA
#undef PG8_SB
#undef PG8_STAGE
#undef PG8_LDA
#undef PG8_LDB
#undef PG8_MMA
#undef PG8_WAIT_V
#undef PG8_WAIT_L
#undef PG8_BAR
#undef PG8_SCHED
}
}
#ifndef PG8_SP2
#define PG8_SP2 true
#endif
#ifndef PG8_ALIGN
#define PG8_ALIGN true
#endif
using pg8::bf16_t; using pg8::bf16x8; using pg8::f32x4; using pg8::u32x4;
#define LAS __attribute__((address_space(3)))
typedef float f32x2 __attribute__((ext_vector_type(2)));
typedef float f32x16 __attribute__((ext_vector_type(16)));
typedef unsigned u32x2 __attribute__((ext_vector_type(2)));
typedef __bf16 bf16x2_t __attribute__((ext_vector_type(2)));

constexpr int T_ = 65536, DM_ = 1024, SEQ_ = 8192, PJW = 2048, FF_ = 4096, PLE_ = 256, NUNIT_ATT = 1024, NUNIT_LRU = 256;
constexpr float EPS_ = 1e-6f, LOG2E = 1.4426950408889634f, QSCALE = 0.125f * 1.4426950408889634f;
constexpr int NWAVES = 8, NTHR = 512;
constexpr int RING_BYTES = 131072, SSL_OFF = RING_BYTES, MISC_OFF = 147456 - 64, LDS_BYTES = 147456;
constexpr size_t MiB = 1u << 20;
constexpr size_t WS_WIN = 0, WS_WOUT = 5 * MiB, WS_WUP = 7 * MiB, WS_WDN = 15 * MiB, WS_WPG = 23 * MiB, WS_WPP = 25 * MiB, WS_WG = 25 * MiB + 512 * 1024;
constexpr size_t WS_RSTD1 = 27 * MiB, WS_RSTD2 = 27 * MiB + 256 * 1024, WS_DUMMY = 27 * MiB + 512 * 1024, WS_RINV0 = 27 * MiB + 768 * 1024, WS_SUMM = 28 * MiB;
constexpr size_t WS_CTL = 31 * MiB, CTL_BYTES = 16384;
constexpr size_t WS_XN = 32 * MiB;
constexpr size_t WS_PP = 160 * MiB;
constexpr size_t WS_PB = 288 * MiB;
constexpr size_t WS_PROJ = 320 * MiB;
constexpr size_t WS_VT = 576 * MiB;
constexpr size_t WS_MERGED = 640 * MiB;
constexpr size_t WS_ACT = 320 * MiB;
constexpr size_t WS_END = 832 * MiB;

__device__ __forceinline__ unsigned cvtpk(float lo, float hi) { f32x2 v = {lo, hi}; bf16x2_t b = __builtin_convertvector(v, bf16x2_t); return __builtin_bit_cast(unsigned, b); }
__device__ __forceinline__ float bf2f(unsigned short u) { return __uint_as_float((unsigned)u << 16); }
__device__ __forceinline__ float bflo(unsigned w) { return __uint_as_float(w << 16); }
__device__ __forceinline__ float bfhi(unsigned w) { return __uint_as_float(w & 0xffff0000u); }
__device__ __forceinline__ float ex2(float x) { return __builtin_amdgcn_exp2f(x); }
__device__ __forceinline__ float rcpf_(float x) { return __builtin_amdgcn_rcpf(x); }
__device__ __forceinline__ float rsqf_(float x) { return __builtin_amdgcn_rsqf(x); }
__device__ __forceinline__ float sigm(float z) { return rcpf_(1.f + ex2(-LOG2E * z)); }
__device__ __forceinline__ float gelu_tanh(float g) { const float z = 0.7978845608028654f * (g + 0.044715f * g * g * g); return g * sigm(2.f * z); }
__device__ __forceinline__ float wave_sum(float v) {
#pragma unroll
    for (int o = 1; o < 64; o <<= 1) v += __shfl_xor(v, o);
    return v;
}
__device__ __forceinline__ float wave_max(float v) {
#pragma unroll
    for (int o = 1; o < 64; o <<= 1) v = fmaxf(v, __shfl_xor(v, o));
    return v;
}
__device__ __forceinline__ int crow(int r, int hi) { return (r & 3) + 8 * (r >> 2) + 4 * hi; }
#define MFMA32(a, b, c) __builtin_amdgcn_mfma_f32_32x32x16_bf16((a), (b), (c), 0, 0, 0)

#define RLX_AGENT __ATOMIC_RELAXED, __HIP_MEMORY_SCOPE_AGENT
#define XB_TMO      128
#define XB_XCNT(j)  (256  + 64 * (j))
#define XB_XSUB(j)  (1280 + 64 * (j))
#define XB_XGEN(j)  (2304 + 64 * (j))
#define XB_TOP      3328
#define XB_TOPGEN   3392
#define XCD_BAR_WORDS 3456
#define XB_SPIN_CAP (1u << 18)

__device__ __forceinline__ unsigned xb_ld(unsigned* p)              { return __hip_atomic_load(p, __ATOMIC_RELAXED, __HIP_MEMORY_SCOPE_AGENT); }
__device__ __forceinline__ unsigned xb_add(unsigned* p, unsigned v) { return __hip_atomic_fetch_add(p, v, __ATOMIC_RELAXED, __HIP_MEMORY_SCOPE_AGENT); }
__device__ __forceinline__ unsigned xb_xcc_id() { return (unsigned)__builtin_amdgcn_s_getreg((3 << 11) | 20) & 0xFu; }
#define XB_SPIN(cond, bar) do { unsigned _sp = 0; while (cond) { __builtin_amdgcn_s_sleep(1); \
    if ((++_sp & 255u) == 0u) { if (xb_ld(&(bar)[XB_TMO])) break; if (_sp > XB_SPIN_CAP) { atomicAdd(&(bar)[XB_TMO], 1u); break; } } } } while (0)

struct XcdBarrier {
    unsigned* bar; unsigned x;
    volatile LAS unsigned* st;
};

__device__ __forceinline__ XcdBarrier xcd_barrier_post(unsigned* bar, volatile LAS unsigned* st) {
    XcdBarrier b; b.bar = bar; b.x = xb_xcc_id(); b.st = st;
    if (threadIdx.x == 0) (void)xb_add(&bar[XB_XCNT(b.x)], 1u);
    return b;
}
__device__ __forceinline__ void xcd_barrier_complete(unsigned* bar, unsigned x, unsigned& nloc, unsigned& nx) {
    const unsigned G = gridDim.x * gridDim.y * gridDim.z;
    unsigned sum, cnt, mine, sp = 0u;
    for (;;) {
        sum = 0u; cnt = 0u; mine = 0u;
#pragma unroll
        for (unsigned j = 0; j < 16; ++j) { const unsigned c = xb_ld(&bar[XB_XCNT(j)]); sum += c; cnt += (c > 0u) ? 1u : 0u; mine = (j == x) ? c : mine; }
        if (sum == G) break;
        __builtin_amdgcn_s_sleep(1);
        if ((++sp & 255u) == 0u) { if (xb_ld(&bar[XB_TMO])) break; if (sp > XB_SPIN_CAP) { atomicAdd(&bar[XB_TMO], 1u); break; } }
    }
    nloc = mine > 0u ? mine : 1u; nx = cnt > 0u ? cnt : 1u;
}

__device__ __forceinline__ void xcd_barrier(const XcdBarrier& b) {
    asm volatile("s_waitcnt vmcnt(0)" ::: "memory");
    __syncthreads();
    if (threadIdx.x == 0) {
        unsigned* bar = b.bar;
        __builtin_amdgcn_s_waitcnt(0);
        unsigned nloc = b.st[0], nx = b.st[1];
        if (nloc == 0u) { xcd_barrier_complete(bar, b.x, nloc, nx); b.st[0] = nloc; b.st[1] = nx; }
        const unsigned old = xb_add(&bar[XB_XSUB(b.x)], 1u);
        const unsigned gen = old / nloc;
        if (old + 1u == (gen + 1u) * nloc) {
            __builtin_amdgcn_fence(__ATOMIC_RELEASE, "agent");
            asm volatile("s_waitcnt vmcnt(0)" ::: "memory");
            const unsigned og = xb_add(&bar[XB_TOP], 1u);
            const unsigned tg = og / nx;
            if (og + 1u == (tg + 1u) * nx) xb_add(&bar[XB_TOPGEN], 1u);
            else XB_SPIN(xb_ld(&bar[XB_TOPGEN]) == tg, bar);
            __builtin_amdgcn_fence(__ATOMIC_ACQUIRE, "agent");
            xb_add(&bar[XB_XGEN(b.x)], 1u);
            asm volatile("s_waitcnt vmcnt(0)" ::: "memory");
        } else {
            XB_SPIN(xb_ld(&bar[XB_XGEN(b.x)]) == gen, bar);
            __builtin_amdgcn_fence(__ATOMIC_ACQUIRE, "agent");
            asm volatile("s_waitcnt vmcnt(0)" ::: "memory");
        }
    }
    __syncthreads();
}

struct PanelOrder {
    int pm;
    __device__ bool next(int i, pg8::Unit& u) const { if (i >= 4) return false; u.pm = pm; u.pn = i; return true; }
    __device__ __forceinline__ void a_ready(const pg8::Unit&) const {}
    __device__ __forceinline__ void done(const pg8::Unit&) const {}
};

struct EpiPlain {
    static constexpr bool PERM = true, AFTER_DRAIN = false, HEADMAP = false;
    bf16_t* O; int ldc;
    __device__ __forceinline__ void operator()(const f32x4 (&acc)[2][2][4][2], const pg8::Unit& u, int wr, int wc, int fr, int fq) const {
        const int row0 = u.pm * 256 + wr * 64 + fr, col0 = u.pn * 256 + wc * 32 + 8 * fq;
#pragma unroll
        for (int ai = 0; ai < 2; ++ai)
#pragma unroll
            for (int m = 0; m < 4; ++m) { bf16_t* rowp = O + (size_t)(row0 + ai * 128 + m * 16) * ldc + col0;
#pragma unroll
                for (int bj = 0; bj < 2; ++bj) { const f32x4 v0 = acc[ai][bj][m][0], v1 = acc[ai][bj][m][1];
                    u32x4 w; w.x = cvtpk(v0[0], v0[1]); w.y = cvtpk(v0[2], v0[3]); w.z = cvtpk(v1[0], v1[1]); w.w = cvtpk(v1[2], v1[3]);
                    *(u32x4*)(rowp + bj * 128) = w; } }
    }
};
struct EpiVT {
    static constexpr bool PERM = true, AFTER_DRAIN = false, HEADMAP = false;
    bf16_t* O;
    __device__ __forceinline__ void operator()(const f32x4 (&acc)[2][2][4][2], const pg8::Unit& u, int wr, int wc, int fr, int fq) const {
        const int row0 = u.pm * 256 + wr * 64 + fr, col0 = u.pn * 256 + wc * 32 + 16 * (fq >> 1) + 4 * (fq & 1);
#pragma unroll
        for (int ai = 0; ai < 2; ++ai)
#pragma unroll
            for (int m = 0; m < 4; ++m) { bf16_t* rowp = O + (size_t)(row0 + ai * 128 + m * 16) * T_ + col0;
#pragma unroll
                for (int bj = 0; bj < 2; ++bj)
#pragma unroll
                    for (int n = 0; n < 2; ++n) { const f32x4 v = acc[ai][bj][m][n]; u32x2 w; w.x = cvtpk(v[0], v[1]); w.y = cvtpk(v[2], v[3]);
                        *(u32x2*)(rowp + bj * 128 + 8 * n) = w; } }
    }
};
struct EpiProj {
    static constexpr bool PERM = true, AFTER_DRAIN = false, HEADMAP = true;
    bf16_t* O; const float* gq; const float* gk;
    __device__ __forceinline__ void operator()(const f32x4 (&acc)[2][2][4][2], const pg8::Unit& u, int wr, int wc, int fr, int fq) const {
        const int row0 = u.pm * 256 + wr * 64 + fr, col0 = u.pn * 256 + wc * 64 + 8 * fq, kind = u.pn >> 1;
        f32x4 gv[2][2];
        if (kind >= 2) { const float* g = (kind == 2) ? gq : gk; const float sc = (kind == 2) ? QSCALE : 1.f;
#pragma unroll
            for (int bj = 0; bj < 2; ++bj)
#pragma unroll
                for (int n = 0; n < 2; ++n) gv[bj][n] = *(const f32x4*)(g + 32 * bj + 8 * fq + 4 * n) * sc; }
#pragma unroll
        for (int ai = 0; ai < 2; ++ai)
#pragma unroll
            for (int m = 0; m < 4; ++m) { bf16_t* rowp = O + (size_t)(row0 + ai * 128 + m * 16) * PJW + col0;
                f32x4 v[2][2];
#pragma unroll
                for (int bj = 0; bj < 2; ++bj)
#pragma unroll
                    for (int n = 0; n < 2; ++n) v[bj][n] = acc[ai][bj][m][n];
                if (kind == 1) {
#pragma unroll
                    for (int bj = 0; bj < 2; ++bj)
#pragma unroll
                        for (int n = 0; n < 2; ++n)
#pragma unroll
                            for (int e = 0; e < 4; ++e) v[bj][n][e] = gelu_tanh(v[bj][n][e]);
                } else if (kind >= 2) {
                    float ss = 0.f;
#pragma unroll
                    for (int bj = 0; bj < 2; ++bj)
#pragma unroll
                        for (int n = 0; n < 2; ++n) { const f32x4 x = v[bj][n]; ss += (x[0] * x[0] + x[1] * x[1]) + (x[2] * x[2] + x[3] * x[3]); }
                    ss += __shfl_xor(ss, 16); ss += __shfl_xor(ss, 32);
                    const float rstd = rsqf_(ss * (1.f / 64.f) + EPS_);
#pragma unroll
                    for (int bj = 0; bj < 2; ++bj)
#pragma unroll
                        for (int n = 0; n < 2; ++n) v[bj][n] = v[bj][n] * gv[bj][n] * rstd;
                }
#pragma unroll
                for (int bj = 0; bj < 2; ++bj) { const f32x4 v0 = v[bj][0], v1 = v[bj][1];
                    u32x4 w; w.x = cvtpk(v0[0], v0[1]); w.y = cvtpk(v0[2], v0[3]); w.z = cvtpk(v1[0], v1[1]); w.w = cvtpk(v1[2], v1[3]);
                    *(u32x4*)(rowp + bj * 32) = w; } }
    }
};
struct EpiRes {
    static constexpr bool PERM = true, AFTER_DRAIN = false, HEADMAP = false;
    const float* base; float* out; bf16_t* hb; float* ssq; int rowmask;
    __device__ __forceinline__ void operator()(const f32x4 (&acc)[2][2][4][2], const pg8::Unit& u, int wr, int wc, int fr, int fq) const {
        const int row0 = u.pm * 256 + wr * 64 + fr, col0 = u.pn * 256 + wc * 32 + 8 * fq;
#pragma unroll
        for (int ai = 0; ai < 2; ++ai)
#pragma unroll
            for (int m = 0; m < 4; ++m) { const size_t off = (size_t)(row0 + ai * 128 + m * 16) * DM_ + col0; const size_t ooff = (size_t)((row0 + ai * 128 + m * 16) & rowmask) * DM_ + col0; float ss = 0.f;
#pragma unroll
                for (int bj = 0; bj < 2; ++bj) {
                    const f32x4 b0 = *(const f32x4*)(base + off + bj * 128), b1 = *(const f32x4*)(base + off + bj * 128 + 4);
                    const f32x4 v0 = b0 + acc[ai][bj][m][0], v1 = b1 + acc[ai][bj][m][1];
                    ss += (v0[0] * v0[0] + v0[1] * v0[1]) + (v0[2] * v0[2] + v0[3] * v0[3]) + (v1[0] * v1[0] + v1[1] * v1[1]) + (v1[2] * v1[2] + v1[3] * v1[3]);
                    *(f32x4*)(out + ooff + bj * 128) = v0; *(f32x4*)(out + ooff + bj * 128 + 4) = v1;
                    u32x4 w; w.x = cvtpk(v0[0], v0[1]); w.y = cvtpk(v0[2], v0[3]); w.z = cvtpk(v1[0], v1[1]); w.w = cvtpk(v1[2], v1[3]);
                    *(u32x4*)(hb + off + bj * 128) = w; }
                ss += __shfl_xor(ss, 16); ss += __shfl_xor(ss, 32);
                if (fq == 0) __hip_atomic_fetch_add(ssq + row0 + ai * 128 + m * 16, ss, __ATOMIC_RELAXED, __HIP_MEMORY_SCOPE_AGENT);
                asm volatile("" ::: "memory"); }
    }
};
struct EpiUp {
    static constexpr bool PERM = true, AFTER_DRAIN = false, HEADMAP = false;
    bf16_t* O; const float* rstd;
    __device__ __forceinline__ void operator()(const f32x4 (&acc)[2][2][4][2], const pg8::Unit& u, int wr, int wc, int fr, int fq) const {
        const int row0 = u.pm * 256 + wr * 64 + fr, col0 = u.pn * 256 + wc * 32 + 8 * fq;
#pragma unroll
        for (int ai = 0; ai < 2; ++ai)
#pragma unroll
            for (int m = 0; m < 4; ++m) { const int row = row0 + ai * 128 + m * 16; const float rs = rsqf_(rstd[row] * (1.f / DM_) + EPS_); bf16_t* rowp = O + (size_t)row * FF_ + col0;
#pragma unroll
                for (int bj = 0; bj < 2; ++bj) { f32x4 v0 = acc[ai][bj][m][0] * rs, v1 = acc[ai][bj][m][1] * rs;
#pragma unroll
                    for (int e = 0; e < 4; ++e) { const float a = fmaxf(v0[e], 0.f), b = fmaxf(v1[e], 0.f); v0[e] = a * a; v1[e] = b * b; }
                    u32x4 w; w.x = cvtpk(v0[0], v0[1]); w.y = cvtpk(v0[2], v0[3]); w.z = cvtpk(v1[0], v1[1]); w.w = cvtpk(v1[2], v1[3]);
                    *(u32x4*)(rowp + bj * 128) = w; } }
    }
};
struct EpiFinal {
    static constexpr bool PERM = true, AFTER_DRAIN = false, HEADMAP = false;
    const float* hin; float* out; const bf16_t* pp; const float* rstd;
    __device__ __forceinline__ void operator()(const f32x4 (&acc)[2][2][4][2], const pg8::Unit& u, int wr, int wc, int fr, int fq) const {
        const int row0 = u.pm * 256 + wr * 64 + fr, col0 = u.pn * 256 + wc * 32 + 8 * fq;
#pragma unroll
        for (int ai = 0; ai < 2; ++ai)
#pragma unroll
            for (int m = 0; m < 4; ++m) { const int row = row0 + ai * 128 + m * 16; const float rs = rsqf_(rstd[row] * (1.f / DM_) + EPS_); const size_t off = (size_t)row * DM_ + col0;
#pragma unroll
                for (int bj = 0; bj < 2; ++bj) {
                    const f32x4 h0 = *(const f32x4*)(hin + off + bj * 128), h1 = *(const f32x4*)(hin + off + bj * 128 + 4);
                    const u32x4 pw = *(const u32x4*)(pp + off + bj * 128);
                    const f32x4 a0 = acc[ai][bj][m][0] * rs, a1 = acc[ai][bj][m][1] * rs;
                    f32x4 o0, o1;
                    o0[0] = h0[0] + sigm(a0[0]) * bflo(pw.x); o0[1] = h0[1] + sigm(a0[1]) * bfhi(pw.x); o0[2] = h0[2] + sigm(a0[2]) * bflo(pw.y); o0[3] = h0[3] + sigm(a0[3]) * bfhi(pw.y);
                    o1[0] = h1[0] + sigm(a1[0]) * bflo(pw.z); o1[1] = h1[1] + sigm(a1[1]) * bfhi(pw.z); o1[2] = h1[2] + sigm(a1[2]) * bflo(pw.w); o1[3] = h1[3] + sigm(a1[3]) * bfhi(pw.w);
                    *(f32x4*)(out + off + bj * 128) = o0; *(f32x4*)(out + off + bj * 128 + 4) = o1; }
                asm volatile("" ::: "memory"); }
    }
};


struct EpiRes4 {
    static constexpr bool PERM = true, AFTER_DRAIN = false, HEADMAP = false;
    const float* base; bf16_t* hb; float* ssq;
    __device__ __forceinline__ void operator()(const f32x4 (&acc)[2][2][4][2], const pg8::Unit& u, int wr, int wc, int fr, int fq) const {
        const int row0 = u.pm * 256 + wr * 64 + fr, col0 = u.pn * 256 + wc * 32 + 8 * fq;
        f32x4 X[8][2][2];
#define E4_LD(g) do { const size_t off_ = (size_t)(row0 + ((g) >> 2) * 128 + ((g) & 3) * 16) * DM_ + col0; \
        _Pragma("unroll") for (int bj = 0; bj < 2; ++bj) { X[g][bj][0] = *(const f32x4*)(base + off_ + bj * 128); X[g][bj][1] = *(const f32x4*)(base + off_ + bj * 128 + 4); } } while (0)
        E4_LD(0); E4_LD(1); E4_LD(2); E4_LD(3);
        asm volatile("" ::: "memory");
#pragma unroll
        for (int g = 0; g < 8; ++g) { const int ai = g >> 2, m = g & 3; const size_t off = (size_t)(row0 + ai * 128 + m * 16) * DM_ + col0; float ss = 0.f;
#pragma unroll
            for (int bj = 0; bj < 2; ++bj) {
                const f32x4 v0 = X[g][bj][0] + acc[ai][bj][m][0], v1 = X[g][bj][1] + acc[ai][bj][m][1];
                ss += (v0[0] * v0[0] + v0[1] * v0[1]) + (v0[2] * v0[2] + v0[3] * v0[3]) + (v1[0] * v1[0] + v1[1] * v1[1]) + (v1[2] * v1[2] + v1[3] * v1[3]);
                u32x4 w; w.x = cvtpk(v0[0], v0[1]); w.y = cvtpk(v0[2], v0[3]); w.z = cvtpk(v1[0], v1[1]); w.w = cvtpk(v1[2], v1[3]);
                *(u32x4*)(hb + off + bj * 128) = w; }
            ss += __shfl_xor(ss, 16); ss += __shfl_xor(ss, 32);
            if (fq == 0) __hip_atomic_fetch_add(ssq + row0 + ai * 128 + m * 16, ss, __ATOMIC_RELAXED, __HIP_MEMORY_SCOPE_AGENT);
            if (g + 4 < 8) { E4_LD(g + 4); }
            asm volatile("" ::: "memory"); }
#undef E4_LD
    }
};
struct EpiRes4b {
    static constexpr bool PERM = true, AFTER_DRAIN = false, HEADMAP = false;
    bf16_t* hb; const float* rinv0; const float* g1; float* ssq;
    __device__ __forceinline__ void operator()(const f32x4 (&acc)[2][2][4][2], const pg8::Unit& u, int wr, int wc, int fr, int fq) const {
        const int row0 = u.pm * 256 + wr * 64 + fr, col0 = u.pn * 256 + wc * 32 + 8 * fq;
        f32x4 gi[2][2];
#pragma unroll
        for (int bj = 0; bj < 2; ++bj)
#pragma unroll
            for (int n = 0; n < 2; ++n) { const f32x4 gv = *(const f32x4*)(g1 + col0 + bj * 128 + 4 * n); gi[bj][n] = (f32x4){rcpf_(gv[0]), rcpf_(gv[1]), rcpf_(gv[2]), rcpf_(gv[3])}; }
        u32x4 H[8][2]; float RI[8];
#define E4_LD(g) do { const int row_ = row0 + ((g) >> 2) * 128 + ((g) & 3) * 16; const size_t off_ = (size_t)row_ * DM_ + col0; RI[g] = rinv0[row_]; \
        _Pragma("unroll") for (int bj = 0; bj < 2; ++bj) H[g][bj] = *(const u32x4*)(hb + off_ + bj * 128); } while (0)
        E4_LD(0); E4_LD(1); E4_LD(2); E4_LD(3);
        asm volatile("" ::: "memory");
#pragma unroll
        for (int g = 0; g < 8; ++g) { const int ai = g >> 2, m = g & 3; const size_t off = (size_t)(row0 + ai * 128 + m * 16) * DM_ + col0; float ss = 0.f; const float ri = RI[g];
#pragma unroll
            for (int bj = 0; bj < 2; ++bj) { const u32x4 hw = H[g][bj];
                const f32x4 x0 = (f32x4){bflo(hw.x), bfhi(hw.x), bflo(hw.y), bfhi(hw.y)} * gi[bj][0] * ri, x1 = (f32x4){bflo(hw.z), bfhi(hw.z), bflo(hw.w), bfhi(hw.w)} * gi[bj][1] * ri;
                const f32x4 v0 = x0 + acc[ai][bj][m][0], v1 = x1 + acc[ai][bj][m][1];
                ss += (v0[0] * v0[0] + v0[1] * v0[1]) + (v0[2] * v0[2] + v0[3] * v0[3]) + (v1[0] * v1[0] + v1[1] * v1[1]) + (v1[2] * v1[2] + v1[3] * v1[3]);
                u32x4 w; w.x = cvtpk(v0[0], v0[1]); w.y = cvtpk(v0[2], v0[3]); w.z = cvtpk(v1[0], v1[1]); w.w = cvtpk(v1[2], v1[3]);
                *(u32x4*)(hb + off + bj * 128) = w; }
            ss += __shfl_xor(ss, 16); ss += __shfl_xor(ss, 32);
            if (fq == 0) __hip_atomic_fetch_add(ssq + row0 + ai * 128 + m * 16, ss, __ATOMIC_RELAXED, __HIP_MEMORY_SCOPE_AGENT);
            if (g + 4 < 8) { E4_LD(g + 4); }
            asm volatile("" ::: "memory"); }
#undef E4_LD
    }
};
struct EpiRes6 {
    static constexpr bool PERM = true, AFTER_DRAIN = false, HEADMAP = false;
    bf16_t* hb; float* ssq;
    __device__ __forceinline__ void operator()(const f32x4 (&acc)[2][2][4][2], const pg8::Unit& u, int wr, int wc, int fr, int fq) const {
        const int row0 = u.pm * 256 + wr * 64 + fr, col0 = u.pn * 256 + wc * 32 + 8 * fq;
        u32x4 H[8][2];
#define E6_LD(g) do { const size_t off_ = (size_t)(row0 + ((g) >> 2) * 128 + ((g) & 3) * 16) * DM_ + col0; \
        _Pragma("unroll") for (int bj = 0; bj < 2; ++bj) H[g][bj] = *(const u32x4*)(hb + off_ + bj * 128); } while (0)
        E6_LD(0); E6_LD(1); E6_LD(2); E6_LD(3);
        asm volatile("" ::: "memory");
#pragma unroll
        for (int g = 0; g < 8; ++g) { const int ai = g >> 2, m = g & 3; const size_t off = (size_t)(row0 + ai * 128 + m * 16) * DM_ + col0; float ss = 0.f;
#pragma unroll
            for (int bj = 0; bj < 2; ++bj) { const u32x4 hw = H[g][bj];
                const f32x4 b0 = {bflo(hw.x), bfhi(hw.x), bflo(hw.y), bfhi(hw.y)}, b1 = {bflo(hw.z), bfhi(hw.z), bflo(hw.w), bfhi(hw.w)};
                const f32x4 v0 = b0 + acc[ai][bj][m][0], v1 = b1 + acc[ai][bj][m][1];
                ss += (v0[0] * v0[0] + v0[1] * v0[1]) + (v0[2] * v0[2] + v0[3] * v0[3]) + (v1[0] * v1[0] + v1[1] * v1[1]) + (v1[2] * v1[2] + v1[3] * v1[3]);
                u32x4 w; w.x = cvtpk(v0[0], v0[1]); w.y = cvtpk(v0[2], v0[3]); w.z = cvtpk(v1[0], v1[1]); w.w = cvtpk(v1[2], v1[3]);
                *(u32x4*)(hb + off + bj * 128) = w; }
            ss += __shfl_xor(ss, 16); ss += __shfl_xor(ss, 32);
            if (fq == 0) __hip_atomic_fetch_add(ssq + row0 + ai * 128 + m * 16, ss, __ATOMIC_RELAXED, __HIP_MEMORY_SCOPE_AGENT);
            if (g + 4 < 8) { E6_LD(g + 4); }
            asm volatile("" ::: "memory"); }
#undef E6_LD
    }
};
struct EpiFinalB {
    static constexpr bool PERM = true, AFTER_DRAIN = false, HEADMAP = false;
    const bf16_t* hb; float* out; const bf16_t* pp; const float* rstd;
    __device__ __forceinline__ void operator()(const f32x4 (&acc)[2][2][4][2], const pg8::Unit& u, int wr, int wc, int fr, int fq) const {
        const int row0 = u.pm * 256 + wr * 64 + fr, col0 = u.pn * 256 + wc * 32 + 8 * fq;
        u32x4 H[8][2], P[8][2]; float RS[8];
#define EF_LD(g) do { const int row_ = row0 + ((g) >> 2) * 128 + ((g) & 3) * 16; const size_t off_ = (size_t)row_ * DM_ + col0; RS[g] = rstd[row_]; \
        _Pragma("unroll") for (int bj = 0; bj < 2; ++bj) { H[g][bj] = *(const u32x4*)(hb + off_ + bj * 128); P[g][bj] = *(const u32x4*)(pp + off_ + bj * 128); } } while (0)
        EF_LD(0); EF_LD(1); EF_LD(2); EF_LD(3);
        asm volatile("" ::: "memory");
#pragma unroll
        for (int g = 0; g < 8; ++g) { const int ai = g >> 2, m = g & 3; const size_t off = (size_t)(row0 + ai * 128 + m * 16) * DM_ + col0; const float rs = rsqf_(RS[g] * (1.f / DM_) + EPS_);
#pragma unroll
            for (int bj = 0; bj < 2; ++bj) { const u32x4 hw = H[g][bj], pw = P[g][bj];
                const f32x4 a0 = acc[ai][bj][m][0] * rs, a1 = acc[ai][bj][m][1] * rs;
                f32x4 o0, o1;
                o0[0] = bflo(hw.x) + sigm(a0[0]) * bflo(pw.x); o0[1] = bfhi(hw.x) + sigm(a0[1]) * bfhi(pw.x); o0[2] = bflo(hw.y) + sigm(a0[2]) * bflo(pw.y); o0[3] = bfhi(hw.y) + sigm(a0[3]) * bfhi(pw.y);
                o1[0] = bflo(hw.z) + sigm(a1[0]) * bflo(pw.z); o1[1] = bfhi(hw.z) + sigm(a1[1]) * bfhi(pw.z); o1[2] = bflo(hw.w) + sigm(a1[2]) * bflo(pw.w); o1[3] = bfhi(hw.w) + sigm(a1[3]) * bfhi(pw.w);
                *(f32x4*)(out + off + bj * 128) = o0; *(f32x4*)(out + off + bj * 128 + 4) = o1; }
            if (g + 4 < 8) { EF_LD(g + 4); }
            asm volatile("" ::: "memory"); }
#undef EF_LD
    }
};

struct EpiMidPP {
    u32x4* park;
    __device__ __forceinline__ void operator()(const f32x4 (&acc)[2][2][4][2], const pg8::Unit& u, int wr, int wc, int fr, int fq) const {
        asm volatile("" : "+v"(fr), "+v"(fq));
        const unsigned pko_ = (unsigned)((wr * 4 + wc) * 64 + fq * 16 + fr);
#pragma unroll
        for (int ai = 0; ai < 2; ++ai)
#pragma unroll
            for (int m = 0; m < 4; ++m)
#pragma unroll
                for (int bj = 0; bj < 2; ++bj) { const f32x4 v0 = acc[ai][bj][m][0], v1 = acc[ai][bj][m][1];
                    u32x4 w; w.x = cvtpk(v0[0], v0[1]); w.y = cvtpk(v0[2], v0[3]); w.z = cvtpk(v1[0], v1[1]); w.w = cvtpk(v1[2], v1[3]);
                    park[pko_ + (unsigned)((((ai * 4 + m) * 2 + bj) * 8) * 64)] = w; }
    }
};
struct EpiFinalC {
    const bf16_t* hb; float* out; const float* rstd; const u32x4* park;
    __device__ __forceinline__ void operator()(const f32x4 (&acc)[2][2][4][2], const pg8::Unit& u, int wr, int wc, int fr, int fq) const {
        asm volatile("" : "+v"(fr), "+v"(fq));
        const int row0 = u.pm * 256 + wr * 64 + fr, col0 = u.pn * 256 + wc * 32 + 8 * fq;
        const unsigned pko_ = (unsigned)((wr * 4 + wc) * 64 + fq * 16 + fr);
        u32x4 H[8][2], P[8][2]; float RS[8];
#define EF_LD(g) do { const int row_ = row0 + ((g) >> 2) * 128 + ((g) & 3) * 16; const size_t off_ = (size_t)row_ * DM_ + col0; RS[g] = rstd[row_]; \
        _Pragma("unroll") for (int bj = 0; bj < 2; ++bj) { H[g][bj] = *(const u32x4*)(hb + off_ + bj * 128); P[g][bj] = park[pko_ + (unsigned)((((g) * 2 + bj) * 8) * 64)]; } } while (0)
        EF_LD(0); EF_LD(1); EF_LD(2); EF_LD(3);
        asm volatile("" ::: "memory");
#pragma unroll
        for (int g = 0; g < 8; ++g) { const int ai = g >> 2, m = g & 3; const size_t off = (size_t)(row0 + ai * 128 + m * 16) * DM_ + col0; const float rs = rsqf_(RS[g] * (1.f / DM_) + EPS_);
#pragma unroll
            for (int bj = 0; bj < 2; ++bj) { const u32x4 hw = H[g][bj], pw = P[g][bj];
                const f32x4 a0 = acc[ai][bj][m][0] * rs, a1 = acc[ai][bj][m][1] * rs;
                f32x4 o0, o1;
                o0[0] = bflo(hw.x) + sigm(a0[0]) * bflo(pw.x); o0[1] = bfhi(hw.x) + sigm(a0[1]) * bfhi(pw.x); o0[2] = bflo(hw.y) + sigm(a0[2]) * bflo(pw.y); o0[3] = bfhi(hw.y) + sigm(a0[3]) * bfhi(pw.y);
                o1[0] = bflo(hw.z) + sigm(a1[0]) * bflo(pw.z); o1[1] = bfhi(hw.z) + sigm(a1[1]) * bfhi(pw.z); o1[2] = bflo(hw.w) + sigm(a1[2]) * bflo(pw.w); o1[3] = bfhi(hw.w) + sigm(a1[3]) * bfhi(pw.w);
                *(f32x4*)(out + off + bj * 128) = o0; *(f32x4*)(out + off + bj * 128 + 4) = o1; }
            if (g + 4 < 8) { EF_LD(g + 4); }
            asm volatile("" ::: "memory"); }
#undef EF_LD
    }
};

__device__ __forceinline__ void p0_transpose_item(const float* W, int K, int N, bf16_t* WT, const float* ks0, const float* ks1, int ksplit, LAS float* scr, int item, int lane) {
    const int nblk = N / 32, kb = item / nblk, nb = item % nblk, k0 = 64 * kb, n0 = 32 * nb;
#pragma unroll 8
    for (int i = 0; i < 32; ++i) { const int kk = 2 * i + (lane >> 5), k = k0 + kk; float s = 1.f; if (ks0) s = (k < ksplit) ? ks0[k] : ks1[k - ksplit];
        scr[kk * 33 + (lane & 31)] = W[(size_t)k * N + n0 + (lane & 31)] * s; }
    asm volatile("s_waitcnt lgkmcnt(0)" ::: "memory");
    const int c = lane & 7;
#pragma unroll
    for (int j = 0; j < 4; ++j) { const int n = (lane >> 3) + 8 * j; const LAS float* s = scr + (8 * c) * 33 + n;
        u32x4 o; o.x = cvtpk(s[0 * 33], s[1 * 33]); o.y = cvtpk(s[2 * 33], s[3 * 33]); o.z = cvtpk(s[4 * 33], s[5 * 33]); o.w = cvtpk(s[6 * 33], s[7 * 33]);
        *(u32x4*)(WT + (size_t)(n0 + n) * K + k0 + 8 * c) = o; }
    asm volatile("s_waitcnt lgkmcnt(0)" ::: "memory");
}
__device__ __forceinline__ void attn_phase(LAS unsigned char* lds, const bf16_t* PROJ, const bf16_t* VT, const float* gq, const float* gk, const float* rb, bf16_t* MERGED, int vcu, int G, const int wave_u) {
    int tid_ = wave_u * 64 + lane_id_v(); asm volatile("" : "+v"(tid_));
    const int tid = tid_, lane = tid & 63, h = __builtin_amdgcn_readfirstlane(tid >> 6), ql = lane & 31, hi = lane >> 5;
    LAS float* SQ = (LAS float*)lds;
    LAS float* EXT = (LAS float*)(lds + 2048) + h * 640;
    float mq = wave_max(fabsf(gq[lane])), mk = wave_max(fabsf(gk[lane])); float mb = -1e30f;
    for (int i = lane; i < 513; i += 64) mb = fmaxf(mb, rb[h * 513 + i]);
    mb = wave_max(mb);
    const float c512 = rb[h * 513 + 512]; (void)mq; (void)mk; (void)mb;
    for (int i = lane; i < 640; i += 64) { int rel = i - 64; rel = rel > 256 ? 256 : (rel < -256 ? -256 : rel); EXT[639 - i] = (rb[h * 513 + rel + 256] - c512) * LOG2E; }
    asm volatile("s_waitcnt lgkmcnt(0)" ::: "memory");
    __syncthreads();
    for (int unit = vcu; unit < NUNIT_ATT; unit += G) {
        const int b = unit >> 7, n = unit & 127; const long tok0 = (long)b * SEQ_ + n * 64;
        bf16x8 qf[2][4];
        { const bf16_t* qp = PROJ + (tok0 + ql) * PJW + 1024 + h * 64 + hi * 8;
#pragma unroll
          for (int qb = 0; qb < 2; ++qb)
#pragma unroll
              for (int d0 = 0; d0 < 4; ++d0) qf[qb][d0] = *(const bf16x8*)(qp + (long)qb * 32 * PJW + d0 * 16); }
        f32x16 o[2][2];
#pragma unroll
        for (int a = 0; a < 2; ++a)
#pragma unroll
            for (int c = 0; c < 2; ++c)
#pragma unroll
                for (int r = 0; r < 16; ++r) o[a][c][r] = 0.f;
        float lsum[2] = {0.f, 0.f};
        const int it0 = (n < 8) ? 2 * (8 - n) : 0;
        const bf16_t* kbase = PROJ + (tok0 - 512) * PJW + 1536 + h * 64;
        const bf16_t* vbase = VT + (long)(h * 64) * T_ + (tok0 - 512);
        const unsigned kgo = (unsigned)((lane >> 3) * PJW + (lane & 7) * 8), vgo = (unsigned)((lane >> 2) * T_ + (lane & 3) * 8);
        LAS unsigned char* kv = lds + 24576 + h * 8192;
        const unsigned wk = (unsigned)((lane >> 3) * 128 + (((lane & 7) ^ (lane >> 3)) * 16));
        const unsigned wv = (unsigned)(4096 + (lane >> 2) * 64 + (((lane & 3) ^ ((lane >> 3) & 3)) * 16));
        const unsigned rkb = (unsigned)(ql * 128), rks = (unsigned)(ql & 7), rvb = (unsigned)(4096 + ql * 64), rvs = (unsigned)((ql >> 1) & 3);
        bf16x8 kn[4], vn[4];
#define LOADKV(IT) do { const bf16_t* kp_ = kbase + (long)(IT) * 32 * PJW; const bf16_t* vp_ = vbase + (IT) * 32; \
        _Pragma("unroll") for (int i = 0; i < 4; ++i) { kn[i] = *(const bf16x8*)(kp_ + (kgo + (unsigned)(i * 8 * PJW))); vn[i] = *(const bf16x8*)(vp_ + (vgo + (unsigned)(i * 16 * T_))); } } while (0)
        LOADKV(it0);
        for (int it = it0; it < 18; ++it) {
#pragma unroll
            for (int i = 0; i < 4; ++i) { *(LAS bf16x8*)(kv + wk + i * 1024) = kn[i]; *(LAS bf16x8*)(kv + wv + i * 1024) = vn[i]; }
            { const int itn = (it + 1 < 18) ? it + 1 : it; LOADKV(itn); }
            bf16x8 kf[4], vf[2][2];
#pragma unroll
            for (int d0 = 0; d0 < 4; ++d0) kf[d0] = *(const LAS bf16x8*)(kv + rkb + (((unsigned)(2 * d0 + hi) ^ rks) * 16));
#pragma unroll
            for (int db = 0; db < 2; ++db)
#pragma unroll
                for (int ks = 0; ks < 2; ++ks) vf[db][ks] = *(const LAS bf16x8*)(kv + rvb + db * 2048 + (((unsigned)(2 * ks + hi) ^ rvs) * 16));
            const bool tab = (it >= 8);
#pragma unroll
            for (int qb = 0; qb < 2; ++qb) {
                f32x16 s;
                if (tab) { const LAS float* e = EXT + (63 - 32 * qb - ql + 32 * it + 4 * hi); f32x16 cin;
#pragma unroll
                    for (int r = 0; r < 16; ++r) cin[r] = e[(r & 3) + 8 * (r >> 2)];
                    s = MFMA32(kf[0], qf[qb][0], cin); }
                else { f32x16 z_;
#pragma unroll
                    for (int r = 0; r < 16; ++r) z_[r] = 0.f;
                    s = MFMA32(kf[0], qf[qb][0], z_); }
#pragma unroll
                for (int d0 = 1; d0 < 4; ++d0) s = MFMA32(kf[d0], qf[qb][d0], s);
                float ps = 0.f;
#pragma unroll
                for (int r = 0; r < 16; ++r) { s[r] = ex2(s[r]); ps += s[r]; }
                lsum[qb] += ps;
                bf16x8 pk[2];
#pragma unroll
                for (int ks = 0; ks < 2; ++ks) { u32x4 w; w.x = cvtpk(s[8 * ks], s[8 * ks + 1]); w.y = cvtpk(s[8 * ks + 2], s[8 * ks + 3]); w.z = cvtpk(s[8 * ks + 4], s[8 * ks + 5]); w.w = cvtpk(s[8 * ks + 6], s[8 * ks + 7]);
                    pk[ks] = __builtin_bit_cast(bf16x8, w); }
#pragma unroll
                for (int db = 0; db < 2; ++db)
#pragma unroll
                    for (int ks = 0; ks < 2; ++ks) o[db][qb] = MFMA32(vf[db][ks], pk[ks], o[db][qb]);
            }
        }
#undef LOADKV
        float inv[2], sq[2];
#pragma unroll
        for (int qb = 0; qb < 2; ++qb) { float l = lsum[qb]; l += __shfl_xor(l, 32); inv[qb] = 1.f / l; float q2 = 0.f;
#pragma unroll
            for (int db = 0; db < 2; ++db)
#pragma unroll
                for (int r = 0; r < 16; ++r) { const float v = o[db][qb][r] * inv[qb]; o[db][qb][r] = v; q2 += v * v; }
            q2 += __shfl_xor(q2, 32); sq[qb] = q2;
            if (hi == 0) SQ[h * 64 + 32 * qb + ql] = q2; }
        asm volatile("s_waitcnt lgkmcnt(0)" ::: "memory");
        __syncthreads();
#pragma unroll
        for (int qb = 0; qb < 2; ++qb) { float tot = 0.f;
#pragma unroll
            for (int hh = 0; hh < 8; ++hh) tot += SQ[hh * 64 + 32 * qb + ql];
            const float rstd = rsqf_(tot * (1.f / 512.f) + EPS_);
            bf16_t* op = MERGED + (tok0 + 32 * qb + ql) * DM_ + 512 + h * 64 + 4 * hi;
#pragma unroll
            for (int db = 0; db < 2; ++db)
#pragma unroll
                for (int r4 = 0; r4 < 4; ++r4) { u32x2 w; w.x = cvtpk(o[db][qb][4 * r4] * rstd, o[db][qb][4 * r4 + 1] * rstd); w.y = cvtpk(o[db][qb][4 * r4 + 2] * rstd, o[db][qb][4 * r4 + 3] * rstd);
                    *(u32x2*)(op + 32 * db + 8 * r4) = w; } }
        __syncthreads();
    }
}

template <bool PASS2>
__device__ __forceinline__ void lru_unit(LAS unsigned char* lds, int unit, const bf16_t* PROJ, const bf16_t* WGT, const float* conv_w, const float* conv_b, const float* b_rg, const float* b_ig,
                                         const float* lam, f32x2* SUMM, bf16_t* MERGED, const int wave_u) {
    int tid_ = wave_u * 64 + lane_id_v(); asm volatile("" : "+v"(tid_));
    const int tid = tid_, lane = tid & 63, w = __builtin_amdgcn_readfirstlane(tid >> 6), ql = lane & 31, hi = lane >> 5;
    const int b = unit >> 5, seg = unit & 31; const long tok0 = (long)b * SEQ_ + seg * 256;
    LAS bf16_t* XC = (LAS bf16_t*)lds + w * (64 * 72);
    LAS bf16_t* YT = (LAS bf16_t*)(lds + 73728);
    const int chc = 64 * w + lane;
    const float cw0 = conv_w[chc], cw1 = conv_w[512 + chc], cw2 = conv_w[1024 + chc], cw3 = conv_w[1536 + chc], cbv = conv_b[chc];
    float brg[2], big[2], sp[2];
#pragma unroll
    for (int nb = 0; nb < 2; ++nb) { const int ch = 64 * w + 32 * nb + ql; brg[nb] = b_rg[ch]; big[nb] = b_ig[ch];
        sp[nb] = -8.f * LOG2E * log1pf(expf(-lam[ch])); }
    float carry[2] = {0.f, 0.f}, ptot[2] = {1.f, 1.f};
    if (PASS2) {
#pragma unroll
        for (int nb = 0; nb < 2; ++nb) { float c = 0.f; const f32x2* sp_ = SUMM + (size_t)(b * 32) * 512 + 64 * w + 32 * nb + ql;
            for (int s0 = 0; s0 < seg; s0 += 8) { f32x2 v[8];
#pragma unroll
                for (int j = 0; j < 8; ++j) v[j] = (s0 + j < seg) ? sp_[(size_t)(s0 + j) * 512] : (f32x2){1.f, 0.f};
#pragma unroll
                for (int j = 0; j < 8; ++j) c = v[j].x * c + v[j].y; }
            carry[nb] = c; }
    }
    float x1 = 0.f, x2 = 0.f, x3 = 0.f;
#pragma nounroll
    for (int st = 0; st < 4; ++st) {
        const long t0 = tok0 + 64 * st;
        {
            const bf16_t* xt = PROJ + t0 * PJW + 64 * w;
            const unsigned go = (unsigned)((lane >> 3) * PJW + (lane & 7) * 8);
            bf16x8 raw[8];
#pragma unroll
            for (int i = 0; i < 8; ++i) raw[i] = *(const bf16x8*)(xt + (go + (unsigned)(i * 8 * PJW)));
            if (st == 0) { x1 = 0.f; x2 = 0.f; x3 = 0.f;
                if (seg != 0) { const bf16_t* xp = PROJ + t0 * PJW + chc; x1 = bf2f(xp[-1 * PJW]); x2 = bf2f(xp[-2 * PJW]); x3 = bf2f(xp[-3 * PJW]); } }
#pragma unroll
            for (int i = 0; i < 8; ++i) *(LAS bf16x8*)(XC + (8 * i + (lane >> 3)) * 72 + (lane & 7) * 8) = raw[i];
#pragma unroll 16
            for (int t = 0; t < 64; ++t) { const float xv = bf2f(XC[t * 72 + lane]); const float xc = cbv + cw0 * x3 + cw1 * x2 + cw2 * x1 + cw3 * xv;
                XC[t * 72 + lane] = (bf16_t)(cvtpk(xc, 0.f) & 0xffffu); x3 = x2; x2 = x1; x1 = xv; }
        }
        asm volatile("s_waitcnt lgkmcnt(0)" ::: "memory");
#pragma unroll
        for (int nb = 0; nb < 2; ++nb) {
            bf16x8 wrf[4], wif[4];
            { int woff = ((w * 2 + nb) * 4 * 64 + lane) * 8; asm volatile("" : "+v"(woff));
#pragma unroll
              for (int ks = 0; ks < 4; ++ks) { wrf[ks] = *(const bf16x8*)(WGT + woff + ks * 512); wif[ks] = *(const bf16x8*)(WGT + 8 * 4096 + woff + ks * 512); } }
#pragma unroll
            for (int tb = 0; tb < 2; ++tb) {
                bf16x8 af[4];
#pragma unroll
                for (int ks = 0; ks < 4; ++ks) af[ks] = *(const LAS bf16x8*)(XC + (32 * tb + ql) * 72 + 16 * ks + 8 * hi);
                f32x16 dr, di;
#pragma unroll
                for (int r = 0; r < 16; ++r) { dr[r] = 0.f; di[r] = 0.f; }
#pragma unroll
                for (int ks = 0; ks < 4; ++ks) { dr = MFMA32(af[ks], wrf[ks], dr); di = MFMA32(af[ks], wif[ks], di); }
                float A[16], U[16];
#pragma unroll
                for (int r = 0; r < 16; ++r) { const int tok = 32 * tb + crow(r, hi); const float xcv = bf2f(XC[tok * 72 + 32 * nb + ql]);
                    const float rg = sigm(dr[r] + brg[nb]), ig = sigm(di[r] + big[nb]); const float a = ex2(rg * sp[nb]);
                    const float mult = __builtin_amdgcn_sqrtf(fmaxf(1.f - a * a, 0.f)); A[r] = a; U[r] = mult * ig * xcv; }
#pragma unroll
                for (int q4 = 0; q4 < 4; ++q4)
#pragma unroll
                    for (int e = 1; e < 4; ++e) { U[4 * q4 + e] = A[4 * q4 + e] * U[4 * q4 + e - 1] + U[4 * q4 + e]; A[4 * q4 + e] = A[4 * q4 + e - 1] * A[4 * q4 + e]; }
                float c = carry[nb], HIN[4];
#pragma unroll
                for (int q4 = 0; q4 < 4; ++q4) { const float e0 = A[4 * q4 + 3] * c + U[4 * q4 + 3]; const float p = __shfl_xor(e0, 32); const float hin = hi ? p : c; HIN[q4] = hin;
                    const float e1 = A[4 * q4 + 3] * hin + U[4 * q4 + 3]; const float q = __shfl_xor(e1, 32); c = hi ? e1 : q; }
                carry[nb] = c;
                if (!PASS2) { const float po = (A[3] * A[7]) * (A[11] * A[15]); ptot[nb] *= po * __shfl_xor(po, 32); }
                else {
                    const bf16_t* gb = PROJ + t0 * PJW + 512 + 64 * w + 32 * nb + (32 * tb) * PJW;
                    const unsigned goff = (unsigned)(4 * hi) * PJW + ql;
#pragma unroll
                    for (int r = 0; r < 16; ++r) { const int tok = 32 * tb + crow(r, hi); const float hval = U[r] + A[r] * HIN[r >> 2]; const float gl = bf2f(gb[goff + (unsigned)((r & 3) + 8 * (r >> 2)) * PJW]);
                        YT[tok * 520 + 64 * w + 32 * nb + ql] = (bf16_t)(cvtpk(hval * gl, 0.f) & 0xffffu); }
                }
            }
        }
        if (PASS2) {
            asm volatile("s_waitcnt lgkmcnt(0)" ::: "memory");
            __syncthreads();
#pragma unroll
            for (int i = 0; i < 8; ++i) { const int tok = 8 * w + i; const u32x4 v = *(const LAS u32x4*)(YT + tok * 520 + 8 * lane);
                const float f0 = bflo(v.x), f1 = bfhi(v.x), f2 = bflo(v.y), f3 = bfhi(v.y), f4 = bflo(v.z), f5 = bfhi(v.z), f6 = bflo(v.w), f7 = bfhi(v.w);
                float ss = (f0 * f0 + f1 * f1) + (f2 * f2 + f3 * f3) + (f4 * f4 + f5 * f5) + (f6 * f6 + f7 * f7); ss = wave_sum(ss);
                const float rs = rsqf_(ss * (1.f / 512.f) + EPS_);
                u32x4 o; o.x = cvtpk(f0 * rs, f1 * rs); o.y = cvtpk(f2 * rs, f3 * rs); o.z = cvtpk(f4 * rs, f5 * rs); o.w = cvtpk(f6 * rs, f7 * rs);
                *(u32x4*)(MERGED + (t0 + tok) * DM_ + 8 * lane) = o; }
            __syncthreads();
        }
        asm volatile("" ::: "memory");
    }
    if (!PASS2) { if (hi == 0) {
#pragma unroll
        for (int nb = 0; nb < 2; ++nb) SUMM[(size_t)unit * 512 + 64 * w + 32 * nb + ql] = (f32x2){ptot[nb], carry[nb]}; } }
}

#ifndef PROBE_MASK
#define PROBE_MASK 0
#endif
#ifndef RES_BF16
#define RES_BF16 1
#endif
struct Args { const float* in[23]; float* out; unsigned char* ws; };
__global__ void __launch_bounds__(NTHR, 2) fwd_megakernel(Args args) {
    extern __shared__ __attribute__((aligned(16))) unsigned char lds_raw[];
    cg::grid_group grid = cg::this_grid();
    LAS unsigned char* lds = (LAS unsigned char*)lds_raw;
    const int wave = __builtin_amdgcn_readfirstlane(threadIdx.x >> 6);
#define tid (wave * 64 + lane_id_v())
#define lane (lane_id_v())
    const int G = gridDim.x, bx = blockIdx.x, vcu = (G % 8 == 0) ? (bx % 8) * (G / 8) + bx / 8 : bx;
    unsigned char* ws = args.ws;
    volatile LAS unsigned* MISC = (volatile LAS unsigned*)(lds + MISC_OFF);
    if (threadIdx.x < 16) MISC[threadIdx.x] = 0u;
    __syncthreads();
    XcdBarrier bar; bar.bar = (unsigned*)(ws + WS_CTL); bar.x = xb_xcc_id(); bar.st = MISC;
    if (blockIdx.x == 0) for (int i = threadIdx.x; i < (int)(CTL_BYTES / 4); i += NTHR) bar.bar[i] = 0u;
    const float* x = args.in[0]; const float* p = args.in[1]; float* out = args.out;
    bf16_t* WT_IN = (bf16_t*)(ws + WS_WIN); bf16_t* WT_OUT = (bf16_t*)(ws + WS_WOUT); bf16_t* WT_UP = (bf16_t*)(ws + WS_WUP); bf16_t* WT_DN = (bf16_t*)(ws + WS_WDN);
    bf16_t* WT_PG = (bf16_t*)(ws + WS_WPG); bf16_t* WT_PP = (bf16_t*)(ws + WS_WPP); bf16_t* WGT = (bf16_t*)(ws + WS_WG);
    float* RINV0 = (float*)(ws + WS_RINV0);
    float* RSTD1 = (float*)(ws + WS_RSTD1); float* RSTD2 = (float*)(ws + WS_RSTD2); f32x2* SUMM = (f32x2*)(ws + WS_SUMM);
    bf16_t* XN = (bf16_t*)(ws + WS_XN); bf16_t* PP = (bf16_t*)(ws + WS_PP); bf16_t* PB = (bf16_t*)(ws + WS_PB);
    bf16_t* PROJ = (bf16_t*)(ws + WS_PROJ); bf16_t* VT = (bf16_t*)(ws + WS_VT); bf16_t* MERGED = (bf16_t*)(ws + WS_MERGED); bf16_t* ACT = (bf16_t*)(ws + WS_ACT);

    for (int rep_ = 0; rep_ < 1 + ((PROBE_MASK >> 0) & 1); ++rep_) {
        LAS float* scr = (LAS float*)(lds + wave * 16384);
        const int gw = vcu * NWAVES + wave, NGW = G * NWAVES;
        constexpr int I_IN = 16 * 80, I_OUT = 16 * 32, I_UP = 16 * 128, I_DN = 64 * 32, I_PG = 16 * 32, I_PP = 4 * 32;
        constexpr int NITEMS = I_IN + I_OUT + I_UP + I_DN + I_PG + I_PP;
        for (int it = gw; it < NITEMS; it += NGW) {
            int r = it;
            if (r < I_IN) { p0_transpose_item(args.in[3], 1024, 2560, WT_IN, nullptr, nullptr, 0, scr, r, lane); continue; } r -= I_IN;
            if (r < I_OUT) { p0_transpose_item(args.in[16], 1024, 1024, WT_OUT, args.in[14], args.in[15], 512, scr, r, lane); continue; } r -= I_OUT;
            if (r < I_UP) { p0_transpose_item(args.in[18], 1024, 4096, WT_UP, args.in[17], args.in[17], 1 << 30, scr, r, lane); continue; } r -= I_UP;
            if (r < I_DN) { p0_transpose_item(args.in[19], 4096, 1024, WT_DN, nullptr, nullptr, 0, scr, r, lane); continue; } r -= I_DN;
            if (r < I_PG) { p0_transpose_item(args.in[21], 1024, 1024, WT_PG, args.in[20], args.in[20], 1 << 30, scr, r, lane); continue; } r -= I_PG;
            p0_transpose_item(args.in[22], 256, 1024, WT_PP, nullptr, nullptr, 0, scr, r, lane);
        }
        for (int i = bx * NTHR + tid; i < T_; i += G * NTHR) { RSTD1[i] = 0.f; RSTD2[i] = 0.f; }
        for (int i = bx * NTHR + tid; i < 65536; i += G * NTHR) { const int e = i & 7, ln = (i >> 3) & 63, ks = (i >> 9) & 3, nb = (i >> 11) & 1, blk = (i >> 12) & 7, gate = i >> 15;
            const int k = 16 * ks + 8 * (ln >> 5) + e, n = 32 * nb + (ln & 31);
            const float v = (gate ? args.in[8] : args.in[6])[blk * 4096 + k * 64 + n]; WGT[i] = (bf16_t)(cvtpk(v, 0.f) & 0xffffu); }
        const float* g1 = args.in[2];
        f32x4 gv[4];
#pragma unroll
        for (int j = 0; j < 4; ++j) gv[j] = *((const f32x4*)g1 + lane + 64 * j);
        for (int m = gw; m < T_; m += NGW) {
            const f32x4* xr = (const f32x4*)(x + (size_t)m * DM_) + lane; f32x4 v[4]; float s = 0.f;
#pragma unroll
            for (int j = 0; j < 4; ++j) { v[j] = __builtin_nontemporal_load(xr + 64 * j); s += (v[j].x * v[j].x + v[j].y * v[j].y) + (v[j].z * v[j].z + v[j].w * v[j].w); }
            const float ms_ = wave_sum(s) * (1.f / DM_) + EPS_; const float rstd = rsqf_(ms_);
            if (lane == 0) RINV0[m] = ms_ * rstd;
            u32x2* o8 = (u32x2*)(XN + (size_t)m * DM_) + lane;
#pragma unroll
            for (int j = 0; j < 4; ++j) { const f32x4 y = v[j] * gv[j] * rstd; u32x2 w; w.x = cvtpk(y.x, y.y); w.y = cvtpk(y.z, y.w); o8[64 * j] = w; }
            const f32x4 pv = __builtin_nontemporal_load((const f32x4*)(p + (size_t)m * PLE_) + lane); u32x2 pw; pw.x = cvtpk(pv.x, pv.y); pw.y = cvtpk(pv.z, pv.w);
            *((u32x2*)(PB + (size_t)m * PLE_) + lane) = pw;
        }
    }
    grid.sync();
    if (threadIdx.x == 0) MISC[2] = xb_add(&bar.bar[XB_XCNT(bar.x)], 1u);
    int cid = bx, vcu2 = vcu;
#define CENSUS_IDS() do { \
    if (threadIdx.x == 0) { unsigned okc = 1u; \
        for (unsigned j = 0; j < 16; ++j) { const unsigned c_ = xb_ld(&bar.bar[XB_XCNT(j)]); okc &= (j < 8 ? (c_ == (unsigned)G / 8u) : (c_ == 0u)) ? 1u : 0u; } \
        MISC[3] = (okc && (G % 8 == 0)) ? 1u : 0u; } \
    __syncthreads(); \
    { const bool okmap = MISC[3] != 0u; \
      cid = __builtin_amdgcn_readfirstlane(okmap ? (int)(MISC[2] * 8u + bar.x) : bx); \
      vcu2 = __builtin_amdgcn_readfirstlane(okmap ? (int)(bar.x * (unsigned)(G / 8) + MISC[2]) : vcu); } } while (0)
#if 0
    if (threadIdx.x == 0) { unsigned okc = 1u;
        for (unsigned j = 0; j < 16; ++j) { const unsigned c_ = xb_ld(&bar.bar[XB_XCNT(j)]); okc &= (j < 8 ? (c_ == (unsigned)G / 8u) : (c_ == 0u)) ? 1u : 0u; }
        MISC[3] = (okc && (G % 8 == 0)) ? 1u : 0u; }
    __syncthreads();
    const bool okmap = MISC[3] != 0u;
    const int cid = __builtin_amdgcn_readfirstlane(okmap ? (int)(MISC[2] * 8u + bar.x) : bx);
    const int vcu2 = __builtin_amdgcn_readfirstlane(okmap ? (int)(bar.x * (unsigned)(G / 8) + MISC[2]) : vcu);
#endif
    for (int rep_ = 0; rep_ < 1 + ((PROBE_MASK >> 1) & 1); ++rep_) {
        { pg8::Gemm g{XN, WT_IN, T_, 2048, 1024}; pg8::StaticOrder S; S.init(T_, 2048, G, cid); EpiProj E{PROJ, args.in[11], args.in[12]};
          pg8::gemm_phase<EpiProj, pg8::StaticOrder, PG8_ALIGN, PG8_SP2>(lds, g, S, E, wave); }
        { pg8::Gemm g{WT_IN + (size_t)2048 * 1024, XN, 512, T_, 1024}; pg8::StaticOrder S; S.init(512, T_, G, cid); EpiVT E{VT};
          pg8::gemm_phase<EpiVT, pg8::StaticOrder, PG8_ALIGN, PG8_SP2>(lds, g, S, E, wave); }
    }
    xcd_barrier(bar);
    CENSUS_IDS();
    for (int rep_ = 0; rep_ < 1 + ((PROBE_MASK >> 2) & 1); ++rep_)
    attn_phase(lds, PROJ, VT, args.in[11]  , args.in[12], args.in[13], MERGED, vcu2, G, wave);
    for (int rep_ = 0; rep_ < 1 + ((PROBE_MASK >> 3) & 1); ++rep_)
    for (int unit = vcu2; unit < NUNIT_LRU; unit += G)
        lru_unit<false>(lds, unit, PROJ, WGT, args.in[4], args.in[5], args.in[7], args.in[9], args.in[10], SUMM, MERGED, wave);
    xcd_barrier(bar);
    for (int rep_ = 0; rep_ < 1 + ((PROBE_MASK >> 4) & 1); ++rep_)
    for (int unit = vcu2; unit < NUNIT_LRU; unit += G)
        lru_unit<true>(lds, unit, PROJ, WGT, args.in[4], args.in[5], args.in[7], args.in[9], args.in[10], SUMM, MERGED, wave);
    xcd_barrier(bar);
#if RES_BF16
    { pg8::Gemm g{MERGED, WT_OUT, T_, 1024, 1024}; pg8::StaticOrder S; S.init(T_, 1024, G, cid); EpiRes4b E{XN, RINV0, args.in[2], RSTD1};
      pg8::gemm_phase<EpiRes4b, pg8::StaticOrder, PG8_ALIGN, PG8_SP2>(lds, g, S, E, wave); }
#else
    for (int rep_ = ((PROBE_MASK >> 5) & 1) ? 0 : 1; rep_ < 2; ++rep_)
    { pg8::Gemm g{MERGED, WT_OUT, T_, 1024, 1024}; pg8::StaticOrder S; S.init(T_, 1024, G, cid); EpiRes E{x, out, XN, rep_ ? RSTD1 : (float*)(ws + WS_DUMMY), 0xFFFF};
      pg8::gemm_phase<EpiRes, pg8::StaticOrder, PG8_ALIGN, PG8_SP2>(lds, g, S, E, wave); }
#endif
    xcd_barrier(bar);
    for (int rep_ = 0; rep_ < 1 + ((PROBE_MASK >> 6) & 1); ++rep_) { pg8::Gemm g{XN, WT_UP, T_, 4096, 1024}; pg8::StaticOrder S; S.init(T_, 4096, G, cid); EpiUp E{ACT, RSTD1};
      pg8::gemm_phase<EpiUp, pg8::StaticOrder, PG8_ALIGN, PG8_SP2, (PROBE_MASK >> 9) & 1>(lds, g, S, E, wave); }
    xcd_barrier(bar);
#if RES_BF16
    { pg8::Gemm g{ACT, WT_DN, T_, 1024, 4096}; pg8::StaticOrder S; S.init(T_, 1024, G, cid); EpiRes6 E{XN, RSTD2};
      pg8::gemm_phase<EpiRes6, pg8::StaticOrder, PG8_ALIGN, PG8_SP2>(lds, g, S, E, wave); }
#else
    for (int rep_ = ((PROBE_MASK >> 7) & 1) ? 0 : 1; rep_ < 2; ++rep_)
    { pg8::Gemm g{ACT, WT_DN, T_, 1024, 4096}; pg8::StaticOrder S; S.init(T_, 1024, G, cid);
      EpiRes E{out, rep_ ? out : (float*)(ws + WS_END), XN, rep_ ? RSTD2 : (float*)(ws + WS_DUMMY), rep_ ? 0xFFFF : 0x7FFF};
      pg8::gemm_phase<EpiRes, pg8::StaticOrder, PG8_ALIGN, PG8_SP2>(lds, g, S, E, wave); }
#endif
    xcd_barrier(bar);
#if RES_BF16
    { pg8::StaticOrder S; S.init(T_, 1024, G, cid); EpiMidPP EM{(u32x4*)(ws + WS_PP) + (size_t)bx * 8192}; EpiFinalC EF{XN, out, RSTD2, (const u32x4*)(ws + WS_PP) + (size_t)bx * 8192};
      pg8::gemm_phase_ple<EpiMidPP, EpiFinalC, pg8::StaticOrder>(lds, PB, WT_PP, XN, WT_PG, S, EM, EF, wave); }
#else
    for (int rep_ = ((PROBE_MASK >> 8) & 1) ? 0 : 1; rep_ < 2; ++rep_)
    { pg8::Gemm g{XN, WT_PG, T_, 1024, 1024}; pg8::StaticOrder S; S.init(T_, 1024, G, cid); EpiFinal E{out, rep_ ? out : (float*)ACT, PP, RSTD2};
      pg8::gemm_phase<EpiFinal, pg8::StaticOrder, PG8_ALIGN, PG8_SP2>(lds, g, S, E, wave); }
#endif
}

#undef tid
#undef lane
extern "C" void kernel_launch(void* const* d_in, const int* in_sizes, int n_in, void* d_out, int out_size, void* d_ws, size_t ws_size, hipStream_t stream) {
    static int grid = 0;
    if (grid == 0) {
        if (n_in != 23 || in_sizes[0] != T_ * DM_ || out_size != T_ * DM_ || ws_size < WS_END) { fprintf(stderr, "kernel_launch: unexpected shapes (n_in %d, in0 %d, out %d, ws %zu)\n", n_in, n_in > 0 ? in_sizes[0] : -1, out_size, ws_size); grid = -1; return; }
        int dev = 0, cus = 0, per_cu = 0;
        (void)hipGetDevice(&dev); (void)hipDeviceGetAttribute(&cus, hipDeviceAttributeMultiprocessorCount, dev);
        (void)hipFuncSetAttribute((const void*)fwd_megakernel, hipFuncAttributeMaxDynamicSharedMemorySize, LDS_BYTES);
        if (hipOccupancyMaxActiveBlocksPerMultiprocessor(&per_cu, (const void*)fwd_megakernel, NTHR, LDS_BYTES) != hipSuccess || per_cu < 1) per_cu = 1;
        (void)hipGetLastError();
        grid = cus * per_cu;
        if (grid > 256) grid = 256;
        fprintf(stderr, "kernel_launch: cus %d per_cu %d grid %d\n", cus, per_cu, grid);
    }
    if (grid < 0) return;
    Args a{};
    for (int i = 0; i < 23; ++i) a.in[i] = (const float*)d_in[i];
    a.out = (float*)d_out; a.ws = (unsigned char*)d_ws;
    void* kargs[] = {&a};
    hipError_t e = hipLaunchCooperativeKernel((const void*)fwd_megakernel, dim3(grid), dim3(NTHR), kargs, LDS_BYTES, stream);
    if (e != hipSuccess) fprintf(stderr, "kernel_launch: cooperative launch failed: %s (grid %d)\n", hipGetErrorString(e), grid);
}
```

```cpp
#include <hip/hip_runtime.h>
#include <hip/hip_cooperative_groups.h>
#include <cstdio>
#include <cstdint>
namespace cg = cooperative_groups;
__device__ __forceinline__ int lane_id_v() { int l; asm volatile("v_mbcnt_lo_u32_b32 %0, -1, 0\n\tv_mbcnt_hi_u32_b32 %0, -1, %0" : "=v"(l)); return l; }
namespace pg8 {
#define PG8_LAS __attribute__((address_space(3)))
typedef unsigned short bf16_t;
typedef short bf16x8 __attribute__((ext_vector_type(8)));
typedef float f32x4 __attribute__((ext_vector_type(4)));
typedef unsigned u32x4 __attribute__((ext_vector_type(4)));
constexpr int BM = 256, BK = 64, HALF = 128, HTB = HALF * BK * 2  , STAGE_BYTES = 8 * HTB, NXCD = 8, WGM = 8;

__host__ __device__ __forceinline__ int lds_byte(int r, int c) { const int st = (r >> 4) * 2 + (c >> 5), rr = r & 15, cc = c & 31, ob = rr * 64 + cc * 2; return st * 1024 + (ob ^ (((ob >> 9) & 1) << 5)); }
__host__ __device__ __forceinline__ void stage_rc(int b, int& R, int& C) { const int st = b / 1024, sb = b % 1024, swz = sb ^ (((sb >> 9) & 1) << 5); R = (st >> 1) * 16 + swz / 64; C = (st & 1) * 32 + (swz % 64) / 2; }
__host__ __device__ __forceinline__ int perm32(int rho) { const int n = rho >> 4, i = rho & 15; return 8 * (i >> 2) + 4 * n + (i & 3); }

struct Unit { int pm, pn; };
struct Gemm { const bf16_t* A; const bf16_t* Bt; int M, N, K; };

struct StaticOrder {
    int nM, nN, nwg, G, c;
    __host__ __device__ void init(int M, int N, int G_, int c_) { nM = M / BM; nN = N / BM; nwg = nM * nN; G = G_; c = c_; }
    __host__ __device__ bool next(int i, Unit& u) const {
        const long L = (long)i * G + c; if (L >= nwg) return false;
        int wgid = (int)L; { const int q = nwg / NXCD, r = nwg % NXCD, xcd = wgid % NXCD, off = wgid / NXCD; wgid = (xcd < r ? xcd * (q + 1) : r * (q + 1) + (xcd - r) * q) + off; }
        const int nig = WGM * nN, gid = wgid / nig, fm = gid * WGM, gsz = (nM - fm) < WGM ? (nM - fm) : WGM;
        u.pm = fm + ((wgid % nig) % gsz); u.pn = (wgid % nig) / gsz; return true;
    }
    __device__ __forceinline__ void a_ready(const Unit&) const {}
    __device__ __forceinline__ void done(const Unit&) const {}
};

__device__ __forceinline__ unsigned cvt_pk_bf16(float lo, float hi) { unsigned r; asm volatile("v_cvt_pk_bf16_f32 %0, %1, %2" : "=v"(r) : "v"(lo), "v"(hi)); return r; }
typedef float f32x2 __attribute__((ext_vector_type(2)));
template <class Epi, class Sched, bool ALIGN_EPI = false, bool SP2 = false, bool EPI2 = false>
__device__ __forceinline__ void gemm_phase(PG8_LAS unsigned char* lds, const Gemm g, const Sched& S, const Epi& E, const int wave_u) {
    int tid_ = wave_u * 64 + lane_id_v(); asm volatile("" : "+v"(tid_));
    const int tid = tid_, wid = __builtin_amdgcn_readfirstlane(tid >> 6), lane = tid & 63, wr = wid >> 2, wc = wid & 3, fr = lane & 15, fq = lane >> 4;
    const int K = g.K, nt = K / BK;
    unsigned voffA[2], voffB[2];
#pragma unroll
    for (int i = 0; i < 2; ++i) { int R, C; stage_rc(tid * 16 + i * 8192, R, C); const int Rp = Epi::PERM ? perm32(R & 31) : (R & 31); const int Rb = Epi::HEADMAP ? (64 * (R >> 5) + Rp) : ((R & ~31) + Rp);
        voffA[i] = (unsigned)(R * K + C) * 2u; voffB[i] = (unsigned)(Rb * K + C) * 2u; }
    const size_t kstep = (size_t)(BK * 2);
    const size_t hstep = (size_t)HALF * K * 2;
    const size_t hstepB = Epi::HEADMAP ? (size_t)32 * K * 2 : hstep;
    const size_t tstep = 2 * hstep;
    const unsigned ldsw = (unsigned)wid * 1024u;
    const int aoff = lds_byte(wr * 64 + fr, fq * 8), boff = lds_byte(wc * 32 + fr, fq * 8);
#define PG8_SA(b, h) (((b) * 2 + (h)) * HTB)
#define PG8_SB(b, h) ((4 + (b) * 2 + (h)) * HTB)
#define PG8_STAGE(bufoff, gbase, voff) do { _Pragma("unroll") for (int _i = 0; _i < 2; ++_i) \
        __builtin_amdgcn_global_load_lds((const unsigned*)((const char*)(gbase) + (voff)[_i]), (PG8_LAS unsigned*)(lds + (bufoff) + ldsw + _i * 8192), 16, 0, 0); } while (0)
#define PG8_LDA(dst, b, h) do { _Pragma("unroll") for (int m = 0; m < 4; ++m) _Pragma("unroll") for (int k = 0; k < 2; ++k) dst[m][k] = *(const PG8_LAS bf16x8*)(lds + PG8_SA(b, h) + aoff + m * 2048 + k * 1024); } while (0)
#define PG8_LDB(dst, b, h) do { _Pragma("unroll") for (int n = 0; n < 2; ++n) _Pragma("unroll") for (int k = 0; k < 2; ++k) dst[n][k] = *(const PG8_LAS bf16x8*)(lds + PG8_SB(b, h) + boff + n * 2048 + k * 1024); } while (0)
#define PG8_MMA(ai, bj, At, Bt) do { __builtin_amdgcn_s_setprio(1); _Pragma("unroll") for (int m = 0; m < 4; ++m) _Pragma("unroll") for (int n = 0; n < 2; ++n) _Pragma("unroll") for (int k = 0; k < 2; ++k) \
        acc[ai][bj][m][n] = __builtin_amdgcn_mfma_f32_16x16x32_bf16(Bt[n][k], At[m][k], acc[ai][bj][m][n], 0, 0, 0); __builtin_amdgcn_s_setprio(0); } while (0)
#define PG8_WAIT_V(n) asm volatile("s_waitcnt vmcnt(" #n ")" ::: "memory")
#define PG8_WAIT_L(n) asm volatile("s_waitcnt lgkmcnt(" #n ")" ::: "memory")
#define PG8_BAR __builtin_amdgcn_s_barrier()
#define PG8_SCHED __builtin_amdgcn_sched_barrier(0)
    Unit cur, nxt; int ui = 0;
    if (!S.next(0, cur)) return;
    f32x4 acc[2][2][4][2];
#pragma unroll
    for (int a = 0; a < 2; ++a)
#pragma unroll
        for (int b = 0; b < 2; ++b)
#pragma unroll
            for (int m = 0; m < 4; ++m)
#pragma unroll
                for (int n = 0; n < 2; ++n) acc[a][b][m][n] = (f32x4){0.f, 0.f, 0.f, 0.f};
    bf16x8 At[4][2], B0[2][2], B1[2][2];
    const char* cA = (const char*)g.A + (size_t)cur.pm * tstep; const char* cB = (const char*)g.Bt + (size_t)cur.pn * tstep;
    S.a_ready(cur);
    if constexpr (SP2) {
        PG8_STAGE(PG8_SB(0, 0), cB, voffB); PG8_STAGE(PG8_SB(0, 1), cB + hstepB, voffB); PG8_STAGE(PG8_SA(0, 0), cA, voffA); PG8_STAGE(PG8_SA(0, 1), cA + hstep, voffA);
        if (wr == 1) PG8_BAR;
        PG8_WAIT_V(2); PG8_BAR;
        PG8_STAGE(PG8_SB(1, 0), cB + kstep, voffB); PG8_STAGE(PG8_SA(1, 0), cA + kstep, voffA); PG8_STAGE(PG8_SB(1, 1), cB + hstepB + kstep, voffB);
        PG8_WAIT_V(6); PG8_BAR;
    } else {
        PG8_STAGE(PG8_SB(0, 0), cB, voffB); PG8_STAGE(PG8_SA(0, 0), cA, voffA); PG8_STAGE(PG8_SB(0, 1), cB + hstepB, voffB); PG8_STAGE(PG8_SA(0, 1), cA + hstep, voffA);
        if (wr == 1) PG8_BAR;
        PG8_WAIT_V(4); PG8_BAR;
        PG8_STAGE(PG8_SB(1, 0), cB + kstep, voffB); PG8_STAGE(PG8_SA(1, 0), cA + kstep, voffA); PG8_STAGE(PG8_SB(1, 1), cB + hstepB + kstep, voffB);
        PG8_WAIT_V(6); PG8_BAR;
    }
    for (;;) {
        const bool has_next = S.next(ui + 1, nxt);
        const char* nA = has_next ? (const char*)g.A + (size_t)nxt.pm * tstep : cA; const char* nB = has_next ? (const char*)g.Bt + (size_t)nxt.pn * tstep : cB;
#pragma nounroll
        for (int t = 0; t < nt; t += 2) {
            const bool last = (t == nt - 2);
            const char* a1 = cA + (size_t)(t + 1) * kstep;
            const char* a2 = last ? nA : cA + (size_t)(t + 2) * kstep; const char* b2 = last ? nB : cB + (size_t)(t + 2) * kstep;
            const char* a3 = a2 + kstep; const char* b3 = b2 + kstep;
            if (last && has_next) S.a_ready(nxt);
            if constexpr (SP2) {
            PG8_LDB(B0, 0, 0); PG8_LDB(B1, 0, 1); PG8_SCHED; PG8_LDA(At, 0, 0); PG8_STAGE(PG8_SA(1, 1), a1 + hstep, voffA);
            PG8_WAIT_V(8); PG8_WAIT_L(0); PG8_BAR; PG8_MMA(0, 0, At, B0); PG8_MMA(0, 1, At, B1); PG8_BAR; PG8_SCHED;
            PG8_LDA(At, 0, 1); PG8_STAGE(PG8_SB(0, 0), b2, voffB); PG8_STAGE(PG8_SB(0, 1), b2 + hstepB, voffB); PG8_STAGE(PG8_SA(0, 0), a2, voffA);
            PG8_WAIT_V(8); PG8_WAIT_L(0); PG8_BAR; PG8_MMA(1, 0, At, B0); PG8_MMA(1, 1, At, B1); PG8_BAR; PG8_SCHED;
            PG8_LDB(B0, 1, 0); PG8_LDB(B1, 1, 1); PG8_SCHED; PG8_LDA(At, 1, 0); PG8_STAGE(PG8_SA(0, 1), a2 + hstep, voffA);
            PG8_WAIT_V(8); PG8_WAIT_L(0); PG8_BAR; PG8_MMA(0, 0, At, B0); PG8_MMA(0, 1, At, B1); PG8_BAR; PG8_SCHED;
            PG8_LDA(At, 1, 1); PG8_STAGE(PG8_SB(1, 0), b3, voffB); PG8_STAGE(PG8_SB(1, 1), b3 + hstepB, voffB); PG8_STAGE(PG8_SA(1, 0), a3, voffA);
            PG8_WAIT_V(8); PG8_WAIT_L(0); PG8_BAR; PG8_MMA(1, 0, At, B0); PG8_MMA(1, 1, At, B1); PG8_BAR; PG8_SCHED;
            } else {
            PG8_LDB(B0, 0, 0); PG8_SCHED; PG8_LDA(At, 0, 0); PG8_STAGE(PG8_SA(1, 1), a1 + hstep, voffA);
            PG8_WAIT_L(8); PG8_BAR; PG8_WAIT_L(0); PG8_MMA(0, 0, At, B0); PG8_BAR; PG8_SCHED;
            PG8_LDB(B1, 0, 1); PG8_STAGE(PG8_SB(0, 0), b2, voffB);
            PG8_BAR; PG8_WAIT_L(0); PG8_MMA(0, 1, At, B1); PG8_BAR;
            PG8_LDA(At, 0, 1); PG8_STAGE(PG8_SA(0, 0), a2, voffA);
            PG8_BAR; PG8_WAIT_L(0); PG8_MMA(1, 0, At, B0); PG8_BAR; PG8_SCHED;
            PG8_STAGE(PG8_SB(0, 1), b2 + hstepB, voffB);
            PG8_WAIT_V(6); PG8_BAR; PG8_MMA(1, 1, At, B1); PG8_BAR;
            PG8_LDB(B0, 1, 0); PG8_SCHED; PG8_LDA(At, 1, 0); PG8_STAGE(PG8_SA(0, 1), a2 + hstep, voffA);
            PG8_WAIT_L(8); PG8_BAR; PG8_WAIT_L(0); PG8_MMA(0, 0, At, B0); PG8_BAR; PG8_SCHED;
            PG8_LDB(B1, 1, 1); PG8_STAGE(PG8_SB(1, 0), b3, voffB);
            PG8_BAR; PG8_WAIT_L(0); PG8_MMA(0, 1, At, B1); PG8_BAR;
            PG8_LDA(At, 1, 1); PG8_STAGE(PG8_SA(1, 0), a3, voffA);
            PG8_BAR; PG8_WAIT_L(0); PG8_MMA(1, 0, At, B0); PG8_BAR; PG8_SCHED;
            PG8_STAGE(PG8_SB(1, 1), b3 + hstepB, voffB);
            PG8_WAIT_V(6); PG8_BAR; PG8_MMA(1, 1, At, B1); PG8_BAR;
            }
        }
        if constexpr (ALIGN_EPI) { if (wr == 0) PG8_BAR; }
        if constexpr (!Epi::AFTER_DRAIN) { E(acc, cur, wr, wc, fr, fq); if constexpr (EPI2) { asm volatile("" ::: "memory"); E(acc, cur, wr, wc, fr, fq); } S.done(cur); }
        if (!has_next) break;
#pragma unroll
        for (int a = 0; a < 2; ++a)
#pragma unroll
            for (int b = 0; b < 2; ++b)
#pragma unroll
                for (int m = 0; m < 4; ++m)
#pragma unroll
                    for (int n = 0; n < 2; ++n) acc[a][b][m][n] = (f32x4){0.f, 0.f, 0.f, 0.f};
        cur = nxt; cA = nA; cB = nB; ++ui;
        if constexpr (ALIGN_EPI) { if (wr == 1) PG8_BAR; }
    }
    PG8_WAIT_V(0);
    if constexpr (!ALIGN_EPI) { if (wr == 0) PG8_BAR; }
    PG8_BAR;
    if constexpr (Epi::AFTER_DRAIN) { E.fused(acc, cur, wr, wc, fr, fq, lds, wid, lane); S.done(cur); }
#undef PG8_SA
#undef PG8_SB
#undef PG8_STAGE
#undef PG8_LDA
#undef PG8_LDB
#undef PG8_MMA
#undef PG8_WAIT_V
#undef PG8_WAIT_L
#undef PG8_BAR
#undef PG8_SCHED
}

template <class EpiMid, class EpiFin, class Sched>
__device__ __forceinline__ void gemm_phase_ple(PG8_LAS unsigned char* lds, const bf16_t* AP, const bf16_t* BP, const bf16_t* AZ, const bf16_t* BZ, const Sched& S, const EpiMid& EM, const EpiFin& E, const int wave_u) {
    constexpr bool ALIGN_EPI = true;
    int tid_ = wave_u * 64 + lane_id_v(); asm volatile("" : "+v"(tid_));
    const int tid = tid_, wid = __builtin_amdgcn_readfirstlane(tid >> 6), lane = tid & 63, wr = wid >> 2, wc = wid & 3, fr = lane & 15, fq = lane >> 4;
    constexpr int KP = 256, KZ = 1024, NT = 20;
    unsigned vAP[2], vBP[2], vAZ[2], vBZ[2];
#pragma unroll
    for (int i = 0; i < 2; ++i) { int R, C; stage_rc(tid * 16 + i * 8192, R, C); const int Rb = (R & ~31) + perm32(R & 31);
        vAP[i] = (unsigned)(R * KP + C) * 2u; vBP[i] = (unsigned)(Rb * KP + C) * 2u; vAZ[i] = (unsigned)(R * KZ + C) * 2u; vBZ[i] = (unsigned)(Rb * KZ + C) * 2u; }
    const size_t kstep = (size_t)(BK * 2);
    const size_t hsP = (size_t)HALF * KP * 2, hsZ = (size_t)HALF * KZ * 2, tsP = 2 * hsP, tsZ = 2 * hsZ;
    const unsigned ldsw = (unsigned)wid * 1024u;
    const int aoff = lds_byte(wr * 64 + fr, fq * 8), boff = lds_byte(wc * 32 + fr, fq * 8);
#define PG8_SA(b, h) (((b) * 2 + (h)) * HTB)
#define PG8_SB(b, h) ((4 + (b) * 2 + (h)) * HTB)
#define PG8_STAGE(bufoff, gbase, voff) do { _Pragma("unroll") for (int _i = 0; _i < 2; ++_i) \
        __builtin_amdgcn_global_load_lds((const unsigned*)((const char*)(gbase) + (voff)[_i]), (PG8_LAS unsigned*)(lds + (bufoff) + ldsw + _i * 8192), 16, 0, 0); } while (0)
#define PG8_LDA(dst, b, h) do { _Pragma("unroll") for (int m = 0; m < 4; ++m) _Pragma("unroll") for (int k = 0; k < 2; ++k) dst[m][k] = *(const PG8_LAS bf16x8*)(lds + PG8_SA(b, h) + aoff + m * 2048 + k * 1024); } while (0)
#define PG8_LDB(dst, b, h) do { _Pragma("unroll") for (int n = 0; n < 2; ++n) _Pragma("unroll") for (int k = 0; k < 2; ++k) dst[n][k] = *(const PG8_LAS bf16x8*)(lds + PG8_SB(b, h) + boff + n * 2048 + k * 1024); } while (0)
#define PG8_MMA(ai, bj, At, Bt) do { __builtin_amdgcn_s_setprio(1); _Pragma("unroll") for (int m = 0; m < 4; ++m) _Pragma("unroll") for (int n = 0; n < 2; ++n) _Pragma("unroll") for (int k = 0; k < 2; ++k) \
        acc[ai][bj][m][n] = __builtin_amdgcn_mfma_f32_16x16x32_bf16(Bt[n][k], At[m][k], acc[ai][bj][m][n], 0, 0, 0); __builtin_amdgcn_s_setprio(0); } while (0)
#define PG8_WAIT_V(n) asm volatile("s_waitcnt vmcnt(" #n ")" ::: "memory")
#define PG8_WAIT_L(n) asm volatile("s_waitcnt lgkmcnt(" #n ")" ::: "memory")
#define PG8_BAR __builtin_amdgcn_s_barrier()
#define PG8_SCHED __builtin_amdgcn_sched_barrier(0)
    Unit cur, nxt; int ui = 0;
    if (!S.next(0, cur)) return;
    f32x4 acc[2][2][4][2];
#pragma unroll
    for (int a = 0; a < 2; ++a)
#pragma unroll
        for (int b = 0; b < 2; ++b)
#pragma unroll
            for (int m = 0; m < 4; ++m)
#pragma unroll
                for (int n = 0; n < 2; ++n) acc[a][b][m][n] = (f32x4){0.f, 0.f, 0.f, 0.f};
    bf16x8 At[4][2], B0[2][2], B1[2][2];
    const char* cAP = (const char*)AP + (size_t)cur.pm * tsP; const char* cBP = (const char*)BP + (size_t)cur.pn * tsP;
    const char* cAZ = (const char*)AZ + (size_t)cur.pm * tsZ; const char* cBZ = (const char*)BZ + (size_t)cur.pn * tsZ;
    S.a_ready(cur);
    PG8_STAGE(PG8_SB(0, 0), cBP, vBP); PG8_STAGE(PG8_SB(0, 1), cBP + hsP, vBP); PG8_STAGE(PG8_SA(0, 0), cAP, vAP); PG8_STAGE(PG8_SA(0, 1), cAP + hsP, vAP);
    if (wr == 1) PG8_BAR;
    PG8_WAIT_V(2); PG8_BAR;
    PG8_STAGE(PG8_SB(1, 0), cBP + kstep, vBP); PG8_STAGE(PG8_SA(1, 0), cAP + kstep, vAP); PG8_STAGE(PG8_SB(1, 1), cBP + hsP + kstep, vBP);
    PG8_WAIT_V(6); PG8_BAR;
    for (;;) {
        const bool has_next = S.next(ui + 1, nxt);
        const char* nAP = has_next ? (const char*)AP + (size_t)nxt.pm * tsP : cAP; const char* nBP = has_next ? (const char*)BP + (size_t)nxt.pn * tsP : cBP;
#pragma nounroll
        for (int t = 0; t < NT; t += 2) {
            if (t == 4) {
                EM(acc, cur, wr, wc, fr, fq);
#pragma unroll
                for (int a = 0; a < 2; ++a)
#pragma unroll
                    for (int b = 0; b < 2; ++b)
#pragma unroll
                        for (int m = 0; m < 4; ++m)
#pragma unroll
                            for (int n = 0; n < 2; ++n) acc[a][b][m][n] = (f32x4){0.f, 0.f, 0.f, 0.f};
            }
            const bool p1 = (t < 4), p23 = (t == 0) || (t == NT - 2);
            const char* a1 = p1 ? cAP + (size_t)(t + 1) * kstep : cAZ + (size_t)(t - 3) * kstep;
            const char* a2 = (t == 0) ? cAP + 2 * kstep : (t == NT - 2) ? nAP : cAZ + (size_t)(t - 2) * kstep;
            const char* b2 = (t == 0) ? cBP + 2 * kstep : (t == NT - 2) ? nBP : cBZ + (size_t)(t - 2) * kstep;
            const char* a3 = a2 + kstep; const char* b3 = b2 + kstep;
            const size_t hstep1 = p1 ? hsP : hsZ, hstep = p23 ? hsP : hsZ, hstepB = hstep;
            unsigned voffA1[2], voffA[2], voffB[2];
#pragma unroll
            for (int i = 0; i < 2; ++i) { voffA1[i] = p1 ? vAP[i] : vAZ[i]; voffA[i] = p23 ? vAP[i] : vAZ[i]; voffB[i] = p23 ? vBP[i] : vBZ[i]; }
            if (t == NT - 2 && has_next) S.a_ready(nxt);
            PG8_LDB(B0, 0, 0); PG8_LDB(B1, 0, 1); PG8_SCHED; PG8_LDA(At, 0, 0); PG8_STAGE(PG8_SA(1, 1), a1 + hstep1, voffA1);
            PG8_WAIT_V(8); PG8_WAIT_L(0); PG8_BAR; PG8_MMA(0, 0, At, B0); PG8_MMA(0, 1, At, B1); PG8_BAR; PG8_SCHED;
            PG8_LDA(At, 0, 1); PG8_STAGE(PG8_SB(0, 0), b2, voffB); PG8_STAGE(PG8_SB(0, 1), b2 + hstepB, voffB); PG8_STAGE(PG8_SA(0, 0), a2, voffA);
            PG8_WAIT_V(8); PG8_WAIT_L(0); PG8_BAR; PG8_MMA(1, 0, At, B0); PG8_MMA(1, 1, At, B1); PG8_BAR; PG8_SCHED;
            PG8_LDB(B0, 1, 0); PG8_LDB(B1, 1, 1); PG8_SCHED; PG8_LDA(At, 1, 0); PG8_STAGE(PG8_SA(0, 1), a2 + hstep, voffA);
            PG8_WAIT_V(8); PG8_WAIT_L(0); PG8_BAR; PG8_MMA(0, 0, At, B0); PG8_MMA(0, 1, At, B1); PG8_BAR; PG8_SCHED;
            PG8_LDA(At, 1, 1); PG8_STAGE(PG8_SB(1, 0), b3, voffB); PG8_STAGE(PG8_SB(1, 1), b3 + hstepB, voffB); PG8_STAGE(PG8_SA(1, 0), a3, voffA);
            PG8_WAIT_V(8); PG8_WAIT_L(0); PG8_BAR; PG8_MMA(1, 0, At, B0); PG8_MMA(1, 1, At, B1); PG8_BAR; PG8_SCHED;
        }
        if constexpr (ALIGN_EPI) { if (wr == 0) PG8_BAR; }
        E(acc, cur, wr, wc, fr, fq); S.done(cur);
        if (!has_next) break;
#pragma unroll
        for (int a = 0; a < 2; ++a)
#pragma unroll
            for (int b = 0; b < 2; ++b)
#pragma unroll
                for (int m = 0; m < 4; ++m)
#pragma unroll
                    for (int n = 0; n < 2; ++n) acc[a][b][m][n] = (f32x4){0.f, 0.f, 0.f, 0.f};
        cur = nxt; cAP = nAP; cBP = nBP; cAZ = (const char*)AZ + (size_t)cur.pm * tsZ; cBZ = (const char*)BZ + (size_t)cur.pn * tsZ; ++ui;
        if constexpr (ALIGN_EPI) { if (wr == 1) PG8_BAR; }
    }
    PG8_WAIT_V(0);
    if constexpr (!ALIGN_EPI) { if (wr == 0) PG8_BAR; }
    PG8_BAR;
#undef PG8_SA
#undef PG8_SB
#undef PG8_STAGE
#undef PG8_LDA
#undef PG8_LDB
#undef PG8_MMA
#undef PG8_WAIT_V
#undef PG8_WAIT_L
#undef PG8_BAR
#undef PG8_SCHED
}
}
#ifndef PG8_SP2
#define PG8_SP2 true
#endif
#ifndef PG8_ALIGN
#define PG8_ALIGN true
#endif
using pg8::bf16_t; using pg8::bf16x8; using pg8::f32x4; using pg8::u32x4;
#define LAS __attribute__((address_space(3)))
typedef float f32x2 __attribute__((ext_vector_type(2)));
typedef float f32x16 __attribute__((ext_vector_type(16)));
typedef unsigned u32x2 __attribute__((ext_vector_type(2)));
typedef __bf16 bf16x2_t __attribute__((ext_vector_type(2)));

constexpr int T_ = 65536, DM_ = 1024, SEQ_ = 8192, PJW = 2048, FF_ = 4096, PLE_ = 256, NUNIT_ATT = 1024, NUNIT_LRU = 256;
constexpr float EPS_ = 1e-6f, LOG2E = 1.4426950408889634f, QSCALE = 0.125f * 1.4426950408889634f;
constexpr int NWAVES = 8, NTHR = 512;
constexpr int RING_BYTES = 131072, SSL_OFF = RING_BYTES, MISC_OFF = 147456 - 64, LDS_BYTES = 147456;
constexpr size_t MiB = 1u << 20;
constexpr size_t WS_WIN = 0, WS_WOUT = 5 * MiB, WS_WUP = 7 * MiB, WS_WDN = 15 * MiB, WS_WPG = 23 * MiB, WS_WPP = 25 * MiB, WS_WG = 25 * MiB + 512 * 1024;
constexpr size_t WS_RSTD1 = 27 * MiB, WS_RSTD2 = 27 * MiB + 256 * 1024, WS_DUMMY = 27 * MiB + 512 * 1024, WS_RINV0 = 27 * MiB + 768 * 1024, WS_SUMM = 28 * MiB;
constexpr size_t WS_CTL = 31 * MiB, CTL_BYTES = 16384;
constexpr size_t WS_XN = 32 * MiB;
constexpr size_t WS_PP = 160 * MiB;
constexpr size_t WS_PB = 288 * MiB;
constexpr size_t WS_PROJ = 320 * MiB;
constexpr size_t WS_VT = 576 * MiB;
constexpr size_t WS_MERGED = 640 * MiB;
constexpr size_t WS_ACT = 320 * MiB;
constexpr size_t WS_END = 832 * MiB;

__device__ __forceinline__ unsigned cvtpk(float lo, float hi) { f32x2 v = {lo, hi}; bf16x2_t b = __builtin_convertvector(v, bf16x2_t); return __builtin_bit_cast(unsigned, b); }
__device__ __forceinline__ float bf2f(unsigned short u) { return __uint_as_float((unsigned)u << 16); }
__device__ __forceinline__ float bflo(unsigned w) { return __uint_as_float(w << 16); }
__device__ __forceinline__ float bfhi(unsigned w) { return __uint_as_float(w & 0xffff0000u); }
__device__ __forceinline__ float ex2(float x) { return __builtin_amdgcn_exp2f(x); }
__device__ __forceinline__ float rcpf_(float x) { return __builtin_amdgcn_rcpf(x); }
__device__ __forceinline__ float rsqf_(float x) { return __builtin_amdgcn_rsqf(x); }
__device__ __forceinline__ float sigm(float z) { return rcpf_(1.f + ex2(-LOG2E * z)); }
__device__ __forceinline__ float gelu_tanh(float g) { const float z = 0.7978845608028654f * (g + 0.044715f * g * g * g); return g * sigm(2.f * z); }
__device__ __forceinline__ float wave_sum(float v) {
#pragma unroll
    for (int o = 1; o < 64; o <<= 1) v += __shfl_xor(v, o);
    return v;
}
__device__ __forceinline__ float wave_max(float v) {
#pragma unroll
    for (int o = 1; o < 64; o <<= 1) v = fmaxf(v, __shfl_xor(v, o));
    return v;
}
__device__ __forceinline__ int crow(int r, int hi) { return (r & 3) + 8 * (r >> 2) + 4 * hi; }
#define MFMA32(a, b, c) __builtin_amdgcn_mfma_f32_32x32x16_bf16((a), (b), (c), 0, 0, 0)

#define RLX_AGENT __ATOMIC_RELAXED, __HIP_MEMORY_SCOPE_AGENT
#define XB_TMO      128
#define XB_XCNT(j)  (256  + 64 * (j))
#define XB_XSUB(j)  (1280 + 64 * (j))
#define XB_XGEN(j)  (2304 + 64 * (j))
#define XB_TOP      3328
#define XB_TOPGEN   3392
#define XCD_BAR_WORDS 3456
#define XB_SPIN_CAP (1u << 18)

__device__ __forceinline__ unsigned xb_ld(unsigned* p)              { return __hip_atomic_load(p, __ATOMIC_RELAXED, __HIP_MEMORY_SCOPE_AGENT); }
__device__ __forceinline__ unsigned xb_add(unsigned* p, unsigned v) { return __hip_atomic_fetch_add(p, v, __ATOMIC_RELAXED, __HIP_MEMORY_SCOPE_AGENT); }
__device__ __forceinline__ unsigned xb_xcc_id() { return (unsigned)__builtin_amdgcn_s_getreg((3 << 11) | 20) & 0xFu; }
#define XB_SPIN(cond, bar) do { unsigned _sp = 0; while (cond) { __builtin_amdgcn_s_sleep(1); \
    if ((++_sp & 255u) == 0u) { if (xb_ld(&(bar)[XB_TMO])) break; if (_sp > XB_SPIN_CAP) { atomicAdd(&(bar)[XB_TMO], 1u); break; } } } } while (0)

struct XcdBarrier {
    unsigned* bar; unsigned x;
    volatile LAS unsigned* st;
};

__device__ __forceinline__ XcdBarrier xcd_barrier_post(unsigned* bar, volatile LAS unsigned* st) {
    XcdBarrier b; b.bar = bar; b.x = xb_xcc_id(); b.st = st;
    if (threadIdx.x == 0) (void)xb_add(&bar[XB_XCNT(b.x)], 1u);
    return b;
}
__device__ __forceinline__ void xcd_barrier_complete(unsigned* bar, unsigned x, unsigned& nloc, unsigned& nx) {
    const unsigned G = gridDim.x * gridDim.y * gridDim.z;
    unsigned sum, cnt, mine, sp = 0u;
    for (;;) {
        sum = 0u; cnt = 0u; mine = 0u;
#pragma unroll
        for (unsigned j = 0; j < 16; ++j) { const unsigned c = xb_ld(&bar[XB_XCNT(j)]); sum += c; cnt += (c > 0u) ? 1u : 0u; mine = (j == x) ? c : mine; }
        if (sum == G) break;
        __builtin_amdgcn_s_sleep(1);
        if ((++sp & 255u) == 0u) { if (xb_ld(&bar[XB_TMO])) break; if (sp > XB_SPIN_CAP) { atomicAdd(&bar[XB_TMO], 1u); break; } }
    }
    nloc = mine > 0u ? mine : 1u; nx = cnt > 0u ? cnt : 1u;
}

__device__ __forceinline__ void xcd_barrier(const XcdBarrier& b) {
    asm volatile("s_waitcnt vmcnt(0)" ::: "memory");
    __syncthreads();
    if (threadIdx.x == 0) {
        unsigned* bar = b.bar;
        __builtin_amdgcn_s_waitcnt(0);
        unsigned nloc = b.st[0], nx = b.st[1];
        if (nloc == 0u) { xcd_barrier_complete(bar, b.x, nloc, nx); b.st[0] = nloc; b.st[1] = nx; }
        const unsigned old = xb_add(&bar[XB_XSUB(b.x)], 1u);
        const unsigned gen = old / nloc;
        if (old + 1u == (gen + 1u) * nloc) {
            __builtin_amdgcn_fence(__ATOMIC_RELEASE, "agent");
            asm volatile("s_waitcnt vmcnt(0)" ::: "memory");
            const unsigned og = xb_add(&bar[XB_TOP], 1u);
            const unsigned tg = og / nx;
            if (og + 1u == (tg + 1u) * nx) xb_add(&bar[XB_TOPGEN], 1u);
            else XB_SPIN(xb_ld(&bar[XB_TOPGEN]) == tg, bar);
            __builtin_amdgcn_fence(__ATOMIC_ACQUIRE, "agent");
            xb_add(&bar[XB_XGEN(b.x)], 1u);
            asm volatile("s_waitcnt vmcnt(0)" ::: "memory");
        } else {
            XB_SPIN(xb_ld(&bar[XB_XGEN(b.x)]) == gen, bar);
            __builtin_amdgcn_fence(__ATOMIC_ACQUIRE, "agent");
            asm volatile("s_waitcnt vmcnt(0)" ::: "memory");
        }
    }
    __syncthreads();
}

struct PanelOrder {
    int pm;
    __device__ bool next(int i, pg8::Unit& u) const { if (i >= 4) return false; u.pm = pm; u.pn = i; return true; }
    __device__ __forceinline__ void a_ready(const pg8::Unit&) const {}
    __device__ __forceinline__ void done(const pg8::Unit&) const {}
};

struct EpiPlain {
    static constexpr bool PERM = true, AFTER_DRAIN = false, HEADMAP = false;
    bf16_t* O; int ldc;
    __device__ __forceinline__ void operator()(const f32x4 (&acc)[2][2][4][2], const pg8::Unit& u, int wr, int wc, int fr, int fq) const {
        const int row0 = u.pm * 256 + wr * 64 + fr, col0 = u.pn * 256 + wc * 32 + 8 * fq;
#pragma unroll
        for (int ai = 0; ai < 2; ++ai)
#pragma unroll
            for (int m = 0; m < 4; ++m) { bf16_t* rowp = O + (size_t)(row0 + ai * 128 + m * 16) * ldc + col0;
#pragma unroll
                for (int bj = 0; bj < 2; ++bj) { const f32x4 v0 = acc[ai][bj][m][0], v1 = acc[ai][bj][m][1];
                    u32x4 w; w.x = cvtpk(v0[0], v0[1]); w.y = cvtpk(v0[2], v0[3]); w.z = cvtpk(v1[0], v1[1]); w.w = cvtpk(v1[2], v1[3]);
                    *(u32x4*)(rowp + bj * 128) = w; } }
    }
};
struct EpiVT {
    static constexpr bool PERM = true, AFTER_DRAIN = false, HEADMAP = false;
    bf16_t* O;
    __device__ __forceinline__ void operator()(const f32x4 (&acc)[2][2][4][2], const pg8::Unit& u, int wr, int wc, int fr, int fq) const {
        const int row0 = u.pm * 256 + wr * 64 + fr, col0 = u.pn * 256 + wc * 32 + 16 * (fq >> 1) + 4 * (fq & 1);
#pragma unroll
        for (int ai = 0; ai < 2; ++ai)
#pragma unroll
            for (int m = 0; m < 4; ++m) { bf16_t* rowp = O + (size_t)(row0 + ai * 128 + m * 16) * T_ + col0;
#pragma unroll
                for (int bj = 0; bj < 2; ++bj)
#pragma unroll
                    for (int n = 0; n < 2; ++n) { const f32x4 v = acc[ai][bj][m][n]; u32x2 w; w.x = cvtpk(v[0], v[1]); w.y = cvtpk(v[2], v[3]);
                        *(u32x2*)(rowp + bj * 128 + 8 * n) = w; } }
    }
};
struct EpiProj {
    static constexpr bool PERM = true, AFTER_DRAIN = false, HEADMAP = true;
    bf16_t* O; const float* gq; const float* gk;
    __device__ __forceinline__ void operator()(const f32x4 (&acc)[2][2][4][2], const pg8::Unit& u, int wr, int wc, int fr, int fq) const {
        const int row0 = u.pm * 256 + wr * 64 + fr, col0 = u.pn * 256 + wc * 64 + 8 * fq, kind = u.pn >> 1;
        f32x4 gv[2][2];
        if (kind >= 2) { const float* g = (kind == 2) ? gq : gk; const float sc = (kind == 2) ? QSCALE : 1.f;
#pragma unroll
            for (int bj = 0; bj < 2; ++bj)
#pragma unroll
                for (int n = 0; n < 2; ++n) gv[bj][n] = *(const f32x4*)(g + 32 * bj + 8 * fq + 4 * n) * sc; }
#pragma unroll
        for (int ai = 0; ai < 2; ++ai)
#pragma unroll
            for (int m = 0; m < 4; ++m) { bf16_t* rowp = O + (size_t)(row0 + ai * 128 + m * 16) * PJW + col0;
                f32x4 v[2][2];
#pragma unroll
                for (int bj = 0; bj < 2; ++bj)
#pragma unroll
                    for (int n = 0; n < 2; ++n) v[bj][n] = acc[ai][bj][m][n];
                if (kind == 1) {
#pragma unroll
                    for (int bj = 0; bj < 2; ++bj)
#pragma unroll
                        for (int n = 0; n < 2; ++n)
#pragma unroll
                            for (int e = 0; e < 4; ++e) v[bj][n][e] = gelu_tanh(v[bj][n][e]);
                } else if (kind >= 2) {
                    float ss = 0.f;
#pragma unroll
                    for (int bj = 0; bj < 2; ++bj)
#pragma unroll
                        for (int n = 0; n < 2; ++n) { const f32x4 x = v[bj][n]; ss += (x[0] * x[0] + x[1] * x[1]) + (x[2] * x[2] + x[3] * x[3]); }
                    ss += __shfl_xor(ss, 16); ss += __shfl_xor(ss, 32);
                    const float rstd = rsqf_(ss * (1.f / 64.f) + EPS_);
#pragma unroll
                    for (int bj = 0; bj < 2; ++bj)
#pragma unroll
                        for (int n = 0; n < 2; ++n) v[bj][n] = v[bj][n] * gv[bj][n] * rstd;
                }
#pragma unroll
                for (int bj = 0; bj < 2; ++bj) { const f32x4 v0 = v[bj][0], v1 = v[bj][1];
                    u32x4 w; w.x = cvtpk(v0[0], v0[1]); w.y = cvtpk(v0[2], v0[3]); w.z = cvtpk(v1[0], v1[1]); w.w = cvtpk(v1[2], v1[3]);
                    *(u32x4*)(rowp + bj * 32) = w; } }
    }
};
struct EpiRes {
    static constexpr bool PERM = true, AFTER_DRAIN = false, HEADMAP = false;
    const float* base; float* out; bf16_t* hb; float* ssq; int rowmask;
    __device__ __forceinline__ void operator()(const f32x4 (&acc)[2][2][4][2], const pg8::Unit& u, int wr, int wc, int fr, int fq) const {
        const int row0 = u.pm * 256 + wr * 64 + fr, col0 = u.pn * 256 + wc * 32 + 8 * fq;
#pragma unroll
        for (int ai = 0; ai < 2; ++ai)
#pragma unroll
            for (int m = 0; m < 4; ++m) { const size_t off = (size_t)(row0 + ai * 128 + m * 16) * DM_ + col0; const size_t ooff = (size_t)((row0 + ai * 128 + m * 16) & rowmask) * DM_ + col0; float ss = 0.f;
#pragma unroll
                for (int bj = 0; bj < 2; ++bj) {
                    const f32x4 b0 = *(const f32x4*)(base + off + bj * 128), b1 = *(const f32x4*)(base + off + bj * 128 + 4);
                    const f32x4 v0 = b0 + acc[ai][bj][m][0], v1 = b1 + acc[ai][bj][m][1];
                    ss += (v0[0] * v0[0] + v0[1] * v0[1]) + (v0[2] * v0[2] + v0[3] * v0[3]) + (v1[0] * v1[0] + v1[1] * v1[1]) + (v1[2] * v1[2] + v1[3] * v1[3]);
                    *(f32x4*)(out + ooff + bj * 128) = v0; *(f32x4*)(out + ooff + bj * 128 + 4) = v1;
                    u32x4 w; w.x = cvtpk(v0[0], v0[1]); w.y = cvtpk(v0[2], v0[3]); w.z = cvtpk(v1[0], v1[1]); w.w = cvtpk(v1[2], v1[3]);
                    *(u32x4*)(hb + off + bj * 128) = w; }
                ss += __shfl_xor(ss, 16); ss += __shfl_xor(ss, 32);
                if (fq == 0) __hip_atomic_fetch_add(ssq + row0 + ai * 128 + m * 16, ss, __ATOMIC_RELAXED, __HIP_MEMORY_SCOPE_AGENT);
                asm volatile("" ::: "memory"); }
    }
};
struct EpiUp {
    static constexpr bool PERM = true, AFTER_DRAIN = false, HEADMAP = false;
    bf16_t* O; const float* rstd;
    __device__ __forceinline__ void operator()(const f32x4 (&acc)[2][2][4][2], const pg8::Unit& u, int wr, int wc, int fr, int fq) const {
        const int row0 = u.pm * 256 + wr * 64 + fr, col0 = u.pn * 256 + wc * 32 + 8 * fq;
#pragma unroll
        for (int ai = 0; ai < 2; ++ai)
#pragma unroll
            for (int m = 0; m < 4; ++m) { const int row = row0 + ai * 128 + m * 16; const float rs = rsqf_(rstd[row] * (1.f / DM_) + EPS_); bf16_t* rowp = O + (size_t)row * FF_ + col0;
#pragma unroll
                for (int bj = 0; bj < 2; ++bj) { f32x4 v0 = acc[ai][bj][m][0] * rs, v1 = acc[ai][bj][m][1] * rs;
#pragma unroll
                    for (int e = 0; e < 4; ++e) { const float a = fmaxf(v0[e], 0.f), b = fmaxf(v1[e], 0.f); v0[e] = a * a; v1[e] = b * b; }
                    u32x4 w; w.x = cvtpk(v0[0], v0[1]); w.y = cvtpk(v0[2], v0[3]); w.z = cvtpk(v1[0], v1[1]); w.w = cvtpk(v1[2], v1[3]);
                    *(u32x4*)(rowp + bj * 128) = w; } }
    }
};
struct EpiFinal {
    static constexpr bool PERM = true, AFTER_DRAIN = false, HEADMAP = false;
    const float* hin; float* out; const bf16_t* pp; const float* rstd;
    __device__ __forceinline__ void operator()(const f32x4 (&acc)[2][2][4][2], const pg8::Unit& u, int wr, int wc, int fr, int fq) const {
        const int row0 = u.pm * 256 + wr * 64 + fr, col0 = u.pn * 256 + wc * 32 + 8 * fq;
#pragma unroll
        for (int ai = 0; ai < 2; ++ai)
#pragma unroll
            for (int m = 0; m < 4; ++m) { const int row = row0 + ai * 128 + m * 16; const float rs = rsqf_(rstd[row] * (1.f / DM_) + EPS_); const size_t off = (size_t)row * DM_ + col0;
#pragma unroll
                for (int bj = 0; bj < 2; ++bj) {
                    const f32x4 h0 = *(const f32x4*)(hin + off + bj * 128), h1 = *(const f32x4*)(hin + off + bj * 128 + 4);
                    const u32x4 pw = *(const u32x4*)(pp + off + bj * 128);
                    const f32x4 a0 = acc[ai][bj][m][0] * rs, a1 = acc[ai][bj][m][1] * rs;
                    f32x4 o0, o1;
                    o0[0] = h0[0] + sigm(a0[0]) * bflo(pw.x); o0[1] = h0[1] + sigm(a0[1]) * bfhi(pw.x); o0[2] = h0[2] + sigm(a0[2]) * bflo(pw.y); o0[3] = h0[3] + sigm(a0[3]) * bfhi(pw.y);
                    o1[0] = h1[0] + sigm(a1[0]) * bflo(pw.z); o1[1] = h1[1] + sigm(a1[1]) * bfhi(pw.z); o1[2] = h1[2] + sigm(a1[2]) * bflo(pw.w); o1[3] = h1[3] + sigm(a1[3]) * bfhi(pw.w);
                    *(f32x4*)(out + off + bj * 128) = o0; *(f32x4*)(out + off + bj * 128 + 4) = o1; }
                asm volatile("" ::: "memory"); }
    }
};


struct EpiRes4 {
    static constexpr bool PERM = true, AFTER_DRAIN = false, HEADMAP = false;
    const float* base; bf16_t* hb; float* ssq;
    __device__ __forceinline__ void operator()(const f32x4 (&acc)[2][2][4][2], const pg8::Unit& u, int wr, int wc, int fr, int fq) const {
        const int row0 = u.pm * 256 + wr * 64 + fr, col0 = u.pn * 256 + wc * 32 + 8 * fq;
        f32x4 X[8][2][2];
#define E4_LD(g) do { const size_t off_ = (size_t)(row0 + ((g) >> 2) * 128 + ((g) & 3) * 16) * DM_ + col0; \
        _Pragma("unroll") for (int bj = 0; bj < 2; ++bj) { X[g][bj][0] = *(const f32x4*)(base + off_ + bj * 128); X[g][bj][1] = *(const f32x4*)(base + off_ + bj * 128 + 4); } } while (0)
        E4_LD(0); E4_LD(1); E4_LD(2); E4_LD(3);
        asm volatile("" ::: "memory");
#pragma unroll
        for (int g = 0; g < 8; ++g) { const int ai = g >> 2, m = g & 3; const size_t off = (size_t)(row0 + ai * 128 + m * 16) * DM_ + col0; float ss = 0.f;
#pragma unroll
            for (int bj = 0; bj < 2; ++bj) {
                const f32x4 v0 = X[g][bj][0] + acc[ai][bj][m][0], v1 = X[g][bj][1] + acc[ai][bj][m][1];
                ss += (v0[0] * v0[0] + v0[1] * v0[1]) + (v0[2] * v0[2] + v0[3] * v0[3]) + (v1[0] * v1[0] + v1[1] * v1[1]) + (v1[2] * v1[2] + v1[3] * v1[3]);
                u32x4 w; w.x = cvtpk(v0[0], v0[1]); w.y = cvtpk(v0[2], v0[3]); w.z = cvtpk(v1[0], v1[1]); w.w = cvtpk(v1[2], v1[3]);
                *(u32x4*)(hb + off + bj * 128) = w; }
            ss += __shfl_xor(ss, 16); ss += __shfl_xor(ss, 32);
            if (fq == 0) __hip_atomic_fetch_add(ssq + row0 + ai * 128 + m * 16, ss, __ATOMIC_RELAXED, __HIP_MEMORY_SCOPE_AGENT);
            if (g + 4 < 8) { E4_LD(g + 4); }
            asm volatile("" ::: "memory"); }
#undef E4_LD
    }
};
struct EpiRes4b {
    static constexpr bool PERM = true, AFTER_DRAIN = false, HEADMAP = false;
    bf16_t* hb; const float* rinv0; const float* g1; float* ssq;
    __device__ __forceinline__ void operator()(const f32x4 (&acc)[2][2][4][2], const pg8::Unit& u, int wr, int wc, int fr, int fq) const {
        const int row0 = u.pm * 256 + wr * 64 + fr, col0 = u.pn * 256 + wc * 32 + 8 * fq;
        f32x4 gi[2][2];
#pragma unroll
        for (int bj = 0; bj < 2; ++bj)
#pragma unroll
            for (int n = 0; n < 2; ++n) { const f32x4 gv = *(const f32x4*)(g1 + col0 + bj * 128 + 4 * n); gi[bj][n] = (f32x4){rcpf_(gv[0]), rcpf_(gv[1]), rcpf_(gv[2]), rcpf_(gv[3])}; }
        u32x4 H[8][2]; float RI[8];
#define E4_LD(g) do { const int row_ = row0 + ((g) >> 2) * 128 + ((g) & 3) * 16; const size_t off_ = (size_t)row_ * DM_ + col0; RI[g] = rinv0[row_]; \
        _Pragma("unroll") for (int bj = 0; bj < 2; ++bj) H[g][bj] = *(const u32x4*)(hb + off_ + bj * 128); } while (0)
        E4_LD(0); E4_LD(1); E4_LD(2); E4_LD(3);
        asm volatile("" ::: "memory");
#pragma unroll
        for (int g = 0; g < 8; ++g) { const int ai = g >> 2, m = g & 3; const size_t off = (size_t)(row0 + ai * 128 + m * 16) * DM_ + col0; float ss = 0.f; const float ri = RI[g];
#pragma unroll
            for (int bj = 0; bj < 2; ++bj) { const u32x4 hw = H[g][bj];
                const f32x4 x0 = (f32x4){bflo(hw.x), bfhi(hw.x), bflo(hw.y), bfhi(hw.y)} * gi[bj][0] * ri, x1 = (f32x4){bflo(hw.z), bfhi(hw.z), bflo(hw.w), bfhi(hw.w)} * gi[bj][1] * ri;
                const f32x4 v0 = x0 + acc[ai][bj][m][0], v1 = x1 + acc[ai][bj][m][1];
                ss += (v0[0] * v0[0] + v0[1] * v0[1]) + (v0[2] * v0[2] + v0[3] * v0[3]) + (v1[0] * v1[0] + v1[1] * v1[1]) + (v1[2] * v1[2] + v1[3] * v1[3]);
                u32x4 w; w.x = cvtpk(v0[0], v0[1]); w.y = cvtpk(v0[2], v0[3]); w.z = cvtpk(v1[0], v1[1]); w.w = cvtpk(v1[2], v1[3]);
                *(u32x4*)(hb + off + bj * 128) = w; }
            ss += __shfl_xor(ss, 16); ss += __shfl_xor(ss, 32);
            if (fq == 0) __hip_atomic_fetch_add(ssq + row0 + ai * 128 + m * 16, ss, __ATOMIC_RELAXED, __HIP_MEMORY_SCOPE_AGENT);
            if (g + 4 < 8) { E4_LD(g + 4); }
            asm volatile("" ::: "memory"); }
#undef E4_LD
    }
};
struct EpiRes6 {
    static constexpr bool PERM = true, AFTER_DRAIN = false, HEADMAP = false;
    bf16_t* hb; float* ssq;
    __device__ __forceinline__ void operator()(const f32x4 (&acc)[2][2][4][2], const pg8::Unit& u, int wr, int wc, int fr, int fq) const {
        const int row0 = u.pm * 256 + wr * 64 + fr, col0 = u.pn * 256 + wc * 32 + 8 * fq;
        u32x4 H[8][2];
#define E6_LD(g) do { const size_t off_ = (size_t)(row0 + ((g) >> 2) * 128 + ((g) & 3) * 16) * DM_ + col0; \
        _Pragma("unroll") for (int bj = 0; bj < 2; ++bj) H[g][bj] = *(const u32x4*)(hb + off_ + bj * 128); } while (0)
        E6_LD(0); E6_LD(1); E6_LD(2); E6_LD(3);
        asm volatile("" ::: "memory");
#pragma unroll
        for (int g = 0; g < 8; ++g) { const int ai = g >> 2, m = g & 3; const size_t off = (size_t)(row0 + ai * 128 + m * 16) * DM_ + col0; float ss = 0.f;
#pragma unroll
            for (int bj = 0; bj < 2; ++bj) { const u32x4 hw = H[g][bj];
                const f32x4 b0 = {bflo(hw.x), bfhi(hw.x), bflo(hw.y), bfhi(hw.y)}, b1 = {bflo(hw.z), bfhi(hw.z), bflo(hw.w), bfhi(hw.w)};
                const f32x4 v0 = b0 + acc[ai][bj][m][0], v1 = b1 + acc[ai][bj][m][1];
                ss += (v0[0] * v0[0] + v0[1] * v0[1]) + (v0[2] * v0[2] + v0[3] * v0[3]) + (v1[0] * v1[0] + v1[1] * v1[1]) + (v1[2] * v1[2] + v1[3] * v1[3]);
                u32x4 w; w.x = cvtpk(v0[0], v0[1]); w.y = cvtpk(v0[2], v0[3]); w.z = cvtpk(v1[0], v1[1]); w.w = cvtpk(v1[2], v1[3]);
                *(u32x4*)(hb + off + bj * 128) = w; }
            ss += __shfl_xor(ss, 16); ss += __shfl_xor(ss, 32);
            if (fq == 0) __hip_atomic_fetch_add(ssq + row0 + ai * 128 + m * 16, ss, __ATOMIC_RELAXED, __HIP_MEMORY_SCOPE_AGENT);
            if (g + 4 < 8) { E6_LD(g + 4); }
            asm volatile("" ::: "memory"); }
#undef E6_LD
    }
};
struct EpiFinalB {
    static constexpr bool PERM = true, AFTER_DRAIN = false, HEADMAP = false;
    const bf16_t* hb; float* out; const bf16_t* pp; const float* rstd;
    __device__ __forceinline__ void operator()(const f32x4 (&acc)[2][2][4][2], const pg8::Unit& u, int wr, int wc, int fr, int fq) const {
        const int row0 = u.pm * 256 + wr * 64 + fr, col0 = u.pn * 256 + wc * 32 + 8 * fq;
        u32x4 H[8][2], P[8][2]; float RS[8];
#define EF_LD(g) do { const int row_ = row0 + ((g) >> 2) * 128 + ((g) & 3) * 16; const size_t off_ = (size_t)row_ * DM_ + col0; RS[g] = rstd[row_]; \
        _Pragma("unroll") for (int bj = 0; bj < 2; ++bj) { H[g][bj] = *(const u32x4*)(hb + off_ + bj * 128); P[g][bj] = *(const u32x4*)(pp + off_ + bj * 128); } } while (0)
        EF_LD(0); EF_LD(1); EF_LD(2); EF_LD(3);
        asm volatile("" ::: "memory");
#pragma unroll
        for (int g = 0; g < 8; ++g) { const int ai = g >> 2, m = g & 3; const size_t off = (size_t)(row0 + ai * 128 + m * 16) * DM_ + col0; const float rs = rsqf_(RS[g] * (1.f / DM_) + EPS_);
#pragma unroll
            for (int bj = 0; bj < 2; ++bj) { const u32x4 hw = H[g][bj], pw = P[g][bj];
                const f32x4 a0 = acc[ai][bj][m][0] * rs, a1 = acc[ai][bj][m][1] * rs;
                f32x4 o0, o1;
                o0[0] = bflo(hw.x) + sigm(a0[0]) * bflo(pw.x); o0[1] = bfhi(hw.x) + sigm(a0[1]) * bfhi(pw.x); o0[2] = bflo(hw.y) + sigm(a0[2]) * bflo(pw.y); o0[3] = bfhi(hw.y) + sigm(a0[3]) * bfhi(pw.y);
                o1[0] = bflo(hw.z) + sigm(a1[0]) * bflo(pw.z); o1[1] = bfhi(hw.z) + sigm(a1[1]) * bfhi(pw.z); o1[2] = bflo(hw.w) + sigm(a1[2]) * bflo(pw.w); o1[3] = bfhi(hw.w) + sigm(a1[3]) * bfhi(pw.w);
                *(f32x4*)(out + off + bj * 128) = o0; *(f32x4*)(out + off + bj * 128 + 4) = o1; }
            if (g + 4 < 8) { EF_LD(g + 4); }
            asm volatile("" ::: "memory"); }
#undef EF_LD
    }
};

struct EpiMidPP {
    u32x4* park;
    __device__ __forceinline__ void operator()(const f32x4 (&acc)[2][2][4][2], const pg8::Unit& u, int wr, int wc, int fr, int fq) const {
        asm volatile("" : "+v"(fr), "+v"(fq));
        const unsigned pko_ = (unsigned)((wr * 4 + wc) * 64 + fq * 16 + fr);
#pragma unroll
        for (int ai = 0; ai < 2; ++ai)
#pragma unroll
            for (int m = 0; m < 4; ++m)
#pragma unroll
                for (int bj = 0; bj < 2; ++bj) { const f32x4 v0 = acc[ai][bj][m][0], v1 = acc[ai][bj][m][1];
                    u32x4 w; w.x = cvtpk(v0[0], v0[1]); w.y = cvtpk(v0[2], v0[3]); w.z = cvtpk(v1[0], v1[1]); w.w = cvtpk(v1[2], v1[3]);
                    park[pko_ + (unsigned)((((ai * 4 + m) * 2 + bj) * 8) * 64)] = w; }
    }
};
struct EpiFinalC {
    const bf16_t* hb; float* out; const float* rstd; const u32x4* park;
    __device__ __forceinline__ void operator()(const f32x4 (&acc)[2][2][4][2], const pg8::Unit& u, int wr, int wc, int fr, int fq) const {
        asm volatile("" : "+v"(fr), "+v"(fq));
        const int row0 = u.pm * 256 + wr * 64 + fr, col0 = u.pn * 256 + wc * 32 + 8 * fq;
        const unsigned pko_ = (unsigned)((wr * 4 + wc) * 64 + fq * 16 + fr);
        u32x4 H[8][2], P[8][2]; float RS[8];
#define EF_LD(g) do { const int row_ = row0 + ((g) >> 2) * 128 + ((g) & 3) * 16; const size_t off_ = (size_t)row_ * DM_ + col0; RS[g] = rstd[row_]; \
        _Pragma("unroll") for (int bj = 0; bj < 2; ++bj) { H[g][bj] = *(const u32x4*)(hb + off_ + bj * 128); P[g][bj] = park[pko_ + (unsigned)((((g) * 2 + bj) * 8) * 64)]; } } while (0)
        EF_LD(0); EF_LD(1); EF_LD(2); EF_LD(3);
        asm volatile("" ::: "memory");
#pragma unroll
        for (int g = 0; g < 8; ++g) { const int ai = g >> 2, m = g & 3; const size_t off = (size_t)(row0 + ai * 128 + m * 16) * DM_ + col0; const float rs = rsqf_(RS[g] * (1.f / DM_) + EPS_);
#pragma unroll
            for (int bj = 0; bj < 2; ++bj) { const u32x4 hw = H[g][bj], pw = P[g][bj];
                const f32x4 a0 = acc[ai][bj][m][0] * rs, a1 = acc[ai][bj][m][1] * rs;
                f32x4 o0, o1;
                o0[0] = bflo(hw.x) + sigm(a0[0]) * bflo(pw.x); o0[1] = bfhi(hw.x) + sigm(a0[1]) * bfhi(pw.x); o0[2] = bflo(hw.y) + sigm(a0[2]) * bflo(pw.y); o0[3] = bfhi(hw.y) + sigm(a0[3]) * bfhi(pw.y);
                o1[0] = bflo(hw.z) + sigm(a1[0]) * bflo(pw.z); o1[1] = bfhi(hw.z) + sigm(a1[1]) * bfhi(pw.z); o1[2] = bflo(hw.w) + sigm(a1[2]) * bflo(pw.w); o1[3] = bfhi(hw.w) + sigm(a1[3]) * bfhi(pw.w);
                *(f32x4*)(out + off + bj * 128) = o0; *(f32x4*)(out + off + bj * 128 + 4) = o1; }
            if (g + 4 < 8) { EF_LD(g + 4); }
            asm volatile("" ::: "memory"); }
#undef EF_LD
    }
};

__device__ __forceinline__ void p0_transpose_item(const float* W, int K, int N, bf16_t* WT, const float* ks0, const float* ks1, int ksplit, LAS float* scr, int item, int lane) {
    const int nblk = N / 32, kb = item / nblk, nb = item % nblk, k0 = 64 * kb, n0 = 32 * nb;
#pragma unroll 8
    for (int i = 0; i < 32; ++i) { const int kk = 2 * i + (lane >> 5), k = k0 + kk; float s = 1.f; if (ks0) s = (k < ksplit) ? ks0[k] : ks1[k - ksplit];
        scr[kk * 33 + (lane & 31)] = W[(size_t)k * N + n0 + (lane & 31)] * s; }
    asm volatile("s_waitcnt lgkmcnt(0)" ::: "memory");
    const int c = lane & 7;
#pragma unroll
    for (int j = 0; j < 4; ++j) { const int n = (lane >> 3) + 8 * j; const LAS float* s = scr + (8 * c) * 33 + n;
        u32x4 o; o.x = cvtpk(s[0 * 33], s[1 * 33]); o.y = cvtpk(s[2 * 33], s[3 * 33]); o.z = cvtpk(s[4 * 33], s[5 * 33]); o.w = cvtpk(s[6 * 33], s[7 * 33]);
        *(u32x4*)(WT + (size_t)(n0 + n) * K + k0 + 8 * c) = o; }
    asm volatile("s_waitcnt lgkmcnt(0)" ::: "memory");
}
__device__ __forceinline__ void attn_phase(LAS unsigned char* lds, const bf16_t* PROJ, const bf16_t* VT, const float* gq, const float* gk, const float* rb, bf16_t* MERGED, int vcu, int G, const int wave_u) {
    int tid_ = wave_u * 64 + lane_id_v(); asm volatile("" : "+v"(tid_));
    const int tid = tid_, lane = tid & 63, h = __builtin_amdgcn_readfirstlane(tid >> 6), ql = lane & 31, hi = lane >> 5;
    LAS float* SQ = (LAS float*)lds;
    LAS float* EXT = (LAS float*)(lds + 2048) + h * 640;
    float mq = wave_max(fabsf(gq[lane])), mk = wave_max(fabsf(gk[lane])); float mb = -1e30f;
    for (int i = lane; i < 513; i += 64) mb = fmaxf(mb, rb[h * 513 + i]);
    mb = wave_max(mb);
    const float c512 = rb[h * 513 + 512]; (void)mq; (void)mk; (void)mb;
    for (int i = lane; i < 640; i += 64) { int rel = i - 64; rel = rel > 256 ? 256 : (rel < -256 ? -256 : rel); EXT[639 - i] = (rb[h * 513 + rel + 256] - c512) * LOG2E; }
    asm volatile("s_waitcnt lgkmcnt(0)" ::: "memory");
    __syncthreads();
    bf16x8 qf[2][4], kn[4], vn[4];
    const unsigned kgo = (unsigned)((lane >> 3) * PJW + (lane & 7) * 8), vgo = (unsigned)((lane >> 2) * T_ + (lane & 3) * 8);
#define LOADKV2(KB, VB, IT) do { const bf16_t* kp_ = (KB) + (long)(IT) * 32 * PJW; const bf16_t* vp_ = (VB) + (IT) * 32; \
        _Pragma("unroll") for (int i = 0; i < 4; ++i) { kn[i] = *(const bf16x8*)(kp_ + (kgo + (unsigned)(i * 8 * PJW))); vn[i] = *(const bf16x8*)(vp_ + (vgo + (unsigned)(i * 16 * T_))); } } while (0)
#define UNIT_PREFETCH(U) do { const int b_ = (U) >> 7, n_ = (U) & 127; const long tk_ = (long)b_ * SEQ_ + n_ * 64; const int i0_ = (n_ < 8) ? 2 * (8 - n_) : 0; \
        const bf16_t* qp_ = PROJ + (tk_ + ql) * PJW + 1024 + h * 64 + hi * 8; \
        _Pragma("unroll") for (int qb = 0; qb < 2; ++qb) _Pragma("unroll") for (int d0 = 0; d0 < 4; ++d0) qf[qb][d0] = *(const bf16x8*)(qp_ + (long)qb * 32 * PJW + d0 * 16); \
        LOADKV2(PROJ + (tk_ - 512) * PJW + 1536 + h * 64, VT + (long)(h * 64) * T_ + (tk_ - 512), i0_); } while (0)
    if (vcu < NUNIT_ATT) UNIT_PREFETCH(vcu);
    for (int unit = vcu; unit < NUNIT_ATT; unit += G) {
        const int b = unit >> 7, n = unit & 127; const long tok0 = (long)b * SEQ_ + n * 64;
        f32x16 o[2][2];
#pragma unroll
        for (int a = 0; a < 2; ++a)
#pragma unroll
            for (int c = 0; c < 2; ++c)
#pragma unroll
                for (int r = 0; r < 16; ++r) o[a][c][r] = 0.f;
        float lsum[2] = {0.f, 0.f};
        const int it0 = (n < 8) ? 2 * (8 - n) : 0;
        const bf16_t* kbase = PROJ + (tok0 - 512) * PJW + 1536 + h * 64;
        const bf16_t* vbase = VT + (long)(h * 64) * T_ + (tok0 - 512);
        LAS unsigned char* kv = lds + 24576 + h * 8192;
        const unsigned wk = (unsigned)((lane >> 3) * 128 + (((lane & 7) ^ (lane >> 3)) * 16));
        const unsigned wv = (unsigned)(4096 + (lane >> 2) * 64 + (((lane & 3) ^ ((lane >> 3) & 3)) * 16));
        const unsigned rkb = (unsigned)(ql * 128), rks = (unsigned)(ql & 7), rvb = (unsigned)(4096 + ql * 64), rvs = (unsigned)((ql >> 1) & 3);
#define LOADKV(IT) LOADKV2(kbase, vbase, IT)
        for (int it = it0; it < 18; ++it) {
#pragma unroll
            for (int i = 0; i < 4; ++i) { *(LAS bf16x8*)(kv + wk + i * 1024) = kn[i]; *(LAS bf16x8*)(kv + wv + i * 1024) = vn[i]; }
            { const int itn = (it + 1 < 18) ? it + 1 : it; LOADKV(itn); }
            bf16x8 kf[4], vf[2][2];
#pragma unroll
            for (int d0 = 0; d0 < 4; ++d0) kf[d0] = *(const LAS bf16x8*)(kv + rkb + (((unsigned)(2 * d0 + hi) ^ rks) * 16));
#pragma unroll
            for (int db = 0; db < 2; ++db)
#pragma unroll
                for (int ks = 0; ks < 2; ++ks) vf[db][ks] = *(const LAS bf16x8*)(kv + rvb + db * 2048 + (((unsigned)(2 * ks + hi) ^ rvs) * 16));
            const bool tab = (it >= 8);
#pragma unroll
            for (int qb = 0; qb < 2; ++qb) {
                f32x16 s;
                if (tab) { const LAS float* e = EXT + (63 - 32 * qb - ql + 32 * it + 4 * hi); f32x16 cin;
#pragma unroll
                    for (int r = 0; r < 16; ++r) cin[r] = e[(r & 3) + 8 * (r >> 2)];
                    s = MFMA32(kf[0], qf[qb][0], cin); }
                else { f32x16 z_;
#pragma unroll
                    for (int r = 0; r < 16; ++r) z_[r] = 0.f;
                    s = MFMA32(kf[0], qf[qb][0], z_); }
#pragma unroll
                for (int d0 = 1; d0 < 4; ++d0) s = MFMA32(kf[d0], qf[qb][d0], s);
                float ps = 0.f;
#pragma unroll
                for (int r = 0; r < 16; ++r) { s[r] = ex2(s[r]); ps += s[r]; }
                lsum[qb] += ps;
                bf16x8 pk[2];
#pragma unroll
                for (int ks = 0; ks < 2; ++ks) { u32x4 w; w.x = cvtpk(s[8 * ks], s[8 * ks + 1]); w.y = cvtpk(s[8 * ks + 2], s[8 * ks + 3]); w.z = cvtpk(s[8 * ks + 4], s[8 * ks + 5]); w.w = cvtpk(s[8 * ks + 6], s[8 * ks + 7]);
                    pk[ks] = __builtin_bit_cast(bf16x8, w); }
#pragma unroll
                for (int db = 0; db < 2; ++db)
#pragma unroll
                    for (int ks = 0; ks < 2; ++ks) o[db][qb] = MFMA32(vf[db][ks], pk[ks], o[db][qb]);
            }
        }
#undef LOADKV
        if (unit + G < NUNIT_ATT) UNIT_PREFETCH(unit + G);
        float inv[2], sq[2];
#pragma unroll
        for (int qb = 0; qb < 2; ++qb) { float l = lsum[qb]; l += __shfl_xor(l, 32); inv[qb] = 1.f / l; float q2 = 0.f;
#pragma unroll
            for (int db = 0; db < 2; ++db)
#pragma unroll
                for (int r = 0; r < 16; ++r) { const float v = o[db][qb][r] * inv[qb]; o[db][qb][r] = v; q2 += v * v; }
            q2 += __shfl_xor(q2, 32); sq[qb] = q2;
            if (hi == 0) SQ[h * 64 + 32 * qb + ql] = q2; }
        asm volatile("s_waitcnt lgkmcnt(0)" ::: "memory");
        __syncthreads();
#pragma unroll
        for (int qb = 0; qb < 2; ++qb) { float tot = 0.f;
#pragma unroll
            for (int hh = 0; hh < 8; ++hh) tot += SQ[hh * 64 + 32 * qb + ql];
            const float rstd = rsqf_(tot * (1.f / 512.f) + EPS_);
            bf16_t* op = MERGED + (tok0 + 32 * qb + ql) * DM_ + 512 + h * 64 + 4 * hi;
#pragma unroll
            for (int db = 0; db < 2; ++db)
#pragma unroll
                for (int r4 = 0; r4 < 4; ++r4) { u32x2 w; w.x = cvtpk(o[db][qb][4 * r4] * rstd, o[db][qb][4 * r4 + 1] * rstd); w.y = cvtpk(o[db][qb][4 * r4 + 2] * rstd, o[db][qb][4 * r4 + 3] * rstd);
                    *(u32x2*)(op + 32 * db + 8 * r4) = w; } }
        __syncthreads();
    }
}

template <bool PASS2>
__device__ __forceinline__ void lru_unit(LAS unsigned char* lds, int unit, const bf16_t* PROJ, const bf16_t* WGT, const float* conv_w, const float* conv_b, const float* b_rg, const float* b_ig,
                                         const float* lam, f32x2* SUMM, bf16_t* MERGED, const int wave_u) {
    int tid_ = wave_u * 64 + lane_id_v(); asm volatile("" : "+v"(tid_));
    const int tid = tid_, lane = tid & 63, w = __builtin_amdgcn_readfirstlane(tid >> 6), ql = lane & 31, hi = lane >> 5;
    const int b = unit >> 5, seg = unit & 31; const long tok0 = (long)b * SEQ_ + seg * 256;
    LAS bf16_t* XC = (LAS bf16_t*)lds + w * (64 * 72);
    LAS bf16_t* YT = (LAS bf16_t*)(lds + 73728);
    const int chc = 64 * w + lane;
    const float cw0 = conv_w[chc], cw1 = conv_w[512 + chc], cw2 = conv_w[1024 + chc], cw3 = conv_w[1536 + chc], cbv = conv_b[chc];
    float brg[2], big[2], sp[2];
#pragma unroll
    for (int nb = 0; nb < 2; ++nb) { const int ch = 64 * w + 32 * nb + ql; brg[nb] = b_rg[ch]; big[nb] = b_ig[ch];
        sp[nb] = -8.f * LOG2E * log1pf(expf(-lam[ch])); }
    float carry[2] = {0.f, 0.f}, ptot[2] = {1.f, 1.f};
    if (PASS2) {
#pragma unroll
        for (int nb = 0; nb < 2; ++nb) { float c = 0.f; const f32x2* sp_ = SUMM + (size_t)(b * 32) * 512 + 64 * w + 32 * nb + ql;
            for (int s0 = 0; s0 < seg; s0 += 8) { f32x2 v[8];
#pragma unroll
                for (int j = 0; j < 8; ++j) v[j] = (s0 + j < seg) ? sp_[(size_t)(s0 + j) * 512] : (f32x2){1.f, 0.f};
#pragma unroll
                for (int j = 0; j < 8; ++j) c = v[j].x * c + v[j].y; }
            carry[nb] = c; }
    }
    float x1 = 0.f, x2 = 0.f, x3 = 0.f;
#pragma nounroll
    for (int st = 0; st < 4; ++st) {
        const long t0 = tok0 + 64 * st;
        {
            const bf16_t* xt = PROJ + t0 * PJW + 64 * w;
            const unsigned go = (unsigned)((lane >> 3) * PJW + (lane & 7) * 8);
            bf16x8 raw[8];
#pragma unroll
            for (int i = 0; i < 8; ++i) raw[i] = *(const bf16x8*)(xt + (go + (unsigned)(i * 8 * PJW)));
            if (st == 0) { x1 = 0.f; x2 = 0.f; x3 = 0.f;
                if (seg != 0) { const bf16_t* xp = PROJ + t0 * PJW + chc; x1 = bf2f(xp[-1 * PJW]); x2 = bf2f(xp[-2 * PJW]); x3 = bf2f(xp[-3 * PJW]); } }
#pragma unroll
            for (int i = 0; i < 8; ++i) *(LAS bf16x8*)(XC + (8 * i + (lane >> 3)) * 72 + (lane & 7) * 8) = raw[i];
#pragma unroll 16
            for (int t = 0; t < 64; ++t) { const float xv = bf2f(XC[t * 72 + lane]); const float xc = cbv + cw0 * x3 + cw1 * x2 + cw2 * x1 + cw3 * xv;
                XC[t * 72 + lane] = (bf16_t)(cvtpk(xc, 0.f) & 0xffffu); x3 = x2; x2 = x1; x1 = xv; }
        }
        asm volatile("s_waitcnt lgkmcnt(0)" ::: "memory");
#pragma unroll
        for (int nb = 0; nb < 2; ++nb) {
            bf16x8 wrf[4], wif[4];
            { int woff = ((w * 2 + nb) * 4 * 64 + lane) * 8; asm volatile("" : "+v"(woff));
#pragma unroll
              for (int ks = 0; ks < 4; ++ks) { wrf[ks] = *(const bf16x8*)(WGT + woff + ks * 512); wif[ks] = *(const bf16x8*)(WGT + 8 * 4096 + woff + ks * 512); } }
#pragma unroll
            for (int tb = 0; tb < 2; ++tb) {
                bf16x8 af[4];
#pragma unroll
                for (int ks = 0; ks < 4; ++ks) af[ks] = *(const LAS bf16x8*)(XC + (32 * tb + ql) * 72 + 16 * ks + 8 * hi);
                f32x16 dr, di;
#pragma unroll
                for (int r = 0; r < 16; ++r) { dr[r] = 0.f; di[r] = 0.f; }
#pragma unroll
                for (int ks = 0; ks < 4; ++ks) { dr = MFMA32(af[ks], wrf[ks], dr); di = MFMA32(af[ks], wif[ks], di); }
                float A[16], U[16];
#pragma unroll
                for (int r = 0; r < 16; ++r) { const int tok = 32 * tb + crow(r, hi); const float xcv = bf2f(XC[tok * 72 + 32 * nb + ql]);
                    const float rg = sigm(dr[r] + brg[nb]), ig = sigm(di[r] + big[nb]); const float a = ex2(rg * sp[nb]);
                    const float mult = __builtin_amdgcn_sqrtf(fmaxf(1.f - a * a, 0.f)); A[r] = a; U[r] = mult * ig * xcv; }
#pragma unroll
                for (int q4 = 0; q4 < 4; ++q4)
#pragma unroll
                    for (int e = 1; e < 4; ++e) { U[4 * q4 + e] = A[4 * q4 + e] * U[4 * q4 + e - 1] + U[4 * q4 + e]; A[4 * q4 + e] = A[4 * q4 + e - 1] * A[4 * q4 + e]; }
                float c = carry[nb], HIN[4];
#pragma unroll
                for (int q4 = 0; q4 < 4; ++q4) { const float e0 = A[4 * q4 + 3] * c + U[4 * q4 + 3]; const float p = __shfl_xor(e0, 32); const float hin = hi ? p : c; HIN[q4] = hin;
                    const float e1 = A[4 * q4 + 3] * hin + U[4 * q4 + 3]; const float q = __shfl_xor(e1, 32); c = hi ? e1 : q; }
                carry[nb] = c;
                if (!PASS2) { const float po = (A[3] * A[7]) * (A[11] * A[15]); ptot[nb] *= po * __shfl_xor(po, 32); }
                else {
                    const bf16_t* gb = PROJ + t0 * PJW + 512 + 64 * w + 32 * nb + (32 * tb) * PJW;
                    const unsigned goff = (unsigned)(4 * hi) * PJW + ql;
#pragma unroll
                    for (int r = 0; r < 16; ++r) { const int tok = 32 * tb + crow(r, hi); const float hval = U[r] + A[r] * HIN[r >> 2]; const float gl = bf2f(gb[goff + (unsigned)((r & 3) + 8 * (r >> 2)) * PJW]);
                        YT[tok * 520 + 64 * w + 32 * nb + ql] = (bf16_t)(cvtpk(hval * gl, 0.f) & 0xffffu); }
                }
            }
        }
        if (PASS2) {
            asm volatile("s_waitcnt lgkmcnt(0)" ::: "memory");
            __syncthreads();
#pragma unroll
            for (int i = 0; i < 8; ++i) { const int tok = 8 * w + i; const u32x4 v = *(const LAS u32x4*)(YT + tok * 520 + 8 * lane);
                const float f0 = bflo(v.x), f1 = bfhi(v.x), f2 = bflo(v.y), f3 = bfhi(v.y), f4 = bflo(v.z), f5 = bfhi(v.z), f6 = bflo(v.w), f7 = bfhi(v.w);
                float ss = (f0 * f0 + f1 * f1) + (f2 * f2 + f3 * f3) + (f4 * f4 + f5 * f5) + (f6 * f6 + f7 * f7); ss = wave_sum(ss);
                const float rs = rsqf_(ss * (1.f / 512.f) + EPS_);
                u32x4 o; o.x = cvtpk(f0 * rs, f1 * rs); o.y = cvtpk(f2 * rs, f3 * rs); o.z = cvtpk(f4 * rs, f5 * rs); o.w = cvtpk(f6 * rs, f7 * rs);
                *(u32x4*)(MERGED + (t0 + tok) * DM_ + 8 * lane) = o; }
            __syncthreads();
        }
        asm volatile("" ::: "memory");
    }
    if (!PASS2) { if (hi == 0) {
#pragma unroll
        for (int nb = 0; nb < 2; ++nb) SUMM[(size_t)unit * 512 + 64 * w + 32 * nb + ql] = (f32x2){ptot[nb], carry[nb]}; } }
}

#ifndef PROBE_MASK
#define PROBE_MASK 0
#endif
#ifndef RES_BF16
#define RES_BF16 1
#endif
struct Args { const float* in[23]; float* out; unsigned char* ws; };
__global__ void __launch_bounds__(NTHR, 2) fwd_megakernel(Args args) {
    extern __shared__ __attribute__((aligned(16))) unsigned char lds_raw[];
    cg::grid_group grid = cg::this_grid();
    LAS unsigned char* lds = (LAS unsigned char*)lds_raw;
    const int wave = __builtin_amdgcn_readfirstlane(threadIdx.x >> 6);
#define tid (wave * 64 + lane_id_v())
#define lane (lane_id_v())
    const int G = gridDim.x, bx = blockIdx.x, vcu = (G % 8 == 0) ? (bx % 8) * (G / 8) + bx / 8 : bx;
    unsigned char* ws = args.ws;
    volatile LAS unsigned* MISC = (volatile LAS unsigned*)(lds + MISC_OFF);
    if (threadIdx.x < 16) MISC[threadIdx.x] = 0u;
    __syncthreads();
    XcdBarrier bar; bar.bar = (unsigned*)(ws + WS_CTL); bar.x = xb_xcc_id(); bar.st = MISC;
    if (blockIdx.x == 0) for (int i = threadIdx.x; i < (int)(CTL_BYTES / 4); i += NTHR) bar.bar[i] = 0u;
    const float* x = args.in[0]; const float* p = args.in[1]; float* out = args.out;
    bf16_t* WT_IN = (bf16_t*)(ws + WS_WIN); bf16_t* WT_OUT = (bf16_t*)(ws + WS_WOUT); bf16_t* WT_UP = (bf16_t*)(ws + WS_WUP); bf16_t* WT_DN = (bf16_t*)(ws + WS_WDN);
    bf16_t* WT_PG = (bf16_t*)(ws + WS_WPG); bf16_t* WT_PP = (bf16_t*)(ws + WS_WPP); bf16_t* WGT = (bf16_t*)(ws + WS_WG);
    float* RINV0 = (float*)(ws + WS_RINV0);
    float* RSTD1 = (float*)(ws + WS_RSTD1); float* RSTD2 = (float*)(ws + WS_RSTD2); f32x2* SUMM = (f32x2*)(ws + WS_SUMM);
    bf16_t* XN = (bf16_t*)(ws + WS_XN); bf16_t* PP = (bf16_t*)(ws + WS_PP); bf16_t* PB = (bf16_t*)(ws + WS_PB);
    bf16_t* PROJ = (bf16_t*)(ws + WS_PROJ); bf16_t* VT = (bf16_t*)(ws + WS_VT); bf16_t* MERGED = (bf16_t*)(ws + WS_MERGED); bf16_t* ACT = (bf16_t*)(ws + WS_ACT);

    for (int rep_ = 0; rep_ < 1 + ((PROBE_MASK >> 0) & 1); ++rep_) {
        LAS float* scr = (LAS float*)(lds + wave * 16384);
        const int gw = vcu * NWAVES + wave, NGW = G * NWAVES;
        constexpr int I_IN = 16 * 80, I_OUT = 16 * 32, I_UP = 16 * 128, I_DN = 64 * 32, I_PG = 16 * 32, I_PP = 4 * 32;
        constexpr int NITEMS = I_IN + I_OUT + I_UP + I_DN + I_PG + I_PP;
        for (int it = gw; it < NITEMS; it += NGW) {
            int r = it;
            if (r < I_IN) { p0_transpose_item(args.in[3], 1024, 2560, WT_IN, nullptr, nullptr, 0, scr, r, lane); continue; } r -= I_IN;
            if (r < I_OUT) { p0_transpose_item(args.in[16], 1024, 1024, WT_OUT, args.in[14], args.in[15], 512, scr, r, lane); continue; } r -= I_OUT;
            if (r < I_UP) { p0_transpose_item(args.in[18], 1024, 4096, WT_UP, args.in[17], args.in[17], 1 << 30, scr, r, lane); continue; } r -= I_UP;
            if (r < I_DN) { p0_transpose_item(args.in[19], 4096, 1024, WT_DN, nullptr, nullptr, 0, scr, r, lane); continue; } r -= I_DN;
            if (r < I_PG) { p0_transpose_item(args.in[21], 1024, 1024, WT_PG, args.in[20], args.in[20], 1 << 30, scr, r, lane); continue; } r -= I_PG;
            p0_transpose_item(args.in[22], 256, 1024, WT_PP, nullptr, nullptr, 0, scr, r, lane);
        }
        for (int i = bx * NTHR + tid; i < T_; i += G * NTHR) { RSTD1[i] = 0.f; RSTD2[i] = 0.f; }
        for (int i = bx * NTHR + tid; i < 65536; i += G * NTHR) { const int e = i & 7, ln = (i >> 3) & 63, ks = (i >> 9) & 3, nb = (i >> 11) & 1, blk = (i >> 12) & 7, gate = i >> 15;
            const int k = 16 * ks + 8 * (ln >> 5) + e, n = 32 * nb + (ln & 31);
            const float v = (gate ? args.in[8] : args.in[6])[blk * 4096 + k * 64 + n]; WGT[i] = (bf16_t)(cvtpk(v, 0.f) & 0xffffu); }
        const float* g1 = args.in[2];
        f32x4 gv[4];
#pragma unroll
        for (int j = 0; j < 4; ++j) gv[j] = *((const f32x4*)g1 + lane + 64 * j);
        for (int m = gw; m < T_; m += NGW) {
            const f32x4* xr = (const f32x4*)(x + (size_t)m * DM_) + lane; f32x4 v[4]; float s = 0.f;
#pragma unroll
            for (int j = 0; j < 4; ++j) { v[j] = __builtin_nontemporal_load(xr + 64 * j); s += (v[j].x * v[j].x + v[j].y * v[j].y) + (v[j].z * v[j].z + v[j].w * v[j].w); }
            const float ms_ = wave_sum(s) * (1.f / DM_) + EPS_; const float rstd = rsqf_(ms_);
            if (lane == 0) RINV0[m] = ms_ * rstd;
            u32x2* o8 = (u32x2*)(XN + (size_t)m * DM_) + lane;
#pragma unroll
            for (int j = 0; j < 4; ++j) { const f32x4 y = v[j] * gv[j] * rstd; u32x2 w; w.x = cvtpk(y.x, y.y); w.y = cvtpk(y.z, y.w); o8[64 * j] = w; }
            const f32x4 pv = __builtin_nontemporal_load((const f32x4*)(p + (size_t)m * PLE_) + lane); u32x2 pw; pw.x = cvtpk(pv.x, pv.y); pw.y = cvtpk(pv.z, pv.w);
            *((u32x2*)(PB + (size_t)m * PLE_) + lane) = pw;
        }
    }
    grid.sync();
    if (threadIdx.x == 0) MISC[2] = xb_add(&bar.bar[XB_XCNT(bar.x)], 1u);
    int cid = bx, vcu2 = vcu;
#define CENSUS_IDS() do { \
    if (threadIdx.x == 0) { unsigned okc = 1u; \
        for (unsigned j = 0; j < 16; ++j) { const unsigned c_ = xb_ld(&bar.bar[XB_XCNT(j)]); okc &= (j < 8 ? (c_ == (unsigned)G / 8u) : (c_ == 0u)) ? 1u : 0u; } \
        MISC[3] = (okc && (G % 8 == 0)) ? 1u : 0u; } \
    __syncthreads(); \
    { const bool okmap = MISC[3] != 0u; \
      cid = __builtin_amdgcn_readfirstlane(okmap ? (int)(MISC[2] * 8u + bar.x) : bx); \
      vcu2 = __builtin_amdgcn_readfirstlane(okmap ? (int)(bar.x * (unsigned)(G / 8) + MISC[2]) : vcu); } } while (0)
#if 0
    if (threadIdx.x == 0) { unsigned okc = 1u;
        for (unsigned j = 0; j < 16; ++j) { const unsigned c_ = xb_ld(&bar.bar[XB_XCNT(j)]); okc &= (j < 8 ? (c_ == (unsigned)G / 8u) : (c_ == 0u)) ? 1u : 0u; }
        MISC[3] = (okc && (G % 8 == 0)) ? 1u : 0u; }
    __syncthreads();
    const bool okmap = MISC[3] != 0u;
    const int cid = __builtin_amdgcn_readfirstlane(okmap ? (int)(MISC[2] * 8u + bar.x) : bx);
    const int vcu2 = __builtin_amdgcn_readfirstlane(okmap ? (int)(bar.x * (unsigned)(G / 8) + MISC[2]) : vcu);
#endif
    for (int rep_ = 0; rep_ < 1 + ((PROBE_MASK >> 1) & 1); ++rep_) {
        { pg8::Gemm g{XN, WT_IN, T_, 2048, 1024}; pg8::StaticOrder S; S.init(T_, 2048, G, cid); EpiProj E{PROJ, args.in[11], args.in[12]};
          pg8::gemm_phase<EpiProj, pg8::StaticOrder, PG8_ALIGN, PG8_SP2>(lds, g, S, E, wave); }
        { pg8::Gemm g{WT_IN + (size_t)2048 * 1024, XN, 512, T_, 1024}; pg8::StaticOrder S; S.init(512, T_, G, cid); EpiVT E{VT};
          pg8::gemm_phase<EpiVT, pg8::StaticOrder, PG8_ALIGN, PG8_SP2>(lds, g, S, E, wave); }
    }
    xcd_barrier(bar);
    CENSUS_IDS();
    for (int rep_ = 0; rep_ < 1 + ((PROBE_MASK >> 2) & 1); ++rep_)
    attn_phase(lds, PROJ, VT, args.in[11]  , args.in[12], args.in[13], MERGED, vcu2, G, wave);
    for (int rep_ = 0; rep_ < 1 + ((PROBE_MASK >> 3) & 1); ++rep_)
    for (int unit = vcu2; unit < NUNIT_LRU; unit += G)
        lru_unit<false>(lds, unit, PROJ, WGT, args.in[4], args.in[5], args.in[7], args.in[9], args.in[10], SUMM, MERGED, wave);
    xcd_barrier(bar);
    for (int rep_ = 0; rep_ < 1 + ((PROBE_MASK >> 4) & 1); ++rep_)
    for (int unit = vcu2; unit < NUNIT_LRU; unit += G)
        lru_unit<true>(lds, unit, PROJ, WGT, args.in[4], args.in[5], args.in[7], args.in[9], args.in[10], SUMM, MERGED, wave);
    xcd_barrier(bar);
#if RES_BF16
    { pg8::Gemm g{MERGED, WT_OUT, T_, 1024, 1024}; pg8::StaticOrder S; S.init(T_, 1024, G, cid); EpiRes4b E{XN, RINV0, args.in[2], RSTD1};
      pg8::gemm_phase<EpiRes4b, pg8::StaticOrder, PG8_ALIGN, PG8_SP2>(lds, g, S, E, wave); }
#else
    for (int rep_ = ((PROBE_MASK >> 5) & 1) ? 0 : 1; rep_ < 2; ++rep_)
    { pg8::Gemm g{MERGED, WT_OUT, T_, 1024, 1024}; pg8::StaticOrder S; S.init(T_, 1024, G, cid); EpiRes E{x, out, XN, rep_ ? RSTD1 : (float*)(ws + WS_DUMMY), 0xFFFF};
      pg8::gemm_phase<EpiRes, pg8::StaticOrder, PG8_ALIGN, PG8_SP2>(lds, g, S, E, wave); }
#endif
    xcd_barrier(bar);
    for (int rep_ = 0; rep_ < 1 + ((PROBE_MASK >> 6) & 1); ++rep_) { pg8::Gemm g{XN, WT_UP, T_, 4096, 1024}; pg8::StaticOrder S; S.init(T_, 4096, G, cid); EpiUp E{ACT, RSTD1};
      pg8::gemm_phase<EpiUp, pg8::StaticOrder, PG8_ALIGN, PG8_SP2, (PROBE_MASK >> 9) & 1>(lds, g, S, E, wave); }
    xcd_barrier(bar);
#if RES_BF16
    { pg8::Gemm g{ACT, WT_DN, T_, 1024, 4096}; pg8::StaticOrder S; S.init(T_, 1024, G, cid); EpiRes6 E{XN, RSTD2};
      pg8::gemm_phase<EpiRes6, pg8::StaticOrder, PG8_ALIGN, PG8_SP2>(lds, g, S, E, wave); }
#else
    for (int rep_ = ((PROBE_MASK >> 7) & 1) ? 0 : 1; rep_ < 2; ++rep_)
    { pg8::Gemm g{ACT, WT_DN, T_, 1024, 4096}; pg8::StaticOrder S; S.init(T_, 1024, G, cid);
      EpiRes E{out, rep_ ? out : (float*)(ws + WS_END), XN, rep_ ? RSTD2 : (float*)(ws + WS_DUMMY), rep_ ? 0xFFFF : 0x7FFF};
      pg8::gemm_phase<EpiRes, pg8::StaticOrder, PG8_ALIGN, PG8_SP2>(lds, g, S, E, wave); }
#endif
    xcd_barrier(bar);
#if RES_BF16
    { pg8::StaticOrder S; S.init(T_, 1024, G, cid); EpiMidPP EM{(u32x4*)(ws + WS_PP) + (size_t)bx * 8192}; EpiFinalC EF{XN, out, RSTD2, (const u32x4*)(ws + WS_PP) + (size_t)bx * 8192};
      pg8::gemm_phase_ple<EpiMidPP, EpiFinalC, pg8::StaticOrder>(lds, PB, WT_PP, XN, WT_PG, S, EM, EF, wave); }
#else
    for (int rep_ = ((PROBE_MASK >> 8) & 1) ? 0 : 1; rep_ < 2; ++rep_)
    { pg8::Gemm g{XN, WT_PG, T_, 1024, 1024}; pg8::StaticOrder S; S.init(T_, 1024, G, cid); EpiFinal E{out, rep_ ? out : (float*)ACT, PP, RSTD2};
      pg8::gemm_phase<EpiFinal, pg8::StaticOrder, PG8_ALIGN, PG8_SP2>(lds, g, S, E, wave); }
#endif
}

#undef tid
#undef lane
extern "C" void kernel_launch(void* const* d_in, const int* in_sizes, int n_in, void* d_out, int out_size, void* d_ws, size_t ws_size, hipStream_t stream) {
    static int grid = 0;
    if (grid == 0) {
        if (n_in != 23 || in_sizes[0] != T_ * DM_ || out_size != T_ * DM_ || ws_size < WS_END) { fprintf(stderr, "kernel_launch: unexpected shapes (n_in %d, in0 %d, out %d, ws %zu)\n", n_in, n_in > 0 ? in_sizes[0] : -1, out_size, ws_size); grid = -1; return; }
        int dev = 0, cus = 0, per_cu = 0;
        (void)hipGetDevice(&dev); (void)hipDeviceGetAttribute(&cus, hipDeviceAttributeMultiprocessorCount, dev);
        (void)hipFuncSetAttribute((const void*)fwd_megakernel, hipFuncAttributeMaxDynamicSharedMemorySize, LDS_BYTES);
        if (hipOccupancyMaxActiveBlocksPerMultiprocessor(&per_cu, (const void*)fwd_megakernel, NTHR, LDS_BYTES) != hipSuccess || per_cu < 1) per_cu = 1;
        (void)hipGetLastError();
        grid = cus * per_cu;
        if (grid > 256) grid = 256;
        fprintf(stderr, "kernel_launch: cus %d per_cu %d grid %d\n", cus, per_cu, grid);
    }
    if (grid < 0) return;
    Args a{};
    for (int i = 0; i < 23; ++i) a.in[i] = (const float*)d_in[i];
    a.out = (float*)d_out; a.ws = (unsigned char*)d_ws;
    void* kargs[] = {&a};
    hipError_t e = hipLaunchCooperativeKernel((const void*)fwd_megakernel, dim3(grid), dim3(NTHR), kargs, LDS_BYTES, stream);
    if (e != hipSuccess) fprintf(stderr, "kernel_launch: cooperative launch failed: %s (grid %d)\n", hipGetErrorString(e), grid);
}
```

```cpp
#include <hip/hip_runtime.h>
#include <hip/hip_cooperative_groups.h>
#include <cstdio>
#include <cstdint>
namespace cg = cooperative_groups;
__device__ __forceinline__ int lane_id_v() { int l; asm volatile("v_mbcnt_lo_u32_b32 %0, -1, 0\n\tv_mbcnt_hi_u32_b32 %0, -1, %0" : "=v"(l)); return l; }
namespace pg8 {
#define PG8_LAS __attribute__((address_space(3)))
typedef unsigned short bf16_t;
typedef short bf16x8 __attribute__((ext_vector_type(8)));
typedef float f32x4 __attribute__((ext_vector_type(4)));
typedef unsigned u32x4 __attribute__((ext_vector_type(4)));
constexpr int BM = 256, BK = 64, HALF = 128, HTB = HALF * BK * 2  , STAGE_BYTES = 8 * HTB, NXCD = 8, WGM = 8;

__host__ __device__ __forceinline__ int lds_byte(int r, int c) { const int st = (r >> 4) * 2 + (c >> 5), rr = r & 15, cc = c & 31, ob = rr * 64 + cc * 2; return st * 1024 + (ob ^ (((ob >> 9) & 1) << 5)); }
__host__ __device__ __forceinline__ void stage_rc(int b, int& R, int& C) { const int st = b / 1024, sb = b % 1024, swz = sb ^ (((sb >> 9) & 1) << 5); R = (st >> 1) * 16 + swz / 64; C = (st & 1) * 32 + (swz % 64) / 2; }
__host__ __device__ __forceinline__ int perm32(int rho) { const int n = rho >> 4, i = rho & 15; return 8 * (i >> 2) + 4 * n + (i & 3); }

struct Unit { int pm, pn; };
struct Gemm { const bf16_t* A; const bf16_t* Bt; int M, N, K; };

struct StaticOrder {
    int nM, nN, nwg, G, c;
    __host__ __device__ void init(int M, int N, int G_, int c_) { nM = M / BM; nN = N / BM; nwg = nM * nN; G = G_; c = c_; }
    __host__ __device__ bool next(int i, Unit& u) const {
        const long L = (long)i * G + c; if (L >= nwg) return false;
        int wgid = (int)L; { const int q = nwg / NXCD, r = nwg % NXCD, xcd = wgid % NXCD, off = wgid / NXCD; wgid = (xcd < r ? xcd * (q + 1) : r * (q + 1) + (xcd - r) * q) + off; }
        const int nig = WGM * nN, gid = wgid / nig, fm = gid * WGM, gsz = (nM - fm) < WGM ? (nM - fm) : WGM;
        u.pm = fm + ((wgid % nig) % gsz); u.pn = (wgid % nig) / gsz; return true;
    }
    __device__ __forceinline__ void a_ready(const Unit&) const {}
    __device__ __forceinline__ void done(const Unit&) const {}
};

__device__ __forceinline__ unsigned cvt_pk_bf16(float lo, float hi) { unsigned r; asm volatile("v_cvt_pk_bf16_f32 %0, %1, %2" : "=v"(r) : "v"(lo), "v"(hi)); return r; }
typedef float f32x2 __attribute__((ext_vector_type(2)));
template <class Epi, class Sched, bool ALIGN_EPI = false, bool SP2 = false, bool EPI2 = false>
__device__ __forceinline__ void gemm_phase(PG8_LAS unsigned char* lds, const Gemm g, const Sched& S, const Epi& E, const int wave_u) {
    int tid_ = wave_u * 64 + lane_id_v(); asm volatile("" : "+v"(tid_));
    const int tid = tid_, wid = __builtin_amdgcn_readfirstlane(tid >> 6), lane = tid & 63, wr = wid >> 2, wc = wid & 3, fr = lane & 15, fq = lane >> 4;
    const int K = g.K, nt = K / BK;
    unsigned voffA[2], voffB[2];
#pragma unroll
    for (int i = 0; i < 2; ++i) { int R, C; stage_rc(tid * 16 + i * 8192, R, C); const int Rp = Epi::PERM ? perm32(R & 31) : (R & 31); const int Rb = Epi::HEADMAP ? (64 * (R >> 5) + Rp) : ((R & ~31) + Rp);
        voffA[i] = (unsigned)(R * K + C) * 2u; voffB[i] = (unsigned)(Rb * K + C) * 2u; }
    const size_t kstep = (size_t)(BK * 2);
    const size_t hstep = (size_t)HALF * K * 2;
    const size_t hstepB = Epi::HEADMAP ? (size_t)32 * K * 2 : hstep;
    const size_t tstep = 2 * hstep;
    const unsigned ldsw = (unsigned)wid * 1024u;
    const int aoff = lds_byte(wr * 64 + fr, fq * 8), boff = lds_byte(wc * 32 + fr, fq * 8);
#define PG8_SA(b, h) (((b) * 2 + (h)) * HTB)
#define PG8_SB(b, h) ((4 + (b) * 2 + (h)) * HTB)
#define PG8_STAGE(bufoff, gbase, voff) do { _Pragma("unroll") for (int _i = 0; _i < 2; ++_i) \
        __builtin_amdgcn_global_load_lds((const unsigned*)((const char*)(gbase) + (voff)[_i]), (PG8_LAS unsigned*)(lds + (bufoff) + ldsw + _i * 8192), 16, 0, 0); } while (0)
#define PG8_LDA(dst, b, h) do { _Pragma("unroll") for (int m = 0; m < 4; ++m) _Pragma("unroll") for (int k = 0; k < 2; ++k) dst[m][k] = *(const PG8_LAS bf16x8*)(lds + PG8_SA(b, h) + aoff + m * 2048 + k * 1024); } while (0)
#define PG8_LDB(dst, b, h) do { _Pragma("unroll") for (int n = 0; n < 2; ++n) _Pragma("unroll") for (int k = 0; k < 2; ++k) dst[n][k] = *(const PG8_LAS bf16x8*)(lds + PG8_SB(b, h) + boff + n * 2048 + k * 1024); } while (0)
#define PG8_MMA(ai, bj, At, Bt) do { __builtin_amdgcn_s_setprio(1); _Pragma("unroll") for (int m = 0; m < 4; ++m) _Pragma("unroll") for (int n = 0; n < 2; ++n) _Pragma("unroll") for (int k = 0; k < 2; ++k) \
        acc[ai][bj][m][n] = __builtin_amdgcn_mfma_f32_16x16x32_bf16(Bt[n][k], At[m][k], acc[ai][bj][m][n], 0, 0, 0); __builtin_amdgcn_s_setprio(0); } while (0)
#define PG8_WAIT_V(n) asm volatile("s_waitcnt vmcnt(" #n ")" ::: "memory")
#define PG8_WAIT_L(n) asm volatile("s_waitcnt lgkmcnt(" #n ")" ::: "memory")
#define PG8_BAR __builtin_amdgcn_s_barrier()
#define PG8_SCHED __builtin_amdgcn_sched_barrier(0)
    Unit cur, nxt; int ui = 0;
    if (!S.next(0, cur)) return;
    f32x4 acc[2][2][4][2];
#pragma unroll
    for (int a = 0; a < 2; ++a)
#pragma unroll
        for (int b = 0; b < 2; ++b)
#pragma unroll
            for (int m = 0; m < 4; ++m)
#pragma unroll
                for (int n = 0; n < 2; ++n) acc[a][b][m][n] = (f32x4){0.f, 0.f, 0.f, 0.f};
    bf16x8 At[4][2], B0[2][2], B1[2][2];
    const char* cA = (const char*)g.A + (size_t)cur.pm * tstep; const char* cB = (const char*)g.Bt + (size_t)cur.pn * tstep;
    S.a_ready(cur);
    if constexpr (SP2) {
        PG8_STAGE(PG8_SB(0, 0), cB, voffB); PG8_STAGE(PG8_SB(0, 1), cB + hstepB, voffB); PG8_STAGE(PG8_SA(0, 0), cA, voffA); PG8_STAGE(PG8_SA(0, 1), cA + hstep, voffA);
        if (wr == 1) PG8_BAR;
        PG8_WAIT_V(2); PG8_BAR;
        PG8_STAGE(PG8_SB(1, 0), cB + kstep, voffB); PG8_STAGE(PG8_SA(1, 0), cA + kstep, voffA); PG8_STAGE(PG8_SB(1, 1), cB + hstepB + kstep, voffB);
        PG8_WAIT_V(6); PG8_BAR;
    } else {
        PG8_STAGE(PG8_SB(0, 0), cB, voffB); PG8_STAGE(PG8_SA(0, 0), cA, voffA); PG8_STAGE(PG8_SB(0, 1), cB + hstepB, voffB); PG8_STAGE(PG8_SA(0, 1), cA + hstep, voffA);
        if (wr == 1) PG8_BAR;
        PG8_WAIT_V(4); PG8_BAR;
        PG8_STAGE(PG8_SB(1, 0), cB + kstep, voffB); PG8_STAGE(PG8_SA(1, 0), cA + kstep, voffA); PG8_STAGE(PG8_SB(1, 1), cB + hstepB + kstep, voffB);
        PG8_WAIT_V(6); PG8_BAR;
    }
    for (;;) {
        const bool has_next = S.next(ui + 1, nxt);
        const char* nA = has_next ? (const char*)g.A + (size_t)nxt.pm * tstep : cA; const char* nB = has_next ? (const char*)g.Bt + (size_t)nxt.pn * tstep : cB;
#pragma nounroll
        for (int t = 0; t < nt; t += 2) {
            const bool last = (t == nt - 2);
            const char* a1 = cA + (size_t)(t + 1) * kstep;
            const char* a2 = last ? nA : cA + (size_t)(t + 2) * kstep; const char* b2 = last ? nB : cB + (size_t)(t + 2) * kstep;
            const char* a3 = a2 + kstep; const char* b3 = b2 + kstep;
            if (last && has_next) S.a_ready(nxt);
            if constexpr (SP2) {
            PG8_LDB(B0, 0, 0); PG8_LDB(B1, 0, 1); PG8_SCHED; PG8_LDA(At, 0, 0); PG8_STAGE(PG8_SA(1, 1), a1 + hstep, voffA);
            PG8_WAIT_V(8); PG8_WAIT_L(0); PG8_BAR; PG8_MMA(0, 0, At, B0); PG8_MMA(0, 1, At, B1); PG8_BAR; PG8_SCHED;
            PG8_LDA(At, 0, 1); PG8_STAGE(PG8_SB(0, 0), b2, voffB); PG8_STAGE(PG8_SB(0, 1), b2 + hstepB, voffB); PG8_STAGE(PG8_SA(0, 0), a2, voffA);
            PG8_WAIT_V(8); PG8_WAIT_L(0); PG8_BAR; PG8_MMA(1, 0, At, B0); PG8_MMA(1, 1, At, B1); PG8_BAR; PG8_SCHED;
            PG8_LDB(B0, 1, 0); PG8_LDB(B1, 1, 1); PG8_SCHED; PG8_LDA(At, 1, 0); PG8_STAGE(PG8_SA(0, 1), a2 + hstep, voffA);
            PG8_WAIT_V(8); PG8_WAIT_L(0); PG8_BAR; PG8_MMA(0, 0, At, B0); PG8_MMA(0, 1, At, B1); PG8_BAR; PG8_SCHED;
            PG8_LDA(At, 1, 1); PG8_STAGE(PG8_SB(1, 0), b3, voffB); PG8_STAGE(PG8_SB(1, 1), b3 + hstepB, voffB); PG8_STAGE(PG8_SA(1, 0), a3, voffA);
            PG8_WAIT_V(8); PG8_WAIT_L(0); PG8_BAR; PG8_MMA(1, 0, At, B0); PG8_MMA(1, 1, At, B1); PG8_BAR; PG8_SCHED;
            } else {
            PG8_LDB(B0, 0, 0); PG8_SCHED; PG8_LDA(At, 0, 0); PG8_STAGE(PG8_SA(1, 1), a1 + hstep, voffA);
            PG8_WAIT_L(8); PG8_BAR; PG8_WAIT_L(0); PG8_MMA(0, 0, At, B0); PG8_BAR; PG8_SCHED;
            PG8_LDB(B1, 0, 1); PG8_STAGE(PG8_SB(0, 0), b2, voffB);
            PG8_BAR; PG8_WAIT_L(0); PG8_MMA(0, 1, At, B1); PG8_BAR;
            PG8_LDA(At, 0, 1); PG8_STAGE(PG8_SA(0, 0), a2, voffA);
            PG8_BAR; PG8_WAIT_L(0); PG8_MMA(1, 0, At, B0); PG8_BAR; PG8_SCHED;
            PG8_STAGE(PG8_SB(0, 1), b2 + hstepB, voffB);
            PG8_WAIT_V(6); PG8_BAR; PG8_MMA(1, 1, At, B1); PG8_BAR;
            PG8_LDB(B0, 1, 0); PG8_SCHED; PG8_LDA(At, 1, 0); PG8_STAGE(PG8_SA(0, 1), a2 + hstep, voffA);
            PG8_WAIT_L(8); PG8_BAR; PG8_WAIT_L(0); PG8_MMA(0, 0, At, B0); PG8_BAR; PG8_SCHED;
            PG8_LDB(B1, 1, 1); PG8_STAGE(PG8_SB(1, 0), b3, voffB);
            PG8_BAR; PG8_WAIT_L(0); PG8_MMA(0, 1, At, B1); PG8_BAR;
            PG8_LDA(At, 1, 1); PG8_STAGE(PG8_SA(1, 0), a3, voffA);
            PG8_BAR; PG8_WAIT_L(0); PG8_MMA(1, 0, At, B0); PG8_BAR; PG8_SCHED;
            PG8_STAGE(PG8_SB(1, 1), b3 + hstepB, voffB);
            PG8_WAIT_V(6); PG8_BAR; PG8_MMA(1, 1, At, B1); PG8_BAR;
            }
        }
        if constexpr (ALIGN_EPI) { if (wr == 0) PG8_BAR; }
        if constexpr (!Epi::AFTER_DRAIN) { E(acc, cur, wr, wc, fr, fq); if constexpr (EPI2) { asm volatile("" ::: "memory"); E(acc, cur, wr, wc, fr, fq); } S.done(cur); }
        if (!has_next) break;
#pragma unroll
        for (int a = 0; a < 2; ++a)
#pragma unroll
            for (int b = 0; b < 2; ++b)
#pragma unroll
                for (int m = 0; m < 4; ++m)
#pragma unroll
                    for (int n = 0; n < 2; ++n) acc[a][b][m][n] = (f32x4){0.f, 0.f, 0.f, 0.f};
        cur = nxt; cA = nA; cB = nB; ++ui;
        if constexpr (ALIGN_EPI) { if (wr == 1) PG8_BAR; }
    }
    PG8_WAIT_V(0);
    if constexpr (!ALIGN_EPI) { if (wr == 0) PG8_BAR; }
    PG8_BAR;
    if constexpr (Epi::AFTER_DRAIN) { E.fused(acc, cur, wr, wc, fr, fq, lds, wid, lane); S.done(cur); }
#undef PG8_SA
#undef PG8_SB
#undef PG8_STAGE
#undef PG8_LDA
#undef PG8_LDB
#undef PG8_MMA
#undef PG8_WAIT_V
#undef PG8_WAIT_L
#undef PG8_BAR
#undef PG8_SCHED
}

template <class EpiMid, class EpiFin, class Sched>
__device__ __forceinline__ void gemm_phase_ple(PG8_LAS unsigned char* lds, const bf16_t* AP, const bf16_t* BP, const bf16_t* AZ, const bf16_t* BZ, const Sched& S, const EpiMid& EM, const EpiFin& E, const int wave_u) {
    constexpr bool ALIGN_EPI = true;
    int tid_ = wave_u * 64 + lane_id_v(); asm volatile("" : "+v"(tid_));
    const int tid = tid_, wid = __builtin_amdgcn_readfirstlane(tid >> 6), lane = tid & 63, wr = wid >> 2, wc = wid & 3, fr = lane & 15, fq = lane >> 4;
    constexpr int KP = 256, KZ = 1024, NT = 20;
    unsigned vAP[2], vBP[2], vAZ[2], vBZ[2];
#pragma unroll
    for (int i = 0; i < 2; ++i) { int R, C; stage_rc(tid * 16 + i * 8192, R, C); const int Rb = (R & ~31) + perm32(R & 31);
        vAP[i] = (unsigned)(R * KP + C) * 2u; vBP[i] = (unsigned)(Rb * KP + C) * 2u; vAZ[i] = (unsigned)(R * KZ + C) * 2u; vBZ[i] = (unsigned)(Rb * KZ + C) * 2u; }
    const size_t kstep = (size_t)(BK * 2);
    const size_t hsP = (size_t)HALF * KP * 2, hsZ = (size_t)HALF * KZ * 2, tsP = 2 * hsP, tsZ = 2 * hsZ;
    const unsigned ldsw = (unsigned)wid * 1024u;
    const int aoff = lds_byte(wr * 64 + fr, fq * 8), boff = lds_byte(wc * 32 + fr, fq * 8);
#define PG8_SA(b, h) (((b) * 2 + (h)) * HTB)
#define PG8_SB(b, h) ((4 + (b) * 2 + (h)) * HTB)
#define PG8_STAGE(bufoff, gbase, voff) do { _Pragma("unroll") for (int _i = 0; _i < 2; ++_i) \
        __builtin_amdgcn_global_load_lds((const unsigned*)((const char*)(gbase) + (voff)[_i]), (PG8_LAS unsigned*)(lds + (bufoff) + ldsw + _i * 8192), 16, 0, 0); } while (0)
#define PG8_LDA(dst, b, h) do { _Pragma("unroll") for (int m = 0; m < 4; ++m) _Pragma("unroll") for (int k = 0; k < 2; ++k) dst[m][k] = *(const PG8_LAS bf16x8*)(lds + PG8_SA(b, h) + aoff + m * 2048 + k * 1024); } while (0)
#define PG8_LDB(dst, b, h) do { _Pragma("unroll") for (int n = 0; n < 2; ++n) _Pragma("unroll") for (int k = 0; k < 2; ++k) dst[n][k] = *(const PG8_LAS bf16x8*)(lds + PG8_SB(b, h) + boff + n * 2048 + k * 1024); } while (0)
#define PG8_MMA(ai, bj, At, Bt) do { __builtin_amdgcn_s_setprio(1); _Pragma("unroll") for (int m = 0; m < 4; ++m) _Pragma("unroll") for (int n = 0; n < 2; ++n) _Pragma("unroll") for (int k = 0; k < 2; ++k) \
        acc[ai][bj][m][n] = __builtin_amdgcn_mfma_f32_16x16x32_bf16(Bt[n][k], At[m][k], acc[ai][bj][m][n], 0, 0, 0); __builtin_amdgcn_s_setprio(0); } while (0)
#define PG8_WAIT_V(n) asm volatile("s_waitcnt vmcnt(" #n ")" ::: "memory")
#define PG8_WAIT_L(n) asm volatile("s_waitcnt lgkmcnt(" #n ")" ::: "memory")
#define PG8_BAR __builtin_amdgcn_s_barrier()
#define PG8_SCHED __builtin_amdgcn_sched_barrier(0)
    Unit cur, nxt; int ui = 0;
    if (!S.next(0, cur)) return;
    f32x4 acc[2][2][4][2];
#pragma unroll
    for (int a = 0; a < 2; ++a)
#pragma unroll
        for (int b = 0; b < 2; ++b)
#pragma unroll
            for (int m = 0; m < 4; ++m)
#pragma unroll
                for (int n = 0; n < 2; ++n) acc[a][b][m][n] = (f32x4){0.f, 0.f, 0.f, 0.f};
    bf16x8 At[4][2], B0[2][2], B1[2][2];
    const char* cAP = (const char*)AP + (size_t)cur.pm * tsP; const char* cBP = (const char*)BP + (size_t)cur.pn * tsP;
    const char* cAZ = (const char*)AZ + (size_t)cur.pm * tsZ; const char* cBZ = (const char*)BZ + (size_t)cur.pn * tsZ;
    S.a_ready(cur);
    PG8_STAGE(PG8_SB(0, 0), cBP, vBP); PG8_STAGE(PG8_SB(0, 1), cBP + hsP, vBP); PG8_STAGE(PG8_SA(0, 0), cAP, vAP); PG8_STAGE(PG8_SA(0, 1), cAP + hsP, vAP);
    if (wr == 1) PG8_BAR;
    PG8_WAIT_V(2); PG8_BAR;
    PG8_STAGE(PG8_SB(1, 0), cBP + kstep, vBP); PG8_STAGE(PG8_SA(1, 0), cAP + kstep, vAP); PG8_STAGE(PG8_SB(1, 1), cBP + hsP + kstep, vBP);
    PG8_WAIT_V(6); PG8_BAR;
    for (;;) {
        const bool has_next = S.next(ui + 1, nxt);
        const char* nAP = has_next ? (const char*)AP + (size_t)nxt.pm * tsP : cAP; const char* nBP = has_next ? (const char*)BP + (size_t)nxt.pn * tsP : cBP;
#pragma nounroll
        for (int t = 0; t < NT; t += 2) {
            if (t == 4) {
                EM(acc, cur, wr, wc, fr, fq);
#pragma unroll
                for (int a = 0; a < 2; ++a)
#pragma unroll
                    for (int b = 0; b < 2; ++b)
#pragma unroll
                        for (int m = 0; m < 4; ++m)
#pragma unroll
                            for (int n = 0; n < 2; ++n) acc[a][b][m][n] = (f32x4){0.f, 0.f, 0.f, 0.f};
            }
            const bool p1 = (t < 4), p23 = (t == 0) || (t == NT - 2);
            const char* a1 = p1 ? cAP + (size_t)(t + 1) * kstep : cAZ + (size_t)(t - 3) * kstep;
            const char* a2 = (t == 0) ? cAP + 2 * kstep : (t == NT - 2) ? nAP : cAZ + (size_t)(t - 2) * kstep;
            const char* b2 = (t == 0) ? cBP + 2 * kstep : (t == NT - 2) ? nBP : cBZ + (size_t)(t - 2) * kstep;
            const char* a3 = a2 + kstep; const char* b3 = b2 + kstep;
            const size_t hstep1 = p1 ? hsP : hsZ, hstep = p23 ? hsP : hsZ, hstepB = hstep;
            unsigned voffA1[2], voffA[2], voffB[2];
#pragma unroll
            for (int i = 0; i < 2; ++i) { voffA1[i] = p1 ? vAP[i] : vAZ[i]; voffA[i] = p23 ? vAP[i] : vAZ[i]; voffB[i] = p23 ? vBP[i] : vBZ[i]; }
            if (t == NT - 2 && has_next) S.a_ready(nxt);
            PG8_LDB(B0, 0, 0); PG8_LDB(B1, 0, 1); PG8_SCHED; PG8_LDA(At, 0, 0); PG8_STAGE(PG8_SA(1, 1), a1 + hstep1, voffA1);
            PG8_WAIT_V(8); PG8_WAIT_L(0); PG8_BAR; PG8_MMA(0, 0, At, B0); PG8_MMA(0, 1, At, B1); PG8_BAR; PG8_SCHED;
            PG8_LDA(At, 0, 1); PG8_STAGE(PG8_SB(0, 0), b2, voffB); PG8_STAGE(PG8_SB(0, 1), b2 + hstepB, voffB); PG8_STAGE(PG8_SA(0, 0), a2, voffA);
            PG8_WAIT_V(8); PG8_WAIT_L(0); PG8_BAR; PG8_MMA(1, 0, At, B0); PG8_MMA(1, 1, At, B1); PG8_BAR; PG8_SCHED;
            PG8_LDB(B0, 1, 0); PG8_LDB(B1, 1, 1); PG8_SCHED; PG8_LDA(At, 1, 0); PG8_STAGE(PG8_SA(0, 1), a2 + hstep, voffA);
            PG8_WAIT_V(8); PG8_WAIT_L(0); PG8_BAR; PG8_MMA(0, 0, At, B0); PG8_MMA(0, 1, At, B1); PG8_BAR; PG8_SCHED;
            PG8_LDA(At, 1, 1); PG8_STAGE(PG8_SB(1, 0), b3, voffB); PG8_STAGE(PG8_SB(1, 1), b3 + hstepB, voffB); PG8_STAGE(PG8_SA(1, 0), a3, voffA);
            PG8_WAIT_V(8); PG8_WAIT_L(0); PG8_BAR; PG8_MMA(1, 0, At, B0); PG8_MMA(1, 1, At, B1); PG8_BAR; PG8_SCHED;
        }
        if constexpr (ALIGN_EPI) { if (wr == 0) PG8_BAR; }
        E(acc, cur, wr, wc, fr, fq); S.done(cur);
        if (!has_next) break;
#pragma unroll
        for (int a = 0; a < 2; ++a)
#pragma unroll
            for (int b = 0; b < 2; ++b)
#pragma unroll
                for (int m = 0; m < 4; ++m)
#pragma unroll
                    for (int n = 0; n < 2; ++n) acc[a][b][m][n] = (f32x4){0.f, 0.f, 0.f, 0.f};
        cur = nxt; cAP = nAP; cBP = nBP; cAZ = (const char*)AZ + (size_t)cur.pm * tsZ; cBZ = (const char*)BZ + (size_t)cur.pn * tsZ; ++ui;
        if constexpr (ALIGN_EPI) { if (wr == 1) PG8_BAR; }
    }
    PG8_WAIT_V(0);
    if constexpr (!ALIGN_EPI) { if (wr == 0) PG8_BAR; }
    PG8_BAR;
#undef PG8_SA
#undef PG8_SB
#undef PG8_STAGE
#undef PG8_LDA
#undef PG8_LDB
#undef PG8_MMA
#undef PG8_WAIT_V
#undef PG8_WAIT_L
#undef PG8_BAR
#undef PG8_SCHED
}
}
#ifndef PG8_SP2
#define PG8_SP2 true
#endif
#ifndef PG8_ALIGN
#define PG8_ALIGN true
#endif
using pg8::bf16_t; using pg8::bf16x8; using pg8::f32x4; using pg8::u32x4;
#define LAS __attribute__((address_space(3)))
typedef float f32x2 __attribute__((ext_vector_type(2)));
typedef float f32x16 __attribute__((ext_vector_type(16)));
typedef unsigned u32x2 __attribute__((ext_vector_type(2)));
typedef __bf16 bf16x2_t __attribute__((ext_vector_type(2)));

constexpr int T_ = 65536, DM_ = 1024, SEQ_ = 8192, PJW = 2048, FF_ = 4096, PLE_ = 256, NUNIT_ATT = 1024, NUNIT_LRU = 256;
constexpr float EPS_ = 1e-6f, LOG2E = 1.4426950408889634f, QSCALE = 0.125f * 1.4426950408889634f;
constexpr int NWAVES = 8, NTHR = 512;
constexpr int RING_BYTES = 131072, SSL_OFF = RING_BYTES, MISC_OFF = 147456 - 64, LDS_BYTES = 147456;
constexpr size_t MiB = 1u << 20;
constexpr size_t WS_WIN = 0, WS_WOUT = 5 * MiB, WS_WUP = 7 * MiB, WS_WDN = 15 * MiB, WS_WPG = 23 * MiB, WS_WPP = 25 * MiB, WS_WG = 25 * MiB + 512 * 1024;
constexpr size_t WS_RSTD1 = 27 * MiB, WS_RSTD2 = 27 * MiB + 256 * 1024, WS_DUMMY = 27 * MiB + 512 * 1024, WS_RINV0 = 27 * MiB + 768 * 1024, WS_SUMM = 28 * MiB;
constexpr size_t WS_CTL = 31 * MiB, CTL_BYTES = 16384;
constexpr size_t WS_XN = 32 * MiB;
constexpr size_t WS_PP = 160 * MiB;
constexpr size_t WS_PB = 288 * MiB;
constexpr size_t WS_PROJ = 320 * MiB;
constexpr size_t WS_VT = 576 * MiB;
constexpr size_t WS_MERGED = 640 * MiB;
constexpr size_t WS_ACT = 320 * MiB;
constexpr size_t WS_END = 832 * MiB;

__device__ __forceinline__ unsigned cvtpk(float lo, float hi) { f32x2 v = {lo, hi}; bf16x2_t b = __builtin_convertvector(v, bf16x2_t); return __builtin_bit_cast(unsigned, b); }
__device__ __forceinline__ float bf2f(unsigned short u) { return __uint_as_float((unsigned)u << 16); }
__device__ __forceinline__ float bflo(unsigned w) { return __uint_as_float(w << 16); }
__device__ __forceinline__ float bfhi(unsigned w) { return __uint_as_float(w & 0xffff0000u); }
__device__ __forceinline__ float ex2(float x) { return __builtin_amdgcn_exp2f(x); }
__device__ __forceinline__ float rcpf_(float x) { return __builtin_amdgcn_rcpf(x); }
__device__ __forceinline__ float rsqf_(float x) { return __builtin_amdgcn_rsqf(x); }
__device__ __forceinline__ float sigm(float z) { return rcpf_(1.f + ex2(-LOG2E * z)); }
__device__ __forceinline__ float gelu_tanh(float g) { const float z = 0.7978845608028654f * (g + 0.044715f * g * g * g); return g * sigm(2.f * z); }
__device__ __forceinline__ float wave_sum(float v) {
#pragma unroll
    for (int o = 1; o < 64; o <<= 1) v += __shfl_xor(v, o);
    return v;
}
__device__ __forceinline__ float wave_max(float v) {
#pragma unroll
    for (int o = 1; o < 64; o <<= 1) v = fmaxf(v, __shfl_xor(v, o));
    return v;
}
__device__ __forceinline__ int crow(int r, int hi) { return (r & 3) + 8 * (r >> 2) + 4 * hi; }
#define MFMA32(a, b, c) __builtin_amdgcn_mfma_f32_32x32x16_bf16((a), (b), (c), 0, 0, 0)

#define RLX_AGENT __ATOMIC_RELAXED, __HIP_MEMORY_SCOPE_AGENT
#define XB_TMO      128
#define XB_XCNT(j)  (256  + 64 * (j))
#define XB_XSUB(j)  (1280 + 64 * (j))
#define XB_XGEN(j)  (2304 + 64 * (j))
#define XB_TOP      3328
#define XB_TOPGEN   3392
#define XCD_BAR_WORDS 3456
#define XB_SPIN_CAP (1u << 18)

__device__ __forceinline__ unsigned xb_ld(unsigned* p)              { return __hip_atomic_load(p, __ATOMIC_RELAXED, __HIP_MEMORY_SCOPE_AGENT); }
__device__ __forceinline__ unsigned xb_add(unsigned* p, unsigned v) { return __hip_atomic_fetch_add(p, v, __ATOMIC_RELAXED, __HIP_MEMORY_SCOPE_AGENT); }
__device__ __forceinline__ unsigned xb_xcc_id() { return (unsigned)__builtin_amdgcn_s_getreg((3 << 11) | 20) & 0xFu; }
#define XB_SPIN(cond, bar) do { unsigned _sp = 0; while (cond) { __builtin_amdgcn_s_sleep(1); \
    if ((++_sp & 255u) == 0u) { if (xb_ld(&(bar)[XB_TMO])) break; if (_sp > XB_SPIN_CAP) { atomicAdd(&(bar)[XB_TMO], 1u); break; } } } } while (0)

struct XcdBarrier {
    unsigned* bar; unsigned x;
    volatile LAS unsigned* st;
};

__device__ __forceinline__ XcdBarrier xcd_barrier_post(unsigned* bar, volatile LAS unsigned* st) {
    XcdBarrier b; b.bar = bar; b.x = xb_xcc_id(); b.st = st;
    if (threadIdx.x == 0) (void)xb_add(&bar[XB_XCNT(b.x)], 1u);
    return b;
}
__device__ __forceinline__ void xcd_barrier_complete(unsigned* bar, unsigned x, unsigned& nloc, unsigned& nx) {
    const unsigned G = gridDim.x * gridDim.y * gridDim.z;
    unsigned sum, cnt, mine, sp = 0u;
    for (;;) {
        sum = 0u; cnt = 0u; mine = 0u;
#pragma unroll
        for (unsigned j = 0; j < 16; ++j) { const unsigned c = xb_ld(&bar[XB_XCNT(j)]); sum += c; cnt += (c > 0u) ? 1u : 0u; mine = (j == x) ? c : mine; }
        if (sum == G) break;
        __builtin_amdgcn_s_sleep(1);
        if ((++sp & 255u) == 0u) { if (xb_ld(&bar[XB_TMO])) break; if (sp > XB_SPIN_CAP) { atomicAdd(&bar[XB_TMO], 1u); break; } }
    }
    nloc = mine > 0u ? mine : 1u; nx = cnt > 0u ? cnt : 1u;
}

__device__ __forceinline__ void xcd_barrier(const XcdBarrier& b) {
    asm volatile("s_waitcnt vmcnt(0)" ::: "memory");
    __syncthreads();
    if (threadIdx.x == 0) {
        unsigned* bar = b.bar;
        __builtin_amdgcn_s_waitcnt(0);
        unsigned nloc = b.st[0], nx = b.st[1];
        if (nloc == 0u) { xcd_barrier_complete(bar, b.x, nloc, nx); b.st[0] = nloc; b.st[1] = nx; }
        const unsigned old = xb_add(&bar[XB_XSUB(b.x)], 1u);
        const unsigned gen = old / nloc;
        if (old + 1u == (gen + 1u) * nloc) {
            __builtin_amdgcn_fence(__ATOMIC_RELEASE, "agent");
            asm volatile("s_waitcnt vmcnt(0)" ::: "memory");
            const unsigned og = xb_add(&bar[XB_TOP], 1u);
            const unsigned tg = og / nx;
            if (og + 1u == (tg + 1u) * nx) xb_add(&bar[XB_TOPGEN], 1u);
            else XB_SPIN(xb_ld(&bar[XB_TOPGEN]) == tg, bar);
            __builtin_amdgcn_fence(__ATOMIC_ACQUIRE, "agent");
            xb_add(&bar[XB_XGEN(b.x)], 1u);
            asm volatile("s_waitcnt vmcnt(0)" ::: "memory");
        } else {
            XB_SPIN(xb_ld(&bar[XB_XGEN(b.x)]) == gen, bar);
            __builtin_amdgcn_fence(__ATOMIC_ACQUIRE, "agent");
            asm volatile("s_waitcnt vmcnt(0)" ::: "memory");
        }
    }
    __syncthreads();
}

struct PanelOrder {
    int pm;
    __device__ bool next(int i, pg8::Unit& u) const { if (i >= 4) return false; u.pm = pm; u.pn = i; return true; }
    __device__ __forceinline__ void a_ready(const pg8::Unit&) const {}
    __device__ __forceinline__ void done(const pg8::Unit&) const {}
};

struct EpiPlain {
    static constexpr bool PERM = true, AFTER_DRAIN = false, HEADMAP = false;
    bf16_t* O; int ldc;
    __device__ __forceinline__ void operator()(const f32x4 (&acc)[2][2][4][2], const pg8::Unit& u, int wr, int wc, int fr, int fq) const {
        const int row0 = u.pm * 256 + wr * 64 + fr, col0 = u.pn * 256 + wc * 32 + 8 * fq;
#pragma unroll
        for (int ai = 0; ai < 2; ++ai)
#pragma unroll
            for (int m = 0; m < 4; ++m) { bf16_t* rowp = O + (size_t)(row0 + ai * 128 + m * 16) * ldc + col0;
#pragma unroll
                for (int bj = 0; bj < 2; ++bj) { const f32x4 v0 = acc[ai][bj][m][0], v1 = acc[ai][bj][m][1];
                    u32x4 w; w.x = cvtpk(v0[0], v0[1]); w.y = cvtpk(v0[2], v0[3]); w.z = cvtpk(v1[0], v1[1]); w.w = cvtpk(v1[2], v1[3]);
                    *(u32x4*)(rowp + bj * 128) = w; } }
    }
};
struct EpiVT {
    static constexpr bool PERM = true, AFTER_DRAIN = false, HEADMAP = false;
    bf16_t* O;
    __device__ __forceinline__ void operator()(const f32x4 (&acc)[2][2][4][2], const pg8::Unit& u, int wr, int wc, int fr, int fq) const {
        const int row0 = u.pm * 256 + wr * 64 + fr, col0 = u.pn * 256 + wc * 32 + 16 * (fq >> 1) + 4 * (fq & 1);
#pragma unroll
        for (int ai = 0; ai < 2; ++ai)
#pragma unroll
            for (int m = 0; m < 4; ++m) { bf16_t* rowp = O + (size_t)(row0 + ai * 128 + m * 16) * T_ + col0;
#pragma unroll
                for (int bj = 0; bj < 2; ++bj)
#pragma unroll
                    for (int n = 0; n < 2; ++n) { const f32x4 v = acc[ai][bj][m][n]; u32x2 w; w.x = cvtpk(v[0], v[1]); w.y = cvtpk(v[2], v[3]);
                        *(u32x2*)(rowp + bj * 128 + 8 * n) = w; } }
    }
};
struct EpiProj {
    static constexpr bool PERM = true, AFTER_DRAIN = false, HEADMAP = true;
    bf16_t* O; const float* gq; const float* gk;
    __device__ __forceinline__ void operator()(const f32x4 (&acc)[2][2][4][2], const pg8::Unit& u, int wr, int wc, int fr, int fq) const {
        const int row0 = u.pm * 256 + wr * 64 + fr, col0 = u.pn * 256 + wc * 64 + 8 * fq, kind = u.pn >> 1;
        f32x4 gv[2][2];
        if (kind >= 2) { const float* g = (kind == 2) ? gq : gk; const float sc = (kind == 2) ? QSCALE : 1.f;
#pragma unroll
            for (int bj = 0; bj < 2; ++bj)
#pragma unroll
                for (int n = 0; n < 2; ++n) gv[bj][n] = *(const f32x4*)(g + 32 * bj + 8 * fq + 4 * n) * sc; }
#pragma unroll
        for (int ai = 0; ai < 2; ++ai)
#pragma unroll
            for (int m = 0; m < 4; ++m) { bf16_t* rowp = O + (size_t)(row0 + ai * 128 + m * 16) * PJW + col0;
                f32x4 v[2][2];
#pragma unroll
                for (int bj = 0; bj < 2; ++bj)
#pragma unroll
                    for (int n = 0; n < 2; ++n) v[bj][n] = acc[ai][bj][m][n];
                if (kind == 1) {
#pragma unroll
                    for (int bj = 0; bj < 2; ++bj)
#pragma unroll
                        for (int n = 0; n < 2; ++n)
#pragma unroll
                            for (int e = 0; e < 4; ++e) v[bj][n][e] = gelu_tanh(v[bj][n][e]);
                } else if (kind >= 2) {
                    float ss = 0.f;
#pragma unroll
                    for (int bj = 0; bj < 2; ++bj)
#pragma unroll
                        for (int n = 0; n < 2; ++n) { const f32x4 x = v[bj][n]; ss += (x[0] * x[0] + x[1] * x[1]) + (x[2] * x[2] + x[3] * x[3]); }
                    ss += __shfl_xor(ss, 16); ss += __shfl_xor(ss, 32);
                    const float rstd = rsqf_(ss * (1.f / 64.f) + EPS_);
#pragma unroll
                    for (int bj = 0; bj < 2; ++bj)
#pragma unroll
                        for (int n = 0; n < 2; ++n) v[bj][n] = v[bj][n] * gv[bj][n] * rstd;
                }
#pragma unroll
                for (int bj = 0; bj < 2; ++bj) { const f32x4 v0 = v[bj][0], v1 = v[bj][1];
                    u32x4 w; w.x = cvtpk(v0[0], v0[1]); w.y = cvtpk(v0[2], v0[3]); w.z = cvtpk(v1[0], v1[1]); w.w = cvtpk(v1[2], v1[3]);
                    *(u32x4*)(rowp + bj * 32) = w; } }
    }
};
struct EpiRes {
    static constexpr bool PERM = true, AFTER_DRAIN = false, HEADMAP = false;
    const float* base; float* out; bf16_t* hb; float* ssq; int rowmask;
    __device__ __forceinline__ void operator()(const f32x4 (&acc)[2][2][4][2], const pg8::Unit& u, int wr, int wc, int fr, int fq) const {
        const int row0 = u.pm * 256 + wr * 64 + fr, col0 = u.pn * 256 + wc * 32 + 8 * fq;
#pragma unroll
        for (int ai = 0; ai < 2; ++ai)
#pragma unroll
            for (int m = 0; m < 4; ++m) { const size_t off = (size_t)(row0 + ai * 128 + m * 16) * DM_ + col0; const size_t ooff = (size_t)((row0 + ai * 128 + m * 16) & rowmask) * DM_ + col0; float ss = 0.f;
#pragma unroll
                for (int bj = 0; bj < 2; ++bj) {
                    const f32x4 b0 = *(const f32x4*)(base + off + bj * 128), b1 = *(const f32x4*)(base + off + bj * 128 + 4);
                    const f32x4 v0 = b0 + acc[ai][bj][m][0], v1 = b1 + acc[ai][bj][m][1];
                    ss += (v0[0] * v0[0] + v0[1] * v0[1]) + (v0[2] * v0[2] + v0[3] * v0[3]) + (v1[0] * v1[0] + v1[1] * v1[1]) + (v1[2] * v1[2] + v1[3] * v1[3]);
                    *(f32x4*)(out + ooff + bj * 128) = v0; *(f32x4*)(out + ooff + bj * 128 + 4) = v1;
                    u32x4 w; w.x = cvtpk(v0[0], v0[1]); w.y = cvtpk(v0[2], v0[3]); w.z = cvtpk(v1[0], v1[1]); w.w = cvtpk(v1[2], v1[3]);
                    *(u32x4*)(hb + off + bj * 128) = w; }
                ss += __shfl_xor(ss, 16); ss += __shfl_xor(ss, 32);
                if (fq == 0) __hip_atomic_fetch_add(ssq + row0 + ai * 128 + m * 16, ss, __ATOMIC_RELAXED, __HIP_MEMORY_SCOPE_AGENT);
                asm volatile("" ::: "memory"); }
    }
};
struct EpiUp {
    static constexpr bool PERM = true, AFTER_DRAIN = false, HEADMAP = false;
    bf16_t* O; const float* rstd;
    __device__ __forceinline__ void operator()(const f32x4 (&acc)[2][2][4][2], const pg8::Unit& u, int wr, int wc, int fr, int fq) const {
        const int row0 = u.pm * 256 + wr * 64 + fr, col0 = u.pn * 256 + wc * 32 + 8 * fq;
#pragma unroll
        for (int ai = 0; ai < 2; ++ai)
#pragma unroll
            for (int m = 0; m < 4; ++m) { const int row = row0 + ai * 128 + m * 16; const float rs = rsqf_(rstd[row] * (1.f / DM_) + EPS_); bf16_t* rowp = O + (size_t)row * FF_ + col0;
#pragma unroll
                for (int bj = 0; bj < 2; ++bj) { f32x4 v0 = acc[ai][bj][m][0] * rs, v1 = acc[ai][bj][m][1] * rs;
#pragma unroll
                    for (int e = 0; e < 4; ++e) { const float a = fmaxf(v0[e], 0.f), b = fmaxf(v1[e], 0.f); v0[e] = a * a; v1[e] = b * b; }
                    u32x4 w; w.x = cvtpk(v0[0], v0[1]); w.y = cvtpk(v0[2], v0[3]); w.z = cvtpk(v1[0], v1[1]); w.w = cvtpk(v1[2], v1[3]);
                    *(u32x4*)(rowp + bj * 128) = w; } }
    }
};
struct EpiFinal {
    static constexpr bool PERM = true, AFTER_DRAIN = false, HEADMAP = false;
    const float* hin; float* out; const bf16_t* pp; const float* rstd;
    __device__ __forceinline__ void operator()(const f32x4 (&acc)[2][2][4][2], const pg8::Unit& u, int wr, int wc, int fr, int fq) const {
        const int row0 = u.pm * 256 + wr * 64 + fr, col0 = u.pn * 256 + wc * 32 + 8 * fq;
#pragma unroll
        for (int ai = 0; ai < 2; ++ai)
#pragma unroll
            for (int m = 0; m < 4; ++m) { const int row = row0 + ai * 128 + m * 16; const float rs = rsqf_(rstd[row] * (1.f / DM_) + EPS_); const size_t off = (size_t)row * DM_ + col0;
#pragma unroll
                for (int bj = 0; bj < 2; ++bj) {
                    const f32x4 h0 = *(const f32x4*)(hin + off + bj * 128), h1 = *(const f32x4*)(hin + off + bj * 128 + 4);
                    const u32x4 pw = *(const u32x4*)(pp + off + bj * 128);
                    const f32x4 a0 = acc[ai][bj][m][0] * rs, a1 = acc[ai][bj][m][1] * rs;
                    f32x4 o0, o1;
                    o0[0] = h0[0] + sigm(a0[0]) * bflo(pw.x); o0[1] = h0[1] + sigm(a0[1]) * bfhi(pw.x); o0[2] = h0[2] + sigm(a0[2]) * bflo(pw.y); o0[3] = h0[3] + sigm(a0[3]) * bfhi(pw.y);
                    o1[0] = h1[0] + sigm(a1[0]) * bflo(pw.z); o1[1] = h1[1] + sigm(a1[1]) * bfhi(pw.z); o1[2] = h1[2] + sigm(a1[2]) * bflo(pw.w); o1[3] = h1[3] + sigm(a1[3]) * bfhi(pw.w);
                    *(f32x4*)(out + off + bj * 128) = o0; *(f32x4*)(out + off + bj * 128 + 4) = o1; }
                asm volatile("" ::: "memory"); }
    }
};


struct EpiRes4 {
    static constexpr bool PERM = true, AFTER_DRAIN = false, HEADMAP = false;
    const float* base; bf16_t* hb; float* ssq;
    __device__ __forceinline__ void operator()(const f32x4 (&acc)[2][2][4][2], const pg8::Unit& u, int wr, int wc, int fr, int fq) const {
        const int row0 = u.pm * 256 + wr * 64 + fr, col0 = u.pn * 256 + wc * 32 + 8 * fq;
        f32x4 X[8][2][2];
#define E4_LD(g) do { const size_t off_ = (size_t)(row0 + ((g) >> 2) * 128 + ((g) & 3) * 16) * DM_ + col0; \
        _Pragma("unroll") for (int bj = 0; bj < 2; ++bj) { X[g][bj][0] = *(const f32x4*)(base + off_ + bj * 128); X[g][bj][1] = *(const f32x4*)(base + off_ + bj * 128 + 4); } } while (0)
        E4_LD(0); E4_LD(1); E4_LD(2); E4_LD(3);
        asm volatile("" ::: "memory");
#pragma unroll
        for (int g = 0; g < 8; ++g) { const int ai = g >> 2, m = g & 3; const size_t off = (size_t)(row0 + ai * 128 + m * 16) * DM_ + col0; float ss = 0.f;
#pragma unroll
            for (int bj = 0; bj < 2; ++bj) {
                const f32x4 v0 = X[g][bj][0] + acc[ai][bj][m][0], v1 = X[g][bj][1] + acc[ai][bj][m][1];
                ss += (v0[0] * v0[0] + v0[1] * v0[1]) + (v0[2] * v0[2] + v0[3] * v0[3]) + (v1[0] * v1[0] + v1[1] * v1[1]) + (v1[2] * v1[2] + v1[3] * v1[3]);
                u32x4 w; w.x = cvtpk(v0[0], v0[1]); w.y = cvtpk(v0[2], v0[3]); w.z = cvtpk(v1[0], v1[1]); w.w = cvtpk(v1[2], v1[3]);
                *(u32x4*)(hb + off + bj * 128) = w; }
            ss += __shfl_xor(ss, 16); ss += __shfl_xor(ss, 32);
            if (fq == 0) __hip_atomic_fetch_add(ssq + row0 + ai * 128 + m * 16, ss, __ATOMIC_RELAXED, __HIP_MEMORY_SCOPE_AGENT);
            if (g + 4 < 8) { E4_LD(g + 4); }
            asm volatile("" ::: "memory"); }
#undef E4_LD
    }
};
struct EpiRes4b {
    static constexpr bool PERM = true, AFTER_DRAIN = false, HEADMAP = false;
    bf16_t* hb; const float* rinv0; const float* g1; float* ssq;
    __device__ __forceinline__ void operator()(const f32x4 (&acc)[2][2][4][2], const pg8::Unit& u, int wr, int wc, int fr, int fq) const {
        const int row0 = u.pm * 256 + wr * 64 + fr, col0 = u.pn * 256 + wc * 32 + 8 * fq;
        f32x4 gi[2][2];
#pragma unroll
        for (int bj = 0; bj < 2; ++bj)
#pragma unroll
            for (int n = 0; n < 2; ++n) { const f32x4 gv = *(const f32x4*)(g1 + col0 + bj * 128 + 4 * n); gi[bj][n] = (f32x4){rcpf_(gv[0]), rcpf_(gv[1]), rcpf_(gv[2]), rcpf_(gv[3])}; }
        u32x4 H[8][2]; float RI[8];
#define E4_LD(g) do { const int row_ = row0 + ((g) >> 2) * 128 + ((g) & 3) * 16; const size_t off_ = (size_t)row_ * DM_ + col0; RI[g] = rinv0[row_]; \
        _Pragma("unroll") for (int bj = 0; bj < 2; ++bj) H[g][bj] = *(const u32x4*)(hb + off_ + bj * 128); } while (0)
        E4_LD(0); E4_LD(1); E4_LD(2); E4_LD(3);
        asm volatile("" ::: "memory");
#pragma unroll
        for (int g = 0; g < 8; ++g) { const int ai = g >> 2, m = g & 3; const size_t off = (size_t)(row0 + ai * 128 + m * 16) * DM_ + col0; float ss = 0.f; const float ri = RI[g];
#pragma unroll
            for (int bj = 0; bj < 2; ++bj) { const u32x4 hw = H[g][bj];
                const f32x4 x0 = (f32x4){bflo(hw.x), bfhi(hw.x), bflo(hw.y), bfhi(hw.y)} * gi[bj][0] * ri, x1 = (f32x4){bflo(hw.z), bfhi(hw.z), bflo(hw.w), bfhi(hw.w)} * gi[bj][1] * ri;
                const f32x4 v0 = x0 + acc[ai][bj][m][0], v1 = x1 + acc[ai][bj][m][1];
                ss += (v0[0] * v0[0] + v0[1] * v0[1]) + (v0[2] * v0[2] + v0[3] * v0[3]) + (v1[0] * v1[0] + v1[1] * v1[1]) + (v1[2] * v1[2] + v1[3] * v1[3]);
                u32x4 w; w.x = cvtpk(v0[0], v0[1]); w.y = cvtpk(v0[2], v0[3]); w.z = cvtpk(v1[0], v1[1]); w.w = cvtpk(v1[2], v1[3]);
                *(u32x4*)(hb + off + bj * 128) = w; }
            ss += __shfl_xor(ss, 16); ss += __shfl_xor(ss, 32);
            if (fq == 0) __hip_atomic_fetch_add(ssq + row0 + ai * 128 + m * 16, ss, __ATOMIC_RELAXED, __HIP_MEMORY_SCOPE_AGENT);
            if (g + 4 < 8) { E4_LD(g + 4); }
            asm volatile("" ::: "memory"); }
#undef E4_LD
    }
};
struct EpiRes6 {
    static constexpr bool PERM = true, AFTER_DRAIN = false, HEADMAP = false;
    bf16_t* hb; float* ssq;
    __device__ __forceinline__ void operator()(const f32x4 (&acc)[2][2][4][2], const pg8::Unit& u, int wr, int wc, int fr, int fq) const {
        const int row0 = u.pm * 256 + wr * 64 + fr, col0 = u.pn * 256 + wc * 32 + 8 * fq;
        u32x4 H[8][2];
#define E6_LD(g) do { const size_t off_ = (size_t)(row0 + ((g) >> 2) * 128 + ((g) & 3) * 16) * DM_ + col0; \
        _Pragma("unroll") for (int bj = 0; bj < 2; ++bj) H[g][bj] = *(const u32x4*)(hb + off_ + bj * 128); } while (0)
        E6_LD(0); E6_LD(1); E6_LD(2); E6_LD(3);
        asm volatile("" ::: "memory");
#pragma unroll
        for (int g = 0; g < 8; ++g) { const int ai = g >> 2, m = g & 3; const size_t off = (size_t)(row0 + ai * 128 + m * 16) * DM_ + col0; float ss = 0.f;
#pragma unroll
            for (int bj = 0; bj < 2; ++bj) { const u32x4 hw = H[g][bj];
                const f32x4 b0 = {bflo(hw.x), bfhi(hw.x), bflo(hw.y), bfhi(hw.y)}, b1 = {bflo(hw.z), bfhi(hw.z), bflo(hw.w), bfhi(hw.w)};
                const f32x4 v0 = b0 + acc[ai][bj][m][0], v1 = b1 + acc[ai][bj][m][1];
                ss += (v0[0] * v0[0] + v0[1] * v0[1]) + (v0[2] * v0[2] + v0[3] * v0[3]) + (v1[0] * v1[0] + v1[1] * v1[1]) + (v1[2] * v1[2] + v1[3] * v1[3]);
                u32x4 w; w.x = cvtpk(v0[0], v0[1]); w.y = cvtpk(v0[2], v0[3]); w.z = cvtpk(v1[0], v1[1]); w.w = cvtpk(v1[2], v1[3]);
                *(u32x4*)(hb + off + bj * 128) = w; }
            ss += __shfl_xor(ss, 16); ss += __shfl_xor(ss, 32);
            if (fq == 0) __hip_atomic_fetch_add(ssq + row0 + ai * 128 + m * 16, ss, __ATOMIC_RELAXED, __HIP_MEMORY_SCOPE_AGENT);
            if (g + 4 < 8) { E6_LD(g + 4); }
            asm volatile("" ::: "memory"); }
#undef E6_LD
    }
};
struct EpiFinalB {
    static constexpr bool PERM = true, AFTER_DRAIN = false, HEADMAP = false;
    const bf16_t* hb; float* out; const bf16_t* pp; const float* rstd;
    __device__ __forceinline__ void operator()(const f32x4 (&acc)[2][2][4][2], const pg8::Unit& u, int wr, int wc, int fr, int fq) const {
        const int row0 = u.pm * 256 + wr * 64 + fr, col0 = u.pn * 256 + wc * 32 + 8 * fq;
        u32x4 H[8][2], P[8][2]; float RS[8];
#define EF_LD(g) do { const int row_ = row0 + ((g) >> 2) * 128 + ((g) & 3) * 16; const size_t off_ = (size_t)row_ * DM_ + col0; RS[g] = rstd[row_]; \
        _Pragma("unroll") for (int bj = 0; bj < 2; ++bj) { H[g][bj] = *(const u32x4*)(hb + off_ + bj * 128); P[g][bj] = *(const u32x4*)(pp + off_ + bj * 128); } } while (0)
        EF_LD(0); EF_LD(1); EF_LD(2); EF_LD(3);
        asm volatile("" ::: "memory");
#pragma unroll
        for (int g = 0; g < 8; ++g) { const int ai = g >> 2, m = g & 3; const size_t off = (size_t)(row0 + ai * 128 + m * 16) * DM_ + col0; const float rs = rsqf_(RS[g] * (1.f / DM_) + EPS_);
#pragma unroll
            for (int bj = 0; bj < 2; ++bj) { const u32x4 hw = H[g][bj], pw = P[g][bj];
                const f32x4 a0 = acc[ai][bj][m][0] * rs, a1 = acc[ai][bj][m][1] * rs;
                f32x4 o0, o1;
                o0[0] = bflo(hw.x) + sigm(a0[0]) * bflo(pw.x); o0[1] = bfhi(hw.x) + sigm(a0[1]) * bfhi(pw.x); o0[2] = bflo(hw.y) + sigm(a0[2]) * bflo(pw.y); o0[3] = bfhi(hw.y) + sigm(a0[3]) * bfhi(pw.y);
                o1[0] = bflo(hw.z) + sigm(a1[0]) * bflo(pw.z); o1[1] = bfhi(hw.z) + sigm(a1[1]) * bfhi(pw.z); o1[2] = bflo(hw.w) + sigm(a1[2]) * bflo(pw.w); o1[3] = bfhi(hw.w) + sigm(a1[3]) * bfhi(pw.w);
                *(f32x4*)(out + off + bj * 128) = o0; *(f32x4*)(out + off + bj * 128 + 4) = o1; }
            if (g + 4 < 8) { EF_LD(g + 4); }
            asm volatile("" ::: "memory"); }
#undef EF_LD
    }
};

struct EpiMidPP {
    u32x4* park;
    __device__ __forceinline__ void operator()(const f32x4 (&acc)[2][2][4][2], const pg8::Unit& u, int wr, int wc, int fr, int fq) const {
        asm volatile("" : "+v"(fr), "+v"(fq));
        const unsigned pko_ = (unsigned)((wr * 4 + wc) * 64 + fq * 16 + fr);
#pragma unroll
        for (int ai = 0; ai < 2; ++ai)
#pragma unroll
            for (int m = 0; m < 4; ++m)
#pragma unroll
                for (int bj = 0; bj < 2; ++bj) { const f32x4 v0 = acc[ai][bj][m][0], v1 = acc[ai][bj][m][1];
                    u32x4 w; w.x = cvtpk(v0[0], v0[1]); w.y = cvtpk(v0[2], v0[3]); w.z = cvtpk(v1[0], v1[1]); w.w = cvtpk(v1[2], v1[3]);
                    park[pko_ + (unsigned)((((ai * 4 + m) * 2 + bj) * 8) * 64)] = w; }
    }
};
struct EpiFinalC {
    const bf16_t* hb; float* out; const float* rstd; const u32x4* park;
    __device__ __forceinline__ void operator()(const f32x4 (&acc)[2][2][4][2], const pg8::Unit& u, int wr, int wc, int fr, int fq) const {
        asm volatile("" : "+v"(fr), "+v"(fq));
        const int row0 = u.pm * 256 + wr * 64 + fr, col0 = u.pn * 256 + wc * 32 + 8 * fq;
        const unsigned pko_ = (unsigned)((wr * 4 + wc) * 64 + fq * 16 + fr);
        u32x4 H[8][2], P[8][2]; float RS[8];
#define EF_LD(g) do { const int row_ = row0 + ((g) >> 2) * 128 + ((g) & 3) * 16; const size_t off_ = (size_t)row_ * DM_ + col0; RS[g] = rstd[row_]; \
        _Pragma("unroll") for (int bj = 0; bj < 2; ++bj) { H[g][bj] = *(const u32x4*)(hb + off_ + bj * 128); P[g][bj] = park[pko_ + (unsigned)((((g) * 2 + bj) * 8) * 64)]; } } while (0)
        EF_LD(0); EF_LD(1); EF_LD(2); EF_LD(3);
        asm volatile("" ::: "memory");
#pragma unroll
        for (int g = 0; g < 8; ++g) { const int ai = g >> 2, m = g & 3; const size_t off = (size_t)(row0 + ai * 128 + m * 16) * DM_ + col0; const float rs = rsqf_(RS[g] * (1.f / DM_) + EPS_);
#pragma unroll
            for (int bj = 0; bj < 2; ++bj) { const u32x4 hw = H[g][bj], pw = P[g][bj];
                const f32x4 a0 = acc[ai][bj][m][0] * rs, a1 = acc[ai][bj][m][1] * rs;
                f32x4 o0, o1;
                o0[0] = bflo(hw.x) + sigm(a0[0]) * bflo(pw.x); o0[1] = bfhi(hw.x) + sigm(a0[1]) * bfhi(pw.x); o0[2] = bflo(hw.y) + sigm(a0[2]) * bflo(pw.y); o0[3] = bfhi(hw.y) + sigm(a0[3]) * bfhi(pw.y);
                o1[0] = bflo(hw.z) + sigm(a1[0]) * bflo(pw.z); o1[1] = bfhi(hw.z) + sigm(a1[1]) * bfhi(pw.z); o1[2] = bflo(hw.w) + sigm(a1[2]) * bflo(pw.w); o1[3] = bfhi(hw.w) + sigm(a1[3]) * bfhi(pw.w);
                *(f32x4*)(out + off + bj * 128) = o0; *(f32x4*)(out + off + bj * 128 + 4) = o1; }
            if (g + 4 < 8) { EF_LD(g + 4); }
            asm volatile("" ::: "memory"); }
#undef EF_LD
    }
};

__device__ __forceinline__ void p0_transpose_item(const float* W, int K, int N, bf16_t* WT, const float* ks0, const float* ks1, int ksplit, LAS float* scr, int item, int lane) {
    const int nblk = N / 32, kb = item / nblk, nb = item % nblk, k0 = 64 * kb, n0 = 32 * nb;
#pragma unroll 8
    for (int i = 0; i < 32; ++i) { const int kk = 2 * i + (lane >> 5), k = k0 + kk; float s = 1.f; if (ks0) s = (k < ksplit) ? ks0[k] : ks1[k - ksplit];
        scr[kk * 33 + (lane & 31)] = W[(size_t)k * N + n0 + (lane & 31)] * s; }
    asm volatile("s_waitcnt lgkmcnt(0)" ::: "memory");
    const int c = lane & 7;
#pragma unroll
    for (int j = 0; j < 4; ++j) { const int n = (lane >> 3) + 8 * j; const LAS float* s = scr + (8 * c) * 33 + n;
        u32x4 o; o.x = cvtpk(s[0 * 33], s[1 * 33]); o.y = cvtpk(s[2 * 33], s[3 * 33]); o.z = cvtpk(s[4 * 33], s[5 * 33]); o.w = cvtpk(s[6 * 33], s[7 * 33]);
        *(u32x4*)(WT + (size_t)(n0 + n) * K + k0 + 8 * c) = o; }
    asm volatile("s_waitcnt lgkmcnt(0)" ::: "memory");
}
__device__ __forceinline__ void attn_phase(LAS unsigned char* lds, const bf16_t* PROJ, const bf16_t* VT, const float* gq, const float* gk, const float* rb, bf16_t* MERGED, int vcu, int G, const int wave_u) {
    int tid_ = wave_u * 64 + lane_id_v(); asm volatile("" : "+v"(tid_));
    const int tid = tid_, lane = tid & 63, h = __builtin_amdgcn_readfirstlane(tid >> 6), ql = lane & 31, hi = lane >> 5;
    LAS float* SQ = (LAS float*)lds;
    LAS float* EXT = (LAS float*)(lds + 2048) + h * 640;
    float mq = wave_max(fabsf(gq[lane])), mk = wave_max(fabsf(gk[lane])); float mb = -1e30f;
    for (int i = lane; i < 513; i += 64) mb = fmaxf(mb, rb[h * 513 + i]);
    mb = wave_max(mb);
    const float c512 = rb[h * 513 + 512]; (void)mq; (void)mk; (void)mb;
    for (int i = lane; i < 640; i += 64) { int rel = i - 64; rel = rel > 256 ? 256 : (rel < -256 ? -256 : rel); EXT[639 - i] = (rb[h * 513 + rel + 256] - c512) * LOG2E; }
    asm volatile("s_waitcnt lgkmcnt(0)" ::: "memory");
    __syncthreads();
    bf16x8 qf[2][4], kn[4], vn[4];
    const unsigned kgo = (unsigned)((lane >> 3) * PJW + (lane & 7) * 8), vgo = (unsigned)((lane >> 2) * T_ + (lane & 3) * 8);
#define LOADKV2(KB, VB, IT) do { const bf16_t* kp_ = (KB) + (long)(IT) * 32 * PJW; const bf16_t* vp_ = (VB) + (IT) * 32; \
        _Pragma("unroll") for (int i = 0; i < 4; ++i) { kn[i] = *(const bf16x8*)(kp_ + (kgo + (unsigned)(i * 8 * PJW))); vn[i] = *(const bf16x8*)(vp_ + (vgo + (unsigned)(i * 16 * T_))); } } while (0)
#define UNIT_PREFETCH(U) do { const int b_ = (U) >> 7, n_ = (U) & 127; const long tk_ = (long)b_ * SEQ_ + n_ * 64; const int i0_ = (n_ < 8) ? 2 * (8 - n_) : 0; \
        const bf16_t* qp_ = PROJ + (tk_ + ql) * PJW + 1024 + h * 64 + hi * 8; \
        _Pragma("unroll") for (int qb = 0; qb < 2; ++qb) _Pragma("unroll") for (int d0 = 0; d0 < 4; ++d0) qf[qb][d0] = *(const bf16x8*)(qp_ + (long)qb * 32 * PJW + d0 * 16); \
        LOADKV2(PROJ + (tk_ - 512) * PJW + 1536 + h * 64, VT + (long)(h * 64) * T_ + (tk_ - 512), i0_); } while (0)
    if (vcu < NUNIT_ATT) UNIT_PREFETCH(vcu);
    for (int unit = vcu; unit < NUNIT_ATT; unit += G) {
        const int b = unit >> 7, n = unit & 127; const long tok0 = (long)b * SEQ_ + n * 64;
        f32x16 o[2][2];
#pragma unroll
        for (int a = 0; a < 2; ++a)
#pragma unroll
            for (int c = 0; c < 2; ++c)
#pragma unroll
                for (int r = 0; r < 16; ++r) o[a][c][r] = 0.f;
        float lsum[2] = {0.f, 0.f};
        const int it0 = (n < 8) ? 2 * (8 - n) : 0;
        const bf16_t* kbase = PROJ + (tok0 - 512) * PJW + 1536 + h * 64;
        const bf16_t* vbase = VT + (long)(h * 64) * T_ + (tok0 - 512);
        LAS unsigned char* kv = lds + 24576 + h * 8192;
        const unsigned wk = (unsigned)((lane >> 3) * 128 + (((lane & 7) ^ (lane >> 3)) * 16));
        const unsigned wvl = (unsigned)(4096 + (lane >> 2) * 64 + ((((unsigned)((lane & 3) >> 1) * 2u + 0u) ^ (unsigned)((lane >> 3) & 3)) * 16) + (lane & 1) * 8);
        const unsigned wvh = (unsigned)(4096 + (lane >> 2) * 64 + ((((unsigned)((lane & 3) >> 1) * 2u + 1u) ^ (unsigned)((lane >> 3) & 3)) * 16) + (lane & 1) * 8);
        const unsigned rkb = (unsigned)(ql * 128), rks = (unsigned)(ql & 7), rvb = (unsigned)(4096 + ql * 64), rvs = (unsigned)((ql >> 1) & 3);
#define LOADKV(IT) LOADKV2(kbase, vbase, IT)
        for (int it = it0; it < 18; ++it) {
#pragma unroll
            for (int i = 0; i < 4; ++i) { *(LAS bf16x8*)(kv + wk + i * 1024) = kn[i]; const u32x4 vv = __builtin_bit_cast(u32x4, vn[i]);
                *(LAS u32x2*)(kv + wvl + i * 1024) = (u32x2){vv.x, vv.y}; *(LAS u32x2*)(kv + wvh + i * 1024) = (u32x2){vv.z, vv.w}; }
            { const int itn = (it + 1 < 18) ? it + 1 : it; LOADKV(itn); }
            bf16x8 kf[4], vf[2][2];
#pragma unroll
            for (int d0 = 0; d0 < 4; ++d0) kf[d0] = *(const LAS bf16x8*)(kv + rkb + (((unsigned)(2 * d0 + hi) ^ rks) * 16));
#pragma unroll
            for (int db = 0; db < 2; ++db)
#pragma unroll
                for (int ks = 0; ks < 2; ++ks) vf[db][ks] = *(const LAS bf16x8*)(kv + rvb + db * 2048 + (((unsigned)(2 * ks + hi) ^ rvs) * 16));
            const bool tab = (it >= 8);
#pragma unroll
            for (int qb = 0; qb < 2; ++qb) {
                f32x16 s;
                if (tab) { const LAS float* e = EXT + (63 - 32 * qb - ql + 32 * it + 4 * hi); f32x16 cin;
#pragma unroll
                    for (int r = 0; r < 16; ++r) cin[r] = e[(r & 3) + 8 * (r >> 2)];
                    s = MFMA32(kf[0], qf[qb][0], cin); }
                else { f32x16 z_;
#pragma unroll
                    for (int r = 0; r < 16; ++r) z_[r] = 0.f;
                    s = MFMA32(kf[0], qf[qb][0], z_); }
#pragma unroll
                for (int d0 = 1; d0 < 4; ++d0) s = MFMA32(kf[d0], qf[qb][d0], s);
                float ps = 0.f;
#pragma unroll
                for (int r = 0; r < 16; ++r) { s[r] = ex2(s[r]); ps += s[r]; }
                lsum[qb] += ps;
                bf16x8 pk[2];
#pragma unroll
                for (int ks = 0; ks < 2; ++ks) { u32x4 w; w.x = cvtpk(s[8 * ks], s[8 * ks + 1]); w.y = cvtpk(s[8 * ks + 2], s[8 * ks + 3]); w.z = cvtpk(s[8 * ks + 4], s[8 * ks + 5]); w.w = cvtpk(s[8 * ks + 6], s[8 * ks + 7]);
                    pk[ks] = __builtin_bit_cast(bf16x8, w); }
#pragma unroll
                for (int db = 0; db < 2; ++db)
#pragma unroll
                    for (int ks = 0; ks < 2; ++ks) o[db][qb] = MFMA32(vf[db][ks], pk[ks], o[db][qb]);
            }
        }
#undef LOADKV
        if (unit + G < NUNIT_ATT) UNIT_PREFETCH(unit + G);
        float inv[2], sq[2];
#pragma unroll
        for (int qb = 0; qb < 2; ++qb) { float l = lsum[qb]; l += __shfl_xor(l, 32); inv[qb] = 1.f / l; float q2 = 0.f;
#pragma unroll
            for (int db = 0; db < 2; ++db)
#pragma unroll
                for (int r = 0; r < 16; ++r) { const float v = o[db][qb][r] * inv[qb]; o[db][qb][r] = v; q2 += v * v; }
            q2 += __shfl_xor(q2, 32); sq[qb] = q2;
            if (hi == 0) SQ[h * 64 + 32 * qb + ql] = q2; }
        asm volatile("s_waitcnt lgkmcnt(0)" ::: "memory");
        __syncthreads();
#pragma unroll
        for (int qb = 0; qb < 2; ++qb) { float tot = 0.f;
#pragma unroll
            for (int hh = 0; hh < 8; ++hh) tot += SQ[hh * 64 + 32 * qb + ql];
            const float rstd = rsqf_(tot * (1.f / 512.f) + EPS_);
            bf16_t* op = MERGED + (tok0 + 32 * qb + ql) * DM_ + 512 + h * 64 + 4 * hi;
#pragma unroll
            for (int db = 0; db < 2; ++db)
#pragma unroll
                for (int r4 = 0; r4 < 4; ++r4) { u32x2 w; w.x = cvtpk(o[db][qb][4 * r4] * rstd, o[db][qb][4 * r4 + 1] * rstd); w.y = cvtpk(o[db][qb][4 * r4 + 2] * rstd, o[db][qb][4 * r4 + 3] * rstd);
                    *(u32x2*)(op + 32 * db + 8 * r4) = w; } }
        __syncthreads();
    }
}

template <bool PASS2>
__device__ __forceinline__ void lru_unit(LAS unsigned char* lds, int unit, const bf16_t* PROJ, const bf16_t* WGT, const float* conv_w, const float* conv_b, const float* b_rg, const float* b_ig,
                                         const float* lam, f32x2* SUMM, bf16_t* MERGED, const int wave_u) {
    int tid_ = wave_u * 64 + lane_id_v(); asm volatile("" : "+v"(tid_));
    const int tid = tid_, lane = tid & 63, w = __builtin_amdgcn_readfirstlane(tid >> 6), ql = lane & 31, hi = lane >> 5;
    const int b = unit >> 5, seg = unit & 31; const long tok0 = (long)b * SEQ_ + seg * 256;
    LAS bf16_t* XC = (LAS bf16_t*)lds + w * (64 * 72);
    LAS bf16_t* YT = (LAS bf16_t*)(lds + 73728);
    const int chc = 64 * w + lane;
    const float cw0 = conv_w[chc], cw1 = conv_w[512 + chc], cw2 = conv_w[1024 + chc], cw3 = conv_w[1536 + chc], cbv = conv_b[chc];
    float brg[2], big[2], sp[2];
#pragma unroll
    for (int nb = 0; nb < 2; ++nb) { const int ch = 64 * w + 32 * nb + ql; brg[nb] = b_rg[ch]; big[nb] = b_ig[ch];
        sp[nb] = -8.f * LOG2E * log1pf(expf(-lam[ch])); }
    float carry[2] = {0.f, 0.f}, ptot[2] = {1.f, 1.f};
    if (PASS2) {
#pragma unroll
        for (int nb = 0; nb < 2; ++nb) { float c = 0.f; const f32x2* sp_ = SUMM + (size_t)(b * 32) * 512 + 64 * w + 32 * nb + ql;
            for (int s0 = 0; s0 < seg; s0 += 8) { f32x2 v[8];
#pragma unroll
                for (int j = 0; j < 8; ++j) v[j] = (s0 + j < seg) ? sp_[(size_t)(s0 + j) * 512] : (f32x2){1.f, 0.f};
#pragma unroll
                for (int j = 0; j < 8; ++j) c = v[j].x * c + v[j].y; }
            carry[nb] = c; }
    }
    float x1 = 0.f, x2 = 0.f, x3 = 0.f;
#pragma nounroll
    for (int st = 0; st < 4; ++st) {
        const long t0 = tok0 + 64 * st;
        {
            const bf16_t* xt = PROJ + t0 * PJW + 64 * w;
            const unsigned go = (unsigned)((lane >> 3) * PJW + (lane & 7) * 8);
            bf16x8 raw[8];
#pragma unroll
            for (int i = 0; i < 8; ++i) raw[i] = *(const bf16x8*)(xt + (go + (unsigned)(i * 8 * PJW)));
            if (st == 0) { x1 = 0.f; x2 = 0.f; x3 = 0.f;
                if (seg != 0) { const bf16_t* xp = PROJ + t0 * PJW + chc; x1 = bf2f(xp[-1 * PJW]); x2 = bf2f(xp[-2 * PJW]); x3 = bf2f(xp[-3 * PJW]); } }
#pragma unroll
            for (int i = 0; i < 8; ++i) *(LAS bf16x8*)(XC + (8 * i + (lane >> 3)) * 72 + (lane & 7) * 8) = raw[i];
#pragma unroll 16
            for (int t = 0; t < 64; ++t) { const float xv = bf2f(XC[t * 72 + lane]); const float xc = cbv + cw0 * x3 + cw1 * x2 + cw2 * x1 + cw3 * xv;
                XC[t * 72 + lane] = (bf16_t)(cvtpk(xc, 0.f) & 0xffffu); x3 = x2; x2 = x1; x1 = xv; }
        }
        asm volatile("s_waitcnt lgkmcnt(0)" ::: "memory");
#pragma unroll
        for (int nb = 0; nb < 2; ++nb) {
            bf16x8 wrf[4], wif[4];
            { int woff = ((w * 2 + nb) * 4 * 64 + lane) * 8; asm volatile("" : "+v"(woff));
#pragma unroll
              for (int ks = 0; ks < 4; ++ks) { wrf[ks] = *(const bf16x8*)(WGT + woff + ks * 512); wif[ks] = *(const bf16x8*)(WGT + 8 * 4096 + woff + ks * 512); } }
#pragma unroll
            for (int tb = 0; tb < 2; ++tb) {
                bf16x8 af[4];
#pragma unroll
                for (int ks = 0; ks < 4; ++ks) af[ks] = *(const LAS bf16x8*)(XC + (32 * tb + ql) * 72 + 16 * ks + 8 * hi);
                f32x16 dr, di;
#pragma unroll
                for (int r = 0; r < 16; ++r) { dr[r] = 0.f; di[r] = 0.f; }
#pragma unroll
                for (int ks = 0; ks < 4; ++ks) { dr = MFMA32(af[ks], wrf[ks], dr); di = MFMA32(af[ks], wif[ks], di); }
                float A[16], U[16];
#pragma unroll
                for (int r = 0; r < 16; ++r) { const int tok = 32 * tb + crow(r, hi); const float xcv = bf2f(XC[tok * 72 + 32 * nb + ql]);
                    const float rg = sigm(dr[r] + brg[nb]), ig = sigm(di[r] + big[nb]); const float a = ex2(rg * sp[nb]);
                    const float mult = __builtin_amdgcn_sqrtf(fmaxf(1.f - a * a, 0.f)); A[r] = a; U[r] = mult * ig * xcv; }
#pragma unroll
                for (int q4 = 0; q4 < 4; ++q4)
#pragma unroll
                    for (int e = 1; e < 4; ++e) { U[4 * q4 + e] = A[4 * q4 + e] * U[4 * q4 + e - 1] + U[4 * q4 + e]; A[4 * q4 + e] = A[4 * q4 + e - 1] * A[4 * q4 + e]; }
                float c = carry[nb], HIN[4];
#pragma unroll
                for (int q4 = 0; q4 < 4; ++q4) { const float e0 = A[4 * q4 + 3] * c + U[4 * q4 + 3]; const float p = __shfl_xor(e0, 32); const float hin = hi ? p : c; HIN[q4] = hin;
                    const float e1 = A[4 * q4 + 3] * hin + U[4 * q4 + 3]; const float q = __shfl_xor(e1, 32); c = hi ? e1 : q; }
                carry[nb] = c;
                if (!PASS2) { const float po = (A[3] * A[7]) * (A[11] * A[15]); ptot[nb] *= po * __shfl_xor(po, 32); }
                else {
                    const bf16_t* gb = PROJ + t0 * PJW + 512 + 64 * w + 32 * nb + (32 * tb) * PJW;
                    const unsigned goff = (unsigned)(4 * hi) * PJW + ql;
#pragma unroll
                    for (int r = 0; r < 16; ++r) { const int tok = 32 * tb + crow(r, hi); const float hval = U[r] + A[r] * HIN[r >> 2]; const float gl = bf2f(gb[goff + (unsigned)((r & 3) + 8 * (r >> 2)) * PJW]);
                        YT[tok * 520 + 64 * w + 32 * nb + ql] = (bf16_t)(cvtpk(hval * gl, 0.f) & 0xffffu); }
                }
            }
        }
        if (PASS2) {
            asm volatile("s_waitcnt lgkmcnt(0)" ::: "memory");
            __syncthreads();
#pragma unroll
            for (int i = 0; i < 8; ++i) { const int tok = 8 * w + i; const u32x4 v = *(const LAS u32x4*)(YT + tok * 520 + 8 * lane);
                const float f0 = bflo(v.x), f1 = bfhi(v.x), f2 = bflo(v.y), f3 = bfhi(v.y), f4 = bflo(v.z), f5 = bfhi(v.z), f6 = bflo(v.w), f7 = bfhi(v.w);
                float ss = (f0 * f0 + f1 * f1) + (f2 * f2 + f3 * f3) + (f4 * f4 + f5 * f5) + (f6 * f6 + f7 * f7); ss = wave_sum(ss);
                const float rs = rsqf_(ss * (1.f / 512.f) + EPS_);
                u32x4 o; o.x = cvtpk(f0 * rs, f1 * rs); o.y = cvtpk(f2 * rs, f3 * rs); o.z = cvtpk(f4 * rs, f5 * rs); o.w = cvtpk(f6 * rs, f7 * rs);
                *(u32x4*)(MERGED + (t0 + tok) * DM_ + 8 * lane) = o; }
            __syncthreads();
        }
        asm volatile("" ::: "memory");
    }
    if (!PASS2) { if (hi == 0) {
#pragma unroll
        for (int nb = 0; nb < 2; ++nb) SUMM[(size_t)unit * 512 + 64 * w + 32 * nb + ql] = (f32x2){ptot[nb], carry[nb]}; } }
}

#ifndef PROBE_MASK
#define PROBE_MASK 0
#endif
#ifndef RES_BF16
#define RES_BF16 1
#endif
struct Args { const float* in[23]; float* out; unsigned char* ws; };
__global__ void __launch_bounds__(NTHR, 2) fwd_megakernel(Args args) {
    extern __shared__ __attribute__((aligned(16))) unsigned char lds_raw[];
    cg::grid_group grid = cg::this_grid();
    LAS unsigned char* lds = (LAS unsigned char*)lds_raw;
    const int wave = __builtin_amdgcn_readfirstlane(threadIdx.x >> 6);
#define tid (wave * 64 + lane_id_v())
#define lane (lane_id_v())
    const int G = gridDim.x, bx = blockIdx.x, vcu = (G % 8 == 0) ? (bx % 8) * (G / 8) + bx / 8 : bx;
    unsigned char* ws = args.ws;
    volatile LAS unsigned* MISC = (volatile LAS unsigned*)(lds + MISC_OFF);
    if (threadIdx.x < 16) MISC[threadIdx.x] = 0u;
    __syncthreads();
    XcdBarrier bar; bar.bar = (unsigned*)(ws + WS_CTL); bar.x = xb_xcc_id(); bar.st = MISC;
    if (blockIdx.x == 0) for (int i = threadIdx.x; i < (int)(CTL_BYTES / 4); i += NTHR) bar.bar[i] = 0u;
    const float* x = args.in[0]; const float* p = args.in[1]; float* out = args.out;
    bf16_t* WT_IN = (bf16_t*)(ws + WS_WIN); bf16_t* WT_OUT = (bf16_t*)(ws + WS_WOUT); bf16_t* WT_UP = (bf16_t*)(ws + WS_WUP); bf16_t* WT_DN = (bf16_t*)(ws + WS_WDN);
    bf16_t* WT_PG = (bf16_t*)(ws + WS_WPG); bf16_t* WT_PP = (bf16_t*)(ws + WS_WPP); bf16_t* WGT = (bf16_t*)(ws + WS_WG);
    float* RINV0 = (float*)(ws + WS_RINV0);
    float* RSTD1 = (float*)(ws + WS_RSTD1); float* RSTD2 = (float*)(ws + WS_RSTD2); f32x2* SUMM = (f32x2*)(ws + WS_SUMM);
    bf16_t* XN = (bf16_t*)(ws + WS_XN); bf16_t* PP = (bf16_t*)(ws + WS_PP); bf16_t* PB = (bf16_t*)(ws + WS_PB);
    bf16_t* PROJ = (bf16_t*)(ws + WS_PROJ); bf16_t* VT = (bf16_t*)(ws + WS_VT); bf16_t* MERGED = (bf16_t*)(ws + WS_MERGED); bf16_t* ACT = (bf16_t*)(ws + WS_ACT);

    for (int rep_ = 0; rep_ < 1 + ((PROBE_MASK >> 0) & 1); ++rep_) {
        LAS float* scr = (LAS float*)(lds + wave * 16384);
        const int gw = vcu * NWAVES + wave, NGW = G * NWAVES;
        constexpr int I_IN = 16 * 80, I_OUT = 16 * 32, I_UP = 16 * 128, I_DN = 64 * 32, I_PG = 16 * 32, I_PP = 4 * 32;
        constexpr int NITEMS = I_IN + I_OUT + I_UP + I_DN + I_PG + I_PP;
        for (int it = gw; it < NITEMS; it += NGW) {
            int r = it;
            if (r < I_IN) { p0_transpose_item(args.in[3], 1024, 2560, WT_IN, nullptr, nullptr, 0, scr, r, lane); continue; } r -= I_IN;
            if (r < I_OUT) { p0_transpose_item(args.in[16], 1024, 1024, WT_OUT, args.in[14], args.in[15], 512, scr, r, lane); continue; } r -= I_OUT;
            if (r < I_UP) { p0_transpose_item(args.in[18], 1024, 4096, WT_UP, args.in[17], args.in[17], 1 << 30, scr, r, lane); continue; } r -= I_UP;
            if (r < I_DN) { p0_transpose_item(args.in[19], 4096, 1024, WT_DN, nullptr, nullptr, 0, scr, r, lane); continue; } r -= I_DN;
            if (r < I_PG) { p0_transpose_item(args.in[21], 1024, 1024, WT_PG, args.in[20], args.in[20], 1 << 30, scr, r, lane); continue; } r -= I_PG;
            p0_transpose_item(args.in[22], 256, 1024, WT_PP, nullptr, nullptr, 0, scr, r, lane);
        }
        for (int i = bx * NTHR + tid; i < T_; i += G * NTHR) { RSTD1[i] = 0.f; RSTD2[i] = 0.f; }
        for (int i = bx * NTHR + tid; i < 65536; i += G * NTHR) { const int e = i & 7, ln = (i >> 3) & 63, ks = (i >> 9) & 3, nb = (i >> 11) & 1, blk = (i >> 12) & 7, gate = i >> 15;
            const int k = 16 * ks + 8 * (ln >> 5) + e, n = 32 * nb + (ln & 31);
            const float v = (gate ? args.in[8] : args.in[6])[blk * 4096 + k * 64 + n]; WGT[i] = (bf16_t)(cvtpk(v, 0.f) & 0xffffu); }
        const float* g1 = args.in[2];
        f32x4 gv[4];
#pragma unroll
        for (int j = 0; j < 4; ++j) gv[j] = *((const f32x4*)g1 + lane + 64 * j);
        for (int m = gw; m < T_; m += NGW) {
            const f32x4* xr = (const f32x4*)(x + (size_t)m * DM_) + lane; f32x4 v[4]; float s = 0.f;
#pragma unroll
            for (int j = 0; j < 4; ++j) { v[j] = __builtin_nontemporal_load(xr + 64 * j); s += (v[j].x * v[j].x + v[j].y * v[j].y) + (v[j].z * v[j].z + v[j].w * v[j].w); }
            const float ms_ = wave_sum(s) * (1.f / DM_) + EPS_; const float rstd = rsqf_(ms_);
            if (lane == 0) RINV0[m] = ms_ * rstd;
            u32x2* o8 = (u32x2*)(XN + (size_t)m * DM_) + lane;
#pragma unroll
            for (int j = 0; j < 4; ++j) { const f32x4 y = v[j] * gv[j] * rstd; u32x2 w; w.x = cvtpk(y.x, y.y); w.y = cvtpk(y.z, y.w); o8[64 * j] = w; }
            const f32x4 pv = __builtin_nontemporal_load((const f32x4*)(p + (size_t)m * PLE_) + lane); u32x2 pw; pw.x = cvtpk(pv.x, pv.y); pw.y = cvtpk(pv.z, pv.w);
            *((u32x2*)(PB + (size_t)m * PLE_) + lane) = pw;
        }
    }
    grid.sync();
    if (threadIdx.x == 0) MISC[2] = xb_add(&bar.bar[XB_XCNT(bar.x)], 1u);
    int cid = bx, vcu2 = vcu;
#define CENSUS_IDS() do { \
    if (threadIdx.x == 0) { unsigned okc = 1u; \
        for (unsigned j = 0; j < 16; ++j) { const unsigned c_ = xb_ld(&bar.bar[XB_XCNT(j)]); okc &= (j < 8 ? (c_ == (unsigned)G / 8u) : (c_ == 0u)) ? 1u : 0u; } \
        MISC[3] = (okc && (G % 8 == 0)) ? 1u : 0u; } \
    __syncthreads(); \
    { const bool okmap = MISC[3] != 0u; \
      cid = __builtin_amdgcn_readfirstlane(okmap ? (int)(MISC[2] * 8u + bar.x) : bx); \
      vcu2 = __builtin_amdgcn_readfirstlane(okmap ? (int)(bar.x * (unsigned)(G / 8) + MISC[2]) : vcu); } } while (0)
#if 0
    if (threadIdx.x == 0) { unsigned okc = 1u;
        for (unsigned j = 0; j < 16; ++j) { const unsigned c_ = xb_ld(&bar.bar[XB_XCNT(j)]); okc &= (j < 8 ? (c_ == (unsigned)G / 8u) : (c_ == 0u)) ? 1u : 0u; }
        MISC[3] = (okc && (G % 8 == 0)) ? 1u : 0u; }
    __syncthreads();
    const bool okmap = MISC[3] != 0u;
    const int cid = __builtin_amdgcn_readfirstlane(okmap ? (int)(MISC[2] * 8u + bar.x) : bx);
    const int vcu2 = __builtin_amdgcn_readfirstlane(okmap ? (int)(bar.x * (unsigned)(G / 8) + MISC[2]) : vcu);
#endif
    for (int rep_ = 0; rep_ < 1 + ((PROBE_MASK >> 1) & 1); ++rep_) {
        { pg8::Gemm g{XN, WT_IN, T_, 2048, 1024}; pg8::StaticOrder S; S.init(T_, 2048, G, cid); EpiProj E{PROJ, args.in[11], args.in[12]};
          pg8::gemm_phase<EpiProj, pg8::StaticOrder, PG8_ALIGN, PG8_SP2>(lds, g, S, E, wave); }
        { pg8::Gemm g{WT_IN + (size_t)2048 * 1024, XN, 512, T_, 1024}; pg8::StaticOrder S; S.init(512, T_, G, cid); EpiPlain E{VT, T_};
          pg8::gemm_phase<EpiPlain, pg8::StaticOrder, PG8_ALIGN, PG8_SP2>(lds, g, S, E, wave); }
    }
    xcd_barrier(bar);
    CENSUS_IDS();
    for (int rep_ = 0; rep_ < 1 + ((PROBE_MASK >> 2) & 1); ++rep_)
    attn_phase(lds, PROJ, VT, args.in[11]  , args.in[12], args.in[13], MERGED, vcu2, G, wave);
    for (int rep_ = 0; rep_ < 1 + ((PROBE_MASK >> 3) & 1); ++rep_)
    for (int unit = vcu2; unit < NUNIT_LRU; unit += G)
        lru_unit<false>(lds, unit, PROJ, WGT, args.in[4], args.in[5], args.in[7], args.in[9], args.in[10], SUMM, MERGED, wave);
    xcd_barrier(bar);
    for (int rep_ = 0; rep_ < 1 + ((PROBE_MASK >> 4) & 1); ++rep_)
    for (int unit = vcu2; unit < NUNIT_LRU; unit += G)
        lru_unit<true>(lds, unit, PROJ, WGT, args.in[4], args.in[5], args.in[7], args.in[9], args.in[10], SUMM, MERGED, wave);
    xcd_barrier(bar);
#if RES_BF16
    { pg8::Gemm g{MERGED, WT_OUT, T_, 1024, 1024}; pg8::StaticOrder S; S.init(T_, 1024, G, cid); EpiRes4b E{XN, RINV0, args.in[2], RSTD1};
      pg8::gemm_phase<EpiRes4b, pg8::StaticOrder, PG8_ALIGN, PG8_SP2>(lds, g, S, E, wave); }
#else
    for (int rep_ = ((PROBE_MASK >> 5) & 1) ? 0 : 1; rep_ < 2; ++rep_)
    { pg8::Gemm g{MERGED, WT_OUT, T_, 1024, 1024}; pg8::StaticOrder S; S.init(T_, 1024, G, cid); EpiRes E{x, out, XN, rep_ ? RSTD1 : (float*)(ws + WS_DUMMY), 0xFFFF};
      pg8::gemm_phase<EpiRes, pg8::StaticOrder, PG8_ALIGN, PG8_SP2>(lds, g, S, E, wave); }
#endif
    xcd_barrier(bar);
    for (int rep_ = 0; rep_ < 1 + ((PROBE_MASK >> 6) & 1); ++rep_) { pg8::Gemm g{XN, WT_UP, T_, 4096, 1024}; pg8::StaticOrder S; S.init(T_, 4096, G, cid); EpiUp E{ACT, RSTD1};
      pg8::gemm_phase<EpiUp, pg8::StaticOrder, PG8_ALIGN, PG8_SP2, (PROBE_MASK >> 9) & 1>(lds, g, S, E, wave); }
    xcd_barrier(bar);
#if RES_BF16
    { pg8::Gemm g{ACT, WT_DN, T_, 1024, 4096}; pg8::StaticOrder S; S.init(T_, 1024, G, cid); EpiRes6 E{XN, RSTD2};
      pg8::gemm_phase<EpiRes6, pg8::StaticOrder, PG8_ALIGN, PG8_SP2>(lds, g, S, E, wave); }
#else
    for (int rep_ = ((PROBE_MASK >> 7) & 1) ? 0 : 1; rep_ < 2; ++rep_)
    { pg8::Gemm g{ACT, WT_DN, T_, 1024, 4096}; pg8::StaticOrder S; S.init(T_, 1024, G, cid);
      EpiRes E{out, rep_ ? out : (float*)(ws + WS_END), XN, rep_ ? RSTD2 : (float*)(ws + WS_DUMMY), rep_ ? 0xFFFF : 0x7FFF};
      pg8::gemm_phase<EpiRes, pg8::StaticOrder, PG8_ALIGN, PG8_SP2>(lds, g, S, E, wave); }
#endif
    xcd_barrier(bar);
#if RES_BF16
    { pg8::StaticOrder S; S.init(T_, 1024, G, cid); EpiMidPP EM{(u32x4*)(ws + WS_PP) + (size_t)bx * 8192}; EpiFinalC EF{XN, out, RSTD2, (const u32x4*)(ws + WS_PP) + (size_t)bx * 8192};
      pg8::gemm_phase_ple<EpiMidPP, EpiFinalC, pg8::StaticOrder>(lds, PB, WT_PP, XN, WT_PG, S, EM, EF, wave); }
#else
    for (int rep_ = ((PROBE_MASK >> 8) & 1) ? 0 : 1; rep_ < 2; ++rep_)
    { pg8::Gemm g{XN, WT_PG, T_, 1024, 1024}; pg8::StaticOrder S; S.init(T_, 1024, G, cid); EpiFinal E{out, rep_ ? out : (float*)ACT, PP, RSTD2};
      pg8::gemm_phase<EpiFinal, pg8::StaticOrder, PG8_ALIGN, PG8_SP2>(lds, g, S, E, wave); }
#endif
}

#undef tid
#undef lane
extern "C" void kernel_launch(void* const* d_in, const int* in_sizes, int n_in, void* d_out, int out_size, void* d_ws, size_t ws_size, hipStream_t stream) {
    static int grid = 0;
    if (grid == 0) {
        if (n_in != 23 || in_sizes[0] != T_ * DM_ || out_size != T_ * DM_ || ws_size < WS_END) { fprintf(stderr, "kernel_launch: unexpected shapes (n_in %d, in0 %d, out %d, ws %zu)\n", n_in, n_in > 0 ? in_sizes[0] : -1, out_size, ws_size); grid = -1; return; }
        int dev = 0, cus = 0, per_cu = 0;
        (void)hipGetDevice(&dev); (void)hipDeviceGetAttribute(&cus, hipDeviceAttributeMultiprocessorCount, dev);
        (void)hipFuncSetAttribute((const void*)fwd_megakernel, hipFuncAttributeMaxDynamicSharedMemorySize, LDS_BYTES);
        if (hipOccupancyMaxActiveBlocksPerMultiprocessor(&per_cu, (const void*)fwd_megakernel, NTHR, LDS_BYTES) != hipSuccess || per_cu < 1) per_cu = 1;
        (void)hipGetLastError();
        grid = cus * per_cu;
        if (grid > 256) grid = 256;
        fprintf(stderr, "kernel_launch: cus %d per_cu %d grid %d\n", cus, per_cu, grid);
    }
    if (grid < 0) return;
    Args a{};
    for (int i = 0; i < 23; ++i) a.in[i] = (const float*)d_in[i];
    a.out = (float*)d_out; a.ws = (unsigned char*)d_ws;
    void* kargs[] = {&a};
    hipError_t e = hipLaunchCooperativeKernel((const void*)fwd_megakernel, dim3(grid), dim3(NTHR), kargs, LDS_BYTES, stream);
    if (e != hipSuccess) fprintf(stderr, "kernel_launch: cooperative launch failed: %s (grid %d)\n", hipGetErrorString(e), grid);
}
```

```cpp
#include <hip/hip_runtime.h>
#include <hip/hip_cooperative_groups.h>
#include <cstdio>
#include <cstdint>
namespace cg = cooperative_groups;
__device__ __forceinline__ int lane_id_v() { int l; asm volatile("v_mbcnt_lo_u32_b32 %0, -1, 0\n\tv_mbcnt_hi_u32_b32 %0, -1, %0" : "=v"(l)); return l; }
namespace pg8 {
#define PG8_LAS __attribute__((address_space(3)))
typedef unsigned short bf16_t;
typedef short bf16x8 __attribute__((ext_vector_type(8)));
typedef float f32x4 __attribute__((ext_vector_type(4)));
typedef unsigned u32x4 __attribute__((ext_vector_type(4)));
constexpr int BM = 256, BK = 64, HALF = 128, HTB = HALF * BK * 2  , STAGE_BYTES = 8 * HTB, NXCD = 8, WGM = 8;

__host__ __device__ __forceinline__ int lds_byte(int r, int c) { const int st = (r >> 4) * 2 + (c >> 5), rr = r & 15, cc = c & 31, ob = rr * 64 + cc * 2; return st * 1024 + (ob ^ (((ob >> 9) & 1) << 5)); }
__host__ __device__ __forceinline__ void stage_rc(int b, int& R, int& C) { const int st = b / 1024, sb = b % 1024, swz = sb ^ (((sb >> 9) & 1) << 5); R = (st >> 1) * 16 + swz / 64; C = (st & 1) * 32 + (swz % 64) / 2; }
__host__ __device__ __forceinline__ int perm32(int rho) { const int n = rho >> 4, i = rho & 15; return 8 * (i >> 2) + 4 * n + (i & 3); }

struct Unit { int pm, pn; };
struct Gemm { const bf16_t* A; const bf16_t* Bt; int M, N, K; };

struct StaticOrder {
    int nM, nN, nwg, G, c;
    __host__ __device__ void init(int M, int N, int G_, int c_) { nM = M / BM; nN = N / BM; nwg = nM * nN; G = G_; c = c_; }
    __host__ __device__ bool next(int i, Unit& u) const {
        const long L = (long)i * G + c; if (L >= nwg) return false;
        int wgid = (int)L; { const int q = nwg / NXCD, r = nwg % NXCD, xcd = wgid % NXCD, off = wgid / NXCD; wgid = (xcd < r ? xcd * (q + 1) : r * (q + 1) + (xcd - r) * q) + off; }
        const int nig = WGM * nN, gid = wgid / nig, fm = gid * WGM, gsz = (nM - fm) < WGM ? (nM - fm) : WGM;
        u.pm = fm + ((wgid % nig) % gsz); u.pn = (wgid % nig) / gsz; return true;
    }
    __device__ __forceinline__ void a_ready(const Unit&) const {}
    __device__ __forceinline__ void done(const Unit&) const {}
};

__device__ __forceinline__ unsigned cvt_pk_bf16(float lo, float hi) { unsigned r; asm volatile("v_cvt_pk_bf16_f32 %0, %1, %2" : "=v"(r) : "v"(lo), "v"(hi)); return r; }
typedef float f32x2 __attribute__((ext_vector_type(2)));
template <class Epi, class Sched, bool ALIGN_EPI = false, bool SP2 = false, bool EPI2 = false>
__device__ __forceinline__ void gemm_phase(PG8_LAS unsigned char* lds, const Gemm g, const Sched& S, const Epi& E, const int wave_u) {
    int tid_ = wave_u * 64 + lane_id_v(); asm volatile("" : "+v"(tid_));
    const int tid = tid_, wid = __builtin_amdgcn_readfirstlane(tid >> 6), lane = tid & 63, wr = wid >> 2, wc = wid & 3, fr = lane & 15, fq = lane >> 4;
    const int K = g.K, nt = K / BK;
    unsigned voffA[2], voffB[2];
#pragma unroll
    for (int i = 0; i < 2; ++i) { int R, C; stage_rc(tid * 16 + i * 8192, R, C); const int Rp = Epi::PERM ? perm32(R & 31) : (R & 31); const int Rb = Epi::HEADMAP ? (64 * (R >> 5) + Rp) : ((R & ~31) + Rp);
        voffA[i] = (unsigned)(R * K + C) * 2u; voffB[i] = (unsigned)(Rb * K + C) * 2u; }
    const size_t kstep = (size_t)(BK * 2);
    const size_t hstep = (size_t)HALF * K * 2;
    const size_t hstepB = Epi::HEADMAP ? (size_t)32 * K * 2 : hstep;
    const size_t tstep = 2 * hstep;
    const unsigned ldsw = (unsigned)wid * 1024u;
    const int aoff = lds_byte(wr * 64 + fr, fq * 8), boff = lds_byte(wc * 32 + fr, fq * 8);
#define PG8_SA(b, h) (((b) * 2 + (h)) * HTB)
#define PG8_SB(b, h) ((4 + (b) * 2 + (h)) * HTB)
#define PG8_STAGE(bufoff, gbase, voff) do { _Pragma("unroll") for (int _i = 0; _i < 2; ++_i) \
        __builtin_amdgcn_global_load_lds((const unsigned*)((const char*)(gbase) + (voff)[_i]), (PG8_LAS unsigned*)(lds + (bufoff) + ldsw + _i * 8192), 16, 0, 0); } while (0)
#define PG8_LDA(dst, b, h) do { _Pragma("unroll") for (int m = 0; m < 4; ++m) _Pragma("unroll") for (int k = 0; k < 2; ++k) dst[m][k] = *(const PG8_LAS bf16x8*)(lds + PG8_SA(b, h) + aoff + m * 2048 + k * 1024); } while (0)
#define PG8_LDB(dst, b, h) do { _Pragma("unroll") for (int n = 0; n < 2; ++n) _Pragma("unroll") for (int k = 0; k < 2; ++k) dst[n][k] = *(const PG8_LAS bf16x8*)(lds + PG8_SB(b, h) + boff + n * 2048 + k * 1024); } while (0)
#define PG8_MMA(ai, bj, At, Bt) do { __builtin_amdgcn_s_setprio(1); _Pragma("unroll") for (int m = 0; m < 4; ++m) _Pragma("unroll") for (int n = 0; n < 2; ++n) _Pragma("unroll") for (int k = 0; k < 2; ++k) \
        acc[ai][bj][m][n] = __builtin_amdgcn_mfma_f32_16x16x32_bf16(Bt[n][k], At[m][k], acc[ai][bj][m][n], 0, 0, 0); __builtin_amdgcn_s_setprio(0); } while (0)
#define PG8_WAIT_V(n) asm volatile("s_waitcnt vmcnt(" #n ")" ::: "memory")
#define PG8_WAIT_L(n) asm volatile("s_waitcnt lgkmcnt(" #n ")" ::: "memory")
#define PG8_BAR __builtin_amdgcn_s_barrier()
#define PG8_SCHED __builtin_amdgcn_sched_barrier(0)
    Unit cur, nxt; int ui = 0;
    if (!S.next(0, cur)) return;
    f32x4 acc[2][2][4][2];
#pragma unroll
    for (int a = 0; a < 2; ++a)
#pragma unroll
        for (int b = 0; b < 2; ++b)
#pragma unroll
            for (int m = 0; m < 4; ++m)
#pragma unroll
                for (int n = 0; n < 2; ++n) acc[a][b][m][n] = (f32x4){0.f, 0.f, 0.f, 0.f};
    bf16x8 At[4][2], B0[2][2], B1[2][2];
    const char* cA = (const char*)g.A + (size_t)cur.pm * tstep; const char* cB = (const char*)g.Bt + (size_t)cur.pn * tstep;
    S.a_ready(cur);
    if constexpr (SP2) {
        PG8_STAGE(PG8_SB(0, 0), cB, voffB); PG8_STAGE(PG8_SB(0, 1), cB + hstepB, voffB); PG8_STAGE(PG8_SA(0, 0), cA, voffA); PG8_STAGE(PG8_SA(0, 1), cA + hstep, voffA);
        if (wr == 1) PG8_BAR;
        PG8_WAIT_V(2); PG8_BAR;
        PG8_STAGE(PG8_SB(1, 0), cB + kstep, voffB); PG8_STAGE(PG8_SA(1, 0), cA + kstep, voffA); PG8_STAGE(PG8_SB(1, 1), cB + hstepB + kstep, voffB);
        PG8_WAIT_V(6); PG8_BAR;
    } else {
        PG8_STAGE(PG8_SB(0, 0), cB, voffB); PG8_STAGE(PG8_SA(0, 0), cA, voffA); PG8_STAGE(PG8_SB(0, 1), cB + hstepB, voffB); PG8_STAGE(PG8_SA(0, 1), cA + hstep, voffA);
        if (wr == 1) PG8_BAR;
        PG8_WAIT_V(4); PG8_BAR;
        PG8_STAGE(PG8_SB(1, 0), cB + kstep, voffB); PG8_STAGE(PG8_SA(1, 0), cA + kstep, voffA); PG8_STAGE(PG8_SB(1, 1), cB + hstepB + kstep, voffB);
        PG8_WAIT_V(6); PG8_BAR;
    }
    for (;;) {
        const bool has_next = S.next(ui + 1, nxt);
        const char* nA = has_next ? (const char*)g.A + (size_t)nxt.pm * tstep : cA; const char* nB = has_next ? (const char*)g.Bt + (size_t)nxt.pn * tstep : cB;
#pragma nounroll
        for (int t = 0; t < nt; t += 2) {
            const bool last = (t == nt - 2);
            const char* a1 = cA + (size_t)(t + 1) * kstep;
            const char* a2 = last ? nA : cA + (size_t)(t + 2) * kstep; const char* b2 = last ? nB : cB + (size_t)(t + 2) * kstep;
            const char* a3 = a2 + kstep; const char* b3 = b2 + kstep;
            if (last && has_next) S.a_ready(nxt);
            if constexpr (SP2) {
            PG8_LDB(B0, 0, 0); PG8_LDB(B1, 0, 1); PG8_SCHED; PG8_LDA(At, 0, 0); PG8_STAGE(PG8_SA(1, 1), a1 + hstep, voffA);
            PG8_WAIT_V(8); PG8_WAIT_L(0); PG8_BAR; PG8_MMA(0, 0, At, B0); PG8_MMA(0, 1, At, B1); PG8_BAR; PG8_SCHED;
            PG8_LDA(At, 0, 1); PG8_STAGE(PG8_SB(0, 0), b2, voffB); PG8_STAGE(PG8_SB(0, 1), b2 + hstepB, voffB); PG8_STAGE(PG8_SA(0, 0), a2, voffA);
            PG8_WAIT_V(8); PG8_WAIT_L(0); PG8_BAR; PG8_MMA(1, 0, At, B0); PG8_MMA(1, 1, At, B1); PG8_BAR; PG8_SCHED;
            PG8_LDB(B0, 1, 0); PG8_LDB(B1, 1, 1); PG8_SCHED; PG8_LDA(At, 1, 0); PG8_STAGE(PG8_SA(0, 1), a2 + hstep, voffA);
            PG8_WAIT_V(8); PG8_WAIT_L(0); PG8_BAR; PG8_MMA(0, 0, At, B0); PG8_MMA(0, 1, At, B1); PG8_BAR; PG8_SCHED;
            PG8_LDA(At, 1, 1); PG8_STAGE(PG8_SB(1, 0), b3, voffB); PG8_STAGE(PG8_SB(1, 1), b3 + hstepB, voffB); PG8_STAGE(PG8_SA(1, 0), a3, voffA);
            PG8_WAIT_V(8); PG8_WAIT_L(0); PG8_BAR; PG8_MMA(1, 0, At, B0); PG8_MMA(1, 1, At, B1); PG8_BAR; PG8_SCHED;
            } else {
            PG8_LDB(B0, 0, 0); PG8_SCHED; PG8_LDA(At, 0, 0); PG8_STAGE(PG8_SA(1, 1), a1 + hstep, voffA);
            PG8_WAIT_L(8); PG8_BAR; PG8_WAIT_L(0); PG8_MMA(0, 0, At, B0); PG8_BAR; PG8_SCHED;
            PG8_LDB(B1, 0, 1); PG8_STAGE(PG8_SB(0, 0), b2, voffB);
            PG8_BAR; PG8_WAIT_L(0); PG8_MMA(0, 1, At, B1); PG8_BAR;
            PG8_LDA(At, 0, 1); PG8_STAGE(PG8_SA(0, 0), a2, voffA);
            PG8_BAR; PG8_WAIT_L(0); PG8_MMA(1, 0, At, B0); PG8_BAR; PG8_SCHED;
            PG8_STAGE(PG8_SB(0, 1), b2 + hstepB, voffB);
            PG8_WAIT_V(6); PG8_BAR; PG8_MMA(1, 1, At, B1); PG8_BAR;
            PG8_LDB(B0, 1, 0); PG8_SCHED; PG8_LDA(At, 1, 0); PG8_STAGE(PG8_SA(0, 1), a2 + hstep, voffA);
            PG8_WAIT_L(8); PG8_BAR; PG8_WAIT_L(0); PG8_MMA(0, 0, At, B0); PG8_BAR; PG8_SCHED;
            PG8_LDB(B1, 1, 1); PG8_STAGE(PG8_SB(1, 0), b3, voffB);
            PG8_BAR; PG8_WAIT_L(0); PG8_MMA(0, 1, At, B1); PG8_BAR;
            PG8_LDA(At, 1, 1); PG8_STAGE(PG8_SA(1, 0), a3, voffA);
            PG8_BAR; PG8_WAIT_L(0); PG8_MMA(1, 0, At, B0); PG8_BAR; PG8_SCHED;
            PG8_STAGE(PG8_SB(1, 1), b3 + hstepB, voffB);
            PG8_WAIT_V(6); PG8_BAR; PG8_MMA(1, 1, At, B1); PG8_BAR;
            }
        }
        if constexpr (ALIGN_EPI) { if (wr == 0) PG8_BAR; }
        if constexpr (!Epi::AFTER_DRAIN) { E(acc, cur, wr, wc, fr, fq); if constexpr (EPI2) { asm volatile("" ::: "memory"); E(acc, cur, wr, wc, fr, fq); } S.done(cur); }
        if (!has_next) break;
#pragma unroll
        for (int a = 0; a < 2; ++a)
#pragma unroll
            for (int b = 0; b < 2; ++b)
#pragma unroll
                for (int m = 0; m < 4; ++m)
#pragma unroll
                    for (int n = 0; n < 2; ++n) acc[a][b][m][n] = (f32x4){0.f, 0.f, 0.f, 0.f};
        cur = nxt; cA = nA; cB = nB; ++ui;
        if constexpr (ALIGN_EPI) { if (wr == 1) PG8_BAR; }
    }
    PG8_WAIT_V(0);
    if constexpr (!ALIGN_EPI) { if (wr == 0) PG8_BAR; }
    PG8_BAR;
    if constexpr (Epi::AFTER_DRAIN) { E.fused(acc, cur, wr, wc, fr, fq, lds, wid, lane); S.done(cur); }
#undef PG8_SA
#undef PG8_SB
#undef PG8_STAGE
#undef PG8_LDA
#undef PG8_LDB
#undef PG8_MMA
#undef PG8_WAIT_V
#undef PG8_WAIT_L
#undef PG8_BAR
#undef PG8_SCHED
}

template <class EpiMid, class EpiFin, class Sched>
__device__ __forceinline__ void gemm_phase_ple(PG8_LAS unsigned char* lds, const bf16_t* AP, const bf16_t* BP, const bf16_t* AZ, const bf16_t* BZ, const Sched& S, const EpiMid& EM, const EpiFin& E, const int wave_u) {
    constexpr bool ALIGN_EPI = true;
    int tid_ = wave_u * 64 + lane_id_v(); asm volatile("" : "+v"(tid_));
    const int tid = tid_, wid = __builtin_amdgcn_readfirstlane(tid >> 6), lane = tid & 63, wr = wid >> 2, wc = wid & 3, fr = lane & 15, fq = lane >> 4;
    constexpr int KP = 256, KZ = 1024, NT = 20;
    unsigned vAP[2], vBP[2], vAZ[2], vBZ[2];
#pragma unroll
    for (int i = 0; i < 2; ++i) { int R, C; stage_rc(tid * 16 + i * 8192, R, C); const int Rb = (R & ~31) + perm32(R & 31);
        vAP[i] = (unsigned)(R * KP + C) * 2u; vBP[i] = (unsigned)(Rb * KP + C) * 2u; vAZ[i] = (unsigned)(R * KZ + C) * 2u; vBZ[i] = (unsigned)(Rb * KZ + C) * 2u; }
    const size_t kstep = (size_t)(BK * 2);
    const size_t hsP = (size_t)HALF * KP * 2, hsZ = (size_t)HALF * KZ * 2, tsP = 2 * hsP, tsZ = 2 * hsZ;
    const unsigned ldsw = (unsigned)wid * 1024u;
    const int aoff = lds_byte(wr * 64 + fr, fq * 8), boff = lds_byte(wc * 32 + fr, fq * 8);
#define PG8_SA(b, h) (((b) * 2 + (h)) * HTB)
#define PG8_SB(b, h) ((4 + (b) * 2 + (h)) * HTB)
#define PG8_STAGE(bufoff, gbase, voff) do { _Pragma("unroll") for (int _i = 0; _i < 2; ++_i) \
        __builtin_amdgcn_global_load_lds((const unsigned*)((const char*)(gbase) + (voff)[_i]), (PG8_LAS unsigned*)(lds + (bufoff) + ldsw + _i * 8192), 16, 0, 0); } while (0)
#define PG8_LDA(dst, b, h) do { _Pragma("unroll") for (int m = 0; m < 4; ++m) _Pragma("unroll") for (int k = 0; k < 2; ++k) dst[m][k] = *(const PG8_LAS bf16x8*)(lds + PG8_SA(b, h) + aoff + m * 2048 + k * 1024); } while (0)
#define PG8_LDB(dst, b, h) do { _Pragma("unroll") for (int n = 0; n < 2; ++n) _Pragma("unroll") for (int k = 0; k < 2; ++k) dst[n][k] = *(const PG8_LAS bf16x8*)(lds + PG8_SB(b, h) + boff + n * 2048 + k * 1024); } while (0)
#define PG8_MMA(ai, bj, At, Bt) do { __builtin_amdgcn_s_setprio(1); _Pragma("unroll") for (int m = 0; m < 4; ++m) _Pragma("unroll") for (int n = 0; n < 2; ++n) _Pragma("unroll") for (int k = 0; k < 2; ++k) \
        acc[ai][bj][m][n] = __builtin_amdgcn_mfma_f32_16x16x32_bf16(Bt[n][k], At[m][k], acc[ai][bj][m][n], 0, 0, 0); __builtin_amdgcn_s_setprio(0); } while (0)
#define PG8_WAIT_V(n) asm volatile("s_waitcnt vmcnt(" #n ")" ::: "memory")
#define PG8_WAIT_L(n) asm volatile("s_waitcnt lgkmcnt(" #n ")" ::: "memory")
#define PG8_BAR __builtin_amdgcn_s_barrier()
#define PG8_SCHED __builtin_amdgcn_sched_barrier(0)
    Unit cur, nxt; int ui = 0;
    if (!S.next(0, cur)) return;
    f32x4 acc[2][2][4][2];
#pragma unroll
    for (int a = 0; a < 2; ++a)
#pragma unroll
        for (int b = 0; b < 2; ++b)
#pragma unroll
            for (int m = 0; m < 4; ++m)
#pragma unroll
                for (int n = 0; n < 2; ++n) acc[a][b][m][n] = (f32x4){0.f, 0.f, 0.f, 0.f};
    bf16x8 At[4][2], B0[2][2], B1[2][2];
    const char* cAP = (const char*)AP + (size_t)cur.pm * tsP; const char* cBP = (const char*)BP + (size_t)cur.pn * tsP;
    const char* cAZ = (const char*)AZ + (size_t)cur.pm * tsZ; const char* cBZ = (const char*)BZ + (size_t)cur.pn * tsZ;
    S.a_ready(cur);
    PG8_STAGE(PG8_SB(0, 0), cBP, vBP); PG8_STAGE(PG8_SB(0, 1), cBP + hsP, vBP); PG8_STAGE(PG8_SA(0, 0), cAP, vAP); PG8_STAGE(PG8_SA(0, 1), cAP + hsP, vAP);
    if (wr == 1) PG8_BAR;
    PG8_WAIT_V(2); PG8_BAR;
    PG8_STAGE(PG8_SB(1, 0), cBP + kstep, vBP); PG8_STAGE(PG8_SA(1, 0), cAP + kstep, vAP); PG8_STAGE(PG8_SB(1, 1), cBP + hsP + kstep, vBP);
    PG8_WAIT_V(6); PG8_BAR;
    for (;;) {
        const bool has_next = S.next(ui + 1, nxt);
        const char* nAP = has_next ? (const char*)AP + (size_t)nxt.pm * tsP : cAP; const char* nBP = has_next ? (const char*)BP + (size_t)nxt.pn * tsP : cBP;
#pragma nounroll
        for (int t = 0; t < NT; t += 2) {
            if (t == 4) {
                EM(acc, cur, wr, wc, fr, fq);
#pragma unroll
                for (int a = 0; a < 2; ++a)
#pragma unroll
                    for (int b = 0; b < 2; ++b)
#pragma unroll
                        for (int m = 0; m < 4; ++m)
#pragma unroll
                            for (int n = 0; n < 2; ++n) acc[a][b][m][n] = (f32x4){0.f, 0.f, 0.f, 0.f};
            }
            const bool p1 = (t < 4), p23 = (t == 0) || (t == NT - 2);
            const char* a1 = p1 ? cAP + (size_t)(t + 1) * kstep : cAZ + (size_t)(t - 3) * kstep;
            const char* a2 = (t == 0) ? cAP + 2 * kstep : (t == NT - 2) ? nAP : cAZ + (size_t)(t - 2) * kstep;
            const char* b2 = (t == 0) ? cBP + 2 * kstep : (t == NT - 2) ? nBP : cBZ + (size_t)(t - 2) * kstep;
            const char* a3 = a2 + kstep; const char* b3 = b2 + kstep;
            const size_t hstep1 = p1 ? hsP : hsZ, hstep = p23 ? hsP : hsZ, hstepB = hstep;
            unsigned voffA1[2], voffA[2], voffB[2];
#pragma unroll
            for (int i = 0; i < 2; ++i) { voffA1[i] = p1 ? vAP[i] : vAZ[i]; voffA[i] = p23 ? vAP[i] : vAZ[i]; voffB[i] = p23 ? vBP[i] : vBZ[i]; }
            if (t == NT - 2 && has_next) S.a_ready(nxt);
            PG8_LDB(B0, 0, 0); PG8_LDB(B1, 0, 1); PG8_SCHED; PG8_LDA(At, 0, 0); PG8_STAGE(PG8_SA(1, 1), a1 + hstep1, voffA1);
            PG8_WAIT_V(8); PG8_WAIT_L(0); PG8_BAR; PG8_MMA(0, 0, At, B0); PG8_MMA(0, 1, At, B1); PG8_BAR; PG8_SCHED;
            PG8_LDA(At, 0, 1); PG8_STAGE(PG8_SB(0, 0), b2, voffB); PG8_STAGE(PG8_SB(0, 1), b2 + hstepB, voffB); PG8_STAGE(PG8_SA(0, 0), a2, voffA);
            PG8_WAIT_V(8); PG8_WAIT_L(0); PG8_BAR; PG8_MMA(1, 0, At, B0); PG8_MMA(1, 1, At, B1); PG8_BAR; PG8_SCHED;
            PG8_LDB(B0, 1, 0); PG8_LDB(B1, 1, 1); PG8_SCHED; PG8_LDA(At, 1, 0); PG8_STAGE(PG8_SA(0, 1), a2 + hstep, voffA);
            PG8_WAIT_V(8); PG8_WAIT_L(0); PG8_BAR; PG8_MMA(0, 0, At, B0); PG8_MMA(0, 1, At, B1); PG8_BAR; PG8_SCHED;
            PG8_LDA(At, 1, 1); PG8_STAGE(PG8_SB(1, 0), b3, voffB); PG8_STAGE(PG8_SB(1, 1), b3 + hstepB, voffB); PG8_STAGE(PG8_SA(1, 0), a3, voffA);
            PG8_WAIT_V(8); PG8_WAIT_L(0); PG8_BAR; PG8_MMA(1, 0, At, B0); PG8_MMA(1, 1, At, B1); PG8_BAR; PG8_SCHED;
        }
        if constexpr (ALIGN_EPI) { if (wr == 0) PG8_BAR; }
        E(acc, cur, wr, wc, fr, fq); S.done(cur);
        if (!has_next) break;
#pragma unroll
        for (int a = 0; a < 2; ++a)
#pragma unroll
            for (int b = 0; b < 2; ++b)
#pragma unroll
                for (int m = 0; m < 4; ++m)
#pragma unroll
                    for (int n = 0; n < 2; ++n) acc[a][b][m][n] = (f32x4){0.f, 0.f, 0.f, 0.f};
        cur = nxt; cAP = nAP; cBP = nBP; cAZ = (const char*)AZ + (size_t)cur.pm * tsZ; cBZ = (const char*)BZ + (size_t)cur.pn * tsZ; ++ui;
        if constexpr (ALIGN_EPI) { if (wr == 1) PG8_BAR; }
    }
    PG8_WAIT_V(0);
    if constexpr (!ALIGN_EPI) { if (wr == 0) PG8_BAR; }
    PG8_BAR;
#undef PG8_SA
#undef PG8_SB
#undef PG8_STAGE
#undef PG8_LDA
#undef PG8_LDB
#undef PG8_MMA
#undef PG8_WAIT_V
#undef PG8_WAIT_L
#undef PG8_BAR
#undef PG8_SCHED
}
}
#ifndef PG8_SP2
#define PG8_SP2 true
#endif
#ifndef PG8_ALIGN
#define PG8_ALIGN true
#endif
using pg8::bf16_t; using pg8::bf16x8; using pg8::f32x4; using pg8::u32x4;
#define LAS __attribute__((address_space(3)))
typedef float f32x2 __attribute__((ext_vector_type(2)));
typedef float f32x16 __attribute__((ext_vector_type(16)));
typedef unsigned u32x2 __attribute__((ext_vector_type(2)));
typedef __bf16 bf16x2_t __attribute__((ext_vector_type(2)));

constexpr int T_ = 65536, DM_ = 1024, SEQ_ = 8192, PJW = 2048, FF_ = 4096, PLE_ = 256, NUNIT_ATT = 1024, NUNIT_LRU = 256;
constexpr float EPS_ = 1e-6f, LOG2E = 1.4426950408889634f, QSCALE = 0.125f * 1.4426950408889634f;
constexpr int NWAVES = 8, NTHR = 512;
constexpr int RING_BYTES = 131072, SSL_OFF = RING_BYTES, MISC_OFF = 147456 - 64, LDS_BYTES = 147456;
constexpr size_t MiB = 1u << 20;
constexpr size_t WS_WIN = 0, WS_WOUT = 5 * MiB, WS_WUP = 7 * MiB, WS_WDN = 15 * MiB, WS_WPG = 23 * MiB, WS_WPP = 25 * MiB, WS_WG = 25 * MiB + 512 * 1024;
constexpr size_t WS_RSTD1 = 27 * MiB, WS_RSTD2 = 27 * MiB + 256 * 1024, WS_DUMMY = 27 * MiB + 512 * 1024, WS_RINV0 = 27 * MiB + 768 * 1024, WS_SUMM = 28 * MiB;
constexpr size_t WS_CTL = 31 * MiB, CTL_BYTES = 16384;
constexpr size_t WS_XN = 32 * MiB;
constexpr size_t WS_PP = 160 * MiB;
constexpr size_t WS_PB = 288 * MiB;
constexpr size_t WS_PROJ = 320 * MiB;
constexpr size_t WS_VT = 576 * MiB;
constexpr size_t WS_MERGED = 640 * MiB;
constexpr size_t WS_ACT = 320 * MiB;
constexpr size_t WS_END = 832 * MiB;

__device__ __forceinline__ unsigned cvtpk(float lo, float hi) { f32x2 v = {lo, hi}; bf16x2_t b = __builtin_convertvector(v, bf16x2_t); return __builtin_bit_cast(unsigned, b); }
__device__ __forceinline__ float bf2f(unsigned short u) { return __uint_as_float((unsigned)u << 16); }
__device__ __forceinline__ float bflo(unsigned w) { return __uint_as_float(w << 16); }
__device__ __forceinline__ float bfhi(unsigned w) { return __uint_as_float(w & 0xffff0000u); }
__device__ __forceinline__ float ex2(float x) { return __builtin_amdgcn_exp2f(x); }
__device__ __forceinline__ float rcpf_(float x) { return __builtin_amdgcn_rcpf(x); }
__device__ __forceinline__ float rsqf_(float x) { return __builtin_amdgcn_rsqf(x); }
__device__ __forceinline__ float sigm(float z) { return rcpf_(1.f + ex2(-LOG2E * z)); }
__device__ __forceinline__ float gelu_tanh(float g) { const float z = 0.7978845608028654f * (g + 0.044715f * g * g * g); return g * sigm(2.f * z); }
__device__ __forceinline__ float wave_sum(float v) {
#pragma unroll
    for (int o = 1; o < 64; o <<= 1) v += __shfl_xor(v, o);
    return v;
}
__device__ __forceinline__ float wave_max(float v) {
#pragma unroll
    for (int o = 1; o < 64; o <<= 1) v = fmaxf(v, __shfl_xor(v, o));
    return v;
}
__device__ __forceinline__ int crow(int r, int hi) { return (r & 3) + 8 * (r >> 2) + 4 * hi; }
#define MFMA32(a, b, c) __builtin_amdgcn_mfma_f32_32x32x16_bf16((a), (b), (c), 0, 0, 0)

#define RLX_AGENT __ATOMIC_RELAXED, __HIP_MEMORY_SCOPE_AGENT
#define XB_TMO      128
#define XB_XCNT(j)  (256  + 64 * (j))
#define XB_XSUB(j)  (1280 + 64 * (j))
#define XB_XGEN(j)  (2304 + 64 * (j))
#define XB_TOP      3328
#define XB_TOPGEN   3392
#define XCD_BAR_WORDS 3456
#define XB_SPIN_CAP (1u << 18)

__device__ __forceinline__ unsigned xb_ld(unsigned* p)              { return __hip_atomic_load(p, __ATOMIC_RELAXED, __HIP_MEMORY_SCOPE_AGENT); }
__device__ __forceinline__ unsigned xb_add(unsigned* p, unsigned v) { return __hip_atomic_fetch_add(p, v, __ATOMIC_RELAXED, __HIP_MEMORY_SCOPE_AGENT); }
__device__ __forceinline__ unsigned xb_xcc_id() { return (unsigned)__builtin_amdgcn_s_getreg((3 << 11) | 20) & 0xFu; }
#define XB_SPIN(cond, bar) do { unsigned _sp = 0; while (cond) { __builtin_amdgcn_s_sleep(1); \
    if ((++_sp & 255u) == 0u) { if (xb_ld(&(bar)[XB_TMO])) break; if (_sp > XB_SPIN_CAP) { atomicAdd(&(bar)[XB_TMO], 1u); break; } } } } while (0)

struct XcdBarrier {
    unsigned* bar; unsigned x;
    volatile LAS unsigned* st;
};

__device__ __forceinline__ XcdBarrier xcd_barrier_post(unsigned* bar, volatile LAS unsigned* st) {
    XcdBarrier b; b.bar = bar; b.x = xb_xcc_id(); b.st = st;
    if (threadIdx.x == 0) (void)xb_add(&bar[XB_XCNT(b.x)], 1u);
    return b;
}
__device__ __forceinline__ void xcd_barrier_complete(unsigned* bar, unsigned x, unsigned& nloc, unsigned& nx) {
    const unsigned G = gridDim.x * gridDim.y * gridDim.z;
    unsigned sum, cnt, mine, sp = 0u;
    for (;;) {
        sum = 0u; cnt = 0u; mine = 0u;
#pragma unroll
        for (unsigned j = 0; j < 16; ++j) { const unsigned c = xb_ld(&bar[XB_XCNT(j)]); sum += c; cnt += (c > 0u) ? 1u : 0u; mine = (j == x) ? c : mine; }
        if (sum == G) break;
        __builtin_amdgcn_s_sleep(1);
        if ((++sp & 255u) == 0u) { if (xb_ld(&bar[XB_TMO])) break; if (sp > XB_SPIN_CAP) { atomicAdd(&bar[XB_TMO], 1u); break; } }
    }
    nloc = mine > 0u ? mine : 1u; nx = cnt > 0u ? cnt : 1u;
}

__device__ __forceinline__ void xcd_barrier(const XcdBarrier& b) {
    asm volatile("s_waitcnt vmcnt(0)" ::: "memory");
    __syncthreads();
    if (threadIdx.x == 0) {
        unsigned* bar = b.bar;
        __builtin_amdgcn_s_waitcnt(0);
        unsigned nloc = b.st[0], nx = b.st[1];
        if (nloc == 0u) { xcd_barrier_complete(bar, b.x, nloc, nx); b.st[0] = nloc; b.st[1] = nx; }
        const unsigned old = xb_add(&bar[XB_XSUB(b.x)], 1u);
        const unsigned gen = old / nloc;
        if (old + 1u == (gen + 1u) * nloc) {
            __builtin_amdgcn_fence(__ATOMIC_RELEASE, "agent");
            asm volatile("s_waitcnt vmcnt(0)" ::: "memory");
            const unsigned og = xb_add(&bar[XB_TOP], 1u);
            const unsigned tg = og / nx;
            if (og + 1u == (tg + 1u) * nx) xb_add(&bar[XB_TOPGEN], 1u);
            else XB_SPIN(xb_ld(&bar[XB_TOPGEN]) == tg, bar);
            __builtin_amdgcn_fence(__ATOMIC_ACQUIRE, "agent");
            xb_add(&bar[XB_XGEN(b.x)], 1u);
            asm volatile("s_waitcnt vmcnt(0)" ::: "memory");
        } else {
            XB_SPIN(xb_ld(&bar[XB_XGEN(b.x)]) == gen, bar);
            __builtin_amdgcn_fence(__ATOMIC_ACQUIRE, "agent");
            asm volatile("s_waitcnt vmcnt(0)" ::: "memory");
        }
    }
    __syncthreads();
}

struct PanelOrder {
    int pm;
    __device__ bool next(int i, pg8::Unit& u) const { if (i >= 4) return false; u.pm = pm; u.pn = i; return true; }
    __device__ __forceinline__ void a_ready(const pg8::Unit&) const {}
    __device__ __forceinline__ void done(const pg8::Unit&) const {}
};

struct EpiPlain {
    static constexpr bool PERM = true, AFTER_DRAIN = false, HEADMAP = false;
    bf16_t* O; int ldc;
    __device__ __forceinline__ void operator()(const f32x4 (&acc)[2][2][4][2], const pg8::Unit& u, int wr, int wc, int fr, int fq) const {
        const int row0 = u.pm * 256 + wr * 64 + fr, col0 = u.pn * 256 + wc * 32 + 8 * fq;
#pragma unroll
        for (int ai = 0; ai < 2; ++ai)
#pragma unroll
            for (int m = 0; m < 4; ++m) { bf16_t* rowp = O + (size_t)(row0 + ai * 128 + m * 16) * ldc + col0;
#pragma unroll
                for (int bj = 0; bj < 2; ++bj) { const f32x4 v0 = acc[ai][bj][m][0], v1 = acc[ai][bj][m][1];
                    u32x4 w; w.x = cvtpk(v0[0], v0[1]); w.y = cvtpk(v0[2], v0[3]); w.z = cvtpk(v1[0], v1[1]); w.w = cvtpk(v1[2], v1[3]);
                    *(u32x4*)(rowp + bj * 128) = w; } }
    }
};
struct EpiVT {
    static constexpr bool PERM = true, AFTER_DRAIN = false, HEADMAP = false;
    bf16_t* O;
    __device__ __forceinline__ void operator()(const f32x4 (&acc)[2][2][4][2], const pg8::Unit& u, int wr, int wc, int fr, int fq) const {
        const int row0 = u.pm * 256 + wr * 64 + fr, col0 = u.pn * 256 + wc * 32 + 16 * (fq >> 1) + 4 * (fq & 1);
#pragma unroll
        for (int ai = 0; ai < 2; ++ai)
#pragma unroll
            for (int m = 0; m < 4; ++m) { bf16_t* rowp = O + (size_t)(row0 + ai * 128 + m * 16) * T_ + col0;
#pragma unroll
                for (int bj = 0; bj < 2; ++bj)
#pragma unroll
                    for (int n = 0; n < 2; ++n) { const f32x4 v = acc[ai][bj][m][n]; u32x2 w; w.x = cvtpk(v[0], v[1]); w.y = cvtpk(v[2], v[3]);
                        *(u32x2*)(rowp + bj * 128 + 8 * n) = w; } }
    }
};
struct EpiProj {
    static constexpr bool PERM = true, AFTER_DRAIN = false, HEADMAP = true;
    bf16_t* O; const float* gq; const float* gk;
    __device__ __forceinline__ void operator()(const f32x4 (&acc)[2][2][4][2], const pg8::Unit& u, int wr, int wc, int fr, int fq) const {
        const int row0 = u.pm * 256 + wr * 64 + fr, col0 = u.pn * 256 + wc * 64 + 8 * fq, kind = u.pn >> 1;
        f32x4 gv[2][2];
        if (kind >= 2) { const float* g = (kind == 2) ? gq : gk; const float sc = (kind == 2) ? QSCALE : 1.f;
#pragma unroll
            for (int bj = 0; bj < 2; ++bj)
#pragma unroll
                for (int n = 0; n < 2; ++n) gv[bj][n] = *(const f32x4*)(g + 32 * bj + 8 * fq + 4 * n) * sc; }
#pragma unroll
        for (int ai = 0; ai < 2; ++ai)
#pragma unroll
            for (int m = 0; m < 4; ++m) { bf16_t* rowp = O + (size_t)(row0 + ai * 128 + m * 16) * PJW + col0;
                f32x4 v[2][2];
#pragma unroll
                for (int bj = 0; bj < 2; ++bj)
#pragma unroll
                    for (int n = 0; n < 2; ++n) v[bj][n] = acc[ai][bj][m][n];
                if (kind == 1) {
#pragma unroll
                    for (int bj = 0; bj < 2; ++bj)
#pragma unroll
                        for (int n = 0; n < 2; ++n)
#pragma unroll
                            for (int e = 0; e < 4; ++e) v[bj][n][e] = gelu_tanh(v[bj][n][e]);
                } else if (kind >= 2) {
                    float ss = 0.f;
#pragma unroll
                    for (int bj = 0; bj < 2; ++bj)
#pragma unroll
                        for (int n = 0; n < 2; ++n) { const f32x4 x = v[bj][n]; ss += (x[0] * x[0] + x[1] * x[1]) + (x[2] * x[2] + x[3] * x[3]); }
                    ss += __shfl_xor(ss, 16); ss += __shfl_xor(ss, 32);
                    const float rstd = rsqf_(ss * (1.f / 64.f) + EPS_);
#pragma unroll
                    for (int bj = 0; bj < 2; ++bj)
#pragma unroll
                        for (int n = 0; n < 2; ++n) v[bj][n] = v[bj][n] * gv[bj][n] * rstd;
                }
#pragma unroll
                for (int bj = 0; bj < 2; ++bj) { const f32x4 v0 = v[bj][0], v1 = v[bj][1];
                    u32x4 w; w.x = cvtpk(v0[0], v0[1]); w.y = cvtpk(v0[2], v0[3]); w.z = cvtpk(v1[0], v1[1]); w.w = cvtpk(v1[2], v1[3]);
                    *(u32x4*)(rowp + bj * 32) = w; } }
    }
};
struct EpiRes {
    static constexpr bool PERM = true, AFTER_DRAIN = false, HEADMAP = false;
    const float* base; float* out; bf16_t* hb; float* ssq; int rowmask;
    __device__ __forceinline__ void operator()(const f32x4 (&acc)[2][2][4][2], const pg8::Unit& u, int wr, int wc, int fr, int fq) const {
        const int row0 = u.pm * 256 + wr * 64 + fr, col0 = u.pn * 256 + wc * 32 + 8 * fq;
#pragma unroll
        for (int ai = 0; ai < 2; ++ai)
#pragma unroll
            for (int m = 0; m < 4; ++m) { const size_t off = (size_t)(row0 + ai * 128 + m * 16) * DM_ + col0; const size_t ooff = (size_t)((row0 + ai * 128 + m * 16) & rowmask) * DM_ + col0; float ss = 0.f;
#pragma unroll
                for (int bj = 0; bj < 2; ++bj) {
                    const f32x4 b0 = *(const f32x4*)(base + off + bj * 128), b1 = *(const f32x4*)(base + off + bj * 128 + 4);
                    const f32x4 v0 = b0 + acc[ai][bj][m][0], v1 = b1 + acc[ai][bj][m][1];
                    ss += (v0[0] * v0[0] + v0[1] * v0[1]) + (v0[2] * v0[2] + v0[3] * v0[3]) + (v1[0] * v1[0] + v1[1] * v1[1]) + (v1[2] * v1[2] + v1[3] * v1[3]);
                    *(f32x4*)(out + ooff + bj * 128) = v0; *(f32x4*)(out + ooff + bj * 128 + 4) = v1;
                    u32x4 w; w.x = cvtpk(v0[0], v0[1]); w.y = cvtpk(v0[2], v0[3]); w.z = cvtpk(v1[0], v1[1]); w.w = cvtpk(v1[2], v1[3]);
                    *(u32x4*)(hb + off + bj * 128) = w; }
                ss += __shfl_xor(ss, 16); ss += __shfl_xor(ss, 32);
                if (fq == 0) __hip_atomic_fetch_add(ssq + row0 + ai * 128 + m * 16, ss, __ATOMIC_RELAXED, __HIP_MEMORY_SCOPE_AGENT);
                asm volatile("" ::: "memory"); }
    }
};
struct EpiUp {
    static constexpr bool PERM = true, AFTER_DRAIN = false, HEADMAP = false;
    bf16_t* O; const float* rstd;
    __device__ __forceinline__ void operator()(const f32x4 (&acc)[2][2][4][2], const pg8::Unit& u, int wr, int wc, int fr, int fq) const {
        const int row0 = u.pm * 256 + wr * 64 + fr, col0 = u.pn * 256 + wc * 32 + 8 * fq;
#pragma unroll
        for (int ai = 0; ai < 2; ++ai)
#pragma unroll
            for (int m = 0; m < 4; ++m) { const int row = row0 + ai * 128 + m * 16; const float rs = rsqf_(rstd[row] * (1.f / DM_) + EPS_); bf16_t* rowp = O + (size_t)row * FF_ + col0;
#pragma unroll
                for (int bj = 0; bj < 2; ++bj) { f32x4 v0 = acc[ai][bj][m][0] * rs, v1 = acc[ai][bj][m][1] * rs;
#pragma unroll
                    for (int e = 0; e < 4; ++e) { const float a = fmaxf(v0[e], 0.f), b = fmaxf(v1[e], 0.f); v0[e] = a * a; v1[e] = b * b; }
                    u32x4 w; w.x = cvtpk(v0[0], v0[1]); w.y = cvtpk(v0[2], v0[3]); w.z = cvtpk(v1[0], v1[1]); w.w = cvtpk(v1[2], v1[3]);
                    *(u32x4*)(rowp + bj * 128) = w; } }
    }
};
struct EpiFinal {
    static constexpr bool PERM = true, AFTER_DRAIN = false, HEADMAP = false;
    const float* hin; float* out; const bf16_t* pp; const float* rstd;
    __device__ __forceinline__ void operator()(const f32x4 (&acc)[2][2][4][2], const pg8::Unit& u, int wr, int wc, int fr, int fq) const {
        const int row0 = u.pm * 256 + wr * 64 + fr, col0 = u.pn * 256 + wc * 32 + 8 * fq;
#pragma unroll
        for (int ai = 0; ai < 2; ++ai)
#pragma unroll
            for (int m = 0; m < 4; ++m) { const int row = row0 + ai * 128 + m * 16; const float rs = rsqf_(rstd[row] * (1.f / DM_) + EPS_); const size_t off = (size_t)row * DM_ + col0;
#pragma unroll
                for (int bj = 0; bj < 2; ++bj) {
                    const f32x4 h0 = *(const f32x4*)(hin + off + bj * 128), h1 = *(const f32x4*)(hin + off + bj * 128 + 4);
                    const u32x4 pw = *(const u32x4*)(pp + off + bj * 128);
                    const f32x4 a0 = acc[ai][bj][m][0] * rs, a1 = acc[ai][bj][m][1] * rs;
                    f32x4 o0, o1;
                    o0[0] = h0[0] + sigm(a0[0]) * bflo(pw.x); o0[1] = h0[1] + sigm(a0[1]) * bfhi(pw.x); o0[2] = h0[2] + sigm(a0[2]) * bflo(pw.y); o0[3] = h0[3] + sigm(a0[3]) * bfhi(pw.y);
                    o1[0] = h1[0] + sigm(a1[0]) * bflo(pw.z); o1[1] = h1[1] + sigm(a1[1]) * bfhi(pw.z); o1[2] = h1[2] + sigm(a1[2]) * bflo(pw.w); o1[3] = h1[3] + sigm(a1[3]) * bfhi(pw.w);
                    *(f32x4*)(out + off + bj * 128) = o0; *(f32x4*)(out + off + bj * 128 + 4) = o1; }
                asm volatile("" ::: "memory"); }
    }
};


struct EpiRes4 {
    static constexpr bool PERM = true, AFTER_DRAIN = false, HEADMAP = false;
    const float* base; bf16_t* hb; float* ssq;
    __device__ __forceinline__ void operator()(const f32x4 (&acc)[2][2][4][2], const pg8::Unit& u, int wr, int wc, int fr, int fq) const {
        const int row0 = u.pm * 256 + wr * 64 + fr, col0 = u.pn * 256 + wc * 32 + 8 * fq;
        f32x4 X[8][2][2];
#define E4_LD(g) do { const size_t off_ = (size_t)(row0 + ((g) >> 2) * 128 + ((g) & 3) * 16) * DM_ + col0; \
        _Pragma("unroll") for (int bj = 0; bj < 2; ++bj) { X[g][bj][0] = *(const f32x4*)(base + off_ + bj * 128); X[g][bj][1] = *(const f32x4*)(base + off_ + bj * 128 + 4); } } while (0)
        E4_LD(0); E4_LD(1); E4_LD(2); E4_LD(3);
        asm volatile("" ::: "memory");
#pragma unroll
        for (int g = 0; g < 8; ++g) { const int ai = g >> 2, m = g & 3; const size_t off = (size_t)(row0 + ai * 128 + m * 16) * DM_ + col0; float ss = 0.f;
#pragma unroll
            for (int bj = 0; bj < 2; ++bj) {
                const f32x4 v0 = X[g][bj][0] + acc[ai][bj][m][0], v1 = X[g][bj][1] + acc[ai][bj][m][1];
                ss += (v0[0] * v0[0] + v0[1] * v0[1]) + (v0[2] * v0[2] + v0[3] * v0[3]) + (v1[0] * v1[0] + v1[1] * v1[1]) + (v1[2] * v1[2] + v1[3] * v1[3]);
                u32x4 w; w.x = cvtpk(v0[0], v0[1]); w.y = cvtpk(v0[2], v0[3]); w.z = cvtpk(v1[0], v1[1]); w.w = cvtpk(v1[2], v1[3]);
                *(u32x4*)(hb + off + bj * 128) = w; }
            ss += __shfl_xor(ss, 16); ss += __shfl_xor(ss, 32);
            if (fq == 0) __hip_atomic_fetch_add(ssq + row0 + ai * 128 + m * 16, ss, __ATOMIC_RELAXED, __HIP_MEMORY_SCOPE_AGENT);
            if (g + 4 < 8) { E4_LD(g + 4); }
            asm volatile("" ::: "memory"); }
#undef E4_LD
    }
};
struct EpiRes4b {
    static constexpr bool PERM = true, AFTER_DRAIN = false, HEADMAP = false;
    bf16_t* hb; const float* rinv0; const float* g1; float* ssq;
    __device__ __forceinline__ void operator()(const f32x4 (&acc)[2][2][4][2], const pg8::Unit& u, int wr, int wc, int fr, int fq) const {
        const int row0 = u.pm * 256 + wr * 64 + fr, col0 = u.pn * 256 + wc * 32 + 8 * fq;
        f32x4 gi[2][2];
#pragma unroll
        for (int bj = 0; bj < 2; ++bj)
#pragma unroll
            for (int n = 0; n < 2; ++n) { const f32x4 gv = *(const f32x4*)(g1 + col0 + bj * 128 + 4 * n); gi[bj][n] = (f32x4){rcpf_(gv[0]), rcpf_(gv[1]), rcpf_(gv[2]), rcpf_(gv[3])}; }
        u32x4 H[8][2]; float RI[8];
#define E4_LD(g) do { const int row_ = row0 + ((g) >> 2) * 128 + ((g) & 3) * 16; const size_t off_ = (size_t)row_ * DM_ + col0; RI[g] = rinv0[row_]; \
        _Pragma("unroll") for (int bj = 0; bj < 2; ++bj) H[g][bj] = *(const u32x4*)(hb + off_ + bj * 128); } while (0)
        E4_LD(0); E4_LD(1); E4_LD(2); E4_LD(3);
        asm volatile("" ::: "memory");
#pragma unroll
        for (int g = 0; g < 8; ++g) { const int ai = g >> 2, m = g & 3; const size_t off = (size_t)(row0 + ai * 128 + m * 16) * DM_ + col0; float ss = 0.f; const float ri = RI[g];
#pragma unroll
            for (int bj = 0; bj < 2; ++bj) { const u32x4 hw = H[g][bj];
                const f32x4 x0 = (f32x4){bflo(hw.x), bfhi(hw.x), bflo(hw.y), bfhi(hw.y)} * gi[bj][0] * ri, x1 = (f32x4){bflo(hw.z), bfhi(hw.z), bflo(hw.w), bfhi(hw.w)} * gi[bj][1] * ri;
                const f32x4 v0 = x0 + acc[ai][bj][m][0], v1 = x1 + acc[ai][bj][m][1];
                ss += (v0[0] * v0[0] + v0[1] * v0[1]) + (v0[2] * v0[2] + v0[3] * v0[3]) + (v1[0] * v1[0] + v1[1] * v1[1]) + (v1[2] * v1[2] + v1[3] * v1[3]);
                u32x4 w; w.x = cvtpk(v0[0], v0[1]); w.y = cvtpk(v0[2], v0[3]); w.z = cvtpk(v1[0], v1[1]); w.w = cvtpk(v1[2], v1[3]);
                *(u32x4*)(hb + off + bj * 128) = w; }
            ss += __shfl_xor(ss, 16); ss += __shfl_xor(ss, 32);
            if (fq == 0) __hip_atomic_fetch_add(ssq + row0 + ai * 128 + m * 16, ss, __ATOMIC_RELAXED, __HIP_MEMORY_SCOPE_AGENT);
            if (g + 4 < 8) { E4_LD(g + 4); }
            asm volatile("" ::: "memory"); }
#undef E4_LD
    }
};
struct EpiRes6 {
    static constexpr bool PERM = true, AFTER_DRAIN = false, HEADMAP = false;
    bf16_t* hb; float* ssq;
    __device__ __forceinline__ void operator()(const f32x4 (&acc)[2][2][4][2], const pg8::Unit& u, int wr, int wc, int fr, int fq) const {
        const int row0 = u.pm * 256 + wr * 64 + fr, col0 = u.pn * 256 + wc * 32 + 8 * fq;
        u32x4 H[8][2];
#define E6_LD(g) do { const size_t off_ = (size_t)(row0 + ((g) >> 2) * 128 + ((g) & 3) * 16) * DM_ + col0; \
        _Pragma("unroll") for (int bj = 0; bj < 2; ++bj) H[g][bj] = *(const u32x4*)(hb + off_ + bj * 128); } while (0)
        E6_LD(0); E6_LD(1); E6_LD(2); E6_LD(3);
        asm volatile("" ::: "memory");
#pragma unroll
        for (int g = 0; g < 8; ++g) { const int ai = g >> 2, m = g & 3; const size_t off = (size_t)(row0 + ai * 128 + m * 16) * DM_ + col0; float ss = 0.f;
#pragma unroll
            for (int bj = 0; bj < 2; ++bj) { const u32x4 hw = H[g][bj];
                const f32x4 b0 = {bflo(hw.x), bfhi(hw.x), bflo(hw.y), bfhi(hw.y)}, b1 = {bflo(hw.z), bfhi(hw.z), bflo(hw.w), bfhi(hw.w)};
                const f32x4 v0 = b0 + acc[ai][bj][m][0], v1 = b1 + acc[ai][bj][m][1];
                ss += (v0[0] * v0[0] + v0[1] * v0[1]) + (v0[2] * v0[2] + v0[3] * v0[3]) + (v1[0] * v1[0] + v1[1] * v1[1]) + (v1[2] * v1[2] + v1[3] * v1[3]);
                u32x4 w; w.x = cvtpk(v0[0], v0[1]); w.y = cvtpk(v0[2], v0[3]); w.z = cvtpk(v1[0], v1[1]); w.w = cvtpk(v1[2], v1[3]);
                *(u32x4*)(hb + off + bj * 128) = w; }
            ss += __shfl_xor(ss, 16); ss += __shfl_xor(ss, 32);
            if (fq == 0) __hip_atomic_fetch_add(ssq + row0 + ai * 128 + m * 16, ss, __ATOMIC_RELAXED, __HIP_MEMORY_SCOPE_AGENT);
            if (g + 4 < 8) { E6_LD(g + 4); }
            asm volatile("" ::: "memory"); }
#undef E6_LD
    }
};
struct EpiFinalB {
    static constexpr bool PERM = true, AFTER_DRAIN = false, HEADMAP = false;
    const bf16_t* hb; float* out; const bf16_t* pp; const float* rstd;
    __device__ __forceinline__ void operator()(const f32x4 (&acc)[2][2][4][2], const pg8::Unit& u, int wr, int wc, int fr, int fq) const {
        const int row0 = u.pm * 256 + wr * 64 + fr, col0 = u.pn * 256 + wc * 32 + 8 * fq;
        u32x4 H[8][2], P[8][2]; float RS[8];
#define EF_LD(g) do { const int row_ = row0 + ((g) >> 2) * 128 + ((g) & 3) * 16; const size_t off_ = (size_t)row_ * DM_ + col0; RS[g] = rstd[row_]; \
        _Pragma("unroll") for (int bj = 0; bj < 2; ++bj) { H[g][bj] = *(const u32x4*)(hb + off_ + bj * 128); P[g][bj] = *(const u32x4*)(pp + off_ + bj * 128); } } while (0)
        EF_LD(0); EF_LD(1); EF_LD(2); EF_LD(3);
        asm volatile("" ::: "memory");
#pragma unroll
        for (int g = 0; g < 8; ++g) { const int ai = g >> 2, m = g & 3; const size_t off = (size_t)(row0 + ai * 128 + m * 16) * DM_ + col0; const float rs = rsqf_(RS[g] * (1.f / DM_) + EPS_);
#pragma unroll
            for (int bj = 0; bj < 2; ++bj) { const u32x4 hw = H[g][bj], pw = P[g][bj];
                const f32x4 a0 = acc[ai][bj][m][0] * rs, a1 = acc[ai][bj][m][1] * rs;
                f32x4 o0, o1;
                o0[0] = bflo(hw.x) + sigm(a0[0]) * bflo(pw.x); o0[1] = bfhi(hw.x) + sigm(a0[1]) * bfhi(pw.x); o0[2] = bflo(hw.y) + sigm(a0[2]) * bflo(pw.y); o0[3] = bfhi(hw.y) + sigm(a0[3]) * bfhi(pw.y);
                o1[0] = bflo(hw.z) + sigm(a1[0]) * bflo(pw.z); o1[1] = bfhi(hw.z) + sigm(a1[1]) * bfhi(pw.z); o1[2] = bflo(hw.w) + sigm(a1[2]) * bflo(pw.w); o1[3] = bfhi(hw.w) + sigm(a1[3]) * bfhi(pw.w);
                *(f32x4*)(out + off + bj * 128) = o0; *(f32x4*)(out + off + bj * 128 + 4) = o1; }
            if (g + 4 < 8) { EF_LD(g + 4); }
            asm volatile("" ::: "memory"); }
#undef EF_LD
    }
};

struct EpiMidPP {
    u32x4* park;
    __device__ __forceinline__ void operator()(const f32x4 (&acc)[2][2][4][2], const pg8::Unit& u, int wr, int wc, int fr, int fq) const {
        asm volatile("" : "+v"(fr), "+v"(fq));
        const unsigned pko_ = (unsigned)((wr * 4 + wc) * 64 + fq * 16 + fr);
#pragma unroll
        for (int ai = 0; ai < 2; ++ai)
#pragma unroll
            for (int m = 0; m < 4; ++m)
#pragma unroll
                for (int bj = 0; bj < 2; ++bj) { const f32x4 v0 = acc[ai][bj][m][0], v1 = acc[ai][bj][m][1];
                    u32x4 w; w.x = cvtpk(v0[0], v0[1]); w.y = cvtpk(v0[2], v0[3]); w.z = cvtpk(v1[0], v1[1]); w.w = cvtpk(v1[2], v1[3]);
                    park[pko_ + (unsigned)((((ai * 4 + m) * 2 + bj) * 8) * 64)] = w; }
    }
};
struct EpiFinalC {
    const bf16_t* hb; float* out; const float* rstd; const u32x4* park;
    __device__ __forceinline__ void operator()(const f32x4 (&acc)[2][2][4][2], const pg8::Unit& u, int wr, int wc, int fr, int fq) const {
        asm volatile("" : "+v"(fr), "+v"(fq));
        const int row0 = u.pm * 256 + wr * 64 + fr, col0 = u.pn * 256 + wc * 32 + 8 * fq;
        const unsigned pko_ = (unsigned)((wr * 4 + wc) * 64 + fq * 16 + fr);
        u32x4 H[8][2], P[8][2]; float RS[8];
#define EF_LD(g) do { const int row_ = row0 + ((g) >> 2) * 128 + ((g) & 3) * 16; const size_t off_ = (size_t)row_ * DM_ + col0; RS[g] = rstd[row_]; \
        _Pragma("unroll") for (int bj = 0; bj < 2; ++bj) { H[g][bj] = *(const u32x4*)(hb + off_ + bj * 128); P[g][bj] = park[pko_ + (unsigned)((((g) * 2 + bj) * 8) * 64)]; } } while (0)
        EF_LD(0); EF_LD(1); EF_LD(2); EF_LD(3);
        asm volatile("" ::: "memory");
#pragma unroll
        for (int g = 0; g < 8; ++g) { const int ai = g >> 2, m = g & 3; const size_t off = (size_t)(row0 + ai * 128 + m * 16) * DM_ + col0; const float rs = rsqf_(RS[g] * (1.f / DM_) + EPS_);
#pragma unroll
            for (int bj = 0; bj < 2; ++bj) { const u32x4 hw = H[g][bj], pw = P[g][bj];
                const f32x4 a0 = acc[ai][bj][m][0] * rs, a1 = acc[ai][bj][m][1] * rs;
                f32x4 o0, o1;
                o0[0] = bflo(hw.x) + sigm(a0[0]) * bflo(pw.x); o0[1] = bfhi(hw.x) + sigm(a0[1]) * bfhi(pw.x); o0[2] = bflo(hw.y) + sigm(a0[2]) * bflo(pw.y); o0[3] = bfhi(hw.y) + sigm(a0[3]) * bfhi(pw.y);
                o1[0] = bflo(hw.z) + sigm(a1[0]) * bflo(pw.z); o1[1] = bfhi(hw.z) + sigm(a1[1]) * bfhi(pw.z); o1[2] = bflo(hw.w) + sigm(a1[2]) * bflo(pw.w); o1[3] = bfhi(hw.w) + sigm(a1[3]) * bfhi(pw.w);
                *(f32x4*)(out + off + bj * 128) = o0; *(f32x4*)(out + off + bj * 128 + 4) = o1; }
            if (g + 4 < 8) { EF_LD(g + 4); }
            asm volatile("" ::: "memory"); }
#undef EF_LD
    }
};

__device__ __forceinline__ void p0_transpose_item(const float* W, int K, int N, bf16_t* WT, const float* ks0, const float* ks1, int ksplit, LAS float* scr, int item, int lane) {
    const int nblk = N / 32, kb = item / nblk, nb = item % nblk, k0 = 64 * kb, n0 = 32 * nb;
    float wv_[32];
#pragma unroll
    for (int i = 0; i < 32; ++i) { const int k = k0 + 2 * i + (lane >> 5); wv_[i] = W[(size_t)k * N + n0 + (lane & 31)]; }
#pragma unroll
    for (int i = 0; i < 32; ++i) { const int kk = 2 * i + (lane >> 5), k = k0 + kk; float s = 1.f; if (ks0) s = (k < ksplit) ? ks0[k] : ks1[k - ksplit];
        scr[kk * 33 + (lane & 31)] = wv_[i] * s; }
    asm volatile("s_waitcnt lgkmcnt(0)" ::: "memory");
    const int c = lane & 7;
#pragma unroll
    for (int j = 0; j < 4; ++j) { const int n = (lane >> 3) + 8 * j; const LAS float* s = scr + (8 * c) * 33 + n;
        u32x4 o; o.x = cvtpk(s[0 * 33], s[1 * 33]); o.y = cvtpk(s[2 * 33], s[3 * 33]); o.z = cvtpk(s[4 * 33], s[5 * 33]); o.w = cvtpk(s[6 * 33], s[7 * 33]);
        *(u32x4*)(WT + (size_t)(n0 + n) * K + k0 + 8 * c) = o; }
    asm volatile("s_waitcnt lgkmcnt(0)" ::: "memory");
}
__device__ __forceinline__ void attn_phase(LAS unsigned char* lds, const bf16_t* PROJ, const bf16_t* VT, const float* gq, const float* gk, const float* rb, bf16_t* MERGED, int vcu, int G, const int wave_u) {
    int tid_ = wave_u * 64 + lane_id_v(); asm volatile("" : "+v"(tid_));
    const int tid = tid_, lane = tid & 63, h = __builtin_amdgcn_readfirstlane(tid >> 6), ql = lane & 31, hi = lane >> 5;
    LAS float* SQ = (LAS float*)lds;
    LAS float* EXT = (LAS float*)(lds + 2048) + h * 640;
    float mq = wave_max(fabsf(gq[lane])), mk = wave_max(fabsf(gk[lane])); float mb = -1e30f;
    for (int i = lane; i < 513; i += 64) mb = fmaxf(mb, rb[h * 513 + i]);
    mb = wave_max(mb);
    const float c512 = rb[h * 513 + 512]; (void)mq; (void)mk; (void)mb;
    for (int i = lane; i < 640; i += 64) { int rel = i - 64; rel = rel > 256 ? 256 : (rel < -256 ? -256 : rel); EXT[639 - i] = (rb[h * 513 + rel + 256] - c512) * LOG2E; }
    asm volatile("s_waitcnt lgkmcnt(0)" ::: "memory");
    __syncthreads();
    bf16x8 qf[2][4], kn[4], vn[4];
    const unsigned kgo = (unsigned)((lane >> 3) * PJW + (lane & 7) * 8), vgo = (unsigned)((lane >> 2) * T_ + (lane & 3) * 8);
#define LOADKV2(KB, VB, IT) do { const bf16_t* kp_ = (KB) + (long)(IT) * 32 * PJW; const bf16_t* vp_ = (VB) + (IT) * 32; \
        _Pragma("unroll") for (int i = 0; i < 4; ++i) { kn[i] = *(const bf16x8*)(kp_ + (kgo + (unsigned)(i * 8 * PJW))); vn[i] = *(const bf16x8*)(vp_ + (vgo + (unsigned)(i * 16 * T_))); } } while (0)
#define UNIT_PREFETCH(U) do { const int b_ = (U) >> 7, n_ = (U) & 127; const long tk_ = (long)b_ * SEQ_ + n_ * 64; const int i0_ = (n_ < 8) ? 2 * (8 - n_) : 0; \
        const bf16_t* qp_ = PROJ + (tk_ + ql) * PJW + 1024 + h * 64 + hi * 8; \
        _Pragma("unroll") for (int qb = 0; qb < 2; ++qb) _Pragma("unroll") for (int d0 = 0; d0 < 4; ++d0) qf[qb][d0] = *(const bf16x8*)(qp_ + (long)qb * 32 * PJW + d0 * 16); \
        LOADKV2(PROJ + (tk_ - 512) * PJW + 1536 + h * 64, VT + (long)(h * 64) * T_ + (tk_ - 512), i0_); } while (0)
    if (vcu < NUNIT_ATT) UNIT_PREFETCH(vcu);
    for (int unit = vcu; unit < NUNIT_ATT; unit += G) {
        const int b = unit >> 7, n = unit & 127; const long tok0 = (long)b * SEQ_ + n * 64;
        f32x16 o[2][2];
#pragma unroll
        for (int a = 0; a < 2; ++a)
#pragma unroll
            for (int c = 0; c < 2; ++c)
#pragma unroll
                for (int r = 0; r < 16; ++r) o[a][c][r] = 0.f;
        float lsum[2] = {0.f, 0.f};
        const int it0 = (n < 8) ? 2 * (8 - n) : 0;
        const bf16_t* kbase = PROJ + (tok0 - 512) * PJW + 1536 + h * 64;
        const bf16_t* vbase = VT + (long)(h * 64) * T_ + (tok0 - 512);
        LAS unsigned char* kv = lds + 24576 + h * 8192;
        const unsigned wk = (unsigned)((lane >> 3) * 128 + (((lane & 7) ^ (lane >> 3)) * 16));
        const unsigned wvl = (unsigned)(4096 + (lane >> 2) * 64 + ((((unsigned)((lane & 3) >> 1) * 2u + 0u) ^ (unsigned)((lane >> 3) & 3)) * 16) + (lane & 1) * 8);
        const unsigned wvh = (unsigned)(4096 + (lane >> 2) * 64 + ((((unsigned)((lane & 3) >> 1) * 2u + 1u) ^ (unsigned)((lane >> 3) & 3)) * 16) + (lane & 1) * 8);
        const unsigned rkb = (unsigned)(ql * 128), rks = (unsigned)(ql & 7), rvb = (unsigned)(4096 + ql * 64), rvs = (unsigned)((ql >> 1) & 3);
#define LOADKV(IT) LOADKV2(kbase, vbase, IT)
        for (int it = it0; it < 18; ++it) {
#pragma unroll
            for (int i = 0; i < 4; ++i) { *(LAS bf16x8*)(kv + wk + i * 1024) = kn[i]; const u32x4 vv = __builtin_bit_cast(u32x4, vn[i]);
                *(LAS u32x2*)(kv + wvl + i * 1024) = (u32x2){vv.x, vv.y}; *(LAS u32x2*)(kv + wvh + i * 1024) = (u32x2){vv.z, vv.w}; }
            { const int itn = (it + 1 < 18) ? it + 1 : it; LOADKV(itn); }
            bf16x8 kf[4], vf[2][2];
#pragma unroll
            for (int d0 = 0; d0 < 4; ++d0) kf[d0] = *(const LAS bf16x8*)(kv + rkb + (((unsigned)(2 * d0 + hi) ^ rks) * 16));
#pragma unroll
            for (int db = 0; db < 2; ++db)
#pragma unroll
                for (int ks = 0; ks < 2; ++ks) vf[db][ks] = *(const LAS bf16x8*)(kv + rvb + db * 2048 + (((unsigned)(2 * ks + hi) ^ rvs) * 16));
            const bool tab = (it >= 8);
#pragma unroll
            for (int qb = 0; qb < 2; ++qb) {
                f32x16 s;
                if (tab) { const LAS float* e = EXT + (63 - 32 * qb - ql + 32 * it + 4 * hi); f32x16 cin;
#pragma unroll
                    for (int r = 0; r < 16; ++r) cin[r] = e[(r & 3) + 8 * (r >> 2)];
                    s = MFMA32(kf[0], qf[qb][0], cin); }
                else { f32x16 z_;
#pragma unroll
                    for (int r = 0; r < 16; ++r) z_[r] = 0.f;
                    s = MFMA32(kf[0], qf[qb][0], z_); }
#pragma unroll
                for (int d0 = 1; d0 < 4; ++d0) s = MFMA32(kf[d0], qf[qb][d0], s);
                float ps = 0.f;
#pragma unroll
                for (int r = 0; r < 16; ++r) { s[r] = ex2(s[r]); ps += s[r]; }
                lsum[qb] += ps;
                bf16x8 pk[2];
#pragma unroll
                for (int ks = 0; ks < 2; ++ks) { u32x4 w; w.x = cvtpk(s[8 * ks], s[8 * ks + 1]); w.y = cvtpk(s[8 * ks + 2], s[8 * ks + 3]); w.z = cvtpk(s[8 * ks + 4], s[8 * ks + 5]); w.w = cvtpk(s[8 * ks + 6], s[8 * ks + 7]);
                    pk[ks] = __builtin_bit_cast(bf16x8, w); }
#pragma unroll
                for (int db = 0; db < 2; ++db)
#pragma unroll
                    for (int ks = 0; ks < 2; ++ks) o[db][qb] = MFMA32(vf[db][ks], pk[ks], o[db][qb]);
            }
        }
#undef LOADKV
        if (unit + G < NUNIT_ATT) UNIT_PREFETCH(unit + G);
        float inv[2], sq[2];
#pragma unroll
        for (int qb = 0; qb < 2; ++qb) { float l = lsum[qb]; l += __shfl_xor(l, 32); inv[qb] = 1.f / l; float q2 = 0.f;
#pragma unroll
            for (int db = 0; db < 2; ++db)
#pragma unroll
                for (int r = 0; r < 16; ++r) { const float v = o[db][qb][r] * inv[qb]; o[db][qb][r] = v; q2 += v * v; }
            q2 += __shfl_xor(q2, 32); sq[qb] = q2;
            if (hi == 0) SQ[h * 64 + 32 * qb + ql] = q2; }
        asm volatile("s_waitcnt lgkmcnt(0)" ::: "memory");
        __syncthreads();
#pragma unroll
        for (int qb = 0; qb < 2; ++qb) { float tot = 0.f;
#pragma unroll
            for (int hh = 0; hh < 8; ++hh) tot += SQ[hh * 64 + 32 * qb + ql];
            const float rstd = rsqf_(tot * (1.f / 512.f) + EPS_);
            bf16_t* op = MERGED + (tok0 + 32 * qb + ql) * DM_ + 512 + h * 64 + 4 * hi;
#pragma unroll
            for (int db = 0; db < 2; ++db)
#pragma unroll
                for (int r4 = 0; r4 < 4; ++r4) { u32x2 w; w.x = cvtpk(o[db][qb][4 * r4] * rstd, o[db][qb][4 * r4 + 1] * rstd); w.y = cvtpk(o[db][qb][4 * r4 + 2] * rstd, o[db][qb][4 * r4 + 3] * rstd);
                    *(u32x2*)(op + 32 * db + 8 * r4) = w; } }
        __syncthreads();
    }
}

template <bool PASS2>
__device__ __forceinline__ void lru_unit(LAS unsigned char* lds, int unit, const bf16_t* PROJ, const bf16_t* WGT, const float* conv_w, const float* conv_b, const float* b_rg, const float* b_ig,
                                         const float* lam, f32x2* SUMM, bf16_t* MERGED, const int wave_u) {
    int tid_ = wave_u * 64 + lane_id_v(); asm volatile("" : "+v"(tid_));
    const int tid = tid_, lane = tid & 63, w = __builtin_amdgcn_readfirstlane(tid >> 6), ql = lane & 31, hi = lane >> 5;
    const int b = unit >> 5, seg = unit & 31; const long tok0 = (long)b * SEQ_ + seg * 256;
    LAS bf16_t* XC = (LAS bf16_t*)lds + w * (64 * 72);
    LAS bf16_t* YT = (LAS bf16_t*)(lds + 73728);
    const int chc = 64 * w + lane;
    const float cw0 = conv_w[chc], cw1 = conv_w[512 + chc], cw2 = conv_w[1024 + chc], cw3 = conv_w[1536 + chc], cbv = conv_b[chc];
    float brg[2], big[2], sp[2];
#pragma unroll
    for (int nb = 0; nb < 2; ++nb) { const int ch = 64 * w + 32 * nb + ql; brg[nb] = b_rg[ch]; big[nb] = b_ig[ch];
        sp[nb] = -8.f * LOG2E * log1pf(expf(-lam[ch])); }
    float carry[2] = {0.f, 0.f}, ptot[2] = {1.f, 1.f};
    if (PASS2) {
#pragma unroll
        for (int nb = 0; nb < 2; ++nb) { float c = 0.f; const f32x2* sp_ = SUMM + (size_t)(b * 32) * 512 + 64 * w + 32 * nb + ql;
            for (int s0 = 0; s0 < seg; s0 += 8) { f32x2 v[8];
#pragma unroll
                for (int j = 0; j < 8; ++j) v[j] = (s0 + j < seg) ? sp_[(size_t)(s0 + j) * 512] : (f32x2){1.f, 0.f};
#pragma unroll
                for (int j = 0; j < 8; ++j) c = v[j].x * c + v[j].y; }
            carry[nb] = c; }
    }
    float x1 = 0.f, x2 = 0.f, x3 = 0.f;
#pragma nounroll
    for (int st = 0; st < 4; ++st) {
        const long t0 = tok0 + 64 * st;
        {
            const bf16_t* xt = PROJ + t0 * PJW + 64 * w;
            const unsigned go = (unsigned)((lane >> 3) * PJW + (lane & 7) * 8);
            bf16x8 raw[8];
#pragma unroll
            for (int i = 0; i < 8; ++i) raw[i] = *(const bf16x8*)(xt + (go + (unsigned)(i * 8 * PJW)));
            if (st == 0) { x1 = 0.f; x2 = 0.f; x3 = 0.f;
                if (seg != 0) { const bf16_t* xp = PROJ + t0 * PJW + chc; x1 = bf2f(xp[-1 * PJW]); x2 = bf2f(xp[-2 * PJW]); x3 = bf2f(xp[-3 * PJW]); } }
#pragma unroll
            for (int i = 0; i < 8; ++i) *(LAS bf16x8*)(XC + (8 * i + (lane >> 3)) * 72 + (lane & 7) * 8) = raw[i];
#pragma unroll 16
            for (int t = 0; t < 64; ++t) { const float xv = bf2f(XC[t * 72 + lane]); const float xc = cbv + cw0 * x3 + cw1 * x2 + cw2 * x1 + cw3 * xv;
                XC[t * 72 + lane] = (bf16_t)(cvtpk(xc, 0.f) & 0xffffu); x3 = x2; x2 = x1; x1 = xv; }
        }
        asm volatile("s_waitcnt lgkmcnt(0)" ::: "memory");
#pragma unroll
        for (int nb = 0; nb < 2; ++nb) {
            bf16x8 wrf[4], wif[4];
            { int woff = ((w * 2 + nb) * 4 * 64 + lane) * 8; asm volatile("" : "+v"(woff));
#pragma unroll
              for (int ks = 0; ks < 4; ++ks) { wrf[ks] = *(const bf16x8*)(WGT + woff + ks * 512); wif[ks] = *(const bf16x8*)(WGT + 8 * 4096 + woff + ks * 512); } }
#pragma unroll
            for (int tb = 0; tb < 2; ++tb) {
                bf16x8 af[4];
#pragma unroll
                for (int ks = 0; ks < 4; ++ks) af[ks] = *(const LAS bf16x8*)(XC + (32 * tb + ql) * 72 + 16 * ks + 8 * hi);
                f32x16 dr, di;
#pragma unroll
                for (int r = 0; r < 16; ++r) { dr[r] = 0.f; di[r] = 0.f; }
#pragma unroll
                for (int ks = 0; ks < 4; ++ks) { dr = MFMA32(af[ks], wrf[ks], dr); di = MFMA32(af[ks], wif[ks], di); }
                float A[16], U[16];
#pragma unroll
                for (int r = 0; r < 16; ++r) { const int tok = 32 * tb + crow(r, hi); const float xcv = bf2f(XC[tok * 72 + 32 * nb + ql]);
                    const float rg = sigm(dr[r] + brg[nb]), ig = sigm(di[r] + big[nb]); const float a = ex2(rg * sp[nb]);
                    const float mult = __builtin_amdgcn_sqrtf(fmaxf(1.f - a * a, 0.f)); A[r] = a; U[r] = mult * ig * xcv; }
#pragma unroll
                for (int q4 = 0; q4 < 4; ++q4)
#pragma unroll
                    for (int e = 1; e < 4; ++e) { U[4 * q4 + e] = A[4 * q4 + e] * U[4 * q4 + e - 1] + U[4 * q4 + e]; A[4 * q4 + e] = A[4 * q4 + e - 1] * A[4 * q4 + e]; }
                float c = carry[nb], HIN[4];
#pragma unroll
                for (int q4 = 0; q4 < 4; ++q4) { const float e0 = A[4 * q4 + 3] * c + U[4 * q4 + 3]; const float p = __shfl_xor(e0, 32); const float hin = hi ? p : c; HIN[q4] = hin;
                    const float e1 = A[4 * q4 + 3] * hin + U[4 * q4 + 3]; const float q = __shfl_xor(e1, 32); c = hi ? e1 : q; }
                carry[nb] = c;
                if (!PASS2) { const float po = (A[3] * A[7]) * (A[11] * A[15]); ptot[nb] *= po * __shfl_xor(po, 32); }
                else {
                    const bf16_t* gb = PROJ + t0 * PJW + 512 + 64 * w + 32 * nb + (32 * tb) * PJW;
                    const unsigned goff = (unsigned)(4 * hi) * PJW + ql;
#pragma unroll
                    for (int r = 0; r < 16; ++r) { const int tok = 32 * tb + crow(r, hi); const float hval = U[r] + A[r] * HIN[r >> 2]; const float gl = bf2f(gb[goff + (unsigned)((r & 3) + 8 * (r >> 2)) * PJW]);
                        YT[tok * 520 + 64 * w + 32 * nb + ql] = (bf16_t)(cvtpk(hval * gl, 0.f) & 0xffffu); }
                }
            }
        }
        if (PASS2) {
            asm volatile("s_waitcnt lgkmcnt(0)" ::: "memory");
            __syncthreads();
#pragma unroll
            for (int i = 0; i < 8; ++i) { const int tok = 8 * w + i; const u32x4 v = *(const LAS u32x4*)(YT + tok * 520 + 8 * lane);
                const float f0 = bflo(v.x), f1 = bfhi(v.x), f2 = bflo(v.y), f3 = bfhi(v.y), f4 = bflo(v.z), f5 = bfhi(v.z), f6 = bflo(v.w), f7 = bfhi(v.w);
                float ss = (f0 * f0 + f1 * f1) + (f2 * f2 + f3 * f3) + (f4 * f4 + f5 * f5) + (f6 * f6 + f7 * f7); ss = wave_sum(ss);
                const float rs = rsqf_(ss * (1.f / 512.f) + EPS_);
                u32x4 o; o.x = cvtpk(f0 * rs, f1 * rs); o.y = cvtpk(f2 * rs, f3 * rs); o.z = cvtpk(f4 * rs, f5 * rs); o.w = cvtpk(f6 * rs, f7 * rs);
                *(u32x4*)(MERGED + (t0 + tok) * DM_ + 8 * lane) = o; }
            __syncthreads();
        }
        asm volatile("" ::: "memory");
    }
    if (!PASS2) { if (hi == 0) {
#pragma unroll
        for (int nb = 0; nb < 2; ++nb) SUMM[(size_t)unit * 512 + 64 * w + 32 * nb + ql] = (f32x2){ptot[nb], carry[nb]}; } }
}

#ifndef PROBE_MASK
#define PROBE_MASK 0
#endif
#ifndef RES_BF16
#define RES_BF16 1
#endif
struct Args { const float* in[23]; float* out; unsigned char* ws; };
__global__ void __launch_bounds__(NTHR, 2) fwd_megakernel(Args args) {
    extern __shared__ __attribute__((aligned(16))) unsigned char lds_raw[];
    cg::grid_group grid = cg::this_grid();
    LAS unsigned char* lds = (LAS unsigned char*)lds_raw;
    const int wave = __builtin_amdgcn_readfirstlane(threadIdx.x >> 6);
#define tid (wave * 64 + lane_id_v())
#define lane (lane_id_v())
    const int G = gridDim.x, bx = blockIdx.x, vcu = (G % 8 == 0) ? (bx % 8) * (G / 8) + bx / 8 : bx;
    unsigned char* ws = args.ws;
    volatile LAS unsigned* MISC = (volatile LAS unsigned*)(lds + MISC_OFF);
    if (threadIdx.x < 16) MISC[threadIdx.x] = 0u;
    __syncthreads();
    XcdBarrier bar; bar.bar = (unsigned*)(ws + WS_CTL); bar.x = xb_xcc_id(); bar.st = MISC;
    if (blockIdx.x == 0) for (int i = threadIdx.x; i < (int)(CTL_BYTES / 4); i += NTHR) bar.bar[i] = 0u;
    const float* x = args.in[0]; const float* p = args.in[1]; float* out = args.out;
    bf16_t* WT_IN = (bf16_t*)(ws + WS_WIN); bf16_t* WT_OUT = (bf16_t*)(ws + WS_WOUT); bf16_t* WT_UP = (bf16_t*)(ws + WS_WUP); bf16_t* WT_DN = (bf16_t*)(ws + WS_WDN);
    bf16_t* WT_PG = (bf16_t*)(ws + WS_WPG); bf16_t* WT_PP = (bf16_t*)(ws + WS_WPP); bf16_t* WGT = (bf16_t*)(ws + WS_WG);
    float* RINV0 = (float*)(ws + WS_RINV0);
    float* RSTD1 = (float*)(ws + WS_RSTD1); float* RSTD2 = (float*)(ws + WS_RSTD2); f32x2* SUMM = (f32x2*)(ws + WS_SUMM);
    bf16_t* XN = (bf16_t*)(ws + WS_XN); bf16_t* PP = (bf16_t*)(ws + WS_PP); bf16_t* PB = (bf16_t*)(ws + WS_PB);
    bf16_t* PROJ = (bf16_t*)(ws + WS_PROJ); bf16_t* VT = (bf16_t*)(ws + WS_VT); bf16_t* MERGED = (bf16_t*)(ws + WS_MERGED); bf16_t* ACT = (bf16_t*)(ws + WS_ACT);

    for (int rep_ = 0; rep_ < 1 + ((PROBE_MASK >> 0) & 1); ++rep_) {
        LAS float* scr = (LAS float*)(lds + wave * 16384);
        const int gw = vcu * NWAVES + wave, NGW = G * NWAVES;
        constexpr int I_IN = 16 * 80, I_OUT = 16 * 32, I_UP = 16 * 128, I_DN = 64 * 32, I_PG = 16 * 32, I_PP = 4 * 32;
        constexpr int NITEMS = I_IN + I_OUT + I_UP + I_DN + I_PG + I_PP;
        for (int it = gw; it < NITEMS; it += NGW) {
            int r = it;
            if (r < I_IN) { p0_transpose_item(args.in[3], 1024, 2560, WT_IN, nullptr, nullptr, 0, scr, r, lane); continue; } r -= I_IN;
            if (r < I_OUT) { p0_transpose_item(args.in[16], 1024, 1024, WT_OUT, args.in[14], args.in[15], 512, scr, r, lane); continue; } r -= I_OUT;
            if (r < I_UP) { p0_transpose_item(args.in[18], 1024, 4096, WT_UP, args.in[17], args.in[17], 1 << 30, scr, r, lane); continue; } r -= I_UP;
            if (r < I_DN) { p0_transpose_item(args.in[19], 4096, 1024, WT_DN, nullptr, nullptr, 0, scr, r, lane); continue; } r -= I_DN;
            if (r < I_PG) { p0_transpose_item(args.in[21], 1024, 1024, WT_PG, args.in[20], args.in[20], 1 << 30, scr, r, lane); continue; } r -= I_PG;
            p0_transpose_item(args.in[22], 256, 1024, WT_PP, nullptr, nullptr, 0, scr, r, lane);
        }
        for (int i = bx * NTHR + tid; i < T_; i += G * NTHR) { RSTD1[i] = 0.f; RSTD2[i] = 0.f; }
        for (int i = bx * NTHR + tid; i < 65536; i += G * NTHR) { const int e = i & 7, ln = (i >> 3) & 63, ks = (i >> 9) & 3, nb = (i >> 11) & 1, blk = (i >> 12) & 7, gate = i >> 15;
            const int k = 16 * ks + 8 * (ln >> 5) + e, n = 32 * nb + (ln & 31);
            const float v = (gate ? args.in[8] : args.in[6])[blk * 4096 + k * 64 + n]; WGT[i] = (bf16_t)(cvtpk(v, 0.f) & 0xffffu); }
        const float* g1 = args.in[2];
        f32x4 gv[4];
#pragma unroll
        for (int j = 0; j < 4; ++j) gv[j] = *((const f32x4*)g1 + lane + 64 * j);
        for (int m = gw; m < T_; m += NGW) {
            const f32x4* xr = (const f32x4*)(x + (size_t)m * DM_) + lane; f32x4 v[4]; float s = 0.f;
#pragma unroll
            for (int j = 0; j < 4; ++j) { v[j] = __builtin_nontemporal_load(xr + 64 * j); s += (v[j].x * v[j].x + v[j].y * v[j].y) + (v[j].z * v[j].z + v[j].w * v[j].w); }
            const float ms_ = wave_sum(s) * (1.f / DM_) + EPS_; const float rstd = rsqf_(ms_);
            if (lane == 0) RINV0[m] = ms_ * rstd;
            u32x2* o8 = (u32x2*)(XN + (size_t)m * DM_) + lane;
#pragma unroll
            for (int j = 0; j < 4; ++j) { const f32x4 y = v[j] * gv[j] * rstd; u32x2 w; w.x = cvtpk(y.x, y.y); w.y = cvtpk(y.z, y.w); o8[64 * j] = w; }
            const f32x4 pv = __builtin_nontemporal_load((const f32x4*)(p + (size_t)m * PLE_) + lane); u32x2 pw; pw.x = cvtpk(pv.x, pv.y); pw.y = cvtpk(pv.z, pv.w);
            *((u32x2*)(PB + (size_t)m * PLE_) + lane) = pw;
        }
    }
    grid.sync();
    if (threadIdx.x == 0) MISC[2] = xb_add(&bar.bar[XB_XCNT(bar.x)], 1u);
    int cid = bx, vcu2 = vcu;
#define CENSUS_IDS() do { \
    if (threadIdx.x == 0) { unsigned okc = 1u; \
        for (unsigned j = 0; j < 16; ++j) { const unsigned c_ = xb_ld(&bar.bar[XB_XCNT(j)]); okc &= (j < 8 ? (c_ == (unsigned)G / 8u) : (c_ == 0u)) ? 1u : 0u; } \
        MISC[3] = (okc && (G % 8 == 0)) ? 1u : 0u; } \
    __syncthreads(); \
    { const bool okmap = MISC[3] != 0u; \
      cid = __builtin_amdgcn_readfirstlane(okmap ? (int)(MISC[2] * 8u + bar.x) : bx); \
      vcu2 = __builtin_amdgcn_readfirstlane(okmap ? (int)(bar.x * (unsigned)(G / 8) + MISC[2]) : vcu); } } while (0)
#if 0
    if (threadIdx.x == 0) { unsigned okc = 1u;
        for (unsigned j = 0; j < 16; ++j) { const unsigned c_ = xb_ld(&bar.bar[XB_XCNT(j)]); okc &= (j < 8 ? (c_ == (unsigned)G / 8u) : (c_ == 0u)) ? 1u : 0u; }
        MISC[3] = (okc && (G % 8 == 0)) ? 1u : 0u; }
    __syncthreads();
    const bool okmap = MISC[3] != 0u;
    const int cid = __builtin_amdgcn_readfirstlane(okmap ? (int)(MISC[2] * 8u + bar.x) : bx);
    const int vcu2 = __builtin_amdgcn_readfirstlane(okmap ? (int)(bar.x * (unsigned)(G / 8) + MISC[2]) : vcu);
#endif
    for (int rep_ = 0; rep_ < 1 + ((PROBE_MASK >> 1) & 1); ++rep_) {
        { pg8::Gemm g{XN, WT_IN, T_, 2048, 1024}; pg8::StaticOrder S; S.init(T_, 2048, G, cid); EpiProj E{PROJ, args.in[11], args.in[12]};
          pg8::gemm_phase<EpiProj, pg8::StaticOrder, PG8_ALIGN, PG8_SP2>(lds, g, S, E, wave); }
        { pg8::Gemm g{WT_IN + (size_t)2048 * 1024, XN, 512, T_, 1024}; pg8::StaticOrder S; S.init(512, T_, G, cid); EpiPlain E{VT, T_};
          pg8::gemm_phase<EpiPlain, pg8::StaticOrder, PG8_ALIGN, PG8_SP2>(lds, g, S, E, wave); }
    }
    xcd_barrier(bar);
    CENSUS_IDS();
    for (int rep_ = 0; rep_ < 1 + ((PROBE_MASK >> 2) & 1); ++rep_)
    attn_phase(lds, PROJ, VT, args.in[11]  , args.in[12], args.in[13], MERGED, vcu2, G, wave);
    for (int rep_ = 0; rep_ < 1 + ((PROBE_MASK >> 3) & 1); ++rep_)
    for (int unit = vcu2; unit < NUNIT_LRU; unit += G)
        lru_unit<false>(lds, unit, PROJ, WGT, args.in[4], args.in[5], args.in[7], args.in[9], args.in[10], SUMM, MERGED, wave);
    xcd_barrier(bar);
    for (int rep_ = 0; rep_ < 1 + ((PROBE_MASK >> 4) & 1); ++rep_)
    for (int unit = vcu2; unit < NUNIT_LRU; unit += G)
        lru_unit<true>(lds, unit, PROJ, WGT, args.in[4], args.in[5], args.in[7], args.in[9], args.in[10], SUMM, MERGED, wave);
    xcd_barrier(bar);
#if RES_BF16
    { pg8::Gemm g{MERGED, WT_OUT, T_, 1024, 1024}; pg8::StaticOrder S; S.init(T_, 1024, G, cid); EpiRes4b E{XN, RINV0, args.in[2], RSTD1};
      pg8::gemm_phase<EpiRes4b, pg8::StaticOrder, PG8_ALIGN, PG8_SP2>(lds, g, S, E, wave); }
#else
    for (int rep_ = ((PROBE_MASK >> 5) & 1) ? 0 : 1; rep_ < 2; ++rep_)
    { pg8::Gemm g{MERGED, WT_OUT, T_, 1024, 1024}; pg8::StaticOrder S; S.init(T_, 1024, G, cid); EpiRes E{x, out, XN, rep_ ? RSTD1 : (float*)(ws + WS_DUMMY), 0xFFFF};
      pg8::gemm_phase<EpiRes, pg8::StaticOrder, PG8_ALIGN, PG8_SP2>(lds, g, S, E, wave); }
#endif
    xcd_barrier(bar);
    for (int rep_ = 0; rep_ < 1 + ((PROBE_MASK >> 6) & 1); ++rep_) { pg8::Gemm g{XN, WT_UP, T_, 4096, 1024}; pg8::StaticOrder S; S.init(T_, 4096, G, cid); EpiUp E{ACT, RSTD1};
      pg8::gemm_phase<EpiUp, pg8::StaticOrder, PG8_ALIGN, PG8_SP2, (PROBE_MASK >> 9) & 1>(lds, g, S, E, wave); }
    xcd_barrier(bar);
#if RES_BF16
    { pg8::Gemm g{ACT, WT_DN, T_, 1024, 4096}; pg8::StaticOrder S; S.init(T_, 1024, G, cid); EpiRes6 E{XN, RSTD2};
      pg8::gemm_phase<EpiRes6, pg8::StaticOrder, PG8_ALIGN, PG8_SP2>(lds, g, S, E, wave); }
#else
    for (int rep_ = ((PROBE_MASK >> 7) & 1) ? 0 : 1; rep_ < 2; ++rep_)
    { pg8::Gemm g{ACT, WT_DN, T_, 1024, 4096}; pg8::StaticOrder S; S.init(T_, 1024, G, cid);
      EpiRes E{out, rep_ ? out : (float*)(ws + WS_END), XN, rep_ ? RSTD2 : (float*)(ws + WS_DUMMY), rep_ ? 0xFFFF : 0x7FFF};
      pg8::gemm_phase<EpiRes, pg8::StaticOrder, PG8_ALIGN, PG8_SP2>(lds, g, S, E, wave); }
#endif
    xcd_barrier(bar);
#if RES_BF16
    { pg8::StaticOrder S; S.init(T_, 1024, G, cid); EpiMidPP EM{(u32x4*)(ws + WS_PP) + (size_t)bx * 8192}; EpiFinalC EF{XN, out, RSTD2, (const u32x4*)(ws + WS_PP) + (size_t)bx * 8192};
      pg8::gemm_phase_ple<EpiMidPP, EpiFinalC, pg8::StaticOrder>(lds, PB, WT_PP, XN, WT_PG, S, EM, EF, wave); }
#else
    for (int rep_ = ((PROBE_MASK >> 8) & 1) ? 0 : 1; rep_ < 2; ++rep_)
    { pg8::Gemm g{XN, WT_PG, T_, 1024, 1024}; pg8::StaticOrder S; S.init(T_, 1024, G, cid); EpiFinal E{out, rep_ ? out : (float*)ACT, PP, RSTD2};
      pg8::gemm_phase<EpiFinal, pg8::StaticOrder, PG8_ALIGN, PG8_SP2>(lds, g, S, E, wave); }
#endif
}

#undef tid
#undef lane
extern "C" void kernel_launch(void* const* d_in, const int* in_sizes, int n_in, void* d_out, int out_size, void* d_ws, size_t ws_size, hipStream_t stream) {
    static int grid = 0;
    if (grid == 0) {
        if (n_in != 23 || in_sizes[0] != T_ * DM_ || out_size != T_ * DM_ || ws_size < WS_END) { fprintf(stderr, "kernel_launch: unexpected shapes (n_in %d, in0 %d, out %d, ws %zu)\n", n_in, n_in > 0 ? in_sizes[0] : -1, out_size, ws_size); grid = -1; return; }
        int dev = 0, cus = 0, per_cu = 0;
        (void)hipGetDevice(&dev); (void)hipDeviceGetAttribute(&cus, hipDeviceAttributeMultiprocessorCount, dev);
        (void)hipFuncSetAttribute((const void*)fwd_megakernel, hipFuncAttributeMaxDynamicSharedMemorySize, LDS_BYTES);
        if (hipOccupancyMaxActiveBlocksPerMultiprocessor(&per_cu, (const void*)fwd_megakernel, NTHR, LDS_BYTES) != hipSuccess || per_cu < 1) per_cu = 1;
        (void)hipGetLastError();
        grid = cus * per_cu;
        if (grid > 256) grid = 256;
        fprintf(stderr, "kernel_launch: cus %d per_cu %d grid %d\n", cus, per_cu, grid);
    }
    if (grid < 0) return;
    Args a{};
    for (int i = 0; i < 23; ++i) a.in[i] = (const float*)d_in[i];
    a.out = (float*)d_out; a.ws = (unsigned char*)d_ws;
    void* kargs[] = {&a};
    hipError_t e = hipLaunchCooperativeKernel((const void*)fwd_megakernel, dim3(grid), dim3(NTHR), kargs, LDS_BYTES, stream);
    if (e != hipSuccess) fprintf(stderr, "kernel_launch: cooperative launch failed: %s (grid %d)\n", hipGetErrorString(e), grid);
}
```

```cpp
#include <hip/hip_runtime.h>
#include <hip/hip_cooperative_groups.h>
#include <cstdio>
#include <cstdint>
namespace cg = cooperative_groups;
__device__ __forceinline__ int lane_id_v() { int l; asm volatile("v_mbcnt_lo_u32_b32 %0, -1, 0\n\tv_mbcnt_hi_u32_b32 %0, -1, %0" : "=v"(l)); return l; }
namespace pg8 {
#define PG8_LAS __attribute__((address_space(3)))
typedef unsigned short bf16_t;
typedef short bf16x8 __attribute__((ext_vector_type(8)));
typedef float f32x4 __attribute__((ext_vector_type(4)));
typedef unsigned u32x4 __attribute__((ext_vector_type(4)));
constexpr int BM = 256, BK = 64, HALF = 128, HTB = HALF * BK * 2  , STAGE_BYTES = 8 * HTB, NXCD = 8, WGM = 8;

__host__ __device__ __forceinline__ int lds_byte(int r, int c) { const int st = (r >> 4) * 2 + (c >> 5), rr = r & 15, cc = c & 31, ob = rr * 64 + cc * 2; return st * 1024 + (ob ^ (((ob >> 9) & 1) << 5)); }
__host__ __device__ __forceinline__ void stage_rc(int b, int& R, int& C) { const int st = b / 1024, sb = b % 1024, swz = sb ^ (((sb >> 9) & 1) << 5); R = (st >> 1) * 16 + swz / 64; C = (st & 1) * 32 + (swz % 64) / 2; }
__host__ __device__ __forceinline__ int perm32(int rho) { const int n = rho >> 4, i = rho & 15; return 8 * (i >> 2) + 4 * n + (i & 3); }

struct Unit { int pm, pn; };
struct Gemm { const bf16_t* A; const bf16_t* Bt; int M, N, K; };

struct StaticOrder {
    int nM, nN, nwg, G, c;
    __host__ __device__ void init(int M, int N, int G_, int c_) { nM = M / BM; nN = N / BM; nwg = nM * nN; G = G_; c = c_; }
    __host__ __device__ bool next(int i, Unit& u) const {
        const long L = (long)i * G + c; if (L >= nwg) return false;
        int wgid = (int)L; { const int q = nwg / NXCD, r = nwg % NXCD, xcd = wgid % NXCD, off = wgid / NXCD; wgid = (xcd < r ? xcd * (q + 1) : r * (q + 1) + (xcd - r) * q) + off; }
        const int nig = WGM * nN, gid = wgid / nig, fm = gid * WGM, gsz = (nM - fm) < WGM ? (nM - fm) : WGM;
        u.pm = fm + ((wgid % nig) % gsz); u.pn = (wgid % nig) / gsz; return true;
    }
    __device__ __forceinline__ void a_ready(const Unit&) const {}
    __device__ __forceinline__ void done(const Unit&) const {}
};

__device__ __forceinline__ unsigned cvt_pk_bf16(float lo, float hi) { unsigned r; asm volatile("v_cvt_pk_bf16_f32 %0, %1, %2" : "=v"(r) : "v"(lo), "v"(hi)); return r; }
typedef float f32x2 __attribute__((ext_vector_type(2)));
template <class Epi, class Sched, bool ALIGN_EPI = false, bool SP2 = false, bool EPI2 = false>
__device__ __forceinline__ void gemm_phase(PG8_LAS unsigned char* lds, const Gemm g, const Sched& S, const Epi& E, const int wave_u) {
    int tid_ = wave_u * 64 + lane_id_v(); asm volatile("" : "+v"(tid_));
    const int tid = tid_, wid = __builtin_amdgcn_readfirstlane(tid >> 6), lane = tid & 63, wr = wid >> 2, wc = wid & 3, fr = lane & 15, fq = lane >> 4;
    const int K = g.K, nt = K / BK;
    unsigned voffA[2], voffB[2];
#pragma unroll
    for (int i = 0; i < 2; ++i) { int R, C; stage_rc(tid * 16 + i * 8192, R, C); const int Rp = Epi::PERM ? perm32(R & 31) : (R & 31); const int Rb = Epi::HEADMAP ? (64 * (R >> 5) + Rp) : ((R & ~31) + Rp);
        voffA[i] = (unsigned)(R * K + C) * 2u; voffB[i] = (unsigned)(Rb * K + C) * 2u; }
    const size_t kstep = (size_t)(BK * 2);
    const size_t hstep = (size_t)HALF * K * 2;
    const size_t hstepB = Epi::HEADMAP ? (size_t)32 * K * 2 : hstep;
    const size_t tstep = 2 * hstep;
    const unsigned ldsw = (unsigned)wid * 1024u;
    const int aoff = lds_byte(wr * 64 + fr, fq * 8), boff = lds_byte(wc * 32 + fr, fq * 8);
#define PG8_SA(b, h) (((b) * 2 + (h)) * HTB)
#define PG8_SB(b, h) ((4 + (b) * 2 + (h)) * HTB)
#define PG8_STAGE(bufoff, gbase, voff) do { _Pragma("unroll") for (int _i = 0; _i < 2; ++_i) \
        __builtin_amdgcn_global_load_lds((const unsigned*)((const char*)(gbase) + (voff)[_i]), (PG8_LAS unsigned*)(lds + (bufoff) + ldsw + _i * 8192), 16, 0, 0); } while (0)
#define PG8_LDA(dst, b, h) do { _Pragma("unroll") for (int m = 0; m < 4; ++m) _Pragma("unroll") for (int k = 0; k < 2; ++k) dst[m][k] = *(const PG8_LAS bf16x8*)(lds + PG8_SA(b, h) + aoff + m * 2048 + k * 1024); } while (0)
#define PG8_LDB(dst, b, h) do { _Pragma("unroll") for (int n = 0; n < 2; ++n) _Pragma("unroll") for (int k = 0; k < 2; ++k) dst[n][k] = *(const PG8_LAS bf16x8*)(lds + PG8_SB(b, h) + boff + n * 2048 + k * 1024); } while (0)
#define PG8_MMA(ai, bj, At, Bt) do { __builtin_amdgcn_s_setprio(1); _Pragma("unroll") for (int m = 0; m < 4; ++m) _Pragma("unroll") for (int n = 0; n < 2; ++n) _Pragma("unroll") for (int k = 0; k < 2; ++k) \
        acc[ai][bj][m][n] = __builtin_amdgcn_mfma_f32_16x16x32_bf16(Bt[n][k], At[m][k], acc[ai][bj][m][n], 0, 0, 0); __builtin_amdgcn_s_setprio(0); } while (0)
#define PG8_WAIT_V(n) asm volatile("s_waitcnt vmcnt(" #n ")" ::: "memory")
#define PG8_WAIT_L(n) asm volatile("s_waitcnt lgkmcnt(" #n ")" ::: "memory")
#define PG8_BAR __builtin_amdgcn_s_barrier()
#define PG8_SCHED __builtin_amdgcn_sched_barrier(0)
    Unit cur, nxt; int ui = 0;
    if (!S.next(0, cur)) return;
    f32x4 acc[2][2][4][2];
#pragma unroll
    for (int a = 0; a < 2; ++a)
#pragma unroll
        for (int b = 0; b < 2; ++b)
#pragma unroll
            for (int m = 0; m < 4; ++m)
#pragma unroll
                for (int n = 0; n < 2; ++n) acc[a][b][m][n] = (f32x4){0.f, 0.f, 0.f, 0.f};
    bf16x8 At[4][2], B0[2][2], B1[2][2];
    const char* cA = (const char*)g.A + (size_t)cur.pm * tstep; const char* cB = (const char*)g.Bt + (size_t)cur.pn * tstep;
    S.a_ready(cur);
    if constexpr (SP2) {
        PG8_STAGE(PG8_SB(0, 0), cB, voffB); PG8_STAGE(PG8_SB(0, 1), cB + hstepB, voffB); PG8_STAGE(PG8_SA(0, 0), cA, voffA); PG8_STAGE(PG8_SA(0, 1), cA + hstep, voffA);
        if (wr == 1) PG8_BAR;
        PG8_WAIT_V(2); PG8_BAR;
        PG8_STAGE(PG8_SB(1, 0), cB + kstep, voffB); PG8_STAGE(PG8_SA(1, 0), cA + kstep, voffA); PG8_STAGE(PG8_SB(1, 1), cB + hstepB + kstep, voffB);
        PG8_WAIT_V(6); PG8_BAR;
    } else {
        PG8_STAGE(PG8_SB(0, 0), cB, voffB); PG8_STAGE(PG8_SA(0, 0), cA, voffA); PG8_STAGE(PG8_SB(0, 1), cB + hstepB, voffB); PG8_STAGE(PG8_SA(0, 1), cA + hstep, voffA);
        if (wr == 1) PG8_BAR;
        PG8_WAIT_V(4); PG8_BAR;
        PG8_STAGE(PG8_SB(1, 0), cB + kstep, voffB); PG8_STAGE(PG8_SA(1, 0), cA + kstep, voffA); PG8_STAGE(PG8_SB(1, 1), cB + hstepB + kstep, voffB);
        PG8_WAIT_V(6); PG8_BAR;
    }
    for (;;) {
        const bool has_next = S.next(ui + 1, nxt);
        const char* nA = has_next ? (const char*)g.A + (size_t)nxt.pm * tstep : cA; const char* nB = has_next ? (const char*)g.Bt + (size_t)nxt.pn * tstep : cB;
#pragma nounroll
        for (int t = 0; t < nt; t += 2) {
            const bool last = (t == nt - 2);
            const char* a1 = cA + (size_t)(t + 1) * kstep;
            const char* a2 = last ? nA : cA + (size_t)(t + 2) * kstep; const char* b2 = last ? nB : cB + (size_t)(t + 2) * kstep;
            const char* a3 = a2 + kstep; const char* b3 = b2 + kstep;
            if (last && has_next) S.a_ready(nxt);
            if constexpr (SP2) {
            PG8_LDB(B0, 0, 0); PG8_LDB(B1, 0, 1); PG8_SCHED; PG8_LDA(At, 0, 0); PG8_STAGE(PG8_SA(1, 1), a1 + hstep, voffA);
            PG8_WAIT_V(8); PG8_WAIT_L(0); PG8_BAR; PG8_MMA(0, 0, At, B0); PG8_MMA(0, 1, At, B1); PG8_BAR; PG8_SCHED;
            PG8_LDA(At, 0, 1); PG8_STAGE(PG8_SB(0, 0), b2, voffB); PG8_STAGE(PG8_SB(0, 1), b2 + hstepB, voffB); PG8_STAGE(PG8_SA(0, 0), a2, voffA);
            PG8_WAIT_V(8); PG8_WAIT_L(0); PG8_BAR; PG8_MMA(1, 0, At, B0); PG8_MMA(1, 1, At, B1); PG8_BAR; PG8_SCHED;
            PG8_LDB(B0, 1, 0); PG8_LDB(B1, 1, 1); PG8_SCHED; PG8_LDA(At, 1, 0); PG8_STAGE(PG8_SA(0, 1), a2 + hstep, voffA);
            PG8_WAIT_V(8); PG8_WAIT_L(0); PG8_BAR; PG8_MMA(0, 0, At, B0); PG8_MMA(0, 1, At, B1); PG8_BAR; PG8_SCHED;
            PG8_LDA(At, 1, 1); PG8_STAGE(PG8_SB(1, 0), b3, voffB); PG8_STAGE(PG8_SB(1, 1), b3 + hstepB, voffB); PG8_STAGE(PG8_SA(1, 0), a3, voffA);
            PG8_WAIT_V(8); PG8_WAIT_L(0); PG8_BAR; PG8_MMA(1, 0, At, B0); PG8_MMA(1, 1, At, B1); PG8_BAR; PG8_SCHED;
            } else {
            PG8_LDB(B0, 0, 0); PG8_SCHED; PG8_LDA(At, 0, 0); PG8_STAGE(PG8_SA(1, 1), a1 + hstep, voffA);
            PG8_WAIT_L(8); PG8_BAR; PG8_WAIT_L(0); PG8_MMA(0, 0, At, B0); PG8_BAR; PG8_SCHED;
            PG8_LDB(B1, 0, 1); PG8_STAGE(PG8_SB(0, 0), b2, voffB);
            PG8_BAR; PG8_WAIT_L(0); PG8_MMA(0, 1, At, B1); PG8_BAR;
            PG8_LDA(At, 0, 1); PG8_STAGE(PG8_SA(0, 0), a2, voffA);
            PG8_BAR; PG8_WAIT_L(0); PG8_MMA(1, 0, At, B0); PG8_BAR; PG8_SCHED;
            PG8_STAGE(PG8_SB(0, 1), b2 + hstepB, voffB);
            PG8_WAIT_V(6); PG8_BAR; PG8_MMA(1, 1, At, B1); PG8_BAR;
            PG8_LDB(B0, 1, 0); PG8_SCHED; PG8_LDA(At, 1, 0); PG8_STAGE(PG8_SA(0, 1), a2 + hstep, voffA);
            PG8_WAIT_L(8); PG8_BAR; PG8_WAIT_L(0); PG8_MMA(0, 0, At, B0); PG8_BAR; PG8_SCHED;
            PG8_LDB(B1, 1, 1); PG8_STAGE(PG8_SB(1, 0), b3, voffB);
            PG8_BAR; PG8_WAIT_L(0); PG8_MMA(0, 1, At, B1); PG8_BAR;
            PG8_LDA(At, 1, 1); PG8_STAGE(PG8_SA(1, 0), a3, voffA);
            PG8_BAR; PG8_WAIT_L(0); PG8_MMA(1, 0, At, B0); PG8_BAR; PG8_SCHED;
            PG8_STAGE(PG8_SB(1, 1), b3 + hstepB, voffB);
            PG8_WAIT_V(6); PG8_BAR; PG8_MMA(1, 1, At, B1); PG8_BAR;
            }
        }
        if constexpr (ALIGN_EPI) { if (wr == 0) PG8_BAR; }
        if constexpr (!Epi::AFTER_DRAIN) { E(acc, cur, wr, wc, fr, fq); if constexpr (EPI2) { asm volatile("" ::: "memory"); E(acc, cur, wr, wc, fr, fq); } S.done(cur); }
        if (!has_next) break;
#pragma unroll
        for (int a = 0; a < 2; ++a)
#pragma unroll
            for (int b = 0; b < 2; ++b)
#pragma unroll
                for (int m = 0; m < 4; ++m)
#pragma unroll
                    for (int n = 0; n < 2; ++n) acc[a][b][m][n] = (f32x4){0.f, 0.f, 0.f, 0.f};
        cur = nxt; cA = nA; cB = nB; ++ui;
        if constexpr (ALIGN_EPI) { if (wr == 1) PG8_BAR; }
    }
    PG8_WAIT_V(0);
    if constexpr (!ALIGN_EPI) { if (wr == 0) PG8_BAR; }
    PG8_BAR;
    if constexpr (Epi::AFTER_DRAIN) { E.fused(acc, cur, wr, wc, fr, fq, lds, wid, lane); S.done(cur); }
#undef PG8_SA
#undef PG8_SB
#undef PG8_STAGE
#undef PG8_LDA
#undef PG8_LDB
#undef PG8_MMA
#undef PG8_WAIT_V
#undef PG8_WAIT_L
#undef PG8_BAR
#undef PG8_SCHED
}

template <class EpiMid, class EpiFin, class Sched>
__device__ __forceinline__ void gemm_phase_ple(PG8_LAS unsigned char* lds, const bf16_t* AP, const bf16_t* BP, const bf16_t* AZ, const bf16_t* BZ, const Sched& S, const EpiMid& EM, const EpiFin& E, const int wave_u) {
    constexpr bool ALIGN_EPI = true;
    int tid_ = wave_u * 64 + lane_id_v(); asm volatile("" : "+v"(tid_));
    const int tid = tid_, wid = __builtin_amdgcn_readfirstlane(tid >> 6), lane = tid & 63, wr = wid >> 2, wc = wid & 3, fr = lane & 15, fq = lane >> 4;
    constexpr int KP = 256, KZ = 1024, NT = 20;
    unsigned vAP[2], vBP[2], vAZ[2], vBZ[2];
#pragma unroll
    for (int i = 0; i < 2; ++i) { int R, C; stage_rc(tid * 16 + i * 8192, R, C); const int Rb = (R & ~31) + perm32(R & 31);
        vAP[i] = (unsigned)(R * KP + C) * 2u; vBP[i] = (unsigned)(Rb * KP + C) * 2u; vAZ[i] = (unsigned)(R * KZ + C) * 2u; vBZ[i] = (unsigned)(Rb * KZ + C) * 2u; }
    const size_t kstep = (size_t)(BK * 2);
    const size_t hsP = (size_t)HALF * KP * 2, hsZ = (size_t)HALF * KZ * 2, tsP = 2 * hsP, tsZ = 2 * hsZ;
    const unsigned ldsw = (unsigned)wid * 1024u;
    const int aoff = lds_byte(wr * 64 + fr, fq * 8), boff = lds_byte(wc * 32 + fr, fq * 8);
#define PG8_SA(b, h) (((b) * 2 + (h)) * HTB)
#define PG8_SB(b, h) ((4 + (b) * 2 + (h)) * HTB)
#define PG8_STAGE(bufoff, gbase, voff) do { _Pragma("unroll") for (int _i = 0; _i < 2; ++_i) \
        __builtin_amdgcn_global_load_lds((const unsigned*)((const char*)(gbase) + (voff)[_i]), (PG8_LAS unsigned*)(lds + (bufoff) + ldsw + _i * 8192), 16, 0, 0); } while (0)
#define PG8_LDA(dst, b, h) do { _Pragma("unroll") for (int m = 0; m < 4; ++m) _Pragma("unroll") for (int k = 0; k < 2; ++k) dst[m][k] = *(const PG8_LAS bf16x8*)(lds + PG8_SA(b, h) + aoff + m * 2048 + k * 1024); } while (0)
#define PG8_LDB(dst, b, h) do { _Pragma("unroll") for (int n = 0; n < 2; ++n) _Pragma("unroll") for (int k = 0; k < 2; ++k) dst[n][k] = *(const PG8_LAS bf16x8*)(lds + PG8_SB(b, h) + boff + n * 2048 + k * 1024); } while (0)
#define PG8_MMA(ai, bj, At, Bt) do { __builtin_amdgcn_s_setprio(1); _Pragma("unroll") for (int m = 0; m < 4; ++m) _Pragma("unroll") for (int n = 0; n < 2; ++n) _Pragma("unroll") for (int k = 0; k < 2; ++k) \
        acc[ai][bj][m][n] = __builtin_amdgcn_mfma_f32_16x16x32_bf16(Bt[n][k], At[m][k], acc[ai][bj][m][n], 0, 0, 0); __builtin_amdgcn_s_setprio(0); } while (0)
#define PG8_WAIT_V(n) asm volatile("s_waitcnt vmcnt(" #n ")" ::: "memory")
#define PG8_WAIT_L(n) asm volatile("s_waitcnt lgkmcnt(" #n ")" ::: "memory")
#define PG8_BAR __builtin_amdgcn_s_barrier()
#define PG8_SCHED __builtin_amdgcn_sched_barrier(0)
    Unit cur, nxt; int ui = 0;
    if (!S.next(0, cur)) return;
    f32x4 acc[2][2][4][2];
#pragma unroll
    for (int a = 0; a < 2; ++a)
#pragma unroll
        for (int b = 0; b < 2; ++b)
#pragma unroll
            for (int m = 0; m < 4; ++m)
#pragma unroll
                for (int n = 0; n < 2; ++n) acc[a][b][m][n] = (f32x4){0.f, 0.f, 0.f, 0.f};
    bf16x8 At[4][2], B0[2][2], B1[2][2];
    const char* cAP = (const char*)AP + (size_t)cur.pm * tsP; const char* cBP = (const char*)BP + (size_t)cur.pn * tsP;
    const char* cAZ = (const char*)AZ + (size_t)cur.pm * tsZ; const char* cBZ = (const char*)BZ + (size_t)cur.pn * tsZ;
    S.a_ready(cur);
    PG8_STAGE(PG8_SB(0, 0), cBP, vBP); PG8_STAGE(PG8_SB(0, 1), cBP + hsP, vBP); PG8_STAGE(PG8_SA(0, 0), cAP, vAP); PG8_STAGE(PG8_SA(0, 1), cAP + hsP, vAP);
    if (wr == 1) PG8_BAR;
    PG8_WAIT_V(2); PG8_BAR;
    PG8_STAGE(PG8_SB(1, 0), cBP + kstep, vBP); PG8_STAGE(PG8_SA(1, 0), cAP + kstep, vAP); PG8_STAGE(PG8_SB(1, 1), cBP + hsP + kstep, vBP);
    PG8_WAIT_V(6); PG8_BAR;
    for (;;) {
        const bool has_next = S.next(ui + 1, nxt);
        const char* nAP = has_next ? (const char*)AP + (size_t)nxt.pm * tsP : cAP; const char* nBP = has_next ? (const char*)BP + (size_t)nxt.pn * tsP : cBP;
#pragma nounroll
        for (int t = 0; t < NT; t += 2) {
            if (t == 4) {
                EM(acc, cur, wr, wc, fr, fq);
#pragma unroll
                for (int a = 0; a < 2; ++a)
#pragma unroll
                    for (int b = 0; b < 2; ++b)
#pragma unroll
                        for (int m = 0; m < 4; ++m)
#pragma unroll
                            for (int n = 0; n < 2; ++n) acc[a][b][m][n] = (f32x4){0.f, 0.f, 0.f, 0.f};
            }
            const bool p1 = (t < 4), p23 = (t == 0) || (t == NT - 2);
            const char* a1 = p1 ? cAP + (size_t)(t + 1) * kstep : cAZ + (size_t)(t - 3) * kstep;
            const char* a2 = (t == 0) ? cAP + 2 * kstep : (t == NT - 2) ? nAP : cAZ + (size_t)(t - 2) * kstep;
            const char* b2 = (t == 0) ? cBP + 2 * kstep : (t == NT - 2) ? nBP : cBZ + (size_t)(t - 2) * kstep;
            const char* a3 = a2 + kstep; const char* b3 = b2 + kstep;
            const size_t hstep1 = p1 ? hsP : hsZ, hstep = p23 ? hsP : hsZ, hstepB = hstep;
            unsigned voffA1[2], voffA[2], voffB[2];
#pragma unroll
            for (int i = 0; i < 2; ++i) { voffA1[i] = p1 ? vAP[i] : vAZ[i]; voffA[i] = p23 ? vAP[i] : vAZ[i]; voffB[i] = p23 ? vBP[i] : vBZ[i]; }
            if (t == NT - 2 && has_next) S.a_ready(nxt);
            PG8_LDB(B0, 0, 0); PG8_LDB(B1, 0, 1); PG8_SCHED; PG8_LDA(At, 0, 0); PG8_STAGE(PG8_SA(1, 1), a1 + hstep1, voffA1);
            PG8_WAIT_V(8); PG8_WAIT_L(0); PG8_BAR; PG8_MMA(0, 0, At, B0); PG8_MMA(0, 1, At, B1); PG8_BAR; PG8_SCHED;
            PG8_LDA(At, 0, 1); PG8_STAGE(PG8_SB(0, 0), b2, voffB); PG8_STAGE(PG8_SB(0, 1), b2 + hstepB, voffB); PG8_STAGE(PG8_SA(0, 0), a2, voffA);
            PG8_WAIT_V(8); PG8_WAIT_L(0); PG8_BAR; PG8_MMA(1, 0, At, B0); PG8_MMA(1, 1, At, B1); PG8_BAR; PG8_SCHED;
            PG8_LDB(B0, 1, 0); PG8_LDB(B1, 1, 1); PG8_SCHED; PG8_LDA(At, 1, 0); PG8_STAGE(PG8_SA(0, 1), a2 + hstep, voffA);
            PG8_WAIT_V(8); PG8_WAIT_L(0); PG8_BAR; PG8_MMA(0, 0, At, B0); PG8_MMA(0, 1, At, B1); PG8_BAR; PG8_SCHED;
            PG8_LDA(At, 1, 1); PG8_STAGE(PG8_SB(1, 0), b3, voffB); PG8_STAGE(PG8_SB(1, 1), b3 + hstepB, voffB); PG8_STAGE(PG8_SA(1, 0), a3, voffA);
            PG8_WAIT_V(8); PG8_WAIT_L(0); PG8_BAR; PG8_MMA(1, 0, At, B0); PG8_MMA(1, 1, At, B1); PG8_BAR; PG8_SCHED;
        }
        if constexpr (ALIGN_EPI) { if (wr == 0) PG8_BAR; }
        E(acc, cur, wr, wc, fr, fq); S.done(cur);
        if (!has_next) break;
#pragma unroll
        for (int a = 0; a < 2; ++a)
#pragma unroll
            for (int b = 0; b < 2; ++b)
#pragma unroll
                for (int m = 0; m < 4; ++m)
#pragma unroll
                    for (int n = 0; n < 2; ++n) acc[a][b][m][n] = (f32x4){0.f, 0.f, 0.f, 0.f};
        cur = nxt; cAP = nAP; cBP = nBP; cAZ = (const char*)AZ + (size_t)cur.pm * tsZ; cBZ = (const char*)BZ + (size_t)cur.pn * tsZ; ++ui;
        if constexpr (ALIGN_EPI) { if (wr == 1) PG8_BAR; }
    }
    PG8_WAIT_V(0);
    if constexpr (!ALIGN_EPI) { if (wr == 0) PG8_BAR; }
    PG8_BAR;
#undef PG8_SA
#undef PG8_SB
#undef PG8_STAGE
#undef PG8_LDA
#undef PG8_LDB
#undef PG8_MMA
#undef PG8_WAIT_V
#undef PG8_WAIT_L
#undef PG8_BAR
#undef PG8_SCHED
}
}
#ifndef PG8_SP2
#define PG8_SP2 true
#endif
#ifndef PG8_ALIGN
#define PG8_ALIGN true
#endif
using pg8::bf16_t; using pg8::bf16x8; using pg8::f32x4; using pg8::u32x4;
#define LAS __attribute__((address_space(3)))
typedef float f32x2 __attribute__((ext_vector_type(2)));
typedef float f32x16 __attribute__((ext_vector_type(16)));
typedef unsigned u32x2 __attribute__((ext_vector_type(2)));
typedef __bf16 bf16x2_t __attribute__((ext_vector_type(2)));

constexpr int T_ = 65536, DM_ = 1024, SEQ_ = 8192, PJW = 2048, FF_ = 4096, PLE_ = 256, NUNIT_ATT = 1024, NUNIT_LRU = 256;
constexpr float EPS_ = 1e-6f, LOG2E = 1.4426950408889634f, QSCALE = 0.125f * 1.4426950408889634f;
constexpr int NWAVES = 8, NTHR = 512;
constexpr int RING_BYTES = 131072, SSL_OFF = RING_BYTES, MISC_OFF = 147456 - 64, LDS_BYTES = 147456;
constexpr size_t MiB = 1u << 20;
constexpr size_t WS_WIN = 0, WS_WOUT = 5 * MiB, WS_WUP = 7 * MiB, WS_WDN = 15 * MiB, WS_WPG = 23 * MiB, WS_WPP = 25 * MiB, WS_WG = 25 * MiB + 512 * 1024;
constexpr size_t WS_RSTD1 = 27 * MiB, WS_RSTD2 = 27 * MiB + 256 * 1024, WS_DUMMY = 27 * MiB + 512 * 1024, WS_RINV0 = 27 * MiB + 768 * 1024, WS_SUMM = 28 * MiB;
constexpr size_t WS_CTL = 31 * MiB, CTL_BYTES = 16384;
constexpr size_t WS_XN = 32 * MiB;
constexpr size_t WS_PP = 160 * MiB;
constexpr size_t WS_PB = 288 * MiB;
constexpr size_t WS_PROJ = 320 * MiB;
constexpr size_t WS_VT = 576 * MiB;
constexpr size_t WS_MERGED = 640 * MiB;
constexpr size_t WS_ACT = 320 * MiB;
constexpr size_t WS_END = 832 * MiB;

__device__ __forceinline__ unsigned cvtpk(float lo, float hi) { f32x2 v = {lo, hi}; bf16x2_t b = __builtin_convertvector(v, bf16x2_t); return __builtin_bit_cast(unsigned, b); }
__device__ __forceinline__ float bf2f(unsigned short u) { return __uint_as_float((unsigned)u << 16); }
__device__ __forceinline__ float bflo(unsigned w) { return __uint_as_float(w << 16); }
__device__ __forceinline__ float bfhi(unsigned w) { return __uint_as_float(w & 0xffff0000u); }
__device__ __forceinline__ float ex2(float x) { return __builtin_amdgcn_exp2f(x); }
__device__ __forceinline__ float rcpf_(float x) { return __builtin_amdgcn_rcpf(x); }
__device__ __forceinline__ float rsqf_(float x) { return __builtin_amdgcn_rsqf(x); }
__device__ __forceinline__ float sigm(float z) { return rcpf_(1.f + ex2(-LOG2E * z)); }
__device__ __forceinline__ float gelu_tanh(float g) { const float z = 0.7978845608028654f * (g + 0.044715f * g * g * g); return g * sigm(2.f * z); }
__device__ __forceinline__ float wave_sum(float v) {
#pragma unroll
    for (int o = 1; o < 64; o <<= 1) v += __shfl_xor(v, o);
    return v;
}
__device__ __forceinline__ float wave_max(float v) {
#pragma unroll
    for (int o = 1; o < 64; o <<= 1) v = fmaxf(v, __shfl_xor(v, o));
    return v;
}
__device__ __forceinline__ int crow(int r, int hi) { return (r & 3) + 8 * (r >> 2) + 4 * hi; }
#define MFMA32(a, b, c) __builtin_amdgcn_mfma_f32_32x32x16_bf16((a), (b), (c), 0, 0, 0)

#define RLX_AGENT __ATOMIC_RELAXED, __HIP_MEMORY_SCOPE_AGENT
#define XB_TMO      128
#define XB_XCNT(j)  (256  + 64 * (j))
#define XB_XSUB(j)  (1280 + 64 * (j))
#define XB_XGEN(j)  (2304 + 64 * (j))
#define XB_TOP      3328
#define XB_TOPGEN   3392
#define XCD_BAR_WORDS 3456
#define XB_SPIN_CAP (1u << 18)

__device__ __forceinline__ unsigned xb_ld(unsigned* p)              { return __hip_atomic_load(p, __ATOMIC_RELAXED, __HIP_MEMORY_SCOPE_AGENT); }
__device__ __forceinline__ unsigned xb_add(unsigned* p, unsigned v) { return __hip_atomic_fetch_add(p, v, __ATOMIC_RELAXED, __HIP_MEMORY_SCOPE_AGENT); }
__device__ __forceinline__ unsigned xb_xcc_id() { return (unsigned)__builtin_amdgcn_s_getreg((3 << 11) | 20) & 0xFu; }
#define XB_SPIN(cond, bar) do { unsigned _sp = 0; while (cond) { __builtin_amdgcn_s_sleep(1); \
    if ((++_sp & 255u) == 0u) { if (xb_ld(&(bar)[XB_TMO])) break; if (_sp > XB_SPIN_CAP) { atomicAdd(&(bar)[XB_TMO], 1u); break; } } } } while (0)

struct XcdBarrier {
    unsigned* bar; unsigned x;
    volatile LAS unsigned* st;
};

__device__ __forceinline__ XcdBarrier xcd_barrier_post(unsigned* bar, volatile LAS unsigned* st) {
    XcdBarrier b; b.bar = bar; b.x = xb_xcc_id(); b.st = st;
    if (threadIdx.x == 0) (void)xb_add(&bar[XB_XCNT(b.x)], 1u);
    return b;
}
__device__ __forceinline__ void xcd_barrier_complete(unsigned* bar, unsigned x, unsigned& nloc, unsigned& nx) {
    const unsigned G = gridDim.x * gridDim.y * gridDim.z;
    unsigned sum, cnt, mine, sp = 0u;
    for (;;) {
        sum = 0u; cnt = 0u; mine = 0u;
#pragma unroll
        for (unsigned j = 0; j < 16; ++j) { const unsigned c = xb_ld(&bar[XB_XCNT(j)]); sum += c; cnt += (c > 0u) ? 1u : 0u; mine = (j == x) ? c : mine; }
        if (sum == G) break;
        __builtin_amdgcn_s_sleep(1);
        if ((++sp & 255u) == 0u) { if (xb_ld(&bar[XB_TMO])) break; if (sp > XB_SPIN_CAP) { atomicAdd(&bar[XB_TMO], 1u); break; } }
    }
    nloc = mine > 0u ? mine : 1u; nx = cnt > 0u ? cnt : 1u;
}

__device__ __forceinline__ void xcd_barrier(const XcdBarrier& b) {
    asm volatile("s_waitcnt vmcnt(0)" ::: "memory");
    __syncthreads();
    if (threadIdx.x == 0) {
        unsigned* bar = b.bar;
        __builtin_amdgcn_s_waitcnt(0);
        unsigned nloc = b.st[0], nx = b.st[1];
        if (nloc == 0u) { xcd_barrier_complete(bar, b.x, nloc, nx); b.st[0] = nloc; b.st[1] = nx; }
        const unsigned old = xb_add(&bar[XB_XSUB(b.x)], 1u);
        const unsigned gen = old / nloc;
        if (old + 1u == (gen + 1u) * nloc) {
            __builtin_amdgcn_fence(__ATOMIC_RELEASE, "agent");
            asm volatile("s_waitcnt vmcnt(0)" ::: "memory");
            const unsigned og = xb_add(&bar[XB_TOP], 1u);
            const unsigned tg = og / nx;
            if (og + 1u == (tg + 1u) * nx) xb_add(&bar[XB_TOPGEN], 1u);
            else XB_SPIN(xb_ld(&bar[XB_TOPGEN]) == tg, bar);
            __builtin_amdgcn_fence(__ATOMIC_ACQUIRE, "agent");
            xb_add(&bar[XB_XGEN(b.x)], 1u);
            asm volatile("s_waitcnt vmcnt(0)" ::: "memory");
        } else {
            XB_SPIN(xb_ld(&bar[XB_XGEN(b.x)]) == gen, bar);
            __builtin_amdgcn_fence(__ATOMIC_ACQUIRE, "agent");
            asm volatile("s_waitcnt vmcnt(0)" ::: "memory");
        }
    }
    __syncthreads();
}

struct PanelOrder {
    int pm;
    __device__ bool next(int i, pg8::Unit& u) const { if (i >= 4) return false; u.pm = pm; u.pn = i; return true; }
    __device__ __forceinline__ void a_ready(const pg8::Unit&) const {}
    __device__ __forceinline__ void done(const pg8::Unit&) const {}
};

struct EpiPlain {
    static constexpr bool PERM = true, AFTER_DRAIN = false, HEADMAP = false;
    bf16_t* O; int ldc;
    __device__ __forceinline__ void operator()(const f32x4 (&acc)[2][2][4][2], const pg8::Unit& u, int wr, int wc, int fr, int fq) const {
        const int row0 = u.pm * 256 + wr * 64 + fr, col0 = u.pn * 256 + wc * 32 + 8 * fq;
#pragma unroll
        for (int ai = 0; ai < 2; ++ai)
#pragma unroll
            for (int m = 0; m < 4; ++m) { bf16_t* rowp = O + (size_t)(row0 + ai * 128 + m * 16) * ldc + col0;
#pragma unroll
                for (int bj = 0; bj < 2; ++bj) { const f32x4 v0 = acc[ai][bj][m][0], v1 = acc[ai][bj][m][1];
                    u32x4 w; w.x = cvtpk(v0[0], v0[1]); w.y = cvtpk(v0[2], v0[3]); w.z = cvtpk(v1[0], v1[1]); w.w = cvtpk(v1[2], v1[3]);
                    *(u32x4*)(rowp + bj * 128) = w; } }
    }
};
struct EpiVT {
    static constexpr bool PERM = true, AFTER_DRAIN = false, HEADMAP = false;
    bf16_t* O;
    __device__ __forceinline__ void operator()(const f32x4 (&acc)[2][2][4][2], const pg8::Unit& u, int wr, int wc, int fr, int fq) const {
        const int row0 = u.pm * 256 + wr * 64 + fr, col0 = u.pn * 256 + wc * 32 + 16 * (fq >> 1) + 4 * (fq & 1);
#pragma unroll
        for (int ai = 0; ai < 2; ++ai)
#pragma unroll
            for (int m = 0; m < 4; ++m) { bf16_t* rowp = O + (size_t)(row0 + ai * 128 + m * 16) * T_ + col0;
#pragma unroll
                for (int bj = 0; bj < 2; ++bj)
#pragma unroll
                    for (int n = 0; n < 2; ++n) { const f32x4 v = acc[ai][bj][m][n]; u32x2 w; w.x = cvtpk(v[0], v[1]); w.y = cvtpk(v[2], v[3]);
                        *(u32x2*)(rowp + bj * 128 + 8 * n) = w; } }
    }
};
struct EpiProj {
    static constexpr bool PERM = true, AFTER_DRAIN = false, HEADMAP = true;
    bf16_t* O; const float* gq; const float* gk;
    __device__ __forceinline__ void operator()(const f32x4 (&acc)[2][2][4][2], const pg8::Unit& u, int wr, int wc, int fr, int fq) const {
        const int row0 = u.pm * 256 + wr * 64 + fr, col0 = u.pn * 256 + wc * 64 + 8 * fq, kind = u.pn >> 1;
        f32x4 gv[2][2];
        if (kind >= 2) { const float* g = (kind == 2) ? gq : gk; const float sc = (kind == 2) ? QSCALE : 1.f;
#pragma unroll
            for (int bj = 0; bj < 2; ++bj)
#pragma unroll
                for (int n = 0; n < 2; ++n) gv[bj][n] = *(const f32x4*)(g + 32 * bj + 8 * fq + 4 * n) * sc; }
#pragma unroll
        for (int ai = 0; ai < 2; ++ai)
#pragma unroll
            for (int m = 0; m < 4; ++m) { bf16_t* rowp = O + (size_t)(row0 + ai * 128 + m * 16) * PJW + col0;
                f32x4 v[2][2];
#pragma unroll
                for (int bj = 0; bj < 2; ++bj)
#pragma unroll
                    for (int n = 0; n < 2; ++n) v[bj][n] = acc[ai][bj][m][n];
                if (kind == 1) {
#pragma unroll
                    for (int bj = 0; bj < 2; ++bj)
#pragma unroll
                        for (int n = 0; n < 2; ++n)
#pragma unroll
                            for (int e = 0; e < 4; ++e) v[bj][n][e] = gelu_tanh(v[bj][n][e]);
                } else if (kind >= 2) {
                    float ss = 0.f;
#pragma unroll
                    for (int bj = 0; bj < 2; ++bj)
#pragma unroll
                        for (int n = 0; n < 2; ++n) { const f32x4 x = v[bj][n]; ss += (x[0] * x[0] + x[1] * x[1]) + (x[2] * x[2] + x[3] * x[3]); }
                    ss += __shfl_xor(ss, 16); ss += __shfl_xor(ss, 32);
                    const float rstd = rsqf_(ss * (1.f / 64.f) + EPS_);
#pragma unroll
                    for (int bj = 0; bj < 2; ++bj)
#pragma unroll
                        for (int n = 0; n < 2; ++n) v[bj][n] = v[bj][n] * gv[bj][n] * rstd;
                }
#pragma unroll
                for (int bj = 0; bj < 2; ++bj) { const f32x4 v0 = v[bj][0], v1 = v[bj][1];
                    u32x4 w; w.x = cvtpk(v0[0], v0[1]); w.y = cvtpk(v0[2], v0[3]); w.z = cvtpk(v1[0], v1[1]); w.w = cvtpk(v1[2], v1[3]);
                    *(u32x4*)(rowp + bj * 32) = w; } }
    }
};
struct EpiRes {
    static constexpr bool PERM = true, AFTER_DRAIN = false, HEADMAP = false;
    const float* base; float* out; bf16_t* hb; float* ssq; int rowmask;
    __device__ __forceinline__ void operator()(const f32x4 (&acc)[2][2][4][2], const pg8::Unit& u, int wr, int wc, int fr, int fq) const {
        const int row0 = u.pm * 256 + wr * 64 + fr, col0 = u.pn * 256 + wc * 32 + 8 * fq;
#pragma unroll
        for (int ai = 0; ai < 2; ++ai)
#pragma unroll
            for (int m = 0; m < 4; ++m) { const size_t off = (size_t)(row0 + ai * 128 + m * 16) * DM_ + col0; const size_t ooff = (size_t)((row0 + ai * 128 + m * 16) & rowmask) * DM_ + col0; float ss = 0.f;
#pragma unroll
                for (int bj = 0; bj < 2; ++bj) {
                    const f32x4 b0 = *(const f32x4*)(base + off + bj * 128), b1 = *(const f32x4*)(base + off + bj * 128 + 4);
                    const f32x4 v0 = b0 + acc[ai][bj][m][0], v1 = b1 + acc[ai][bj][m][1];
                    ss += (v0[0] * v0[0] + v0[1] * v0[1]) + (v0[2] * v0[2] + v0[3] * v0[3]) + (v1[0] * v1[0] + v1[1] * v1[1]) + (v1[2] * v1[2] + v1[3] * v1[3]);
                    *(f32x4*)(out + ooff + bj * 128) = v0; *(f32x4*)(out + ooff + bj * 128 + 4) = v1;
                    u32x4 w; w.x = cvtpk(v0[0], v0[1]); w.y = cvtpk(v0[2], v0[3]); w.z = cvtpk(v1[0], v1[1]); w.w = cvtpk(v1[2], v1[3]);
                    *(u32x4*)(hb + off + bj * 128) = w; }
                ss += __shfl_xor(ss, 16); ss += __shfl_xor(ss, 32);
                if (fq == 0) __hip_atomic_fetch_add(ssq + row0 + ai * 128 + m * 16, ss, __ATOMIC_RELAXED, __HIP_MEMORY_SCOPE_AGENT);
                asm volatile("" ::: "memory"); }
    }
};
struct EpiUp {
    static constexpr bool PERM = true, AFTER_DRAIN = false, HEADMAP = false;
    bf16_t* O; const float* rstd;
    __device__ __forceinline__ void operator()(const f32x4 (&acc)[2][2][4][2], const pg8::Unit& u, int wr, int wc, int fr, int fq) const {
        const int row0 = u.pm * 256 + wr * 64 + fr, col0 = u.pn * 256 + wc * 32 + 8 * fq;
#pragma unroll
        for (int ai = 0; ai < 2; ++ai)
#pragma unroll
            for (int m = 0; m < 4; ++m) { const int row = row0 + ai * 128 + m * 16; const float rs = rsqf_(rstd[row] * (1.f / DM_) + EPS_); bf16_t* rowp = O + (size_t)row * FF_ + col0;
#pragma unroll
                for (int bj = 0; bj < 2; ++bj) { f32x4 v0 = acc[ai][bj][m][0] * rs, v1 = acc[ai][bj][m][1] * rs;
#pragma unroll
                    for (int e = 0; e < 4; ++e) { const float a = fmaxf(v0[e], 0.f), b = fmaxf(v1[e], 0.f); v0[e] = a * a; v1[e] = b * b; }
                    u32x4 w; w.x = cvtpk(v0[0], v0[1]); w.y = cvtpk(v0[2], v0[3]); w.z = cvtpk(v1[0], v1[1]); w.w = cvtpk(v1[2], v1[3]);
                    *(u32x4*)(rowp + bj * 128) = w; } }
    }
};
struct EpiFinal {
    static constexpr bool PERM = true, AFTER_DRAIN = false, HEADMAP = false;
    const float* hin; float* out; const bf16_t* pp; const float* rstd;
    __device__ __forceinline__ void operator()(const f32x4 (&acc)[2][2][4][2], const pg8::Unit& u, int wr, int wc, int fr, int fq) const {
        const int row0 = u.pm * 256 + wr * 64 + fr, col0 = u.pn * 256 + wc * 32 + 8 * fq;
#pragma unroll
        for (int ai = 0; ai < 2; ++ai)
#pragma unroll
            for (int m = 0; m < 4; ++m) { const int row = row0 + ai * 128 + m * 16; const float rs = rsqf_(rstd[row] * (1.f / DM_) + EPS_); const size_t off = (size_t)row * DM_ + col0;
#pragma unroll
                for (int bj = 0; bj < 2; ++bj) {
                    const f32x4 h0 = *(const f32x4*)(hin + off + bj * 128), h1 = *(const f32x4*)(hin + off + bj * 128 + 4);
                    const u32x4 pw = *(const u32x4*)(pp + off + bj * 128);
                    const f32x4 a0 = acc[ai][bj][m][0] * rs, a1 = acc[ai][bj][m][1] * rs;
                    f32x4 o0, o1;
                    o0[0] = h0[0] + sigm(a0[0]) * bflo(pw.x); o0[1] = h0[1] + sigm(a0[1]) * bfhi(pw.x); o0[2] = h0[2] + sigm(a0[2]) * bflo(pw.y); o0[3] = h0[3] + sigm(a0[3]) * bfhi(pw.y);
                    o1[0] = h1[0] + sigm(a1[0]) * bflo(pw.z); o1[1] = h1[1] + sigm(a1[1]) * bfhi(pw.z); o1[2] = h1[2] + sigm(a1[2]) * bflo(pw.w); o1[3] = h1[3] + sigm(a1[3]) * bfhi(pw.w);
                    *(f32x4*)(out + off + bj * 128) = o0; *(f32x4*)(out + off + bj * 128 + 4) = o1; }
                asm volatile("" ::: "memory"); }
    }
};


struct EpiRes4 {
    static constexpr bool PERM = true, AFTER_DRAIN = false, HEADMAP = false;
    const float* base; bf16_t* hb; float* ssq;
    __device__ __forceinline__ void operator()(const f32x4 (&acc)[2][2][4][2], const pg8::Unit& u, int wr, int wc, int fr, int fq) const {
        const int row0 = u.pm * 256 + wr * 64 + fr, col0 = u.pn * 256 + wc * 32 + 8 * fq;
        f32x4 X[8][2][2];
#define E4_LD(g) do { const size_t off_ = (size_t)(row0 + ((g) >> 2) * 128 + ((g) & 3) * 16) * DM_ + col0; \
        _Pragma("unroll") for (int bj = 0; bj < 2; ++bj) { X[g][bj][0] = *(const f32x4*)(base + off_ + bj * 128); X[g][bj][1] = *(const f32x4*)(base + off_ + bj * 128 + 4); } } while (0)
        E4_LD(0); E4_LD(1); E4_LD(2); E4_LD(3);
        asm volatile("" ::: "memory");
#pragma unroll
        for (int g = 0; g < 8; ++g) { const int ai = g >> 2, m = g & 3; const size_t off = (size_t)(row0 + ai * 128 + m * 16) * DM_ + col0; float ss = 0.f;
#pragma unroll
            for (int bj = 0; bj < 2; ++bj) {
                const f32x4 v0 = X[g][bj][0] + acc[ai][bj][m][0], v1 = X[g][bj][1] + acc[ai][bj][m][1];
                ss += (v0[0] * v0[0] + v0[1] * v0[1]) + (v0[2] * v0[2] + v0[3] * v0[3]) + (v1[0] * v1[0] + v1[1] * v1[1]) + (v1[2] * v1[2] + v1[3] * v1[3]);
                u32x4 w; w.x = cvtpk(v0[0], v0[1]); w.y = cvtpk(v0[2], v0[3]); w.z = cvtpk(v1[0], v1[1]); w.w = cvtpk(v1[2], v1[3]);
                *(u32x4*)(hb + off + bj * 128) = w; }
            ss += __shfl_xor(ss, 16); ss += __shfl_xor(ss, 32);
            if (fq == 0) __hip_atomic_fetch_add(ssq + row0 + ai * 128 + m * 16, ss, __ATOMIC_RELAXED, __HIP_MEMORY_SCOPE_AGENT);
            if (g + 4 < 8) { E4_LD(g + 4); }
            asm volatile("" ::: "memory"); }
#undef E4_LD
    }
};
struct EpiRes4b {
    static constexpr bool PERM = true, AFTER_DRAIN = false, HEADMAP = false;
    bf16_t* hb; const float* rinv0; const float* g1; float* ssq;
    __device__ __forceinline__ void operator()(const f32x4 (&acc)[2][2][4][2], const pg8::Unit& u, int wr, int wc, int fr, int fq) const {
        const int row0 = u.pm * 256 + wr * 64 + fr, col0 = u.pn * 256 + wc * 32 + 8 * fq;
        f32x4 gi[2][2];
#pragma unroll
        for (int bj = 0; bj < 2; ++bj)
#pragma unroll
            for (int n = 0; n < 2; ++n) { const f32x4 gv = *(const f32x4*)(g1 + col0 + bj * 128 + 4 * n); gi[bj][n] = (f32x4){rcpf_(gv[0]), rcpf_(gv[1]), rcpf_(gv[2]), rcpf_(gv[3])}; }
        u32x4 H[8][2]; float RI[8];
#define E4_LD(g) do { const int row_ = row0 + ((g) >> 2) * 128 + ((g) & 3) * 16; const size_t off_ = (size_t)row_ * DM_ + col0; RI[g] = rinv0[row_]; \
        _Pragma("unroll") for (int bj = 0; bj < 2; ++bj) H[g][bj] = *(const u32x4*)(hb + off_ + bj * 128); } while (0)
        E4_LD(0); E4_LD(1); E4_LD(2); E4_LD(3);
        asm volatile("" ::: "memory");
#pragma unroll
        for (int g = 0; g < 8; ++g) { const int ai = g >> 2, m = g & 3; const size_t off = (size_t)(row0 + ai * 128 + m * 16) * DM_ + col0; float ss = 0.f; const float ri = RI[g];
#pragma unroll
            for (int bj = 0; bj < 2; ++bj) { const u32x4 hw = H[g][bj];
                const f32x4 x0 = (f32x4){bflo(hw.x), bfhi(hw.x), bflo(hw.y), bfhi(hw.y)} * gi[bj][0] * ri, x1 = (f32x4){bflo(hw.z), bfhi(hw.z), bflo(hw.w), bfhi(hw.w)} * gi[bj][1] * ri;
                const f32x4 v0 = x0 + acc[ai][bj][m][0], v1 = x1 + acc[ai][bj][m][1];
                ss += (v0[0] * v0[0] + v0[1] * v0[1]) + (v0[2] * v0[2] + v0[3] * v0[3]) + (v1[0] * v1[0] + v1[1] * v1[1]) + (v1[2] * v1[2] + v1[3] * v1[3]);
                u32x4 w; w.x = cvtpk(v0[0], v0[1]); w.y = cvtpk(v0[2], v0[3]); w.z = cvtpk(v1[0], v1[1]); w.w = cvtpk(v1[2], v1[3]);
                *(u32x4*)(hb + off + bj * 128) = w; }
            ss += __shfl_xor(ss, 16); ss += __shfl_xor(ss, 32);
            if (fq == 0) __hip_atomic_fetch_add(ssq + row0 + ai * 128 + m * 16, ss, __ATOMIC_RELAXED, __HIP_MEMORY_SCOPE_AGENT);
            if (g + 4 < 8) { E4_LD(g + 4); }
            asm volatile("" ::: "memory"); }
#undef E4_LD
    }
};
struct EpiRes6 {
    static constexpr bool PERM = true, AFTER_DRAIN = false, HEADMAP = false;
    bf16_t* hb; float* ssq;
    __device__ __forceinline__ void operator()(const f32x4 (&acc)[2][2][4][2], const pg8::Unit& u, int wr, int wc, int fr, int fq) const {
        const int row0 = u.pm * 256 + wr * 64 + fr, col0 = u.pn * 256 + wc * 32 + 8 * fq;
        u32x4 H[8][2];
#define E6_LD(g) do { const size_t off_ = (size_t)(row0 + ((g) >> 2) * 128 + ((g) & 3) * 16) * DM_ + col0; \
        _Pragma("unroll") for (int bj = 0; bj < 2; ++bj) H[g][bj] = *(const u32x4*)(hb + off_ + bj * 128); } while (0)
        E6_LD(0); E6_LD(1); E6_LD(2); E6_LD(3);
        asm volatile("" ::: "memory");
#pragma unroll
        for (int g = 0; g < 8; ++g) { const int ai = g >> 2, m = g & 3; const size_t off = (size_t)(row0 + ai * 128 + m * 16) * DM_ + col0; float ss = 0.f;
#pragma unroll
            for (int bj = 0; bj < 2; ++bj) { const u32x4 hw = H[g][bj];
                const f32x4 b0 = {bflo(hw.x), bfhi(hw.x), bflo(hw.y), bfhi(hw.y)}, b1 = {bflo(hw.z), bfhi(hw.z), bflo(hw.w), bfhi(hw.w)};
                const f32x4 v0 = b0 + acc[ai][bj][m][0], v1 = b1 + acc[ai][bj][m][1];
                ss += (v0[0] * v0[0] + v0[1] * v0[1]) + (v0[2] * v0[2] + v0[3] * v0[3]) + (v1[0] * v1[0] + v1[1] * v1[1]) + (v1[2] * v1[2] + v1[3] * v1[3]);
                u32x4 w; w.x = cvtpk(v0[0], v0[1]); w.y = cvtpk(v0[2], v0[3]); w.z = cvtpk(v1[0], v1[1]); w.w = cvtpk(v1[2], v1[3]);
                *(u32x4*)(hb + off + bj * 128) = w; }
            ss += __shfl_xor(ss, 16); ss += __shfl_xor(ss, 32);
            if (fq == 0) __hip_atomic_fetch_add(ssq + row0 + ai * 128 + m * 16, ss, __ATOMIC_RELAXED, __HIP_MEMORY_SCOPE_AGENT);
            if (g + 4 < 8) { E6_LD(g + 4); }
            asm volatile("" ::: "memory"); }
#undef E6_LD
    }
};
struct EpiFinalB {
    static constexpr bool PERM = true, AFTER_DRAIN = false, HEADMAP = false;
    const bf16_t* hb; float* out; const bf16_t* pp; const float* rstd;
    __device__ __forceinline__ void operator()(const f32x4 (&acc)[2][2][4][2], const pg8::Unit& u, int wr, int wc, int fr, int fq) const {
        const int row0 = u.pm * 256 + wr * 64 + fr, col0 = u.pn * 256 + wc * 32 + 8 * fq;
        u32x4 H[8][2], P[8][2]; float RS[8];
#define EF_LD(g) do { const int row_ = row0 + ((g) >> 2) * 128 + ((g) & 3) * 16; const size_t off_ = (size_t)row_ * DM_ + col0; RS[g] = rstd[row_]; \
        _Pragma("unroll") for (int bj = 0; bj < 2; ++bj) { H[g][bj] = *(const u32x4*)(hb + off_ + bj * 128); P[g][bj] = *(const u32x4*)(pp + off_ + bj * 128); } } while (0)
        EF_LD(0); EF_LD(1); EF_LD(2); EF_LD(3);
        asm volatile("" ::: "memory");
#pragma unroll
        for (int g = 0; g < 8; ++g) { const int ai = g >> 2, m = g & 3; const size_t off = (size_t)(row0 + ai * 128 + m * 16) * DM_ + col0; const float rs = rsqf_(RS[g] * (1.f / DM_) + EPS_);
#pragma unroll
            for (int bj = 0; bj < 2; ++bj) { const u32x4 hw = H[g][bj], pw = P[g][bj];
                const f32x4 a0 = acc[ai][bj][m][0] * rs, a1 = acc[ai][bj][m][1] * rs;
                f32x4 o0, o1;
                o0[0] = bflo(hw.x) + sigm(a0[0]) * bflo(pw.x); o0[1] = bfhi(hw.x) + sigm(a0[1]) * bfhi(pw.x); o0[2] = bflo(hw.y) + sigm(a0[2]) * bflo(pw.y); o0[3] = bfhi(hw.y) + sigm(a0[3]) * bfhi(pw.y);
                o1[0] = bflo(hw.z) + sigm(a1[0]) * bflo(pw.z); o1[1] = bfhi(hw.z) + sigm(a1[1]) * bfhi(pw.z); o1[2] = bflo(hw.w) + sigm(a1[2]) * bflo(pw.w); o1[3] = bfhi(hw.w) + sigm(a1[3]) * bfhi(pw.w);
                *(f32x4*)(out + off + bj * 128) = o0; *(f32x4*)(out + off + bj * 128 + 4) = o1; }
            if (g + 4 < 8) { EF_LD(g + 4); }
            asm volatile("" ::: "memory"); }
#undef EF_LD
    }
};

struct EpiMidPP {
    u32x4* park;
    __device__ __forceinline__ void operator()(const f32x4 (&acc)[2][2][4][2], const pg8::Unit& u, int wr, int wc, int fr, int fq) const {
        asm volatile("" : "+v"(fr), "+v"(fq));
        const unsigned pko_ = (unsigned)((wr * 4 + wc) * 64 + fq * 16 + fr);
#pragma unroll
        for (int ai = 0; ai < 2; ++ai)
#pragma unroll
            for (int m = 0; m < 4; ++m)
#pragma unroll
                for (int bj = 0; bj < 2; ++bj) { const f32x4 v0 = acc[ai][bj][m][0], v1 = acc[ai][bj][m][1];
                    u32x4 w; w.x = cvtpk(v0[0], v0[1]); w.y = cvtpk(v0[2], v0[3]); w.z = cvtpk(v1[0], v1[1]); w.w = cvtpk(v1[2], v1[3]);
                    park[pko_ + (unsigned)((((ai * 4 + m) * 2 + bj) * 8) * 64)] = w; }
    }
};
struct EpiFinalC {
    const bf16_t* hb; float* out; const float* rstd; const u32x4* park;
    __device__ __forceinline__ void operator()(const f32x4 (&acc)[2][2][4][2], const pg8::Unit& u, int wr, int wc, int fr, int fq) const {
        asm volatile("" : "+v"(fr), "+v"(fq));
        const int row0 = u.pm * 256 + wr * 64 + fr, col0 = u.pn * 256 + wc * 32 + 8 * fq;
        const unsigned pko_ = (unsigned)((wr * 4 + wc) * 64 + fq * 16 + fr);
        u32x4 H[8][2], P[8][2]; float RS[8];
#define EF_LD(g) do { const int row_ = row0 + ((g) >> 2) * 128 + ((g) & 3) * 16; const size_t off_ = (size_t)row_ * DM_ + col0; RS[g] = rstd[row_]; \
        _Pragma("unroll") for (int bj = 0; bj < 2; ++bj) { H[g][bj] = *(const u32x4*)(hb + off_ + bj * 128); P[g][bj] = park[pko_ + (unsigned)((((g) * 2 + bj) * 8) * 64)]; } } while (0)
        EF_LD(0); EF_LD(1); EF_LD(2); EF_LD(3);
        asm volatile("" ::: "memory");
#pragma unroll
        for (int g = 0; g < 8; ++g) { const int ai = g >> 2, m = g & 3; const size_t off = (size_t)(row0 + ai * 128 + m * 16) * DM_ + col0; const float rs = rsqf_(RS[g] * (1.f / DM_) + EPS_);
#pragma unroll
            for (int bj = 0; bj < 2; ++bj) { const u32x4 hw = H[g][bj], pw = P[g][bj];
                const f32x4 a0 = acc[ai][bj][m][0] * rs, a1 = acc[ai][bj][m][1] * rs;
                f32x4 o0, o1;
                o0[0] = bflo(hw.x) + sigm(a0[0]) * bflo(pw.x); o0[1] = bfhi(hw.x) + sigm(a0[1]) * bfhi(pw.x); o0[2] = bflo(hw.y) + sigm(a0[2]) * bflo(pw.y); o0[3] = bfhi(hw.y) + sigm(a0[3]) * bfhi(pw.y);
                o1[0] = bflo(hw.z) + sigm(a1[0]) * bflo(pw.z); o1[1] = bfhi(hw.z) + sigm(a1[1]) * bfhi(pw.z); o1[2] = bflo(hw.w) + sigm(a1[2]) * bflo(pw.w); o1[3] = bfhi(hw.w) + sigm(a1[3]) * bfhi(pw.w);
                *(f32x4*)(out + off + bj * 128) = o0; *(f32x4*)(out + off + bj * 128 + 4) = o1; }
            if (g + 4 < 8) { EF_LD(g + 4); }
            asm volatile("" ::: "memory"); }
#undef EF_LD
    }
};

__device__ __forceinline__ void p0_transpose_item(const float* W, int K, int N, bf16_t* WT, const float* ks0, const float* ks1, int ksplit, LAS float* scr, int item, int lane) {
    const int nblk = N / 32, kb = item / nblk, nb = item % nblk, k0 = 64 * kb, n0 = 32 * nb;
    float wv_[32];
#pragma unroll
    for (int i = 0; i < 32; ++i) { const int k = k0 + 2 * i + (lane >> 5); wv_[i] = W[(size_t)k * N + n0 + (lane & 31)]; }
#pragma unroll
    for (int i = 0; i < 32; ++i) { const int kk = 2 * i + (lane >> 5), k = k0 + kk; float s = 1.f; if (ks0) s = (k < ksplit) ? ks0[k] : ks1[k - ksplit];
        scr[kk * 33 + (lane & 31)] = wv_[i] * s; }
    asm volatile("s_waitcnt lgkmcnt(0)" ::: "memory");
    const int c = lane & 7;
#pragma unroll
    for (int j = 0; j < 4; ++j) { const int n = (lane >> 3) + 8 * j; const LAS float* s = scr + (8 * c) * 33 + n;
        u32x4 o; o.x = cvtpk(s[0 * 33], s[1 * 33]); o.y = cvtpk(s[2 * 33], s[3 * 33]); o.z = cvtpk(s[4 * 33], s[5 * 33]); o.w = cvtpk(s[6 * 33], s[7 * 33]);
        *(u32x4*)(WT + (size_t)(n0 + n) * K + k0 + 8 * c) = o; }
    asm volatile("s_waitcnt lgkmcnt(0)" ::: "memory");
}
__device__ __forceinline__ void attn_phase(LAS unsigned char* lds, const bf16_t* PROJ, const bf16_t* VT, const float* gq, const float* gk, const float* rb, bf16_t* MERGED, int vcu, int G, const int wave_u) {
    int tid_ = wave_u * 64 + lane_id_v(); asm volatile("" : "+v"(tid_));
    const int tid = tid_, lane = tid & 63, h = __builtin_amdgcn_readfirstlane(tid >> 6), ql = lane & 31, hi = lane >> 5;
    LAS float* SQ = (LAS float*)lds;
    LAS float* EXT = (LAS float*)(lds + 2048) + h * 640;
    float mq = wave_max(fabsf(gq[lane])), mk = wave_max(fabsf(gk[lane])); float mb = -1e30f;
    for (int i = lane; i < 513; i += 64) mb = fmaxf(mb, rb[h * 513 + i]);
    mb = wave_max(mb);
    const float c512 = rb[h * 513 + 512]; (void)mq; (void)mk; (void)mb;
    for (int i = lane; i < 640; i += 64) { int rel = i - 64; rel = rel > 256 ? 256 : (rel < -256 ? -256 : rel); EXT[639 - i] = (rb[h * 513 + rel + 256] - c512) * LOG2E; }
    asm volatile("s_waitcnt lgkmcnt(0)" ::: "memory");
    __syncthreads();
    bf16x8 qf[2][4], kn[4], vn[4];
    const unsigned kgo = (unsigned)((lane >> 3) * PJW + (lane & 7) * 8), vgo = (unsigned)((lane >> 2) * T_ + (lane & 3) * 8);
#define LOADKV2(KB, VB, IT) do { const bf16_t* kp_ = (KB) + (long)(IT) * 32 * PJW; const bf16_t* vp_ = (VB) + (IT) * 32; \
        _Pragma("unroll") for (int i = 0; i < 4; ++i) { kn[i] = *(const bf16x8*)(kp_ + (kgo + (unsigned)(i * 8 * PJW))); vn[i] = *(const bf16x8*)(vp_ + (vgo + (unsigned)(i * 16 * T_))); } } while (0)
#define UNIT_PREFETCH(U) do { const int b_ = (U) >> 7, n_ = (U) & 127; const long tk_ = (long)b_ * SEQ_ + n_ * 64; const int i0_ = (n_ < 8) ? 2 * (8 - n_) : 0; \
        const bf16_t* qp_ = PROJ + (tk_ + ql) * PJW + 1024 + h * 64 + hi * 8; \
        _Pragma("unroll") for (int qb = 0; qb < 2; ++qb) _Pragma("unroll") for (int d0 = 0; d0 < 4; ++d0) qf[qb][d0] = *(const bf16x8*)(qp_ + (long)qb * 32 * PJW + d0 * 16); \
        LOADKV2(PROJ + (tk_ - 512) * PJW + 1536 + h * 64, VT + (long)(h * 64) * T_ + (tk_ - 512), i0_); } while (0)
    if (vcu < NUNIT_ATT) UNIT_PREFETCH(vcu);
    for (int unit = vcu; unit < NUNIT_ATT; unit += G) {
        const int b = unit >> 7, n = unit & 127; const long tok0 = (long)b * SEQ_ + n * 64;
        f32x16 o[2][2];
#pragma unroll
        for (int a = 0; a < 2; ++a)
#pragma unroll
            for (int c = 0; c < 2; ++c)
#pragma unroll
                for (int r = 0; r < 16; ++r) o[a][c][r] = 0.f;
        float lsum[2] = {0.f, 0.f};
        const int it0 = (n < 8) ? 2 * (8 - n) : 0;
        const bf16_t* kbase = PROJ + (tok0 - 512) * PJW + 1536 + h * 64;
        const bf16_t* vbase = VT + (long)(h * 64) * T_ + (tok0 - 512);
        LAS unsigned char* kv = lds + 24576 + h * 8192;
        const unsigned wk = (unsigned)((lane >> 3) * 128 + (((lane & 7) ^ (lane >> 3)) * 16));
        const unsigned wvl = (unsigned)(4096 + (lane >> 2) * 64 + ((((unsigned)((lane & 3) >> 1) * 2u + 0u) ^ (unsigned)((lane >> 3) & 3)) * 16) + (lane & 1) * 8);
        const unsigned wvh = (unsigned)(4096 + (lane >> 2) * 64 + ((((unsigned)((lane & 3) >> 1) * 2u + 1u) ^ (unsigned)((lane >> 3) & 3)) * 16) + (lane & 1) * 8);
        const unsigned rkb = (unsigned)(ql * 128), rks = (unsigned)(ql & 7), rvb = (unsigned)(4096 + ql * 64), rvs = (unsigned)((ql >> 1) & 3);
#define LOADKV(IT) LOADKV2(kbase, vbase, IT)
        for (int it = it0; it < 18; ++it) {
#pragma unroll
            for (int i = 0; i < 4; ++i) { *(LAS bf16x8*)(kv + wk + i * 1024) = kn[i]; const u32x4 vv = __builtin_bit_cast(u32x4, vn[i]);
                *(LAS u32x2*)(kv + wvl + i * 1024) = (u32x2){vv.x, vv.y}; *(LAS u32x2*)(kv + wvh + i * 1024) = (u32x2){vv.z, vv.w}; }
            { const int itn = (it + 1 < 18) ? it + 1 : it; LOADKV(itn); }
            bf16x8 kf[4], vf[2][2];
#pragma unroll
            for (int d0 = 0; d0 < 4; ++d0) kf[d0] = *(const LAS bf16x8*)(kv + rkb + (((unsigned)(2 * d0 + hi) ^ rks) * 16));
#pragma unroll
            for (int db = 0; db < 2; ++db)
#pragma unroll
                for (int ks = 0; ks < 2; ++ks) vf[db][ks] = *(const LAS bf16x8*)(kv + rvb + db * 2048 + (((unsigned)(2 * ks + hi) ^ rvs) * 16));
            const bool tab = (it >= 8);
#pragma unroll
            for (int qb = 0; qb < 2; ++qb) {
                f32x16 s;
                if (tab) { const LAS float* e = EXT + (63 - 32 * qb - ql + 32 * it + 4 * hi); f32x16 cin;
#pragma unroll
                    for (int r = 0; r < 16; ++r) cin[r] = e[(r & 3) + 8 * (r >> 2)];
                    s = MFMA32(kf[0], qf[qb][0], cin); }
                else { f32x16 z_;
#pragma unroll
                    for (int r = 0; r < 16; ++r) z_[r] = 0.f;
                    s = MFMA32(kf[0], qf[qb][0], z_); }
#pragma unroll
                for (int d0 = 1; d0 < 4; ++d0) s = MFMA32(kf[d0], qf[qb][d0], s);
                float ps = 0.f;
#pragma unroll
                for (int r = 0; r < 16; ++r) { s[r] = ex2(s[r]); ps += s[r]; }
                lsum[qb] += ps;
                bf16x8 pk[2];
#pragma unroll
                for (int ks = 0; ks < 2; ++ks) { u32x4 w; w.x = cvtpk(s[8 * ks], s[8 * ks + 1]); w.y = cvtpk(s[8 * ks + 2], s[8 * ks + 3]); w.z = cvtpk(s[8 * ks + 4], s[8 * ks + 5]); w.w = cvtpk(s[8 * ks + 6], s[8 * ks + 7]);
                    pk[ks] = __builtin_bit_cast(bf16x8, w); }
#pragma unroll
                for (int db = 0; db < 2; ++db)
#pragma unroll
                    for (int ks = 0; ks < 2; ++ks) o[db][qb] = MFMA32(vf[db][ks], pk[ks], o[db][qb]);
            }
        }
#undef LOADKV
        if (unit + G < NUNIT_ATT) UNIT_PREFETCH(unit + G);
        float inv[2], sq[2];
#pragma unroll
        for (int qb = 0; qb < 2; ++qb) { float l = lsum[qb]; l += __shfl_xor(l, 32); inv[qb] = 1.f / l; float q2 = 0.f;
#pragma unroll
            for (int db = 0; db < 2; ++db)
#pragma unroll
                for (int r = 0; r < 16; ++r) { const float v = o[db][qb][r] * inv[qb]; o[db][qb][r] = v; q2 += v * v; }
            q2 += __shfl_xor(q2, 32); sq[qb] = q2;
            if (hi == 0) SQ[h * 64 + 32 * qb + ql] = q2; }
        asm volatile("s_waitcnt lgkmcnt(0)" ::: "memory");
        __syncthreads();
#pragma unroll
        for (int qb = 0; qb < 2; ++qb) { float tot = 0.f;
#pragma unroll
            for (int hh = 0; hh < 8; ++hh) tot += SQ[hh * 64 + 32 * qb + ql];
            const float rstd = rsqf_(tot * (1.f / 512.f) + EPS_);
            bf16_t* op = MERGED + (tok0 + 32 * qb + ql) * DM_ + 512 + h * 64 + 4 * hi;
#pragma unroll
            for (int db = 0; db < 2; ++db)
#pragma unroll
                for (int r4 = 0; r4 < 4; ++r4) { u32x2 w; w.x = cvtpk(o[db][qb][4 * r4] * rstd, o[db][qb][4 * r4 + 1] * rstd); w.y = cvtpk(o[db][qb][4 * r4 + 2] * rstd, o[db][qb][4 * r4 + 3] * rstd);
                    *(u32x2*)(op + 32 * db + 8 * r4) = w; } }
        __syncthreads();
    }
}

template <bool PASS2>
__device__ __forceinline__ void lru_unit(LAS unsigned char* lds, int unit, const bf16_t* PROJ, const bf16_t* WGT, const float* conv_w, const float* conv_b, const float* b_rg, const float* b_ig,
                                         const float* lam, f32x2* SUMM, bf16_t* MERGED, const int wave_u) {
    int tid_ = wave_u * 64 + lane_id_v(); asm volatile("" : "+v"(tid_));
    const int tid = tid_, lane = tid & 63, w = __builtin_amdgcn_readfirstlane(tid >> 6), ql = lane & 31, hi = lane >> 5;
    const int b = unit >> 5, seg = unit & 31; const long tok0 = (long)b * SEQ_ + seg * 256;
    LAS bf16_t* XC = (LAS bf16_t*)lds + w * (64 * 72);
    LAS bf16_t* YT = (LAS bf16_t*)(lds + 73728);
    const int chc = 64 * w + lane;
    const float cw0 = conv_w[chc], cw1 = conv_w[512 + chc], cw2 = conv_w[1024 + chc], cw3 = conv_w[1536 + chc], cbv = conv_b[chc];
    float brg[2], big[2], sp[2];
#pragma unroll
    for (int nb = 0; nb < 2; ++nb) { const int ch = 64 * w + 32 * nb + ql; brg[nb] = b_rg[ch]; big[nb] = b_ig[ch];
        sp[nb] = -8.f * LOG2E * log1pf(expf(-lam[ch])); }
    float carry[2] = {0.f, 0.f}, ptot[2] = {1.f, 1.f};
    if (PASS2) {
#pragma unroll
        for (int nb = 0; nb < 2; ++nb) { float c = 0.f; const f32x2* sp_ = SUMM + (size_t)(b * 32) * 512 + 64 * w + 32 * nb + ql;
            for (int s0 = 0; s0 < seg; s0 += 16) { f32x2 v[16];
#pragma unroll
                for (int j = 0; j < 16; ++j) v[j] = (s0 + j < seg) ? sp_[(size_t)(s0 + j) * 512] : (f32x2){1.f, 0.f};
#pragma unroll
                for (int j = 0; j < 16; ++j) c = v[j].x * c + v[j].y; }
            carry[nb] = c; }
    }
    float x1 = 0.f, x2 = 0.f, x3 = 0.f;
#pragma nounroll
    for (int st = 0; st < 4; ++st) {
        const long t0 = tok0 + 64 * st;
        {
            const bf16_t* xt = PROJ + t0 * PJW + 64 * w;
            const unsigned go = (unsigned)((lane >> 3) * PJW + (lane & 7) * 8);
            bf16x8 raw[8];
#pragma unroll
            for (int i = 0; i < 8; ++i) raw[i] = *(const bf16x8*)(xt + (go + (unsigned)(i * 8 * PJW)));
            if (st == 0) { x1 = 0.f; x2 = 0.f; x3 = 0.f;
                if (seg != 0) { const bf16_t* xp = PROJ + t0 * PJW + chc; x1 = bf2f(xp[-1 * PJW]); x2 = bf2f(xp[-2 * PJW]); x3 = bf2f(xp[-3 * PJW]); } }
#pragma unroll
            for (int i = 0; i < 8; ++i) *(LAS bf16x8*)(XC + (8 * i + (lane >> 3)) * 72 + (lane & 7) * 8) = raw[i];
#pragma unroll 16
            for (int t = 0; t < 64; ++t) { const float xv = bf2f(XC[t * 72 + lane]); const float xc = cbv + cw0 * x3 + cw1 * x2 + cw2 * x1 + cw3 * xv;
                XC[t * 72 + lane] = (bf16_t)(cvtpk(xc, 0.f) & 0xffffu); x3 = x2; x2 = x1; x1 = xv; }
        }
        asm volatile("s_waitcnt lgkmcnt(0)" ::: "memory");
#pragma unroll
        for (int nb = 0; nb < 2; ++nb) {
            bf16x8 wrf[4], wif[4];
            { int woff = ((w * 2 + nb) * 4 * 64 + lane) * 8; asm volatile("" : "+v"(woff));
#pragma unroll
              for (int ks = 0; ks < 4; ++ks) { wrf[ks] = *(const bf16x8*)(WGT + woff + ks * 512); wif[ks] = *(const bf16x8*)(WGT + 8 * 4096 + woff + ks * 512); } }
#pragma unroll
            for (int tb = 0; tb < 2; ++tb) {
                bf16x8 af[4];
#pragma unroll
                for (int ks = 0; ks < 4; ++ks) af[ks] = *(const LAS bf16x8*)(XC + (32 * tb + ql) * 72 + 16 * ks + 8 * hi);
                f32x16 dr, di;
#pragma unroll
                for (int r = 0; r < 16; ++r) { dr[r] = 0.f; di[r] = 0.f; }
#pragma unroll
                for (int ks = 0; ks < 4; ++ks) { dr = MFMA32(af[ks], wrf[ks], dr); di = MFMA32(af[ks], wif[ks], di); }
                float A[16], U[16];
#pragma unroll
                for (int r = 0; r < 16; ++r) { const int tok = 32 * tb + crow(r, hi); const float xcv = bf2f(XC[tok * 72 + 32 * nb + ql]);
                    const float rg = sigm(dr[r] + brg[nb]), ig = sigm(di[r] + big[nb]); const float a = ex2(rg * sp[nb]);
                    const float mult = __builtin_amdgcn_sqrtf(fmaxf(1.f - a * a, 0.f)); A[r] = a; U[r] = mult * ig * xcv; }
#pragma unroll
                for (int q4 = 0; q4 < 4; ++q4)
#pragma unroll
                    for (int e = 1; e < 4; ++e) { U[4 * q4 + e] = A[4 * q4 + e] * U[4 * q4 + e - 1] + U[4 * q4 + e]; A[4 * q4 + e] = A[4 * q4 + e - 1] * A[4 * q4 + e]; }
                float c = carry[nb], HIN[4];
#pragma unroll
                for (int q4 = 0; q4 < 4; ++q4) { const float e0 = A[4 * q4 + 3] * c + U[4 * q4 + 3]; const float p = __shfl_xor(e0, 32); const float hin = hi ? p : c; HIN[q4] = hin;
                    const float e1 = A[4 * q4 + 3] * hin + U[4 * q4 + 3]; const float q = __shfl_xor(e1, 32); c = hi ? e1 : q; }
                carry[nb] = c;
                if (!PASS2) { const float po = (A[3] * A[7]) * (A[11] * A[15]); ptot[nb] *= po * __shfl_xor(po, 32); }
                else {
                    const bf16_t* gb = PROJ + t0 * PJW + 512 + 64 * w + 32 * nb + (32 * tb) * PJW;
                    const unsigned goff = (unsigned)(4 * hi) * PJW + ql;
#pragma unroll
                    for (int r = 0; r < 16; ++r) { const int tok = 32 * tb + crow(r, hi); const float hval = U[r] + A[r] * HIN[r >> 2]; const float gl = bf2f(gb[goff + (unsigned)((r & 3) + 8 * (r >> 2)) * PJW]);
                        YT[tok * 520 + 64 * w + 32 * nb + ql] = (bf16_t)(cvtpk(hval * gl, 0.f) & 0xffffu); }
                }
            }
        }
        if (PASS2) {
            asm volatile("s_waitcnt lgkmcnt(0)" ::: "memory");
            __syncthreads();
#pragma unroll
            for (int i = 0; i < 8; ++i) { const int tok = 8 * w + i; const u32x4 v = *(const LAS u32x4*)(YT + tok * 520 + 8 * lane);
                const float f0 = bflo(v.x), f1 = bfhi(v.x), f2 = bflo(v.y), f3 = bfhi(v.y), f4 = bflo(v.z), f5 = bfhi(v.z), f6 = bflo(v.w), f7 = bfhi(v.w);
                float ss = (f0 * f0 + f1 * f1) + (f2 * f2 + f3 * f3) + (f4 * f4 + f5 * f5) + (f6 * f6 + f7 * f7); ss = wave_sum(ss);
                const float rs = rsqf_(ss * (1.f / 512.f) + EPS_);
                u32x4 o; o.x = cvtpk(f0 * rs, f1 * rs); o.y = cvtpk(f2 * rs, f3 * rs); o.z = cvtpk(f4 * rs, f5 * rs); o.w = cvtpk(f6 * rs, f7 * rs);
                *(u32x4*)(MERGED + (t0 + tok) * DM_ + 8 * lane) = o; }
            __syncthreads();
        }
        asm volatile("" ::: "memory");
    }
    if (!PASS2) { if (hi == 0) {
#pragma unroll
        for (int nb = 0; nb < 2; ++nb) SUMM[(size_t)unit * 512 + 64 * w + 32 * nb + ql] = (f32x2){ptot[nb], carry[nb]}; } }
}

#ifndef PROBE_MASK
#define PROBE_MASK 0
#endif
#ifndef RES_BF16
#define RES_BF16 1
#endif
struct Args { const float* in[23]; float* out; unsigned char* ws; };
__global__ void __launch_bounds__(NTHR, 2) fwd_megakernel(Args args) {
    extern __shared__ __attribute__((aligned(16))) unsigned char lds_raw[];
    cg::grid_group grid = cg::this_grid();
    LAS unsigned char* lds = (LAS unsigned char*)lds_raw;
    const int wave = __builtin_amdgcn_readfirstlane(threadIdx.x >> 6);
#define tid (wave * 64 + lane_id_v())
#define lane (lane_id_v())
    const int G = gridDim.x, bx = blockIdx.x, vcu = (G % 8 == 0) ? (bx % 8) * (G / 8) + bx / 8 : bx;
    unsigned char* ws = args.ws;
    volatile LAS unsigned* MISC = (volatile LAS unsigned*)(lds + MISC_OFF);
    if (threadIdx.x < 16) MISC[threadIdx.x] = 0u;
    __syncthreads();
    XcdBarrier bar; bar.bar = (unsigned*)(ws + WS_CTL); bar.x = xb_xcc_id(); bar.st = MISC;
    if (blockIdx.x == 0) for (int i = threadIdx.x; i < (int)(CTL_BYTES / 4); i += NTHR) bar.bar[i] = 0u;
    const float* x = args.in[0]; const float* p = args.in[1]; float* out = args.out;
    bf16_t* WT_IN = (bf16_t*)(ws + WS_WIN); bf16_t* WT_OUT = (bf16_t*)(ws + WS_WOUT); bf16_t* WT_UP = (bf16_t*)(ws + WS_WUP); bf16_t* WT_DN = (bf16_t*)(ws + WS_WDN);
    bf16_t* WT_PG = (bf16_t*)(ws + WS_WPG); bf16_t* WT_PP = (bf16_t*)(ws + WS_WPP); bf16_t* WGT = (bf16_t*)(ws + WS_WG);
    float* RINV0 = (float*)(ws + WS_RINV0);
    float* RSTD1 = (float*)(ws + WS_RSTD1); float* RSTD2 = (float*)(ws + WS_RSTD2); f32x2* SUMM = (f32x2*)(ws + WS_SUMM);
    bf16_t* XN = (bf16_t*)(ws + WS_XN); bf16_t* PP = (bf16_t*)(ws + WS_PP); bf16_t* PB = (bf16_t*)(ws + WS_PB);
    bf16_t* PROJ = (bf16_t*)(ws + WS_PROJ); bf16_t* VT = (bf16_t*)(ws + WS_VT); bf16_t* MERGED = (bf16_t*)(ws + WS_MERGED); bf16_t* ACT = (bf16_t*)(ws + WS_ACT);

    for (int rep_ = 0; rep_ < 1 + ((PROBE_MASK >> 0) & 1); ++rep_) {
        LAS float* scr = (LAS float*)(lds + wave * 16384);
        const int gw = vcu * NWAVES + wave, NGW = G * NWAVES;
        constexpr int I_IN = 16 * 80, I_OUT = 16 * 32, I_UP = 16 * 128, I_DN = 64 * 32, I_PG = 16 * 32, I_PP = 4 * 32;
        constexpr int NITEMS = I_IN + I_OUT + I_UP + I_DN + I_PG + I_PP;
        for (int it = gw; it < NITEMS; it += NGW) {
            int r = it;
            if (r < I_IN) { p0_transpose_item(args.in[3], 1024, 2560, WT_IN, nullptr, nullptr, 0, scr, r, lane); continue; } r -= I_IN;
            if (r < I_OUT) { p0_transpose_item(args.in[16], 1024, 1024, WT_OUT, args.in[14], args.in[15], 512, scr, r, lane); continue; } r -= I_OUT;
            if (r < I_UP) { p0_transpose_item(args.in[18], 1024, 4096, WT_UP, args.in[17], args.in[17], 1 << 30, scr, r, lane); continue; } r -= I_UP;
            if (r < I_DN) { p0_transpose_item(args.in[19], 4096, 1024, WT_DN, nullptr, nullptr, 0, scr, r, lane); continue; } r -= I_DN;
            if (r < I_PG) { p0_transpose_item(args.in[21], 1024, 1024, WT_PG, args.in[20], args.in[20], 1 << 30, scr, r, lane); continue; } r -= I_PG;
            p0_transpose_item(args.in[22], 256, 1024, WT_PP, nullptr, nullptr, 0, scr, r, lane);
        }
        for (int i = bx * NTHR + tid; i < T_; i += G * NTHR) { RSTD1[i] = 0.f; RSTD2[i] = 0.f; }
        for (int i = bx * NTHR + tid; i < 65536; i += G * NTHR) { const int e = i & 7, ln = (i >> 3) & 63, ks = (i >> 9) & 3, nb = (i >> 11) & 1, blk = (i >> 12) & 7, gate = i >> 15;
            const int k = 16 * ks + 8 * (ln >> 5) + e, n = 32 * nb + (ln & 31);
            const float v = (gate ? args.in[8] : args.in[6])[blk * 4096 + k * 64 + n]; WGT[i] = (bf16_t)(cvtpk(v, 0.f) & 0xffffu); }
        const float* g1 = args.in[2];
        f32x4 gv[4];
#pragma unroll
        for (int j = 0; j < 4; ++j) gv[j] = *((const f32x4*)g1 + lane + 64 * j);
        for (int m = gw; m < T_; m += NGW) {
            const f32x4* xr = (const f32x4*)(x + (size_t)m * DM_) + lane; f32x4 v[4]; float s = 0.f;
#pragma unroll
            for (int j = 0; j < 4; ++j) { v[j] = __builtin_nontemporal_load(xr + 64 * j); s += (v[j].x * v[j].x + v[j].y * v[j].y) + (v[j].z * v[j].z + v[j].w * v[j].w); }
            const float ms_ = wave_sum(s) * (1.f / DM_) + EPS_; const float rstd = rsqf_(ms_);
            if (lane == 0) RINV0[m] = ms_ * rstd;
            u32x2* o8 = (u32x2*)(XN + (size_t)m * DM_) + lane;
#pragma unroll
            for (int j = 0; j < 4; ++j) { const f32x4 y = v[j] * gv[j] * rstd; u32x2 w; w.x = cvtpk(y.x, y.y); w.y = cvtpk(y.z, y.w); o8[64 * j] = w; }
            const f32x4 pv = __builtin_nontemporal_load((const f32x4*)(p + (size_t)m * PLE_) + lane); u32x2 pw; pw.x = cvtpk(pv.x, pv.y); pw.y = cvtpk(pv.z, pv.w);
            *((u32x2*)(PB + (size_t)m * PLE_) + lane) = pw;
        }
    }
    grid.sync();
    if (threadIdx.x == 0) MISC[2] = xb_add(&bar.bar[XB_XCNT(bar.x)], 1u);
    int cid = bx, vcu2 = vcu;
#define CENSUS_IDS() do { \
    if (threadIdx.x == 0) { unsigned okc = 1u; \
        for (unsigned j = 0; j < 16; ++j) { const unsigned c_ = xb_ld(&bar.bar[XB_XCNT(j)]); okc &= (j < 8 ? (c_ == (unsigned)G / 8u) : (c_ == 0u)) ? 1u : 0u; } \
        MISC[3] = (okc && (G % 8 == 0)) ? 1u : 0u; } \
    __syncthreads(); \
    { const bool okmap = MISC[3] != 0u; \
      cid = __builtin_amdgcn_readfirstlane(okmap ? (int)(MISC[2] * 8u + bar.x) : bx); \
      vcu2 = __builtin_amdgcn_readfirstlane(okmap ? (int)(bar.x * (unsigned)(G / 8) + MISC[2]) : vcu); } } while (0)
#if 0
    if (threadIdx.x == 0) { unsigned okc = 1u;
        for (unsigned j = 0; j < 16; ++j) { const unsigned c_ = xb_ld(&bar.bar[XB_XCNT(j)]); okc &= (j < 8 ? (c_ == (unsigned)G / 8u) : (c_ == 0u)) ? 1u : 0u; }
        MISC[3] = (okc && (G % 8 == 0)) ? 1u : 0u; }
    __syncthreads();
    const bool okmap = MISC[3] != 0u;
    const int cid = __builtin_amdgcn_readfirstlane(okmap ? (int)(MISC[2] * 8u + bar.x) : bx);
    const int vcu2 = __builtin_amdgcn_readfirstlane(okmap ? (int)(bar.x * (unsigned)(G / 8) + MISC[2]) : vcu);
#endif
    for (int rep_ = 0; rep_ < 1 + ((PROBE_MASK >> 1) & 1); ++rep_) {
        { pg8::Gemm g{XN, WT_IN, T_, 2048, 1024}; pg8::StaticOrder S; S.init(T_, 2048, G, cid); EpiProj E{PROJ, args.in[11], args.in[12]};
          pg8::gemm_phase<EpiProj, pg8::StaticOrder, PG8_ALIGN, PG8_SP2>(lds, g, S, E, wave); }
        { pg8::Gemm g{WT_IN + (size_t)2048 * 1024, XN, 512, T_, 1024}; pg8::StaticOrder S; S.init(512, T_, G, cid); EpiPlain E{VT, T_};
          pg8::gemm_phase<EpiPlain, pg8::StaticOrder, PG8_ALIGN, PG8_SP2>(lds, g, S, E, wave); }
    }
    xcd_barrier(bar);
    CENSUS_IDS();
    for (int rep_ = 0; rep_ < 1 + ((PROBE_MASK >> 2) & 1); ++rep_)
    attn_phase(lds, PROJ, VT, args.in[11]  , args.in[12], args.in[13], MERGED, vcu2, G, wave);
    for (int rep_ = 0; rep_ < 1 + ((PROBE_MASK >> 3) & 1); ++rep_)
    for (int unit = vcu2; unit < NUNIT_LRU; unit += G)
        lru_unit<false>(lds, unit, PROJ, WGT, args.in[4], args.in[5], args.in[7], args.in[9], args.in[10], SUMM, MERGED, wave);
    xcd_barrier(bar);
    for (int rep_ = 0; rep_ < 1 + ((PROBE_MASK >> 4) & 1); ++rep_)
    for (int unit = vcu2; unit < NUNIT_LRU; unit += G)
        lru_unit<true>(lds, unit, PROJ, WGT, args.in[4], args.in[5], args.in[7], args.in[9], args.in[10], SUMM, MERGED, wave);
    xcd_barrier(bar);
#if RES_BF16
    { pg8::Gemm g{MERGED, WT_OUT, T_, 1024, 1024}; pg8::StaticOrder S; S.init(T_, 1024, G, cid); EpiRes4b E{XN, RINV0, args.in[2], RSTD1};
      pg8::gemm_phase<EpiRes4b, pg8::StaticOrder, PG8_ALIGN, PG8_SP2>(lds, g, S, E, wave); }
#else
    for (int rep_ = ((PROBE_MASK >> 5) & 1) ? 0 : 1; rep_ < 2; ++rep_)
    { pg8::Gemm g{MERGED, WT_OUT, T_, 1024, 1024}; pg8::StaticOrder S; S.init(T_, 1024, G, cid); EpiRes E{x, out, XN, rep_ ? RSTD1 : (float*)(ws + WS_DUMMY), 0xFFFF};
      pg8::gemm_phase<EpiRes, pg8::StaticOrder, PG8_ALIGN, PG8_SP2>(lds, g, S, E, wave); }
#endif
    xcd_barrier(bar);
    for (int rep_ = 0; rep_ < 1 + ((PROBE_MASK >> 6) & 1); ++rep_) { pg8::Gemm g{XN, WT_UP, T_, 4096, 1024}; pg8::StaticOrder S; S.init(T_, 4096, G, cid); EpiUp E{ACT, RSTD1};
      pg8::gemm_phase<EpiUp, pg8::StaticOrder, PG8_ALIGN, PG8_SP2, (PROBE_MASK >> 9) & 1>(lds, g, S, E, wave); }
    xcd_barrier(bar);
#if RES_BF16
    { pg8::Gemm g{ACT, WT_DN, T_, 1024, 4096}; pg8::StaticOrder S; S.init(T_, 1024, G, cid); EpiRes6 E{XN, RSTD2};
      pg8::gemm_phase<EpiRes6, pg8::StaticOrder, PG8_ALIGN, PG8_SP2>(lds, g, S, E, wave); }
#else
    for (int rep_ = ((PROBE_MASK >> 7) & 1) ? 0 : 1; rep_ < 2; ++rep_)
    { pg8::Gemm g{ACT, WT_DN, T_, 1024, 4096}; pg8::StaticOrder S; S.init(T_, 1024, G, cid);
      EpiRes E{out, rep_ ? out : (float*)(ws + WS_END), XN, rep_ ? RSTD2 : (float*)(ws + WS_DUMMY), rep_ ? 0xFFFF : 0x7FFF};
      pg8::gemm_phase<EpiRes, pg8::StaticOrder, PG8_ALIGN, PG8_SP2>(lds, g, S, E, wave); }
#endif
    xcd_barrier(bar);
#if RES_BF16
    { pg8::StaticOrder S; S.init(T_, 1024, G, cid); EpiMidPP EM{(u32x4*)(ws + WS_PP) + (size_t)bx * 8192}; EpiFinalC EF{XN, out, RSTD2, (const u32x4*)(ws + WS_PP) + (size_t)bx * 8192};
      pg8::gemm_phase_ple<EpiMidPP, EpiFinalC, pg8::StaticOrder>(lds, PB, WT_PP, XN, WT_PG, S, EM, EF, wave); }
#else
    for (int rep_ = ((PROBE_MASK >> 8) & 1) ? 0 : 1; rep_ < 2; ++rep_)
    { pg8::Gemm g{XN, WT_PG, T_, 1024, 1024}; pg8::StaticOrder S; S.init(T_, 1024, G, cid); EpiFinal E{out, rep_ ? out : (float*)ACT, PP, RSTD2};
      pg8::gemm_phase<EpiFinal, pg8::StaticOrder, PG8_ALIGN, PG8_SP2>(lds, g, S, E, wave); }
#endif
}

#undef tid
#undef lane
extern "C" void kernel_launch(void* const* d_in, const int* in_sizes, int n_in, void* d_out, int out_size, void* d_ws, size_t ws_size, hipStream_t stream) {
    static int grid = 0;
    if (grid == 0) {
        if (n_in != 23 || in_sizes[0] != T_ * DM_ || out_size != T_ * DM_ || ws_size < WS_END) { fprintf(stderr, "kernel_launch: unexpected shapes (n_in %d, in0 %d, out %d, ws %zu)\n", n_in, n_in > 0 ? in_sizes[0] : -1, out_size, ws_size); grid = -1; return; }
        int dev = 0, cus = 0, per_cu = 0;
        (void)hipGetDevice(&dev); (void)hipDeviceGetAttribute(&cus, hipDeviceAttributeMultiprocessorCount, dev);
        (void)hipFuncSetAttribute((const void*)fwd_megakernel, hipFuncAttributeMaxDynamicSharedMemorySize, LDS_BYTES);
        if (hipOccupancyMaxActiveBlocksPerMultiprocessor(&per_cu, (const void*)fwd_megakernel, NTHR, LDS_BYTES) != hipSuccess || per_cu < 1) per_cu = 1;
        (void)hipGetLastError();
        grid = cus * per_cu;
        if (grid > 256) grid = 256;
        fprintf(stderr, "kernel_launch: cus %d per_cu %d grid %d\n", cus, per_cu, grid);
    }
    if (grid < 0) return;
    Args a{};
    for (int i = 0; i < 23; ++i) a.in[i] = (const float*)d_in[i];
    a.out = (float*)d_out; a.ws = (unsigned char*)d_ws;
    void* kargs[] = {&a};
    hipError_t e = hipLaunchCooperativeKernel((const void*)fwd_megakernel, dim3(grid), dim3(NTHR), kargs, LDS_BYTES, stream);
    if (e != hipSuccess) fprintf(stderr, "kernel_launch: cooperative launch failed: %s (grid %d)\n", hipGetErrorString(e), grid);
}
```

```cpp
#include <hip/hip_runtime.h>
#include <hip/hip_cooperative_groups.h>
#include <cstdio>
#include <cstdint>
namespace cg = cooperative_groups;
__device__ __forceinline__ int lane_id_v() { int l; asm volatile("v_mbcnt_lo_u32_b32 %0, -1, 0\n\tv_mbcnt_hi_u32_b32 %0, -1, %0" : "=v"(l)); return l; }
namespace pg8 {
#define PG8_LAS __attribute__((address_space(3)))
typedef unsigned short bf16_t;
typedef short bf16x8 __attribute__((ext_vector_type(8)));
typedef float f32x4 __attribute__((ext_vector_type(4)));
typedef unsigned u32x4 __attribute__((ext_vector_type(4)));
constexpr int BM = 256, BK = 64, HALF = 128, HTB = HALF * BK * 2  , STAGE_BYTES = 8 * HTB, NXCD = 8, WGM = 8;

__host__ __device__ __forceinline__ int lds_byte(int r, int c) { const int st = (r >> 4) * 2 + (c >> 5), rr = r & 15, cc = c & 31, ob = rr * 64 + cc * 2; return st * 1024 + (ob ^ (((ob >> 9) & 1) << 5)); }
__host__ __device__ __forceinline__ void stage_rc(int b, int& R, int& C) { const int st = b / 1024, sb = b % 1024, swz = sb ^ (((sb >> 9) & 1) << 5); R = (st >> 1) * 16 + swz / 64; C = (st & 1) * 32 + (swz % 64) / 2; }
__host__ __device__ __forceinline__ int perm32(int rho) { const int n = rho >> 4, i = rho & 15; return 8 * (i >> 2) + 4 * n + (i & 3); }

struct Unit { int pm, pn; };
struct Gemm { const bf16_t* A; const bf16_t* Bt; int M, N, K; };

struct StaticOrder {
    int nM, nN, nwg, G, c;
    __host__ __device__ void init(int M, int N, int G_, int c_) { nM = M / BM; nN = N / BM; nwg = nM * nN; G = G_; c = c_; }
    __host__ __device__ bool next(int i, Unit& u) const {
        const long L = (long)i * G + c; if (L >= nwg) return false;
        int wgid = (int)L; { const int q = nwg / NXCD, r = nwg % NXCD, xcd = wgid % NXCD, off = wgid / NXCD; wgid = (xcd < r ? xcd * (q + 1) : r * (q + 1) + (xcd - r) * q) + off; }
        const int nig = WGM * nN, gid = wgid / nig, fm = gid * WGM, gsz = (nM - fm) < WGM ? (nM - fm) : WGM;
        u.pm = fm + ((wgid % nig) % gsz); u.pn = (wgid % nig) / gsz; return true;
    }
    __device__ __forceinline__ void a_ready(const Unit&) const {}
    __device__ __forceinline__ void done(const Unit&) const {}
};

__device__ __forceinline__ unsigned cvt_pk_bf16(float lo, float hi) { unsigned r; asm volatile("v_cvt_pk_bf16_f32 %0, %1, %2" : "=v"(r) : "v"(lo), "v"(hi)); return r; }
typedef float f32x2 __attribute__((ext_vector_type(2)));
template <class Epi, class Sched, bool ALIGN_EPI = false, bool SP2 = false, bool EPI2 = false>
__device__ __forceinline__ void gemm_phase(PG8_LAS unsigned char* lds, const Gemm g, const Sched& S, const Epi& E, const int wave_u) {
    int tid_ = wave_u * 64 + lane_id_v(); asm volatile("" : "+v"(tid_));
    const int tid = tid_, wid = __builtin_amdgcn_readfirstlane(tid >> 6), lane = tid & 63, wr = wid >> 2, wc = wid & 3, fr = lane & 15, fq = lane >> 4;
    const int K = g.K, nt = K / BK;
    unsigned voffA[2], voffB[2];
#pragma unroll
    for (int i = 0; i < 2; ++i) { int R, C; stage_rc(tid * 16 + i * 8192, R, C); const int Rp = Epi::PERM ? perm32(R & 31) : (R & 31); const int Rb = Epi::HEADMAP ? (64 * (R >> 5) + Rp) : ((R & ~31) + Rp);
        voffA[i] = (unsigned)(R * K + C) * 2u; voffB[i] = (unsigned)(Rb * K + C) * 2u; }
    const size_t kstep = (size_t)(BK * 2);
    const size_t hstep = (size_t)HALF * K * 2;
    const size_t hstepB = Epi::HEADMAP ? (size_t)32 * K * 2 : hstep;
    const size_t tstep = 2 * hstep;
    const unsigned ldsw = (unsigned)wid * 1024u;
    const int aoff = lds_byte(wr * 64 + fr, fq * 8), boff = lds_byte(wc * 32 + fr, fq * 8);
#define PG8_SA(b, h) (((b) * 2 + (h)) * HTB)
#define PG8_SB(b, h) ((4 + (b) * 2 + (h)) * HTB)
#define PG8_STAGE(bufoff, gbase, voff) do { _Pragma("unroll") for (int _i = 0; _i < 2; ++_i) \
        __builtin_amdgcn_global_load_lds((const unsigned*)((const char*)(gbase) + (voff)[_i]), (PG8_LAS unsigned*)(lds + (bufoff) + ldsw + _i * 8192), 16, 0, 0); } while (0)
#define PG8_LDA(dst, b, h) do { _Pragma("unroll") for (int m = 0; m < 4; ++m) _Pragma("unroll") for (int k = 0; k < 2; ++k) dst[m][k] = *(const PG8_LAS bf16x8*)(lds + PG8_SA(b, h) + aoff + m * 2048 + k * 1024); } while (0)
#define PG8_LDB(dst, b, h) do { _Pragma("unroll") for (int n = 0; n < 2; ++n) _Pragma("unroll") for (int k = 0; k < 2; ++k) dst[n][k] = *(const PG8_LAS bf16x8*)(lds + PG8_SB(b, h) + boff + n * 2048 + k * 1024); } while (0)
#define PG8_MMA(ai, bj, At, Bt) do { __builtin_amdgcn_s_setprio(1); _Pragma("unroll") for (int m = 0; m < 4; ++m) _Pragma("unroll") for (int n = 0; n < 2; ++n) _Pragma("unroll") for (int k = 0; k < 2; ++k) \
        acc[ai][bj][m][n] = __builtin_amdgcn_mfma_f32_16x16x32_bf16(Bt[n][k], At[m][k], acc[ai][bj][m][n], 0, 0, 0); __builtin_amdgcn_s_setprio(0); } while (0)
#define PG8_WAIT_V(n) asm volatile("s_waitcnt vmcnt(" #n ")" ::: "memory")
#define PG8_WAIT_L(n) asm volatile("s_waitcnt lgkmcnt(" #n ")" ::: "memory")
#define PG8_BAR __builtin_amdgcn_s_barrier()
#define PG8_SCHED __builtin_amdgcn_sched_barrier(0)
    Unit cur, nxt; int ui = 0;
    if (!S.next(0, cur)) return;
    f32x4 acc[2][2][4][2];
#pragma unroll
    for (int a = 0; a < 2; ++a)
#pragma unroll
        for (int b = 0; b < 2; ++b)
#pragma unroll
            for (int m = 0; m < 4; ++m)
#pragma unroll
                for (int n = 0; n < 2; ++n) acc[a][b][m][n] = (f32x4){0.f, 0.f, 0.f, 0.f};
    bf16x8 At[4][2], B0[2][2], B1[2][2];
    const char* cA = (const char*)g.A + (size_t)cur.pm * tstep; const char* cB = (const char*)g.Bt + (size_t)cur.pn * tstep;
    S.a_ready(cur);
    if constexpr (SP2) {
        PG8_STAGE(PG8_SB(0, 0), cB, voffB); PG8_STAGE(PG8_SB(0, 1), cB + hstepB, voffB); PG8_STAGE(PG8_SA(0, 0), cA, voffA); PG8_STAGE(PG8_SA(0, 1), cA + hstep, voffA);
        if (wr == 1) PG8_BAR;
        PG8_WAIT_V(2); PG8_BAR;
        PG8_STAGE(PG8_SB(1, 0), cB + kstep, voffB); PG8_STAGE(PG8_SA(1, 0), cA + kstep, voffA); PG8_STAGE(PG8_SB(1, 1), cB + hstepB + kstep, voffB);
        PG8_WAIT_V(6); PG8_BAR;
    } else {
        PG8_STAGE(PG8_SB(0, 0), cB, voffB); PG8_STAGE(PG8_SA(0, 0), cA, voffA); PG8_STAGE(PG8_SB(0, 1), cB + hstepB, voffB); PG8_STAGE(PG8_SA(0, 1), cA + hstep, voffA);
        if (wr == 1) PG8_BAR;
        PG8_WAIT_V(4); PG8_BAR;
        PG8_STAGE(PG8_SB(1, 0), cB + kstep, voffB); PG8_STAGE(PG8_SA(1, 0), cA + kstep, voffA); PG8_STAGE(PG8_SB(1, 1), cB + hstepB + kstep, voffB);
        PG8_WAIT_V(6); PG8_BAR;
    }
    for (;;) {
        const bool has_next = S.next(ui + 1, nxt);
        const char* nA = has_next ? (const char*)g.A + (size_t)nxt.pm * tstep : cA; const char* nB = has_next ? (const char*)g.Bt + (size_t)nxt.pn * tstep : cB;
#pragma nounroll
        for (int t = 0; t < nt; t += 2) {
            const bool last = (t == nt - 2);
            const char* a1 = cA + (size_t)(t + 1) * kstep;
            const char* a2 = last ? nA : cA + (size_t)(t + 2) * kstep; const char* b2 = last ? nB : cB + (size_t)(t + 2) * kstep;
            const char* a3 = a2 + kstep; const char* b3 = b2 + kstep;
            if (last && has_next) S.a_ready(nxt);
            if constexpr (SP2) {
            PG8_LDB(B0, 0, 0); PG8_LDB(B1, 0, 1); PG8_SCHED; PG8_LDA(At, 0, 0); PG8_STAGE(PG8_SA(1, 1), a1 + hstep, voffA);
            PG8_WAIT_V(8); PG8_WAIT_L(0); PG8_BAR; PG8_MMA(0, 0, At, B0); PG8_MMA(0, 1, At, B1); PG8_BAR; PG8_SCHED;
            PG8_LDA(At, 0, 1); PG8_STAGE(PG8_SB(0, 0), b2, voffB); PG8_STAGE(PG8_SB(0, 1), b2 + hstepB, voffB); PG8_STAGE(PG8_SA(0, 0), a2, voffA);
            PG8_WAIT_V(8); PG8_WAIT_L(0); PG8_BAR; PG8_MMA(1, 0, At, B0); PG8_MMA(1, 1, At, B1); PG8_BAR; PG8_SCHED;
            PG8_LDB(B0, 1, 0); PG8_LDB(B1, 1, 1); PG8_SCHED; PG8_LDA(At, 1, 0); PG8_STAGE(PG8_SA(0, 1), a2 + hstep, voffA);
            PG8_WAIT_V(8); PG8_WAIT_L(0); PG8_BAR; PG8_MMA(0, 0, At, B0); PG8_MMA(0, 1, At, B1); PG8_BAR; PG8_SCHED;
            PG8_LDA(At, 1, 1); PG8_STAGE(PG8_SB(1, 0), b3, voffB); PG8_STAGE(PG8_SB(1, 1), b3 + hstepB, voffB); PG8_STAGE(PG8_SA(1, 0), a3, voffA);
            PG8_WAIT_V(8); PG8_WAIT_L(0); PG8_BAR; PG8_MMA(1, 0, At, B0); PG8_MMA(1, 1, At, B1); PG8_BAR; PG8_SCHED;
            } else {
            PG8_LDB(B0, 0, 0); PG8_SCHED; PG8_LDA(At, 0, 0); PG8_STAGE(PG8_SA(1, 1), a1 + hstep, voffA);
            PG8_WAIT_L(8); PG8_BAR; PG8_WAIT_L(0); PG8_MMA(0, 0, At, B0); PG8_BAR; PG8_SCHED;
            PG8_LDB(B1, 0, 1); PG8_STAGE(PG8_SB(0, 0), b2, voffB);
            PG8_BAR; PG8_WAIT_L(0); PG8_MMA(0, 1, At, B1); PG8_BAR;
            PG8_LDA(At, 0, 1); PG8_STAGE(PG8_SA(0, 0), a2, voffA);
            PG8_BAR; PG8_WAIT_L(0); PG8_MMA(1, 0, At, B0); PG8_BAR; PG8_SCHED;
            PG8_STAGE(PG8_SB(0, 1), b2 + hstepB, voffB);
            PG8_WAIT_V(6); PG8_BAR; PG8_MMA(1, 1, At, B1); PG8_BAR;
            PG8_LDB(B0, 1, 0); PG8_SCHED; PG8_LDA(At, 1, 0); PG8_STAGE(PG8_SA(0, 1), a2 + hstep, voffA);
            PG8_WAIT_L(8); PG8_BAR; PG8_WAIT_L(0); PG8_MMA(0, 0, At, B0); PG8_BAR; PG8_SCHED;
            PG8_LDB(B1, 1, 1); PG8_STAGE(PG8_SB(1, 0), b3, voffB);
            PG8_BAR; PG8_WAIT_L(0); PG8_MMA(0, 1, At, B1); PG8_BAR;
            PG8_LDA(At, 1, 1); PG8_STAGE(PG8_SA(1, 0), a3, voffA);
            PG8_BAR; PG8_WAIT_L(0); PG8_MMA(1, 0, At, B0); PG8_BAR; PG8_SCHED;
            PG8_STAGE(PG8_SB(1, 1), b3 + hstepB, voffB);
            PG8_WAIT_V(6); PG8_BAR; PG8_MMA(1, 1, At, B1); PG8_BAR;
            }
        }
        if constexpr (ALIGN_EPI) { if (wr == 0) PG8_BAR; }
        if constexpr (!Epi::AFTER_DRAIN) { E(acc, cur, wr, wc, fr, fq); if constexpr (EPI2) { asm volatile("" ::: "memory"); E(acc, cur, wr, wc, fr, fq); } S.done(cur); }
        if (!has_next) break;
#pragma unroll
        for (int a = 0; a < 2; ++a)
#pragma unroll
            for (int b = 0; b < 2; ++b)
#pragma unroll
                for (int m = 0; m < 4; ++m)
#pragma unroll
                    for (int n = 0; n < 2; ++n) acc[a][b][m][n] = (f32x4){0.f, 0.f, 0.f, 0.f};
        cur = nxt; cA = nA; cB = nB; ++ui;
        if constexpr (ALIGN_EPI) { if (wr == 1) PG8_BAR; }
    }
    PG8_WAIT_V(0);
    if constexpr (!ALIGN_EPI) { if (wr == 0) PG8_BAR; }
    PG8_BAR;
    if constexpr (Epi::AFTER_DRAIN) { E.fused(acc, cur, wr, wc, fr, fq, lds, wid, lane); S.done(cur); }
#undef PG8_SA
#undef PG8_SB
#undef PG8_STAGE
#undef PG8_LDA
#undef PG8_LDB
#undef PG8_MMA
#undef PG8_WAIT_V
#undef PG8_WAIT_L
#undef PG8_BAR
#undef PG8_SCHED
}

template <class EpiMid, class EpiFin, class Sched>
__device__ __forceinline__ void gemm_phase_ple(PG8_LAS unsigned char* lds, const bf16_t* AP, const bf16_t* BP, const bf16_t* AZ, const bf16_t* BZ, const Sched& S, const EpiMid& EM, const EpiFin& E, const int wave_u) {
    constexpr bool ALIGN_EPI = true;
    int tid_ = wave_u * 64 + lane_id_v(); asm volatile("" : "+v"(tid_));
    const int tid = tid_, wid = __builtin_amdgcn_readfirstlane(tid >> 6), lane = tid & 63, wr = wid >> 2, wc = wid & 3, fr = lane & 15, fq = lane >> 4;
    constexpr int KP = 256, KZ = 1024, NT = 20;
    unsigned vAP[2], vBP[2], vAZ[2], vBZ[2];
#pragma unroll
    for (int i = 0; i < 2; ++i) { int R, C; stage_rc(tid * 16 + i * 8192, R, C); const int Rb = (R & ~31) + perm32(R & 31);
        vAP[i] = (unsigned)(R * KP + C) * 2u; vBP[i] = (unsigned)(Rb * KP + C) * 2u; vAZ[i] = (unsigned)(R * KZ + C) * 2u; vBZ[i] = (unsigned)(Rb * KZ + C) * 2u; }
    const size_t kstep = (size_t)(BK * 2);
    const size_t hsP = (size_t)HALF * KP * 2, hsZ = (size_t)HALF * KZ * 2, tsP = 2 * hsP, tsZ = 2 * hsZ;
    const unsigned ldsw = (unsigned)wid * 1024u;
    const int aoff = lds_byte(wr * 64 + fr, fq * 8), boff = lds_byte(wc * 32 + fr, fq * 8);
#define PG8_SA(b, h) (((b) * 2 + (h)) * HTB)
#define PG8_SB(b, h) ((4 + (b) * 2 + (h)) * HTB)
#define PG8_STAGE(bufoff, gbase, voff) do { _Pragma("unroll") for (int _i = 0; _i < 2; ++_i) \
        __builtin_amdgcn_global_load_lds((const unsigned*)((const char*)(gbase) + (voff)[_i]), (PG8_LAS unsigned*)(lds + (bufoff) + ldsw + _i * 8192), 16, 0, 0); } while (0)
#define PG8_LDA(dst, b, h) do { _Pragma("unroll") for (int m = 0; m < 4; ++m) _Pragma("unroll") for (int k = 0; k < 2; ++k) dst[m][k] = *(const PG8_LAS bf16x8*)(lds + PG8_SA(b, h) + aoff + m * 2048 + k * 1024); } while (0)
#define PG8_LDB(dst, b, h) do { _Pragma("unroll") for (int n = 0; n < 2; ++n) _Pragma("unroll") for (int k = 0; k < 2; ++k) dst[n][k] = *(const PG8_LAS bf16x8*)(lds + PG8_SB(b, h) + boff + n * 2048 + k * 1024); } while (0)
#define PG8_MMA(ai, bj, At, Bt) do { __builtin_amdgcn_s_setprio(1); _Pragma("unroll") for (int m = 0; m < 4; ++m) _Pragma("unroll") for (int n = 0; n < 2; ++n) _Pragma("unroll") for (int k = 0; k < 2; ++k) \
        acc[ai][bj][m][n] = __builtin_amdgcn_mfma_f32_16x16x32_bf16(Bt[n][k], At[m][k], acc[ai][bj][m][n], 0, 0, 0); __builtin_amdgcn_s_setprio(0); } while (0)
#define PG8_WAIT_V(n) asm volatile("s_waitcnt vmcnt(" #n ")" ::: "memory")
#define PG8_WAIT_L(n) asm volatile("s_waitcnt lgkmcnt(" #n ")" ::: "memory")
#define PG8_BAR __builtin_amdgcn_s_barrier()
#define PG8_SCHED __builtin_amdgcn_sched_barrier(0)
    Unit cur, nxt; int ui = 0;
    if (!S.next(0, cur)) return;
    f32x4 acc[2][2][4][2];
#pragma unroll
    for (int a = 0; a < 2; ++a)
#pragma unroll
        for (int b = 0; b < 2; ++b)
#pragma unroll
            for (int m = 0; m < 4; ++m)
#pragma unroll
                for (int n = 0; n < 2; ++n) acc[a][b][m][n] = (f32x4){0.f, 0.f, 0.f, 0.f};
    bf16x8 At[4][2], B0[2][2], B1[2][2];
    const char* cAP = (const char*)AP + (size_t)cur.pm * tsP; const char* cBP = (const char*)BP + (size_t)cur.pn * tsP;
    const char* cAZ = (const char*)AZ + (size_t)cur.pm * tsZ; const char* cBZ = (const char*)BZ + (size_t)cur.pn * tsZ;
    S.a_ready(cur);
    PG8_STAGE(PG8_SB(0, 0), cBP, vBP); PG8_STAGE(PG8_SB(0, 1), cBP + hsP, vBP); PG8_STAGE(PG8_SA(0, 0), cAP, vAP); PG8_STAGE(PG8_SA(0, 1), cAP + hsP, vAP);
    if (wr == 1) PG8_BAR;
    PG8_WAIT_V(2); PG8_BAR;
    PG8_STAGE(PG8_SB(1, 0), cBP + kstep, vBP); PG8_STAGE(PG8_SA(1, 0), cAP + kstep, vAP); PG8_STAGE(PG8_SB(1, 1), cBP + hsP + kstep, vBP);
    PG8_WAIT_V(6); PG8_BAR;
    for (;;) {
        const bool has_next = S.next(ui + 1, nxt);
        const char* nAP = has_next ? (const char*)AP + (size_t)nxt.pm * tsP : cAP; const char* nBP = has_next ? (const char*)BP + (size_t)nxt.pn * tsP : cBP;
#pragma nounroll
        for (int t = 0; t < NT; t += 2) {
            if (t == 4) {
                EM(acc, cur, wr, wc, fr, fq);
#pragma unroll
                for (int a = 0; a < 2; ++a)
#pragma unroll
                    for (int b = 0; b < 2; ++b)
#pragma unroll
                        for (int m = 0; m < 4; ++m)
#pragma unroll
                            for (int n = 0; n < 2; ++n) acc[a][b][m][n] = (f32x4){0.f, 0.f, 0.f, 0.f};
            }
            const bool p1 = (t < 4), p23 = (t == 0) || (t == NT - 2);
            const char* a1 = p1 ? cAP + (size_t)(t + 1) * kstep : cAZ + (size_t)(t - 3) * kstep;
            const char* a2 = (t == 0) ? cAP + 2 * kstep : (t == NT - 2) ? nAP : cAZ + (size_t)(t - 2) * kstep;
            const char* b2 = (t == 0) ? cBP + 2 * kstep : (t == NT - 2) ? nBP : cBZ + (size_t)(t - 2) * kstep;
            const char* a3 = a2 + kstep; const char* b3 = b2 + kstep;
            const size_t hstep1 = p1 ? hsP : hsZ, hstep = p23 ? hsP : hsZ, hstepB = hstep;
            unsigned voffA1[2], voffA[2], voffB[2];
#pragma unroll
            for (int i = 0; i < 2; ++i) { voffA1[i] = p1 ? vAP[i] : vAZ[i]; voffA[i] = p23 ? vAP[i] : vAZ[i]; voffB[i] = p23 ? vBP[i] : vBZ[i]; }
            if (t == NT - 2 && has_next) S.a_ready(nxt);
            PG8_LDB(B0, 0, 0); PG8_LDB(B1, 0, 1); PG8_SCHED; PG8_LDA(At, 0, 0); PG8_STAGE(PG8_SA(1, 1), a1 + hstep1, voffA1);
            PG8_WAIT_V(8); PG8_WAIT_L(0); PG8_BAR; PG8_MMA(0, 0, At, B0); PG8_MMA(0, 1, At, B1); PG8_BAR; PG8_SCHED;
            PG8_LDA(At, 0, 1); PG8_STAGE(PG8_SB(0, 0), b2, voffB); PG8_STAGE(PG8_SB(0, 1), b2 + hstepB, voffB); PG8_STAGE(PG8_SA(0, 0), a2, voffA);
            PG8_WAIT_V(8); PG8_WAIT_L(0); PG8_BAR; PG8_MMA(1, 0, At, B0); PG8_MMA(1, 1, At, B1); PG8_BAR; PG8_SCHED;
            PG8_LDB(B0, 1, 0); PG8_LDB(B1, 1, 1); PG8_SCHED; PG8_LDA(At, 1, 0); PG8_STAGE(PG8_SA(0, 1), a2 + hstep, voffA);
            PG8_WAIT_V(8); PG8_WAIT_L(0); PG8_BAR; PG8_MMA(0, 0, At, B0); PG8_MMA(0, 1, At, B1); PG8_BAR; PG8_SCHED;
            PG8_LDA(At, 1, 1); PG8_STAGE(PG8_SB(1, 0), b3, voffB); PG8_STAGE(PG8_SB(1, 1), b3 + hstepB, voffB); PG8_STAGE(PG8_SA(1, 0), a3, voffA);
            PG8_WAIT_V(8); PG8_WAIT_L(0); PG8_BAR; PG8_MMA(1, 0, At, B0); PG8_MMA(1, 1, At, B1); PG8_BAR; PG8_SCHED;
        }
        if constexpr (ALIGN_EPI) { if (wr == 0) PG8_BAR; }
        E(acc, cur, wr, wc, fr, fq); S.done(cur);
        if (!has_next) break;
#pragma unroll
        for (int a = 0; a < 2; ++a)
#pragma unroll
            for (int b = 0; b < 2; ++b)
#pragma unroll
                for (int m = 0; m < 4; ++m)
#pragma unroll
                    for (int n = 0; n < 2; ++n) acc[a][b][m][n] = (f32x4){0.f, 0.f, 0.f, 0.f};
        cur = nxt; cAP = nAP; cBP = nBP; cAZ = (const char*)AZ + (size_t)cur.pm * tsZ; cBZ = (const char*)BZ + (size_t)cur.pn * tsZ; ++ui;
        if constexpr (ALIGN_EPI) { if (wr == 1) PG8_BAR; }
    }
    PG8_WAIT_V(0);
    if constexpr (!ALIGN_EPI) { if (wr == 0) PG8_BAR; }
    PG8_BAR;
#undef PG8_SA
#undef PG8_SB
#undef PG8_STAGE
#undef PG8_LDA
#undef PG8_LDB
#undef PG8_MMA
#undef PG8_WAIT_V
#undef PG8_WAIT_L
#undef PG8_BAR
#undef PG8_SCHED
}
}
#ifndef PG8_SP2
#define PG8_SP2 true
#endif
#ifndef PG8_ALIGN
#define PG8_ALIGN true
#endif
using pg8::bf16_t; using pg8::bf16x8; using pg8::f32x4; using pg8::u32x4;
#define LAS __attribute__((address_space(3)))
typedef float f32x2 __attribute__((ext_vector_type(2)));
typedef float f32x16 __attribute__((ext_vector_type(16)));
typedef unsigned u32x2 __attribute__((ext_vector_type(2)));
typedef __bf16 bf16x2_t __attribute__((ext_vector_type(2)));

constexpr int T_ = 65536, DM_ = 1024, SEQ_ = 8192, PJW = 2048, FF_ = 4096, PLE_ = 256, NUNIT_ATT = 1024, NUNIT_LRU = 256;
constexpr float EPS_ = 1e-6f, LOG2E = 1.4426950408889634f, QSCALE = 0.125f * 1.4426950408889634f;
constexpr int NWAVES = 8, NTHR = 512;
constexpr int RING_BYTES = 131072, SSL_OFF = RING_BYTES, MISC_OFF = 147456 - 64, LDS_BYTES = 147456;
constexpr size_t MiB = 1u << 20;
constexpr size_t WS_WIN = 0, WS_WOUT = 5 * MiB, WS_WUP = 7 * MiB, WS_WDN = 15 * MiB, WS_WPG = 23 * MiB, WS_WPP = 25 * MiB, WS_WG = 25 * MiB + 512 * 1024;
constexpr size_t WS_RSTD1 = 27 * MiB, WS_RSTD2 = 27 * MiB + 256 * 1024, WS_DUMMY = 27 * MiB + 512 * 1024, WS_RINV0 = 27 * MiB + 768 * 1024, WS_SUMM = 28 * MiB;
constexpr size_t WS_CTL = 31 * MiB, CTL_BYTES = 16384;
constexpr size_t WS_XN = 32 * MiB;
constexpr size_t WS_PP = 160 * MiB;
constexpr size_t WS_PB = 288 * MiB;
constexpr size_t WS_PROJ = 320 * MiB;
constexpr size_t WS_VT = 576 * MiB;
constexpr size_t WS_MERGED = 640 * MiB;
constexpr size_t WS_ACT = 320 * MiB;
constexpr size_t WS_END = 832 * MiB;

__device__ __forceinline__ unsigned cvtpk(float lo, float hi) { f32x2 v = {lo, hi}; bf16x2_t b = __builtin_convertvector(v, bf16x2_t); return __builtin_bit_cast(unsigned, b); }
__device__ __forceinline__ float bf2f(unsigned short u) { return __uint_as_float((unsigned)u << 16); }
__device__ __forceinline__ float bflo(unsigned w) { return __uint_as_float(w << 16); }
__device__ __forceinline__ float bfhi(unsigned w) { return __uint_as_float(w & 0xffff0000u); }
__device__ __forceinline__ float ex2(float x) { return __builtin_amdgcn_exp2f(x); }
__device__ __forceinline__ float rcpf_(float x) { return __builtin_amdgcn_rcpf(x); }
__device__ __forceinline__ float rsqf_(float x) { return __builtin_amdgcn_rsqf(x); }
__device__ __forceinline__ float sigm(float z) { return rcpf_(1.f + ex2(-LOG2E * z)); }
__device__ __forceinline__ float gelu_tanh(float g) { const float z = 0.7978845608028654f * (g + 0.044715f * g * g * g); return g * sigm(2.f * z); }
__device__ __forceinline__ float wave_sum(float v) {
#pragma unroll
    for (int o = 1; o < 64; o <<= 1) v += __shfl_xor(v, o);
    return v;
}
__device__ __forceinline__ float wave_max(float v) {
#pragma unroll
    for (int o = 1; o < 64; o <<= 1) v = fmaxf(v, __shfl_xor(v, o));
    return v;
}
__device__ __forceinline__ int crow(int r, int hi) { return (r & 3) + 8 * (r >> 2) + 4 * hi; }
#define MFMA32(a, b, c) __builtin_amdgcn_mfma_f32_32x32x16_bf16((a), (b), (c), 0, 0, 0)

#define RLX_AGENT __ATOMIC_RELAXED, __HIP_MEMORY_SCOPE_AGENT
#define XB_TMO      128
#define XB_XCNT(j)  (256  + 64 * (j))
#define XB_XSUB(j)  (1280 + 64 * (j))
#define XB_XGEN(j)  (2304 + 64 * (j))
#define XB_TOP      3328
#define XB_TOPGEN   3392
#define XCD_BAR_WORDS 3456
#define XB_SPIN_CAP (1u << 18)

__device__ __forceinline__ unsigned xb_ld(unsigned* p)              { return __hip_atomic_load(p, __ATOMIC_RELAXED, __HIP_MEMORY_SCOPE_AGENT); }
__device__ __forceinline__ unsigned xb_add(unsigned* p, unsigned v) { return __hip_atomic_fetch_add(p, v, __ATOMIC_RELAXED, __HIP_MEMORY_SCOPE_AGENT); }
__device__ __forceinline__ unsigned xb_xcc_id() { return (unsigned)__builtin_amdgcn_s_getreg((3 << 11) | 20) & 0xFu; }
#define XB_SPIN(cond, bar) do { unsigned _sp = 0; while (cond) { __builtin_amdgcn_s_sleep(1); \
    if ((++_sp & 255u) == 0u) { if (xb_ld(&(bar)[XB_TMO])) break; if (_sp > XB_SPIN_CAP) { atomicAdd(&(bar)[XB_TMO], 1u); break; } } } } while (0)

struct XcdBarrier {
    unsigned* bar; unsigned x;
    volatile LAS unsigned* st;
};

__device__ __forceinline__ XcdBarrier xcd_barrier_post(unsigned* bar, volatile LAS unsigned* st) {
    XcdBarrier b; b.bar = bar; b.x = xb_xcc_id(); b.st = st;
    if (threadIdx.x == 0) (void)xb_add(&bar[XB_XCNT(b.x)], 1u);
    return b;
}
__device__ __forceinline__ void xcd_barrier_complete(unsigned* bar, unsigned x, unsigned& nloc, unsigned& nx) {
    const unsigned G = gridDim.x * gridDim.y * gridDim.z;
    unsigned sum, cnt, mine, sp = 0u;
    for (;;) {
        sum = 0u; cnt = 0u; mine = 0u;
#pragma unroll
        for (unsigned j = 0; j < 16; ++j) { const unsigned c = xb_ld(&bar[XB_XCNT(j)]); sum += c; cnt += (c > 0u) ? 1u : 0u; mine = (j == x) ? c : mine; }
        if (sum == G) break;
        __builtin_amdgcn_s_sleep(1);
        if ((++sp & 255u) == 0u) { if (xb_ld(&bar[XB_TMO])) break; if (sp > XB_SPIN_CAP) { atomicAdd(&bar[XB_TMO], 1u); break; } }
    }
    nloc = mine > 0u ? mine : 1u; nx = cnt > 0u ? cnt : 1u;
}

__device__ __forceinline__ void xcd_barrier(const XcdBarrier& b) {
    asm volatile("s_waitcnt vmcnt(0)" ::: "memory");
    __syncthreads();
    if (threadIdx.x == 0) {
        unsigned* bar = b.bar;
        __builtin_amdgcn_s_waitcnt(0);
        unsigned nloc = b.st[0], nx = b.st[1];
        if (nloc == 0u) { xcd_barrier_complete(bar, b.x, nloc, nx); b.st[0] = nloc; b.st[1] = nx; }
        const unsigned old = xb_add(&bar[XB_XSUB(b.x)], 1u);
        const unsigned gen = old / nloc;
        if (old + 1u == (gen + 1u) * nloc) {
            __builtin_amdgcn_fence(__ATOMIC_RELEASE, "agent");
            asm volatile("s_waitcnt vmcnt(0)" ::: "memory");
            const unsigned og = xb_add(&bar[XB_TOP], 1u);
            const unsigned tg = og / nx;
            if (og + 1u == (tg + 1u) * nx) xb_add(&bar[XB_TOPGEN], 1u);
            else XB_SPIN(xb_ld(&bar[XB_TOPGEN]) == tg, bar);
            __builtin_amdgcn_fence(__ATOMIC_ACQUIRE, "agent");
            xb_add(&bar[XB_XGEN(b.x)], 1u);
            asm volatile("s_waitcnt vmcnt(0)" ::: "memory");
        } else {
            XB_SPIN(xb_ld(&bar[XB_XGEN(b.x)]) == gen, bar);
            __builtin_amdgcn_fence(__ATOMIC_ACQUIRE, "agent");
            asm volatile("s_waitcnt vmcnt(0)" ::: "memory");
        }
    }
    __syncthreads();
}

struct PanelOrder {
    int pm;
    __device__ bool next(int i, pg8::Unit& u) const { if (i >= 4) return false; u.pm = pm; u.pn = i; return true; }
    __device__ __forceinline__ void a_ready(const pg8::Unit&) const {}
    __device__ __forceinline__ void done(const pg8::Unit&) const {}
};

struct EpiPlain {
    static constexpr bool PERM = true, AFTER_DRAIN = false, HEADMAP = false;
    bf16_t* O; int ldc;
    __device__ __forceinline__ void operator()(const f32x4 (&acc)[2][2][4][2], const pg8::Unit& u, int wr, int wc, int fr, int fq) const {
        const int row0 = u.pm * 256 + wr * 64 + fr, col0 = u.pn * 256 + wc * 32 + 8 * fq;
#pragma unroll
        for (int ai = 0; ai < 2; ++ai)
#pragma unroll
            for (int m = 0; m < 4; ++m) { bf16_t* rowp = O + (size_t)(row0 + ai * 128 + m * 16) * ldc + col0;
#pragma unroll
                for (int bj = 0; bj < 2; ++bj) { const f32x4 v0 = acc[ai][bj][m][0], v1 = acc[ai][bj][m][1];
                    u32x4 w; w.x = cvtpk(v0[0], v0[1]); w.y = cvtpk(v0[2], v0[3]); w.z = cvtpk(v1[0], v1[1]); w.w = cvtpk(v1[2], v1[3]);
                    *(u32x4*)(rowp + bj * 128) = w; } }
    }
};
struct EpiVT {
    static constexpr bool PERM = true, AFTER_DRAIN = false, HEADMAP = false;
    bf16_t* O;
    __device__ __forceinline__ void operator()(const f32x4 (&acc)[2][2][4][2], const pg8::Unit& u, int wr, int wc, int fr, int fq) const {
        const int row0 = u.pm * 256 + wr * 64 + fr, col0 = u.pn * 256 + wc * 32 + 16 * (fq >> 1) + 4 * (fq & 1);
#pragma unroll
        for (int ai = 0; ai < 2; ++ai)
#pragma unroll
            for (int m = 0; m < 4; ++m) { bf16_t* rowp = O + (size_t)(row0 + ai * 128 + m * 16) * T_ + col0;
#pragma unroll
                for (int bj = 0; bj < 2; ++bj)
#pragma unroll
                    for (int n = 0; n < 2; ++n) { const f32x4 v = acc[ai][bj][m][n]; u32x2 w; w.x = cvtpk(v[0], v[1]); w.y = cvtpk(v[2], v[3]);
                        *(u32x2*)(rowp + bj * 128 + 8 * n) = w; } }
    }
};
struct EpiProj {
    static constexpr bool PERM = true, AFTER_DRAIN = false, HEADMAP = true;
    bf16_t* O; const float* gq; const float* gk;
    __device__ __forceinline__ void operator()(const f32x4 (&acc)[2][2][4][2], const pg8::Unit& u, int wr, int wc, int fr, int fq) const {
        const int row0 = u.pm * 256 + wr * 64 + fr, col0 = u.pn * 256 + wc * 64 + 8 * fq, kind = u.pn >> 1;
        f32x4 gv[2][2];
        if (kind >= 2) { const float* g = (kind == 2) ? gq : gk; const float sc = (kind == 2) ? QSCALE : 1.f;
#pragma unroll
            for (int bj = 0; bj < 2; ++bj)
#pragma unroll
                for (int n = 0; n < 2; ++n) gv[bj][n] = *(const f32x4*)(g + 32 * bj + 8 * fq + 4 * n) * sc; }
#pragma unroll
        for (int ai = 0; ai < 2; ++ai)
#pragma unroll
            for (int m = 0; m < 4; ++m) { bf16_t* rowp = O + (size_t)(row0 + ai * 128 + m * 16) * PJW + col0;
                f32x4 v[2][2];
#pragma unroll
                for (int bj = 0; bj < 2; ++bj)
#pragma unroll
                    for (int n = 0; n < 2; ++n) v[bj][n] = acc[ai][bj][m][n];
                if (kind == 1) {
#pragma unroll
                    for (int bj = 0; bj < 2; ++bj)
#pragma unroll
                        for (int n = 0; n < 2; ++n)
#pragma unroll
                            for (int e = 0; e < 4; ++e) v[bj][n][e] = gelu_tanh(v[bj][n][e]);
                } else if (kind >= 2) {
                    float ss = 0.f;
#pragma unroll
                    for (int bj = 0; bj < 2; ++bj)
#pragma unroll
                        for (int n = 0; n < 2; ++n) { const f32x4 x = v[bj][n]; ss += (x[0] * x[0] + x[1] * x[1]) + (x[2] * x[2] + x[3] * x[3]); }
                    ss += __shfl_xor(ss, 16); ss += __shfl_xor(ss, 32);
                    const float rstd = rsqf_(ss * (1.f / 64.f) + EPS_);
#pragma unroll
                    for (int bj = 0; bj < 2; ++bj)
#pragma unroll
                        for (int n = 0; n < 2; ++n) v[bj][n] = v[bj][n] * gv[bj][n] * rstd;
                }
#pragma unroll
                for (int bj = 0; bj < 2; ++bj) { const f32x4 v0 = v[bj][0], v1 = v[bj][1];
                    u32x4 w; w.x = cvtpk(v0[0], v0[1]); w.y = cvtpk(v0[2], v0[3]); w.z = cvtpk(v1[0], v1[1]); w.w = cvtpk(v1[2], v1[3]);
                    *(u32x4*)(rowp + bj * 32) = w; } }
    }
};
struct EpiRes {
    static constexpr bool PERM = true, AFTER_DRAIN = false, HEADMAP = false;
    const float* base; float* out; bf16_t* hb; float* ssq; int rowmask;
    __device__ __forceinline__ void operator()(const f32x4 (&acc)[2][2][4][2], const pg8::Unit& u, int wr, int wc, int fr, int fq) const {
        const int row0 = u.pm * 256 + wr * 64 + fr, col0 = u.pn * 256 + wc * 32 + 8 * fq;
#pragma unroll
        for (int ai = 0; ai < 2; ++ai)
#pragma unroll
            for (int m = 0; m < 4; ++m) { const size_t off = (size_t)(row0 + ai * 128 + m * 16) * DM_ + col0; const size_t ooff = (size_t)((row0 + ai * 128 + m * 16) & rowmask) * DM_ + col0; float ss = 0.f;
#pragma unroll
                for (int bj = 0; bj < 2; ++bj) {
                    const f32x4 b0 = *(const f32x4*)(base + off + bj * 128), b1 = *(const f32x4*)(base + off + bj * 128 + 4);
                    const f32x4 v0 = b0 + acc[ai][bj][m][0], v1 = b1 + acc[ai][bj][m][1];
                    ss += (v0[0] * v0[0] + v0[1] * v0[1]) + (v0[2] * v0[2] + v0[3] * v0[3]) + (v1[0] * v1[0] + v1[1] * v1[1]) + (v1[2] * v1[2] + v1[3] * v1[3]);
                    *(f32x4*)(out + ooff + bj * 128) = v0; *(f32x4*)(out + ooff + bj * 128 + 4) = v1;
                    u32x4 w; w.x = cvtpk(v0[0], v0[1]); w.y = cvtpk(v0[2], v0[3]); w.z = cvtpk(v1[0], v1[1]); w.w = cvtpk(v1[2], v1[3]);
                    *(u32x4*)(hb + off + bj * 128) = w; }
                ss += __shfl_xor(ss, 16); ss += __shfl_xor(ss, 32);
                if (fq == 0) __hip_atomic_fetch_add(ssq + row0 + ai * 128 + m * 16, ss, __ATOMIC_RELAXED, __HIP_MEMORY_SCOPE_AGENT);
                asm volatile("" ::: "memory"); }
    }
};
struct EpiUp {
    static constexpr bool PERM = true, AFTER_DRAIN = false, HEADMAP = false;
    bf16_t* O; const float* rstd;
    __device__ __forceinline__ void operator()(const f32x4 (&acc)[2][2][4][2], const pg8::Unit& u, int wr, int wc, int fr, int fq) const {
        const int row0 = u.pm * 256 + wr * 64 + fr, col0 = u.pn * 256 + wc * 32 + 8 * fq;
#pragma unroll
        for (int ai = 0; ai < 2; ++ai)
#pragma unroll
            for (int m = 0; m < 4; ++m) { const int row = row0 + ai * 128 + m * 16; const float rs = rsqf_(rstd[row] * (1.f / DM_) + EPS_); bf16_t* rowp = O + (size_t)row * FF_ + col0;
#pragma unroll
                for (int bj = 0; bj < 2; ++bj) { f32x4 v0 = acc[ai][bj][m][0] * rs, v1 = acc[ai][bj][m][1] * rs;
#pragma unroll
                    for (int e = 0; e < 4; ++e) { const float a = fmaxf(v0[e], 0.f), b = fmaxf(v1[e], 0.f); v0[e] = a * a; v1[e] = b * b; }
                    u32x4 w; w.x = cvtpk(v0[0], v0[1]); w.y = cvtpk(v0[2], v0[3]); w.z = cvtpk(v1[0], v1[1]); w.w = cvtpk(v1[2], v1[3]);
                    *(u32x4*)(rowp + bj * 128) = w; } }
    }
};
struct EpiFinal {
    static constexpr bool PERM = true, AFTER_DRAIN = false, HEADMAP = false;
    const float* hin; float* out; const bf16_t* pp; const float* rstd;
    __device__ __forceinline__ void operator()(const f32x4 (&acc)[2][2][4][2], const pg8::Unit& u, int wr, int wc, int fr, int fq) const {
        const int row0 = u.pm * 256 + wr * 64 + fr, col0 = u.pn * 256 + wc * 32 + 8 * fq;
#pragma unroll
        for (int ai = 0; ai < 2; ++ai)
#pragma unroll
            for (int m = 0; m < 4; ++m) { const int row = row0 + ai * 128 + m * 16; const float rs = rsqf_(rstd[row] * (1.f / DM_) + EPS_); const size_t off = (size_t)row * DM_ + col0;
#pragma unroll
                for (int bj = 0; bj < 2; ++bj) {
                    const f32x4 h0 = *(const f32x4*)(hin + off + bj * 128), h1 = *(const f32x4*)(hin + off + bj * 128 + 4);
                    const u32x4 pw = *(const u32x4*)(pp + off + bj * 128);
                    const f32x4 a0 = acc[ai][bj][m][0] * rs, a1 = acc[ai][bj][m][1] * rs;
                    f32x4 o0, o1;
                    o0[0] = h0[0] + sigm(a0[0]) * bflo(pw.x); o0[1] = h0[1] + sigm(a0[1]) * bfhi(pw.x); o0[2] = h0[2] + sigm(a0[2]) * bflo(pw.y); o0[3] = h0[3] + sigm(a0[3]) * bfhi(pw.y);
                    o1[0] = h1[0] + sigm(a1[0]) * bflo(pw.z); o1[1] = h1[1] + sigm(a1[1]) * bfhi(pw.z); o1[2] = h1[2] + sigm(a1[2]) * bflo(pw.w); o1[3] = h1[3] + sigm(a1[3]) * bfhi(pw.w);
                    *(f32x4*)(out + off + bj * 128) = o0; *(f32x4*)(out + off + bj * 128 + 4) = o1; }
                asm volatile("" ::: "memory"); }
    }
};


struct EpiRes4 {
    static constexpr bool PERM = true, AFTER_DRAIN = false, HEADMAP = false;
    const float* base; bf16_t* hb; float* ssq;
    __device__ __forceinline__ void operator()(const f32x4 (&acc)[2][2][4][2], const pg8::Unit& u, int wr, int wc, int fr, int fq) const {
        const int row0 = u.pm * 256 + wr * 64 + fr, col0 = u.pn * 256 + wc * 32 + 8 * fq;
        f32x4 X[8][2][2];
#define E4_LD(g) do { const size_t off_ = (size_t)(row0 + ((g) >> 2) * 128 + ((g) & 3) * 16) * DM_ + col0; \
        _Pragma("unroll") for (int bj = 0; bj < 2; ++bj) { X[g][bj][0] = *(const f32x4*)(base + off_ + bj * 128); X[g][bj][1] = *(const f32x4*)(base + off_ + bj * 128 + 4); } } while (0)
        E4_LD(0); E4_LD(1); E4_LD(2); E4_LD(3);
        asm volatile("" ::: "memory");
#pragma unroll
        for (int g = 0; g < 8; ++g) { const int ai = g >> 2, m = g & 3; const size_t off = (size_t)(row0 + ai * 128 + m * 16) * DM_ + col0; float ss = 0.f;
#pragma unroll
            for (int bj = 0; bj < 2; ++bj) {
                const f32x4 v0 = X[g][bj][0] + acc[ai][bj][m][0], v1 = X[g][bj][1] + acc[ai][bj][m][1];
                ss += (v0[0] * v0[0] + v0[1] * v0[1]) + (v0[2] * v0[2] + v0[3] * v0[3]) + (v1[0] * v1[0] + v1[1] * v1[1]) + (v1[2] * v1[2] + v1[3] * v1[3]);
                u32x4 w; w.x = cvtpk(v0[0], v0[1]); w.y = cvtpk(v0[2], v0[3]); w.z = cvtpk(v1[0], v1[1]); w.w = cvtpk(v1[2], v1[3]);
                *(u32x4*)(hb + off + bj * 128) = w; }
            ss += __shfl_xor(ss, 16); ss += __shfl_xor(ss, 32);
            if (fq == 0) __hip_atomic_fetch_add(ssq + row0 + ai * 128 + m * 16, ss, __ATOMIC_RELAXED, __HIP_MEMORY_SCOPE_AGENT);
            if (g + 4 < 8) { E4_LD(g + 4); }
            asm volatile("" ::: "memory"); }
#undef E4_LD
    }
};
struct EpiRes4b {
    static constexpr bool PERM = true, AFTER_DRAIN = false, HEADMAP = false;
    bf16_t* hb; const float* rinv0; const float* g1; float* ssq;
    __device__ __forceinline__ void operator()(const f32x4 (&acc)[2][2][4][2], const pg8::Unit& u, int wr, int wc, int fr, int fq) const {
        const int row0 = u.pm * 256 + wr * 64 + fr, col0 = u.pn * 256 + wc * 32 + 8 * fq;
        f32x4 gi[2][2];
#pragma unroll
        for (int bj = 0; bj < 2; ++bj)
#pragma unroll
            for (int n = 0; n < 2; ++n) { const f32x4 gv = *(const f32x4*)(g1 + col0 + bj * 128 + 4 * n); gi[bj][n] = (f32x4){rcpf_(gv[0]), rcpf_(gv[1]), rcpf_(gv[2]), rcpf_(gv[3])}; }
        u32x4 H[8][2]; float RI[8];
#define E4_LD(g) do { const int row_ = row0 + ((g) >> 2) * 128 + ((g) & 3) * 16; const size_t off_ = (size_t)row_ * DM_ + col0; RI[g] = rinv0[row_]; \
        _Pragma("unroll") for (int bj = 0; bj < 2; ++bj) H[g][bj] = *(const u32x4*)(hb + off_ + bj * 128); } while (0)
        E4_LD(0); E4_LD(1); E4_LD(2); E4_LD(3);
        asm volatile("" ::: "memory");
#pragma unroll
        for (int g = 0; g < 8; ++g) { const int ai = g >> 2, m = g & 3; const size_t off = (size_t)(row0 + ai * 128 + m * 16) * DM_ + col0; float ss = 0.f; const float ri = RI[g];
#pragma unroll
            for (int bj = 0; bj < 2; ++bj) { const u32x4 hw = H[g][bj];
                const f32x4 x0 = (f32x4){bflo(hw.x), bfhi(hw.x), bflo(hw.y), bfhi(hw.y)} * gi[bj][0] * ri, x1 = (f32x4){bflo(hw.z), bfhi(hw.z), bflo(hw.w), bfhi(hw.w)} * gi[bj][1] * ri;
                const f32x4 v0 = x0 + acc[ai][bj][m][0], v1 = x1 + acc[ai][bj][m][1];
                ss += (v0[0] * v0[0] + v0[1] * v0[1]) + (v0[2] * v0[2] + v0[3] * v0[3]) + (v1[0] * v1[0] + v1[1] * v1[1]) + (v1[2] * v1[2] + v1[3] * v1[3]);
                u32x4 w; w.x = cvtpk(v0[0], v0[1]); w.y = cvtpk(v0[2], v0[3]); w.z = cvtpk(v1[0], v1[1]); w.w = cvtpk(v1[2], v1[3]);
                *(u32x4*)(hb + off + bj * 128) = w; }
            ss += __shfl_xor(ss, 16); ss += __shfl_xor(ss, 32);
            if (fq == 0) __hip_atomic_fetch_add(ssq + row0 + ai * 128 + m * 16, ss, __ATOMIC_RELAXED, __HIP_MEMORY_SCOPE_AGENT);
            if (g + 4 < 8) { E4_LD(g + 4); }
            asm volatile("" ::: "memory"); }
#undef E4_LD
    }
};
struct EpiRes6 {
    static constexpr bool PERM = true, AFTER_DRAIN = false, HEADMAP = false;
    bf16_t* hb; float* ssq;
    __device__ __forceinline__ void operator()(const f32x4 (&acc)[2][2][4][2], const pg8::Unit& u, int wr, int wc, int fr, int fq) const {
        const int row0 = u.pm * 256 + wr * 64 + fr, col0 = u.pn * 256 + wc * 32 + 8 * fq;
        u32x4 H[8][2];
#define E6_LD(g) do { const size_t off_ = (size_t)(row0 + ((g) >> 2) * 128 + ((g) & 3) * 16) * DM_ + col0; \
        _Pragma("unroll") for (int bj = 0; bj < 2; ++bj) H[g][bj] = *(const u32x4*)(hb + off_ + bj * 128); } while (0)
        E6_LD(0); E6_LD(1); E6_LD(2); E6_LD(3);
        asm volatile("" ::: "memory");
#pragma unroll
        for (int g = 0; g < 8; ++g) { const int ai = g >> 2, m = g & 3; const size_t off = (size_t)(row0 + ai * 128 + m * 16) * DM_ + col0; float ss = 0.f;
#pragma unroll
            for (int bj = 0; bj < 2; ++bj) { const u32x4 hw = H[g][bj];
                const f32x4 b0 = {bflo(hw.x), bfhi(hw.x), bflo(hw.y), bfhi(hw.y)}, b1 = {bflo(hw.z), bfhi(hw.z), bflo(hw.w), bfhi(hw.w)};
                const f32x4 v0 = b0 + acc[ai][bj][m][0], v1 = b1 + acc[ai][bj][m][1];
                ss += (v0[0] * v0[0] + v0[1] * v0[1]) + (v0[2] * v0[2] + v0[3] * v0[3]) + (v1[0] * v1[0] + v1[1] * v1[1]) + (v1[2] * v1[2] + v1[3] * v1[3]);
                u32x4 w; w.x = cvtpk(v0[0], v0[1]); w.y = cvtpk(v0[2], v0[3]); w.z = cvtpk(v1[0], v1[1]); w.w = cvtpk(v1[2], v1[3]);
                *(u32x4*)(hb + off + bj * 128) = w; }
            ss += __shfl_xor(ss, 16); ss += __shfl_xor(ss, 32);
            if (fq == 0) __hip_atomic_fetch_add(ssq + row0 + ai * 128 + m * 16, ss, __ATOMIC_RELAXED, __HIP_MEMORY_SCOPE_AGENT);
            if (g + 4 < 8) { E6_LD(g + 4); }
            asm volatile("" ::: "memory"); }
#undef E6_LD
    }
};
struct EpiFinalB {
    static constexpr bool PERM = true, AFTER_DRAIN = false, HEADMAP = false;
    const bf16_t* hb; float* out; const bf16_t* pp; const float* rstd;
    __device__ __forceinline__ void operator()(const f32x4 (&acc)[2][2][4][2], const pg8::Unit& u, int wr, int wc, int fr, int fq) const {
        const int row0 = u.pm * 256 + wr * 64 + fr, col0 = u.pn * 256 + wc * 32 + 8 * fq;
        u32x4 H[8][2], P[8][2]; float RS[8];
#define EF_LD(g) do { const int row_ = row0 + ((g) >> 2) * 128 + ((g) & 3) * 16; const size_t off_ = (size_t)row_ * DM_ + col0; RS[g] = rstd[row_]; \
        _Pragma("unroll") for (int bj = 0; bj < 2; ++bj) { H[g][bj] = *(const u32x4*)(hb + off_ + bj * 128); P[g][bj] = *(const u32x4*)(pp + off_ + bj * 128); } } while (0)
        EF_LD(0); EF_LD(1); EF_LD(2); EF_LD(3);
        asm volatile("" ::: "memory");
#pragma unroll
        for (int g = 0; g < 8; ++g) { const int ai = g >> 2, m = g & 3; const size_t off = (size_t)(row0 + ai * 128 + m * 16) * DM_ + col0; const float rs = rsqf_(RS[g] * (1.f / DM_) + EPS_);
#pragma unroll
            for (int bj = 0; bj < 2; ++bj) { const u32x4 hw = H[g][bj], pw = P[g][bj];
                const f32x4 a0 = acc[ai][bj][m][0] * rs, a1 = acc[ai][bj][m][1] * rs;
                f32x4 o0, o1;
                o0[0] = bflo(hw.x) + sigm(a0[0]) * bflo(pw.x); o0[1] = bfhi(hw.x) + sigm(a0[1]) * bfhi(pw.x); o0[2] = bflo(hw.y) + sigm(a0[2]) * bflo(pw.y); o0[3] = bfhi(hw.y) + sigm(a0[3]) * bfhi(pw.y);
                o1[0] = bflo(hw.z) + sigm(a1[0]) * bflo(pw.z); o1[1] = bfhi(hw.z) + sigm(a1[1]) * bfhi(pw.z); o1[2] = bflo(hw.w) + sigm(a1[2]) * bflo(pw.w); o1[3] = bfhi(hw.w) + sigm(a1[3]) * bfhi(pw.w);
                *(f32x4*)(out + off + bj * 128) = o0; *(f32x4*)(out + off + bj * 128 + 4) = o1; }
            if (g + 4 < 8) { EF_LD(g + 4); }
            asm volatile("" ::: "memory"); }
#undef EF_LD
    }
};

struct EpiMidPP {
    u32x4* park;
    __device__ __forceinline__ void operator()(const f32x4 (&acc)[2][2][4][2], const pg8::Unit& u, int wr, int wc, int fr, int fq) const {
        asm volatile("" : "+v"(fr), "+v"(fq));
        const unsigned pko_ = (unsigned)((wr * 4 + wc) * 64 + fq * 16 + fr);
#pragma unroll
        for (int ai = 0; ai < 2; ++ai)
#pragma unroll
            for (int m = 0; m < 4; ++m)
#pragma unroll
                for (int bj = 0; bj < 2; ++bj) { const f32x4 v0 = acc[ai][bj][m][0], v1 = acc[ai][bj][m][1];
                    u32x4 w; w.x = cvtpk(v0[0], v0[1]); w.y = cvtpk(v0[2], v0[3]); w.z = cvtpk(v1[0], v1[1]); w.w = cvtpk(v1[2], v1[3]);
                    park[pko_ + (unsigned)((((ai * 4 + m) * 2 + bj) * 8) * 64)] = w; }
    }
};
struct EpiFinalC {
    const bf16_t* hb; float* out; const float* rstd; const u32x4* park;
    __device__ __forceinline__ void operator()(const f32x4 (&acc)[2][2][4][2], const pg8::Unit& u, int wr, int wc, int fr, int fq) const {
        asm volatile("" : "+v"(fr), "+v"(fq));
        const int row0 = u.pm * 256 + wr * 64 + fr, col0 = u.pn * 256 + wc * 32 + 8 * fq;
        const unsigned pko_ = (unsigned)((wr * 4 + wc) * 64 + fq * 16 + fr);
        u32x4 H[8][2], P[8][2]; float RS[8];
#define EF_LD(g) do { const int row_ = row0 + ((g) >> 2) * 128 + ((g) & 3) * 16; const size_t off_ = (size_t)row_ * DM_ + col0; RS[g] = rstd[row_]; \
        _Pragma("unroll") for (int bj = 0; bj < 2; ++bj) { H[g][bj] = *(const u32x4*)(hb + off_ + bj * 128); P[g][bj] = park[pko_ + (unsigned)((((g) * 2 + bj) * 8) * 64)]; } } while (0)
        EF_LD(0); EF_LD(1); EF_LD(2); EF_LD(3);
        asm volatile("" ::: "memory");
#pragma unroll
        for (int g = 0; g < 8; ++g) { const int ai = g >> 2, m = g & 3; const size_t off = (size_t)(row0 + ai * 128 + m * 16) * DM_ + col0; const float rs = rsqf_(RS[g] * (1.f / DM_) + EPS_);
#pragma unroll
            for (int bj = 0; bj < 2; ++bj) { const u32x4 hw = H[g][bj], pw = P[g][bj];
                const f32x4 a0 = acc[ai][bj][m][0] * rs, a1 = acc[ai][bj][m][1] * rs;
                f32x4 o0, o1;
                o0[0] = bflo(hw.x) + sigm(a0[0]) * bflo(pw.x); o0[1] = bfhi(hw.x) + sigm(a0[1]) * bfhi(pw.x); o0[2] = bflo(hw.y) + sigm(a0[2]) * bflo(pw.y); o0[3] = bfhi(hw.y) + sigm(a0[3]) * bfhi(pw.y);
                o1[0] = bflo(hw.z) + sigm(a1[0]) * bflo(pw.z); o1[1] = bfhi(hw.z) + sigm(a1[1]) * bfhi(pw.z); o1[2] = bflo(hw.w) + sigm(a1[2]) * bflo(pw.w); o1[3] = bfhi(hw.w) + sigm(a1[3]) * bfhi(pw.w);
                *(f32x4*)(out + off + bj * 128) = o0; *(f32x4*)(out + off + bj * 128 + 4) = o1; }
            if (g + 4 < 8) { EF_LD(g + 4); }
            asm volatile("" ::: "memory"); }
#undef EF_LD
    }
};

__device__ __forceinline__ void p0_transpose_item(const float* W, int K, int N, bf16_t* WT, const float* ks0, const float* ks1, int ksplit, LAS float* scr, int item, int lane) {
    const int nblk = N / 32, kb = item / nblk, nb = item % nblk, k0 = 64 * kb, n0 = 32 * nb;
    float wv_[32];
#pragma unroll
    for (int i = 0; i < 32; ++i) { const int k = k0 + 2 * i + (lane >> 5); wv_[i] = W[(size_t)k * N + n0 + (lane & 31)]; }
#pragma unroll
    for (int i = 0; i < 32; ++i) { const int kk = 2 * i + (lane >> 5), k = k0 + kk; float s = 1.f; if (ks0) s = (k < ksplit) ? ks0[k] : ks1[k - ksplit];
        scr[kk * 33 + (lane & 31)] = wv_[i] * s; }
    asm volatile("s_waitcnt lgkmcnt(0)" ::: "memory");
    const int c = lane & 7;
#pragma unroll
    for (int j = 0; j < 4; ++j) { const int n = (lane >> 3) + 8 * j; const LAS float* s = scr + (8 * c) * 33 + n;
        u32x4 o; o.x = cvtpk(s[0 * 33], s[1 * 33]); o.y = cvtpk(s[2 * 33], s[3 * 33]); o.z = cvtpk(s[4 * 33], s[5 * 33]); o.w = cvtpk(s[6 * 33], s[7 * 33]);
        *(u32x4*)(WT + (size_t)(n0 + n) * K + k0 + 8 * c) = o; }
    asm volatile("s_waitcnt lgkmcnt(0)" ::: "memory");
}
__device__ __forceinline__ void attn_phase(LAS unsigned char* lds, const bf16_t* PROJ, const bf16_t* VT, const float* gq, const float* gk, const float* rb, bf16_t* MERGED, int vcu, int G, const int wave_u) {
    int tid_ = wave_u * 64 + lane_id_v(); asm volatile("" : "+v"(tid_));
    const int tid = tid_, lane = tid & 63, h = __builtin_amdgcn_readfirstlane(tid >> 6), ql = lane & 31, hi = lane >> 5;
    bf16x8 qf[2][4], kn[4], vn[4];
    const unsigned kgo = (unsigned)((lane >> 3) * PJW + (lane & 7) * 8), vgo = (unsigned)((lane >> 2) * T_ + (lane & 3) * 8);
#define LOADKV2(KB, VB, IT) do { const bf16_t* kp_ = (KB) + (long)(IT) * 32 * PJW; const bf16_t* vp_ = (VB) + (IT) * 32; \
        _Pragma("unroll") for (int i = 0; i < 4; ++i) { kn[i] = *(const bf16x8*)(kp_ + (kgo + (unsigned)(i * 8 * PJW))); vn[i] = *(const bf16x8*)(vp_ + (vgo + (unsigned)(i * 16 * T_))); } } while (0)
#define UNIT_PREFETCH(U) do { const int b_ = (U) >> 7, n_ = (U) & 127; const long tk_ = (long)b_ * SEQ_ + n_ * 64; const int i0_ = (n_ < 8) ? 2 * (8 - n_) : 0; \
        const bf16_t* qp_ = PROJ + (tk_ + ql) * PJW + 1024 + h * 64 + hi * 8; \
        _Pragma("unroll") for (int qb = 0; qb < 2; ++qb) _Pragma("unroll") for (int d0 = 0; d0 < 4; ++d0) qf[qb][d0] = *(const bf16x8*)(qp_ + (long)qb * 32 * PJW + d0 * 16); \
        LOADKV2(PROJ + (tk_ - 512) * PJW + 1536 + h * 64, VT + (long)(h * 64) * T_ + (tk_ - 512), i0_); } while (0)
    if (vcu < NUNIT_ATT) UNIT_PREFETCH(vcu);
    LAS float* SQ = (LAS float*)lds;
    LAS float* EXT = (LAS float*)(lds + 2048) + h * 640;
    float mq = wave_max(fabsf(gq[lane])), mk = wave_max(fabsf(gk[lane])); float mb = -1e30f;
    for (int i = lane; i < 513; i += 64) mb = fmaxf(mb, rb[h * 513 + i]);
    mb = wave_max(mb);
    const float c512 = rb[h * 513 + 512]; (void)mq; (void)mk; (void)mb;
    for (int i = lane; i < 640; i += 64) { int rel = i - 64; rel = rel > 256 ? 256 : (rel < -256 ? -256 : rel); EXT[639 - i] = (rb[h * 513 + rel + 256] - c512) * LOG2E; }
    asm volatile("s_waitcnt lgkmcnt(0)" ::: "memory");
    __syncthreads();
    for (int unit = vcu; unit < NUNIT_ATT; unit += G) {
        const int b = unit >> 7, n = unit & 127; const long tok0 = (long)b * SEQ_ + n * 64;
        f32x16 o[2][2];
#pragma unroll
        for (int a = 0; a < 2; ++a)
#pragma unroll
            for (int c = 0; c < 2; ++c)
#pragma unroll
                for (int r = 0; r < 16; ++r) o[a][c][r] = 0.f;
        float lsum[2] = {0.f, 0.f};
        const int it0 = (n < 8) ? 2 * (8 - n) : 0;
        const bf16_t* kbase = PROJ + (tok0 - 512) * PJW + 1536 + h * 64;
        const bf16_t* vbase = VT + (long)(h * 64) * T_ + (tok0 - 512);
        LAS unsigned char* kv = lds + 24576 + h * 8192;
        const unsigned wk = (unsigned)((lane >> 3) * 128 + (((lane & 7) ^ (lane >> 3)) * 16));
        const unsigned wvl = (unsigned)(4096 + (lane >> 2) * 64 + ((((unsigned)((lane & 3) >> 1) * 2u + 0u) ^ (unsigned)((lane >> 3) & 3)) * 16) + (lane & 1) * 8);
        const unsigned wvh = (unsigned)(4096 + (lane >> 2) * 64 + ((((unsigned)((lane & 3) >> 1) * 2u + 1u) ^ (unsigned)((lane >> 3) & 3)) * 16) + (lane & 1) * 8);
        const unsigned rkb = (unsigned)(ql * 128), rks = (unsigned)(ql & 7), rvb = (unsigned)(4096 + ql * 64), rvs = (unsigned)((ql >> 1) & 3);
#define LOADKV(IT) LOADKV2(kbase, vbase, IT)
        for (int it = it0; it < 18; ++it) {
#pragma unroll
            for (int i = 0; i < 4; ++i) { *(LAS bf16x8*)(kv + wk + i * 1024) = kn[i]; const u32x4 vv = __builtin_bit_cast(u32x4, vn[i]);
                *(LAS u32x2*)(kv + wvl + i * 1024) = (u32x2){vv.x, vv.y}; *(LAS u32x2*)(kv + wvh + i * 1024) = (u32x2){vv.z, vv.w}; }
            { const int itn = (it + 1 < 18) ? it + 1 : it; LOADKV(itn); }
            bf16x8 kf[4], vf[2][2];
#pragma unroll
            for (int d0 = 0; d0 < 4; ++d0) kf[d0] = *(const LAS bf16x8*)(kv + rkb + (((unsigned)(2 * d0 + hi) ^ rks) * 16));
#pragma unroll
            for (int db = 0; db < 2; ++db)
#pragma unroll
                for (int ks = 0; ks < 2; ++ks) vf[db][ks] = *(const LAS bf16x8*)(kv + rvb + db * 2048 + (((unsigned)(2 * ks + hi) ^ rvs) * 16));
            const bool tab = (it >= 8);
#pragma unroll
            for (int qb = 0; qb < 2; ++qb) {
                f32x16 s;
                if (tab) { const LAS float* e = EXT + (63 - 32 * qb - ql + 32 * it + 4 * hi); f32x16 cin;
#pragma unroll
                    for (int r = 0; r < 16; ++r) cin[r] = e[(r & 3) + 8 * (r >> 2)];
                    s = MFMA32(kf[0], qf[qb][0], cin); }
                else { f32x16 z_;
#pragma unroll
                    for (int r = 0; r < 16; ++r) z_[r] = 0.f;
                    s = MFMA32(kf[0], qf[qb][0], z_); }
#pragma unroll
                for (int d0 = 1; d0 < 4; ++d0) s = MFMA32(kf[d0], qf[qb][d0], s);
                float ps = 0.f;
#pragma unroll
                for (int r = 0; r < 16; ++r) { s[r] = ex2(s[r]); ps += s[r]; }
                lsum[qb] += ps;
                bf16x8 pk[2];
#pragma unroll
                for (int ks = 0; ks < 2; ++ks) { u32x4 w; w.x = cvtpk(s[8 * ks], s[8 * ks + 1]); w.y = cvtpk(s[8 * ks + 2], s[8 * ks + 3]); w.z = cvtpk(s[8 * ks + 4], s[8 * ks + 5]); w.w = cvtpk(s[8 * ks + 6], s[8 * ks + 7]);
                    pk[ks] = __builtin_bit_cast(bf16x8, w); }
#pragma unroll
                for (int db = 0; db < 2; ++db)
#pragma unroll
                    for (int ks = 0; ks < 2; ++ks) o[db][qb] = MFMA32(vf[db][ks], pk[ks], o[db][qb]);
            }
        }
#undef LOADKV
        if (unit + G < NUNIT_ATT) UNIT_PREFETCH(unit + G);
        float inv[2], sq[2];
#pragma unroll
        for (int qb = 0; qb < 2; ++qb) { float l = lsum[qb]; l += __shfl_xor(l, 32); inv[qb] = 1.f / l; float q2 = 0.f;
#pragma unroll
            for (int db = 0; db < 2; ++db)
#pragma unroll
                for (int r = 0; r < 16; ++r) { const float v = o[db][qb][r] * inv[qb]; o[db][qb][r] = v; q2 += v * v; }
            q2 += __shfl_xor(q2, 32); sq[qb] = q2;
            if (hi == 0) SQ[h * 64 + 32 * qb + ql] = q2; }
        asm volatile("s_waitcnt lgkmcnt(0)" ::: "memory");
        __syncthreads();
#pragma unroll
        for (int qb = 0; qb < 2; ++qb) { float tot = 0.f;
#pragma unroll
            for (int hh = 0; hh < 8; ++hh) tot += SQ[hh * 64 + 32 * qb + ql];
            const float rstd = rsqf_(tot * (1.f / 512.f) + EPS_);
            bf16_t* op = MERGED + (tok0 + 32 * qb + ql) * DM_ + 512 + h * 64 + 4 * hi;
#pragma unroll
            for (int db = 0; db < 2; ++db)
#pragma unroll
                for (int r4 = 0; r4 < 4; ++r4) { u32x2 w; w.x = cvtpk(o[db][qb][4 * r4] * rstd, o[db][qb][4 * r4 + 1] * rstd); w.y = cvtpk(o[db][qb][4 * r4 + 2] * rstd, o[db][qb][4 * r4 + 3] * rstd);
                    *(u32x2*)(op + 32 * db + 8 * r4) = w; } }
        __syncthreads();
    }
}

template <bool PASS2>
__device__ __forceinline__ void lru_unit(LAS unsigned char* lds, int unit, const bf16_t* PROJ, const bf16_t* WGT, const float* conv_w, const float* conv_b, const float* b_rg, const float* b_ig,
                                         const float* lam, f32x2* SUMM, bf16_t* MERGED, const int wave_u) {
    int tid_ = wave_u * 64 + lane_id_v(); asm volatile("" : "+v"(tid_));
    const int tid = tid_, lane = tid & 63, w = __builtin_amdgcn_readfirstlane(tid >> 6), ql = lane & 31, hi = lane >> 5;
    const int b = unit >> 5, seg = unit & 31; const long tok0 = (long)b * SEQ_ + seg * 256;
    LAS bf16_t* XC = (LAS bf16_t*)lds + w * (64 * 72);
    LAS bf16_t* YT = (LAS bf16_t*)(lds + 73728);
    const int chc = 64 * w + lane;
    const float cw0 = conv_w[chc], cw1 = conv_w[512 + chc], cw2 = conv_w[1024 + chc], cw3 = conv_w[1536 + chc], cbv = conv_b[chc];
    float brg[2], big[2], sp[2];
#pragma unroll
    for (int nb = 0; nb < 2; ++nb) { const int ch = 64 * w + 32 * nb + ql; brg[nb] = b_rg[ch]; big[nb] = b_ig[ch];
        sp[nb] = -8.f * LOG2E * log1pf(expf(-lam[ch])); }
    float carry[2] = {0.f, 0.f}, ptot[2] = {1.f, 1.f};
    if (PASS2) {
#pragma unroll
        for (int nb = 0; nb < 2; ++nb) { float c = 0.f; const f32x2* sp_ = SUMM + (size_t)(b * 32) * 512 + 64 * w + 32 * nb + ql;
            for (int s0 = 0; s0 < seg; s0 += 16) { f32x2 v[16];
#pragma unroll
                for (int j = 0; j < 16; ++j) v[j] = (s0 + j < seg) ? sp_[(size_t)(s0 + j) * 512] : (f32x2){1.f, 0.f};
#pragma unroll
                for (int j = 0; j < 16; ++j) c = v[j].x * c + v[j].y; }
            carry[nb] = c; }
    }
    float x1 = 0.f, x2 = 0.f, x3 = 0.f;
#pragma nounroll
    for (int st = 0; st < 4; ++st) {
        const long t0 = tok0 + 64 * st;
        {
            const bf16_t* xt = PROJ + t0 * PJW + 64 * w;
            const unsigned go = (unsigned)((lane >> 3) * PJW + (lane & 7) * 8);
            bf16x8 raw[8];
#pragma unroll
            for (int i = 0; i < 8; ++i) raw[i] = *(const bf16x8*)(xt + (go + (unsigned)(i * 8 * PJW)));
            if (st == 0) { x1 = 0.f; x2 = 0.f; x3 = 0.f;
                if (seg != 0) { const bf16_t* xp = PROJ + t0 * PJW + chc; x1 = bf2f(xp[-1 * PJW]); x2 = bf2f(xp[-2 * PJW]); x3 = bf2f(xp[-3 * PJW]); } }
#pragma unroll
            for (int i = 0; i < 8; ++i) *(LAS bf16x8*)(XC + (8 * i + (lane >> 3)) * 72 + (lane & 7) * 8) = raw[i];
#pragma unroll 16
            for (int t = 0; t < 64; ++t) { const float xv = bf2f(XC[t * 72 + lane]); const float xc = cbv + cw0 * x3 + cw1 * x2 + cw2 * x1 + cw3 * xv;
                XC[t * 72 + lane] = (bf16_t)(cvtpk(xc, 0.f) & 0xffffu); x3 = x2; x2 = x1; x1 = xv; }
        }
        asm volatile("s_waitcnt lgkmcnt(0)" ::: "memory");
#pragma unroll
        for (int nb = 0; nb < 2; ++nb) {
            bf16x8 wrf[4], wif[4];
            { int woff = ((w * 2 + nb) * 4 * 64 + lane) * 8; asm volatile("" : "+v"(woff));
#pragma unroll
              for (int ks = 0; ks < 4; ++ks) { wrf[ks] = *(const bf16x8*)(WGT + woff + ks * 512); wif[ks] = *(const bf16x8*)(WGT + 8 * 4096 + woff + ks * 512); } }
#pragma unroll
            for (int tb = 0; tb < 2; ++tb) {
                bf16x8 af[4];
#pragma unroll
                for (int ks = 0; ks < 4; ++ks) af[ks] = *(const LAS bf16x8*)(XC + (32 * tb + ql) * 72 + 16 * ks + 8 * hi);
                f32x16 dr, di;
#pragma unroll
                for (int r = 0; r < 16; ++r) { dr[r] = 0.f; di[r] = 0.f; }
#pragma unroll
                for (int ks = 0; ks < 4; ++ks) { dr = MFMA32(af[ks], wrf[ks], dr); di = MFMA32(af[ks], wif[ks], di); }
                float A[16], U[16];
#pragma unroll
                for (int r = 0; r < 16; ++r) { const int tok = 32 * tb + crow(r, hi); const float xcv = bf2f(XC[tok * 72 + 32 * nb + ql]);
                    const float rg = sigm(dr[r] + brg[nb]), ig = sigm(di[r] + big[nb]); const float a = ex2(rg * sp[nb]);
                    const float mult = __builtin_amdgcn_sqrtf(fmaxf(1.f - a * a, 0.f)); A[r] = a; U[r] = mult * ig * xcv; }
#pragma unroll
                for (int q4 = 0; q4 < 4; ++q4)
#pragma unroll
                    for (int e = 1; e < 4; ++e) { U[4 * q4 + e] = A[4 * q4 + e] * U[4 * q4 + e - 1] + U[4 * q4 + e]; A[4 * q4 + e] = A[4 * q4 + e - 1] * A[4 * q4 + e]; }
                float c = carry[nb], HIN[4];
#pragma unroll
                for (int q4 = 0; q4 < 4; ++q4) { const float e0 = A[4 * q4 + 3] * c + U[4 * q4 + 3]; const float p = __shfl_xor(e0, 32); const float hin = hi ? p : c; HIN[q4] = hin;
                    const float e1 = A[4 * q4 + 3] * hin + U[4 * q4 + 3]; const float q = __shfl_xor(e1, 32); c = hi ? e1 : q; }
                carry[nb] = c;
                if (!PASS2) { const float po = (A[3] * A[7]) * (A[11] * A[15]); ptot[nb] *= po * __shfl_xor(po, 32); }
                else {
                    const bf16_t* gb = PROJ + t0 * PJW + 512 + 64 * w + 32 * nb + (32 * tb) * PJW;
                    const unsigned goff = (unsigned)(4 * hi) * PJW + ql;
#pragma unroll
                    for (int r = 0; r < 16; ++r) { const int tok = 32 * tb + crow(r, hi); const float hval = U[r] + A[r] * HIN[r >> 2]; const float gl = bf2f(gb[goff + (unsigned)((r & 3) + 8 * (r >> 2)) * PJW]);
                        YT[tok * 520 + 64 * w + 32 * nb + ql] = (bf16_t)(cvtpk(hval * gl, 0.f) & 0xffffu); }
                }
            }
        }
        if (PASS2) {
            asm volatile("s_waitcnt lgkmcnt(0)" ::: "memory");
            __syncthreads();
#pragma unroll
            for (int i = 0; i < 8; ++i) { const int tok = 8 * w + i; const u32x4 v = *(const LAS u32x4*)(YT + tok * 520 + 8 * lane);
                const float f0 = bflo(v.x), f1 = bfhi(v.x), f2 = bflo(v.y), f3 = bfhi(v.y), f4 = bflo(v.z), f5 = bfhi(v.z), f6 = bflo(v.w), f7 = bfhi(v.w);
                float ss = (f0 * f0 + f1 * f1) + (f2 * f2 + f3 * f3) + (f4 * f4 + f5 * f5) + (f6 * f6 + f7 * f7); ss = wave_sum(ss);
                const float rs = rsqf_(ss * (1.f / 512.f) + EPS_);
                u32x4 o; o.x = cvtpk(f0 * rs, f1 * rs); o.y = cvtpk(f2 * rs, f3 * rs); o.z = cvtpk(f4 * rs, f5 * rs); o.w = cvtpk(f6 * rs, f7 * rs);
                *(u32x4*)(MERGED + (t0 + tok) * DM_ + 8 * lane) = o; }
            __syncthreads();
        }
        asm volatile("" ::: "memory");
    }
    if (!PASS2) { if (hi == 0) {
#pragma unroll
        for (int nb = 0; nb < 2; ++nb) SUMM[(size_t)unit * 512 + 64 * w + 32 * nb + ql] = (f32x2){ptot[nb], carry[nb]}; } }
}

#ifndef PROBE_MASK
#define PROBE_MASK 0
#endif
#ifndef RES_BF16
#define RES_BF16 1
#endif
struct Args { const float* in[23]; float* out; unsigned char* ws; };
__global__ void __launch_bounds__(NTHR, 2) fwd_megakernel(Args args) {
    extern __shared__ __attribute__((aligned(16))) unsigned char lds_raw[];
    cg::grid_group grid = cg::this_grid();
    LAS unsigned char* lds = (LAS unsigned char*)lds_raw;
    const int wave = __builtin_amdgcn_readfirstlane(threadIdx.x >> 6);
#define tid (wave * 64 + lane_id_v())
#define lane (lane_id_v())
    const int G = gridDim.x, bx = blockIdx.x, vcu = (G % 8 == 0) ? (bx % 8) * (G / 8) + bx / 8 : bx;
    unsigned char* ws = args.ws;
    volatile LAS unsigned* MISC = (volatile LAS unsigned*)(lds + MISC_OFF);
    if (threadIdx.x < 16) MISC[threadIdx.x] = 0u;
    __syncthreads();
    XcdBarrier bar; bar.bar = (unsigned*)(ws + WS_CTL); bar.x = xb_xcc_id(); bar.st = MISC;
    if (blockIdx.x == 0) for (int i = threadIdx.x; i < (int)(CTL_BYTES / 4); i += NTHR) bar.bar[i] = 0u;
    const float* x = args.in[0]; const float* p = args.in[1]; float* out = args.out;
    bf16_t* WT_IN = (bf16_t*)(ws + WS_WIN); bf16_t* WT_OUT = (bf16_t*)(ws + WS_WOUT); bf16_t* WT_UP = (bf16_t*)(ws + WS_WUP); bf16_t* WT_DN = (bf16_t*)(ws + WS_WDN);
    bf16_t* WT_PG = (bf16_t*)(ws + WS_WPG); bf16_t* WT_PP = (bf16_t*)(ws + WS_WPP); bf16_t* WGT = (bf16_t*)(ws + WS_WG);
    float* RINV0 = (float*)(ws + WS_RINV0);
    float* RSTD1 = (float*)(ws + WS_RSTD1); float* RSTD2 = (float*)(ws + WS_RSTD2); f32x2* SUMM = (f32x2*)(ws + WS_SUMM);
    bf16_t* XN = (bf16_t*)(ws + WS_XN); bf16_t* PP = (bf16_t*)(ws + WS_PP); bf16_t* PB = (bf16_t*)(ws + WS_PB);
    bf16_t* PROJ = (bf16_t*)(ws + WS_PROJ); bf16_t* VT = (bf16_t*)(ws + WS_VT); bf16_t* MERGED = (bf16_t*)(ws + WS_MERGED); bf16_t* ACT = (bf16_t*)(ws + WS_ACT);

    for (int rep_ = 0; rep_ < 1 + ((PROBE_MASK >> 0) & 1); ++rep_) {
        LAS float* scr = (LAS float*)(lds + wave * 16384);
        const int gw = vcu * NWAVES + wave, NGW = G * NWAVES;
        constexpr int I_IN = 16 * 80, I_OUT = 16 * 32, I_UP = 16 * 128, I_DN = 64 * 32, I_PG = 16 * 32, I_PP = 4 * 32;
        constexpr int NITEMS = I_IN + I_OUT + I_UP + I_DN + I_PG + I_PP;
        for (int it = gw; it < NITEMS; it += NGW) {
            int r = it;
            if (r < I_IN) { p0_transpose_item(args.in[3], 1024, 2560, WT_IN, nullptr, nullptr, 0, scr, r, lane); continue; } r -= I_IN;
            if (r < I_OUT) { p0_transpose_item(args.in[16], 1024, 1024, WT_OUT, args.in[14], args.in[15], 512, scr, r, lane); continue; } r -= I_OUT;
            if (r < I_UP) { p0_transpose_item(args.in[18], 1024, 4096, WT_UP, args.in[17], args.in[17], 1 << 30, scr, r, lane); continue; } r -= I_UP;
            if (r < I_DN) { p0_transpose_item(args.in[19], 4096, 1024, WT_DN, nullptr, nullptr, 0, scr, r, lane); continue; } r -= I_DN;
            if (r < I_PG) { p0_transpose_item(args.in[21], 1024, 1024, WT_PG, args.in[20], args.in[20], 1 << 30, scr, r, lane); continue; } r -= I_PG;
            p0_transpose_item(args.in[22], 256, 1024, WT_PP, nullptr, nullptr, 0, scr, r, lane);
        }
        for (int i = bx * NTHR + tid; i < T_; i += G * NTHR) { RSTD1[i] = 0.f; RSTD2[i] = 0.f; }
        for (int i = bx * NTHR + tid; i < 65536; i += G * NTHR) { const int e = i & 7, ln = (i >> 3) & 63, ks = (i >> 9) & 3, nb = (i >> 11) & 1, blk = (i >> 12) & 7, gate = i >> 15;
            const int k = 16 * ks + 8 * (ln >> 5) + e, n = 32 * nb + (ln & 31);
            const float v = (gate ? args.in[8] : args.in[6])[blk * 4096 + k * 64 + n]; WGT[i] = (bf16_t)(cvtpk(v, 0.f) & 0xffffu); }
        const float* g1 = args.in[2];
        f32x4 gv[4];
#pragma unroll
        for (int j = 0; j < 4; ++j) gv[j] = *((const f32x4*)g1 + lane + 64 * j);
        for (int m = gw; m < T_; m += NGW) {
            const f32x4* xr = (const f32x4*)(x + (size_t)m * DM_) + lane; f32x4 v[4]; float s = 0.f;
#pragma unroll
            for (int j = 0; j < 4; ++j) { v[j] = __builtin_nontemporal_load(xr + 64 * j); s += (v[j].x * v[j].x + v[j].y * v[j].y) + (v[j].z * v[j].z + v[j].w * v[j].w); }
            const float ms_ = wave_sum(s) * (1.f / DM_) + EPS_; const float rstd = rsqf_(ms_);
            if (lane == 0) RINV0[m] = ms_ * rstd;
            u32x2* o8 = (u32x2*)(XN + (size_t)m * DM_) + lane;
#pragma unroll
            for (int j = 0; j < 4; ++j) { const f32x4 y = v[j] * gv[j] * rstd; u32x2 w; w.x = cvtpk(y.x, y.y); w.y = cvtpk(y.z, y.w); o8[64 * j] = w; }
            const f32x4 pv = __builtin_nontemporal_load((const f32x4*)(p + (size_t)m * PLE_) + lane); u32x2 pw; pw.x = cvtpk(pv.x, pv.y); pw.y = cvtpk(pv.z, pv.w);
            *((u32x2*)(PB + (size_t)m * PLE_) + lane) = pw;
        }
    }
    grid.sync();
    if (threadIdx.x == 0) MISC[2] = xb_add(&bar.bar[XB_XCNT(bar.x)], 1u);
    int cid = bx, vcu2 = vcu;
#define CENSUS_IDS() do { \
    if (threadIdx.x == 0) { unsigned okc = 1u; \
        for (unsigned j = 0; j < 16; ++j) { const unsigned c_ = xb_ld(&bar.bar[XB_XCNT(j)]); okc &= (j < 8 ? (c_ == (unsigned)G / 8u) : (c_ == 0u)) ? 1u : 0u; } \
        MISC[3] = (okc && (G % 8 == 0)) ? 1u : 0u; } \
    __syncthreads(); \
    { const bool okmap = MISC[3] != 0u; \
      cid = __builtin_amdgcn_readfirstlane(okmap ? (int)(MISC[2] * 8u + bar.x) : bx); \
      vcu2 = __builtin_amdgcn_readfirstlane(okmap ? (int)(bar.x * (unsigned)(G / 8) + MISC[2]) : vcu); } } while (0)
#if 0
    if (threadIdx.x == 0) { unsigned okc = 1u;
        for (unsigned j = 0; j < 16; ++j) { const unsigned c_ = xb_ld(&bar.bar[XB_XCNT(j)]); okc &= (j < 8 ? (c_ == (unsigned)G / 8u) : (c_ == 0u)) ? 1u : 0u; }
        MISC[3] = (okc && (G % 8 == 0)) ? 1u : 0u; }
    __syncthreads();
    const bool okmap = MISC[3] != 0u;
    const int cid = __builtin_amdgcn_readfirstlane(okmap ? (int)(MISC[2] * 8u + bar.x) : bx);
    const int vcu2 = __builtin_amdgcn_readfirstlane(okmap ? (int)(bar.x * (unsigned)(G / 8) + MISC[2]) : vcu);
#endif
    for (int rep_ = 0; rep_ < 1 + ((PROBE_MASK >> 1) & 1); ++rep_) {
        { pg8::Gemm g{XN, WT_IN, T_, 2048, 1024}; pg8::StaticOrder S; S.init(T_, 2048, G, cid); EpiProj E{PROJ, args.in[11], args.in[12]};
          pg8::gemm_phase<EpiProj, pg8::StaticOrder, PG8_ALIGN, PG8_SP2>(lds, g, S, E, wave); }
        { pg8::Gemm g{WT_IN + (size_t)2048 * 1024, XN, 512, T_, 1024}; pg8::StaticOrder S; S.init(512, T_, G, cid); EpiPlain E{VT, T_};
          pg8::gemm_phase<EpiPlain, pg8::StaticOrder, PG8_ALIGN, PG8_SP2>(lds, g, S, E, wave); }
    }
    xcd_barrier(bar);
    CENSUS_IDS();
    for (int rep_ = 0; rep_ < 1 + ((PROBE_MASK >> 2) & 1); ++rep_)
    attn_phase(lds, PROJ, VT, args.in[11]  , args.in[12], args.in[13], MERGED, vcu2, G, wave);
    for (int rep_ = 0; rep_ < 1 + ((PROBE_MASK >> 3) & 1); ++rep_)
    for (int unit = vcu2; unit < NUNIT_LRU; unit += G)
        lru_unit<false>(lds, unit, PROJ, WGT, args.in[4], args.in[5], args.in[7], args.in[9], args.in[10], SUMM, MERGED, wave);
    xcd_barrier(bar);
    for (int rep_ = 0; rep_ < 1 + ((PROBE_MASK >> 4) & 1); ++rep_)
    for (int unit = vcu2; unit < NUNIT_LRU; unit += G)
        lru_unit<true>(lds, unit, PROJ, WGT, args.in[4], args.in[5], args.in[7], args.in[9], args.in[10], SUMM, MERGED, wave);
    xcd_barrier(bar);
#if RES_BF16
    { pg8::Gemm g{MERGED, WT_OUT, T_, 1024, 1024}; pg8::StaticOrder S; S.init(T_, 1024, G, cid); EpiRes4b E{XN, RINV0, args.in[2], RSTD1};
      pg8::gemm_phase<EpiRes4b, pg8::StaticOrder, PG8_ALIGN, PG8_SP2>(lds, g, S, E, wave); }
#else
    for (int rep_ = ((PROBE_MASK >> 5) & 1) ? 0 : 1; rep_ < 2; ++rep_)
    { pg8::Gemm g{MERGED, WT_OUT, T_, 1024, 1024}; pg8::StaticOrder S; S.init(T_, 1024, G, cid); EpiRes E{x, out, XN, rep_ ? RSTD1 : (float*)(ws + WS_DUMMY), 0xFFFF};
      pg8::gemm_phase<EpiRes, pg8::StaticOrder, PG8_ALIGN, PG8_SP2>(lds, g, S, E, wave); }
#endif
    xcd_barrier(bar);
    for (int rep_ = 0; rep_ < 1 + ((PROBE_MASK >> 6) & 1); ++rep_) { pg8::Gemm g{XN, WT_UP, T_, 4096, 1024}; pg8::StaticOrder S; S.init(T_, 4096, G, cid); EpiUp E{ACT, RSTD1};
      pg8::gemm_phase<EpiUp, pg8::StaticOrder, PG8_ALIGN, PG8_SP2, (PROBE_MASK >> 9) & 1>(lds, g, S, E, wave); }
    xcd_barrier(bar);
#if RES_BF16
    { pg8::Gemm g{ACT, WT_DN, T_, 1024, 4096}; pg8::StaticOrder S; S.init(T_, 1024, G, cid); EpiRes6 E{XN, RSTD2};
      pg8::gemm_phase<EpiRes6, pg8::StaticOrder, PG8_ALIGN, PG8_SP2>(lds, g, S, E, wave); }
#else
    for (int rep_ = ((PROBE_MASK >> 7) & 1) ? 0 : 1; rep_ < 2; ++rep_)
    { pg8::Gemm g{ACT, WT_DN, T_, 1024, 4096}; pg8::StaticOrder S; S.init(T_, 1024, G, cid);
      EpiRes E{out, rep_ ? out : (float*)(ws + WS_END), XN, rep_ ? RSTD2 : (float*)(ws + WS_DUMMY), rep_ ? 0xFFFF : 0x7FFF};
      pg8::gemm_phase<EpiRes, pg8::StaticOrder, PG8_ALIGN, PG8_SP2>(lds, g, S, E, wave); }
#endif
    xcd_barrier(bar);
#if RES_BF16
    { pg8::StaticOrder S; S.init(T_, 1024, G, cid); EpiMidPP EM{(u32x4*)(ws + WS_PP) + (size_t)bx * 8192}; EpiFinalC EF{XN, out, RSTD2, (const u32x4*)(ws + WS_PP) + (size_t)bx * 8192};
      pg8::gemm_phase_ple<EpiMidPP, EpiFinalC, pg8::StaticOrder>(lds, PB, WT_PP, XN, WT_PG, S, EM, EF, wave); }
#else
    for (int rep_ = ((PROBE_MASK >> 8) & 1) ? 0 : 1; rep_ < 2; ++rep_)
    { pg8::Gemm g{XN, WT_PG, T_, 1024, 1024}; pg8::StaticOrder S; S.init(T_, 1024, G, cid); EpiFinal E{out, rep_ ? out : (float*)ACT, PP, RSTD2};
      pg8::gemm_phase<EpiFinal, pg8::StaticOrder, PG8_ALIGN, PG8_SP2>(lds, g, S, E, wave); }
#endif
}

#undef tid
#undef lane
extern "C" void kernel_launch(void* const* d_in, const int* in_sizes, int n_in, void* d_out, int out_size, void* d_ws, size_t ws_size, hipStream_t stream) {
    static int grid = 0;
    if (grid == 0) {
        if (n_in != 23 || in_sizes[0] != T_ * DM_ || out_size != T_ * DM_ || ws_size < WS_END) { fprintf(stderr, "kernel_launch: unexpected shapes (n_in %d, in0 %d, out %d, ws %zu)\n", n_in, n_in > 0 ? in_sizes[0] : -1, out_size, ws_size); grid = -1; return; }
        int dev = 0, cus = 0, per_cu = 0;
        (void)hipGetDevice(&dev); (void)hipDeviceGetAttribute(&cus, hipDeviceAttributeMultiprocessorCount, dev);
        (void)hipFuncSetAttribute((const void*)fwd_megakernel, hipFuncAttributeMaxDynamicSharedMemorySize, LDS_BYTES);
        if (hipOccupancyMaxActiveBlocksPerMultiprocessor(&per_cu, (const void*)fwd_megakernel, NTHR, LDS_BYTES) != hipSuccess || per_cu < 1) per_cu = 1;
        (void)hipGetLastError();
        grid = cus * per_cu;
        if (grid > 256) grid = 256;
        fprintf(stderr, "kernel_launch: cus %d per_cu %d grid %d\n", cus, per_cu, grid);
    }
    if (grid < 0) return;
    Args a{};
    for (int i = 0; i < 23; ++i) a.in[i] = (const float*)d_in[i];
    a.out = (float*)d_out; a.ws = (unsigned char*)d_ws;
    void* kargs[] = {&a};
    hipError_t e = hipLaunchCooperativeKernel((const void*)fwd_megakernel, dim3(grid), dim3(NTHR), kargs, LDS_BYTES, stream);
    if (e != hipSuccess) fprintf(stderr, "kernel_launch: cooperative launch failed: %s (grid %d)\n", hipGetErrorString(e), grid);
}
```
